# Optimizing an MI355X kernel written in HIP

```python
import jax, jax.numpy as jnp
from jax import lax
import numpy as np

D_MODEL = 1024
BATCH = 2
SEQ = 16384
DEPTH = 4

N_MIXERS = 2
N_CONV_LAYERS = (DEPTH + N_MIXERS - 1) // N_MIXERS
N_MLA_LAYERS = DEPTH // N_MIXERS
CONV_WIDTH = 3
N_HEADS = 8
Q_LORA_RANK = 384
KV_LORA_RANK = 256
QK_NOPE_DIM = 128
QK_ROPE_DIM = 64
QK_HEAD_DIM = QK_NOPE_DIM + QK_ROPE_DIM
V_HEAD_DIM = 128
LATENT_DIM = Q_LORA_RANK + KV_LORA_RANK + QK_ROPE_DIM
ROPE_THETA = 10000.0
Q_BLOCK = 128
N_GROUPS = 8
EXPERTS_PER_GROUP = 8
N_EXPERTS = N_GROUPS * EXPERTS_PER_GROUP
TOP_K = 2
D_FF_EXPERT = 384
MOE_BLOCK = 128
RMS_EPS = 1e-6
MAX_POS_OFFSET = 1024

kernel_name = 'hybrid_conv_mla_hier_moe_encoder'


def rms_norm(x, w):
    xf = x.astype(jnp.float32)
    y = xf * lax.rsqrt(jnp.mean(xf * xf, axis=-1, keepdims=True) + RMS_EPS)
    return (y * w.astype(jnp.float32)).astype(x.dtype)


def rope(x, cos, sin):
    half = x.shape[-1] // 2
    x1, x2 = x[..., :half], x[..., half:]
    return jnp.concatenate([x1 * cos - x2 * sin, x2 * cos + x1 * sin], axis=-1)


def short_conv_mixer(h, w_in, conv_k, w_out):
    bcu = h @ w_in
    gb, gc, u = jnp.split(bcu, 3, axis=-1)
    z = gc * u
    zp = jnp.pad(z, ((0, 0), (1, 1), (0, 0)))
    conv = zp[:, :-2] * conv_k[0] + zp[:, 1:-1] * conv_k[1] + zp[:, 2:] * conv_k[2]
    return (gb * conv) @ w_out


def mla_mixer(h, cos, sin, w_down, q_lat_norm, kv_lat_norm, w_q_up, w_kv_up,
              q_head_norm, k_head_norm, w_out):
    b, s, _ = h.shape
    lat = h @ w_down
    q_lat = rms_norm(lat[..., :Q_LORA_RANK], q_lat_norm)
    kv_lat = rms_norm(lat[..., Q_LORA_RANK:Q_LORA_RANK + KV_LORA_RANK], kv_lat_norm)
    k_rope = lat[..., Q_LORA_RANK + KV_LORA_RANK:]
    q = (q_lat @ w_q_up).reshape(b, s, N_HEADS, QK_HEAD_DIM)
    kv = (kv_lat @ w_kv_up).reshape(b, s, N_HEADS, QK_NOPE_DIM + V_HEAD_DIM)
    k_nope, v = kv[..., :QK_NOPE_DIM], kv[..., QK_NOPE_DIM:]
    k = jnp.concatenate(
        [k_nope, jnp.broadcast_to(k_rope[:, :, None, :], (b, s, N_HEADS, QK_ROPE_DIM))], axis=-1)
    q = rms_norm(q, q_head_norm)
    k = rms_norm(k, k_head_norm)
    q = jnp.concatenate([q[..., :QK_NOPE_DIM], rope(q[..., QK_NOPE_DIM:], cos, sin)], axis=-1)
    k = jnp.concatenate([k[..., :QK_NOPE_DIM], rope(k[..., QK_NOPE_DIM:], cos, sin)], axis=-1)
    scale = QK_HEAD_DIM ** -0.5
    n_qb = s // Q_BLOCK
    q_blocks = q.reshape(b, n_qb, Q_BLOCK, N_HEADS, QK_HEAD_DIM).transpose(1, 0, 2, 3, 4)

    def attend(qb):
        scores = jnp.einsum('bqhd,bkhd->bhqk', qb, k).astype(jnp.float32) * scale
        probs = jax.nn.softmax(scores, axis=-1).astype(v.dtype)
        return jnp.einsum('bhqk,bkhd->bqhd', probs, v)

    o = lax.map(attend, q_blocks)
    o = o.transpose(1, 0, 2, 3, 4).reshape(b, s, N_HEADS * V_HEAD_DIM)
    return o @ w_out


def hier_moe(h, w_group, b_group, w_expert, b_expert, w_gate, w_up, w_down):
    b, s, d = h.shape
    t = h.reshape(b * s, d)
    n_tok = b * s
    tok_ids = jnp.arange(n_tok)
    g_logits = (t @ w_group).astype(jnp.float32)
    g_prob = jax.nn.softmax(g_logits, axis=-1)
    g_sel = jnp.argmax(g_logits + b_group.astype(jnp.float32), axis=-1)
    g_gate = g_prob[tok_ids, g_sel]
    e_logits = (t @ w_expert).astype(jnp.float32).reshape(n_tok, N_GROUPS, EXPERTS_PER_GROUP)
    e_logits = e_logits[tok_ids, g_sel]
    e_bias = b_expert.astype(jnp.float32).reshape(N_GROUPS, EXPERTS_PER_GROUP)[g_sel]
    _, e_top = lax.top_k(e_logits + e_bias, TOP_K)
    e_prob = jnp.take_along_axis(jax.nn.softmax(e_logits, axis=-1), e_top, axis=-1)
    e_prob = e_prob / jnp.sum(e_prob, axis=-1, keepdims=True)
    gate = g_gate[:, None] * e_prob
    expert_id = g_sel[:, None] * EXPERTS_PER_GROUP + e_top
    n_assign = n_tok * TOP_K
    flat_e = expert_id.reshape(n_assign).astype(jnp.int32)
    flat_tok = jnp.repeat(tok_ids.astype(jnp.int32), TOP_K)
    flat_gate = gate.reshape(n_assign)
    order = jnp.argsort(flat_e)
    se, stok, sgate = flat_e[order], flat_tok[order], flat_gate[order]
    counts = jnp.bincount(flat_e, length=N_EXPERTS)
    starts = jnp.cumsum(counts) - counts
    padded = (counts + MOE_BLOCK - 1) // MOE_BLOCK * MOE_BLOCK
    pends = jnp.cumsum(padded)
    pstarts = pends - padded
    dest = pstarts[se] + (jnp.arange(n_assign) - starts[se])
    n_blocks = -(-n_assign // MOE_BLOCK) + N_EXPERTS
    n_rows = n_blocks * MOE_BLOCK
    buf_tok = jnp.zeros((n_rows,), jnp.int32).at[dest].set(stok)
    buf_gate = jnp.zeros((n_rows,), jnp.float32).at[dest].set(sgate)
    block_expert = jnp.minimum(
        jnp.searchsorted(pends, jnp.arange(n_blocks) * MOE_BLOCK, side='right'), N_EXPERTS - 1)
    xb = t[buf_tok].reshape(n_blocks, MOE_BLOCK, d)

    def run_block(args):
        xblk, e = args
        hid = jax.nn.silu(xblk @ w_gate[e]) * (xblk @ w_up[e])
        return hid @ w_down[e]

    yb = lax.map(run_block, (xb, block_expert)).reshape(n_rows, d)
    out = jnp.zeros((n_tok, d), h.dtype).at[buf_tok].add(yb * buf_gate[:, None].astype(yb.dtype))
    return out.reshape(b, s, d)


def setup_inputs(seed: int = 0) -> dict:
    key = jax.random.key(seed)
    ks = iter(jax.random.split(key, 32))
    f32 = jnp.float32

    def w(shape, fan_in):
        return jax.random.normal(next(ks), shape, f32) * (fan_in ** -0.5)

    def gain(shape):
        return 1.0 + 0.02 * jax.random.normal(next(ks), shape, f32)

    x = jax.random.normal(next(ks), (BATCH, SEQ, D_MODEL), f32)
    offsets = jax.random.randint(next(ks), (BATCH, 1), 0, MAX_POS_OFFSET, dtype=jnp.int32)
    positions = offsets + jnp.arange(SEQ, dtype=jnp.int32)[None, :]
    nc, nm, L = N_CONV_LAYERS, N_MLA_LAYERS, DEPTH
    return {
        'x': x,
        'positions': positions,
        'conv_norm_w': gain((nc, D_MODEL)),
        'conv_w_in': w((nc, D_MODEL, 3 * D_MODEL), D_MODEL),
        'conv_k': w((nc, CONV_WIDTH, D_MODEL), CONV_WIDTH),
        'conv_w_out': w((nc, D_MODEL, D_MODEL), D_MODEL),
        'mla_norm_w': gain((nm, D_MODEL)),
        'mla_w_down': w((nm, D_MODEL, LATENT_DIM), D_MODEL),
        'mla_q_lat_norm': gain((nm, Q_LORA_RANK)),
        'mla_kv_lat_norm': gain((nm, KV_LORA_RANK)),
        'mla_w_q_up': w((nm, Q_LORA_RANK, N_HEADS * QK_HEAD_DIM), Q_LORA_RANK),
        'mla_w_kv_up': w((nm, KV_LORA_RANK, N_HEADS * (QK_NOPE_DIM + V_HEAD_DIM)), KV_LORA_RANK),
        'mla_q_head_norm': gain((nm, QK_HEAD_DIM)),
        'mla_k_head_norm': gain((nm, QK_HEAD_DIM)),
        'mla_w_out': w((nm, N_HEADS * V_HEAD_DIM, D_MODEL), N_HEADS * V_HEAD_DIM),
        'ffn_norm_w': gain((L, D_MODEL)),
        'router_w_group': w((L, D_MODEL, N_GROUPS), D_MODEL),
        'router_b_group': 0.01 * jax.random.normal(next(ks), (L, N_GROUPS), f32),
        'router_w_expert': w((L, D_MODEL, N_EXPERTS), D_MODEL),
        'router_b_expert': 0.01 * jax.random.normal(next(ks), (L, N_EXPERTS), f32),
        'exp_w_gate': w((L, N_EXPERTS, D_MODEL, D_FF_EXPERT), D_MODEL),
        'exp_w_up': w((L, N_EXPERTS, D_MODEL, D_FF_EXPERT), D_MODEL),
        'exp_w_down': w((L, N_EXPERTS, D_FF_EXPERT, D_MODEL), D_FF_EXPERT),
    }


def reference(x, positions, conv_norm_w, conv_w_in, conv_k, conv_w_out,
              mla_norm_w, mla_w_down, mla_q_lat_norm, mla_kv_lat_norm, mla_w_q_up,
              mla_w_kv_up, mla_q_head_norm, mla_k_head_norm, mla_w_out,
              ffn_norm_w, router_w_group, router_b_group, router_w_expert, router_b_expert,
              exp_w_gate, exp_w_up, exp_w_down):
    inv_freq = ROPE_THETA ** (-jnp.arange(0, QK_ROPE_DIM, 2, dtype=jnp.float32) / QK_ROPE_DIM)
    ang = positions.astype(jnp.float32)[..., None] * inv_freq
    cos = jnp.cos(ang)[:, :, None, :].astype(x.dtype)
    sin = jnp.sin(ang)[:, :, None, :].astype(x.dtype)
    for i in range(DEPTH):
        j = i // N_MIXERS
        if i % N_MIXERS == 0:
            h = rms_norm(x, conv_norm_w[j])
            x = x + short_conv_mixer(h, conv_w_in[j], conv_k[j], conv_w_out[j])
        else:
            h = rms_norm(x, mla_norm_w[j])
            x = x + mla_mixer(h, cos, sin, mla_w_down[j], mla_q_lat_norm[j], mla_kv_lat_norm[j],
                              mla_w_q_up[j], mla_w_kv_up[j], mla_q_head_norm[j],
                              mla_k_head_norm[j], mla_w_out[j])
        h = rms_norm(x, ffn_norm_w[i])
        x = x + hier_moe(h, router_w_group[i], router_b_group[i], router_w_expert[i],
                         router_b_expert[i], exp_w_gate[i], exp_w_up[i], exp_w_down[i])
    return x
```

```cpp
#include <hip/hip_runtime.h>
#include <cstdio>
#include <cstdint>

#ifndef MK_ONE_LAUNCH
#define MK_ONE_LAUNCH 1
#endif
#ifndef REP_ATT
#define REP_ATT 1
#endif
#ifndef REP_PRO
#define REP_PRO 2
#endif
#ifndef MK_ENABLE_MLA
#define MK_ENABLE_MLA 1
#endif
#ifndef MK_ENABLE_MOE
#define MK_ENABLE_MOE 1
#endif

#define GAS __attribute__((address_space(1)))
#define LAS __attribute__((address_space(3)))
typedef unsigned short bf16_t;
typedef short bf16x8 __attribute__((ext_vector_type(8)));
typedef short s16x4 __attribute__((ext_vector_type(4)));
typedef float f32x2 __attribute__((ext_vector_type(2)));
typedef float f32x4 __attribute__((ext_vector_type(4)));
typedef float f32x16 __attribute__((ext_vector_type(16)));
typedef unsigned u32x2 __attribute__((ext_vector_type(2)));
typedef unsigned u32x4 __attribute__((ext_vector_type(4)));
typedef GAS unsigned gu32;

constexpr int DM = 1024, NB = 2, SEQ = 16384, T = NB * SEQ;
constexpr int NH = 8, QLR = 384, KVLR = 256, DNOPE = 128, DROPE = 64, DQK = 192, DV = 128, LAT = 704, LATP = 768;
constexpr int NE = 64, DFF = 384;
constexpr int NASSIGN = 2 * T;
constexpr int NSLOT = NASSIGN + NE * 256;
constexpr int MAXTILES = NSLOT / 256;
constexpr float EPS = 1e-6f;
constexpr int NWAVES = 8;

constexpr size_t MiB = 1u << 20;
constexpr size_t WS_CTL = 0, CTL_ZERO_BYTES = 1 * MiB;
constexpr size_t WS_WIN = 2 * MiB;
constexpr size_t WS_WOUTC = 14 * MiB;
constexpr size_t WS_WDOWN = 18 * MiB;
constexpr size_t WS_WQ = 21 * MiB;
constexpr size_t WS_WKV = 24 * MiB;
constexpr size_t WS_WO = 26 * MiB;
constexpr size_t WS_WRT = 30 * MiB;
constexpr size_t WS_WE1 = 32 * MiB;
constexpr size_t WS_WE2 = 416 * MiB;
constexpr size_t WS_H = 608 * MiB;
constexpr size_t WS_S = 672 * MiB;
constexpr size_t WS_GB = WS_S, WS_Z = WS_S + 64 * MiB, WS_YC = WS_S + 128 * MiB;
constexpr size_t WS_LAT = WS_S, WS_QRAW = WS_S + 48 * MiB, WS_KVRAW = WS_S + 144 * MiB;
constexpr size_t WS_Q = WS_S + 272 * MiB, WS_K = WS_S + 368 * MiB, WS_V = WS_S + 464 * MiB, WS_O = WS_QRAW;
constexpr size_t WS_XS = WS_S, WS_HID = WS_S + 160 * MiB, WS_Y = WS_S + 224 * MiB, WS_LG = WS_S + 352 * MiB;
constexpr size_t WS_RT = WS_S + 368 * MiB;
constexpr size_t WS_END = WS_S + 528 * MiB;
constexpr size_t RT_EID = 0, RT_RANK = 256 * 1024, RT_GATE = 512 * 1024, RT_SDEST = 768 * 1024, RT_SGATE = 768 * 1024 + 327680;
static_assert(RT_SGATE + 327680 <= 2 * MiB, "routing arrays");
constexpr int CW_TMO = 0, CW_CODE = 1, CW_BAR = 4096, CW_CNT = 8192  , CW_CHK = 12288;

constexpr int RING_BYTES = 131072;
constexpr int LDSCTL_OFF = RING_BYTES, MISC_OFF = LDSCTL_OFF + 320;
constexpr int TBL_OFF = LDSCTL_OFF + 1024;
constexpr int LDS_BYTES = 147456;

#define RLX_AGENT __ATOMIC_RELAXED, __HIP_MEMORY_SCOPE_AGENT
#define LDS_WAIT() asm volatile("s_waitcnt lgkmcnt(0)" ::: "memory")
#define VM_WAIT() asm volatile("s_waitcnt vmcnt(0)" ::: "memory")
__device__ __forceinline__ unsigned f2bf(float f) { unsigned u = __builtin_bit_cast(unsigned, f); return (u + 0x7fffu + ((u >> 16) & 1u)) >> 16; }
__device__ __forceinline__ unsigned pk2(float lo, float hi) { return f2bf(lo) | (f2bf(hi) << 16); }
__device__ __forceinline__ float bflo(unsigned w) { return __builtin_bit_cast(float, w << 16); }
__device__ __forceinline__ float bfhi(unsigned w) { return __builtin_bit_cast(float, w & 0xffff0000u); }
__device__ __forceinline__ float bf2f(bf16_t h) { return __builtin_bit_cast(float, (unsigned)h << 16); }
__device__ __forceinline__ unsigned cvt_pk_bf16(float lo, float hi) { unsigned r; asm volatile("v_cvt_pk_bf16_f32 %0, %1, %2" : "=v"(r) : "v"(lo), "v"(hi)); return r; }
__device__ __forceinline__ int tid_now(int wave_s) { int l; asm volatile("v_mbcnt_lo_u32_b32 %0, -1, 0\n\tv_mbcnt_hi_u32_b32 %0, -1, %0" : "=v"(l)); return wave_s * 64 + l; }
__device__ __forceinline__ int sgpr_now(int v) { asm volatile("" : "+s"(v)); return v; }
__device__ __forceinline__ float lane_xor_f(float v, int m, int lane) { return __builtin_bit_cast(float, __builtin_amdgcn_ds_bpermute((lane ^ m) << 2, __builtin_bit_cast(int, v))); }
__device__ __forceinline__ float wave_sum(float v, int lane) {
#pragma unroll
    for (int o = 1; o < 64; o <<= 1) v += lane_xor_f(v, o, lane);
    return v;
}

#define XB_TMO      128
#define XB_XCNT(j)  (256  + 64 * (j))
#define XB_XSUB(j)  (1280 + 64 * (j))
#define XB_XGEN(j)  (2304 + 64 * (j))
#define XB_TOP      3328
#define XB_TOPGEN   3392
#define XCD_BAR_WORDS 3456
#define XB_SPIN_CAP (1u << 18)
__device__ __forceinline__ unsigned xb_ld(unsigned* p)              { return __hip_atomic_load(p, __ATOMIC_RELAXED, __HIP_MEMORY_SCOPE_AGENT); }
__device__ __forceinline__ unsigned xb_add(unsigned* p, unsigned v) { return __hip_atomic_fetch_add(p, v, __ATOMIC_RELAXED, __HIP_MEMORY_SCOPE_AGENT); }
__device__ __forceinline__ unsigned xb_xcc_id() { return (unsigned)__builtin_amdgcn_s_getreg((3 << 11) | 20) & 0xFu; }
#define XB_SPIN(cond, bar) do { unsigned _sp = 0; while (cond) { __builtin_amdgcn_s_sleep(1); \
    if ((++_sp & 255u) == 0u) { if (xb_ld(&(bar)[XB_TMO])) break; if (_sp > XB_SPIN_CAP) { atomicAdd(&(bar)[XB_TMO], 1u); break; } } } } while (0)
struct XcdBarrier { unsigned* bar; unsigned x; volatile LAS unsigned* st; };
__device__ __forceinline__ XcdBarrier xcd_barrier_post(unsigned* bar, volatile LAS unsigned* st, bool leader) {
    XcdBarrier b; b.bar = bar; b.x = xb_xcc_id(); b.st = st;
    if (leader) (void)xb_add(&bar[XB_XCNT(b.x)], 1u);
    return b;
}
__device__ __forceinline__ void xcd_barrier_complete(unsigned* bar, unsigned x, unsigned& nloc, unsigned& nx) {
    const unsigned G = gridDim.x * gridDim.y * gridDim.z;
    unsigned sum, cnt, mine, sp = 0u;
    for (;;) {
        sum = 0u; cnt = 0u; mine = 0u;
#pragma unroll
        for (unsigned j = 0; j < 16; ++j) { const unsigned c = xb_ld(&bar[XB_XCNT(j)]); sum += c; cnt += (c > 0u) ? 1u : 0u; mine = (j == x) ? c : mine; }
        if (sum == G) break;
        __builtin_amdgcn_s_sleep(1);
        if ((++sp & 255u) == 0u) { if (xb_ld(&bar[XB_TMO])) break; if (sp > XB_SPIN_CAP) { atomicAdd(&bar[XB_TMO], 1u); break; } }
    }
    nloc = mine > 0u ? mine : 1u; nx = cnt > 0u ? cnt : 1u;
}
__device__ __forceinline__ void xcd_barrier(const XcdBarrier& b, bool leader) {
    asm volatile("s_waitcnt vmcnt(0)" ::: "memory");
    __syncthreads();
    if (leader) {
        unsigned* bar = b.bar;
        __builtin_amdgcn_s_waitcnt(0);
        unsigned nloc = b.st[0], nx = b.st[1];
        if (nloc == 0u) { xcd_barrier_complete(bar, b.x, nloc, nx); b.st[0] = nloc; b.st[1] = nx; }
        const unsigned old = xb_add(&bar[XB_XSUB(b.x)], 1u);
        const unsigned gen = old / nloc;
        if (old + 1u == (gen + 1u) * nloc) {
            __builtin_amdgcn_fence(__ATOMIC_RELEASE, "agent");
            asm volatile("s_waitcnt vmcnt(0)" ::: "memory");
            const unsigned og = xb_add(&bar[XB_TOP], 1u);
            const unsigned tg = og / nx;
            if (og + 1u == (tg + 1u) * nx) xb_add(&bar[XB_TOPGEN], 1u);
            else XB_SPIN(xb_ld(&bar[XB_TOPGEN]) == tg, bar);
            __builtin_amdgcn_fence(__ATOMIC_ACQUIRE, "agent");
            xb_add(&bar[XB_XGEN(b.x)], 1u);
            asm volatile("s_waitcnt vmcnt(0)" ::: "memory");
        } else {
            XB_SPIN(xb_ld(&bar[XB_XGEN(b.x)]) == gen, bar);
            __builtin_amdgcn_fence(__ATOMIC_ACQUIRE, "agent");
            asm volatile("s_waitcnt vmcnt(0)" ::: "memory");
        }
    }
    __syncthreads();
}

namespace pg8 {
constexpr int BM = 256, BK = 64, HALF = 128, HTB = HALF * BK * 2, NXCD = 8, WGM = 8;
__host__ __device__ __forceinline__ int lds_byte(int r, int c) { const int st = (r >> 4) * 2 + (c >> 5), rr = r & 15, cc = c & 31, ob = rr * 64 + cc * 2; return st * 1024 + (ob ^ (((ob >> 9) & 1) << 5)); }
__host__ __device__ __forceinline__ void stage_rc(int b, int& R, int& C) { const int st = b / 1024, sb = b % 1024, swz = sb ^ (((sb >> 9) & 1) << 5); R = (st >> 1) * 16 + swz / 64; C = (st & 1) * 32 + (swz % 64) / 2; }
__host__ __device__ __forceinline__ int perm32(int rho) { const int n = rho >> 4, i = rho & 15; return 8 * (i >> 2) + 4 * n + (i & 3); }

struct Unit { const char* A; const char* B; int pm, pn; };
struct Gemm { int lda, K; };

struct StaticOrder {
    int nM, nN, nwg, G, c; const char* A; const char* B; size_t astep, bstep;
    __device__ void init(const void* A_, int lda, const void* B_, int K, int M, int N, int G_, int c_) { nM = M / BM; nN = N / BM; nwg = nM * nN; G = G_; c = c_; A = (const char*)A_; B = (const char*)B_; astep = (size_t)BM * lda * 2; bstep = (size_t)BM * K * 2; }
    __device__ __forceinline__ bool next(int i, Unit& u) const {
        const long L = (long)i * G + c; if (L >= nwg) return false;
        int wgid = (int)L; { const int q = nwg / NXCD, r = nwg % NXCD, xcd = wgid % NXCD, off = wgid / NXCD; wgid = (xcd < r ? xcd * (q + 1) : r * (q + 1) + (xcd - r) * q) + off; }
        const int nig = WGM * nN, gid = wgid / nig, fm = gid * WGM, gsz = (nM - fm) < WGM ? (nM - fm) : WGM;
        u.pm = fm + ((wgid % nig) % gsz); u.pn = (wgid % nig) / gsz; u.A = A + (size_t)u.pm * astep; u.B = B + (size_t)u.pn * bstep; return true;
    }
};
struct GroupedOrder {
    int n_units, nN, G, c; const char* A; const char* B; size_t astep, bexp, bstep; const LAS int* tbl;
    __device__ __forceinline__ bool next(int i, Unit& u) const {
        const int L = i * G + c; if (L >= n_units) return false;
        const int tile = L / nN, pn = L - tile * nN; const int e = __builtin_amdgcn_readfirstlane(tbl[tile]);
        u.pm = tile; u.pn = pn; u.A = A + (size_t)tile * astep; u.B = B + (size_t)e * bexp + (size_t)pn * bstep; return true;
    }
};

typedef f32x4 Acc[2][2][4][2];

struct EpiBf16 {
    static constexpr bool PERM = true;
    bf16_t* O; int ldc;
    __device__ __forceinline__ void operator()(const Acc& acc, const Unit& u, int wr, int wc, int fr, int fq) const {
        const int row0 = u.pm * BM + wr * 64 + fr, col0 = u.pn * BM + wc * 32 + 8 * fq;
#pragma unroll
        for (int ai = 0; ai < 2; ++ai)
#pragma unroll
            for (int m = 0; m < 4; ++m) { bf16_t* rowp = O + (size_t)(row0 + ai * HALF + m * 16) * ldc + col0;
#pragma unroll
                for (int bj = 0; bj < 2; ++bj) { const f32x4 v0 = acc[ai][bj][m][0], v1 = acc[ai][bj][m][1];
                    u32x4 w; w.x = cvt_pk_bf16(v0[0], v0[1]); w.y = cvt_pk_bf16(v0[2], v0[3]); w.z = cvt_pk_bf16(v1[0], v1[1]); w.w = cvt_pk_bf16(v1[2], v1[3]);
                    *(u32x4*)(rowp + bj * HALF) = w; } }
    }
};
struct EpiConvIn {
    static constexpr bool PERM = true;
    bf16_t* GBp; bf16_t* Zp;
    __device__ __forceinline__ void operator()(const Acc& acc, const Unit& u, int wr, int wc, int fr, int fq) const {
        const int row0 = u.pm * BM + wr * 64 + fr;
        if (u.pn < 4) {
            const int col0 = u.pn * BM + wc * 32 + 8 * fq;
#pragma unroll
            for (int ai = 0; ai < 2; ++ai)
#pragma unroll
                for (int m = 0; m < 4; ++m) { bf16_t* rowp = GBp + (size_t)(row0 + ai * HALF + m * 16) * DM + col0;
#pragma unroll
                    for (int bj = 0; bj < 2; ++bj) { const f32x4 v0 = acc[ai][bj][m][0], v1 = acc[ai][bj][m][1];
                        u32x4 w; w.x = cvt_pk_bf16(v0[0], v0[1]); w.y = cvt_pk_bf16(v0[2], v0[3]); w.z = cvt_pk_bf16(v1[0], v1[1]); w.w = cvt_pk_bf16(v1[2], v1[3]);
                        *(u32x4*)(rowp + bj * HALF) = w; } }
        } else {
            const int col0 = (u.pn - 4) * HALF + wc * 32 + 8 * fq;
#pragma unroll
            for (int ai = 0; ai < 2; ++ai)
#pragma unroll
                for (int m = 0; m < 4; ++m) { bf16_t* rowp = Zp + (size_t)(row0 + ai * HALF + m * 16) * DM + col0;
                    const f32x4 v0 = acc[ai][0][m][0] * acc[ai][1][m][0], v1 = acc[ai][0][m][1] * acc[ai][1][m][1];
                    u32x4 w; w.x = cvt_pk_bf16(v0[0], v0[1]); w.y = cvt_pk_bf16(v0[2], v0[3]); w.z = cvt_pk_bf16(v1[0], v1[1]); w.w = cvt_pk_bf16(v1[2], v1[3]);
                    *(u32x4*)rowp = w; }
        }
    }
};
__device__ __forceinline__ float silu_mul(float g, float u) { return g * __builtin_amdgcn_rcpf(1.f + __expf(-g)) * u; }
struct EpiSwiGLU {
    static constexpr bool PERM = true;
    bf16_t* Hd;
    __device__ __forceinline__ void operator()(const Acc& acc, const Unit& u, int wr, int wc, int fr, int fq) const {
        const int row0 = u.pm * BM + wr * 64 + fr, col0 = u.pn * HALF + wc * 32 + 8 * fq;
#pragma unroll
        for (int ai = 0; ai < 2; ++ai)
#pragma unroll
            for (int m = 0; m < 4; ++m) { bf16_t* rowp = Hd + (size_t)(row0 + ai * HALF + m * 16) * DFF + col0;
                f32x4 v0, v1;
#pragma unroll
                for (int q = 0; q < 4; ++q) { v0[q] = silu_mul(acc[ai][0][m][0][q], acc[ai][1][m][0][q]); v1[q] = silu_mul(acc[ai][0][m][1][q], acc[ai][1][m][1][q]); }
                u32x4 w; w.x = cvt_pk_bf16(v0[0], v0[1]); w.y = cvt_pk_bf16(v0[2], v0[3]); w.z = cvt_pk_bf16(v1[0], v1[1]); w.w = cvt_pk_bf16(v1[2], v1[3]);
                *(u32x4*)rowp = w; }
    }
};
struct EpiResid {
    static constexpr bool PERM = false;
    const float* xin; float* xout;
    __device__ __forceinline__ void operator()(const Acc& acc, const Unit& u, int wr, int wc, int fr, int fq) const {
        const int row0 = u.pm * BM + wr * 64 + fr, col0 = u.pn * BM + wc * 32 + 4 * fq;
#pragma unroll
        for (int ai = 0; ai < 2; ++ai)
#pragma unroll
            for (int m = 0; m < 4; ++m) { const size_t off = (size_t)(row0 + ai * HALF + m * 16) * DM + col0;
#pragma unroll
                for (int bj = 0; bj < 2; ++bj)
#pragma unroll
                    for (int n = 0; n < 2; ++n) { const f32x4 xv = *(const f32x4*)(xin + off + bj * HALF + n * 16); *(f32x4*)(xout + off + bj * HALF + n * 16) = xv + acc[ai][bj][m][n]; } }
    }
};
struct EpiLogits {
    static constexpr bool PERM = false;
    float* LG;
    __device__ __forceinline__ void operator()(const Acc& acc, const Unit& u, int wr, int wc, int fr, int fq) const {
        const int row0 = u.pm * BM + wr * 64 + fr, col0 = wc * 32 + 4 * fq;
#pragma unroll
        for (int ai = 0; ai < 2; ++ai)
#pragma unroll
            for (int m = 0; m < 4; ++m) { const size_t off = (size_t)(row0 + ai * HALF + m * 16) * 128 + col0;
#pragma unroll
                for (int n = 0; n < 2; ++n) *(f32x4*)(LG + off + n * 16) = acc[ai][0][m][n]; }
    }
};
struct EpiScatterY {
    static constexpr bool PERM = true;
    bf16_t* Y; const int* sdest; const float* sgate;
    __device__ __forceinline__ void operator()(const Acc& acc, const Unit& u, int wr, int wc, int fr, int fq) const {
        const int row0 = u.pm * BM + wr * 64 + fr, col0 = u.pn * BM + wc * 32 + 8 * fq;
#pragma unroll
        for (int ai = 0; ai < 2; ++ai)
#pragma unroll
            for (int m = 0; m < 4; ++m) { const int slot = row0 + ai * HALF + m * 16; const int d = sdest[slot]; const float g = sgate[slot];
                if (d >= 0) { bf16_t* rowp = Y + (size_t)d * DM + col0;
#pragma unroll
                    for (int bj = 0; bj < 2; ++bj) { const f32x4 v0 = acc[ai][bj][m][0] * g, v1 = acc[ai][bj][m][1] * g;
                        u32x4 w; w.x = cvt_pk_bf16(v0[0], v0[1]); w.y = cvt_pk_bf16(v0[2], v0[3]); w.z = cvt_pk_bf16(v1[0], v1[1]); w.w = cvt_pk_bf16(v1[2], v1[3]);
                        *(u32x4*)(rowp + bj * HALF) = w; } }
                asm volatile("" ::: "memory"); }
    }
};

template <class Epi, class Sched>
__device__ __forceinline__ void gemm_phase(LAS unsigned char* lds, const Gemm g, const Sched& S, const Epi& E, int tid) {
    const int wid = __builtin_amdgcn_readfirstlane(tid >> 6), lane = tid & 63, wr = wid >> 2, wc = wid & 3, fr = lane & 15, fq = lane >> 4;
    const int K = g.K, lda = g.lda, nt = K / BK;
    unsigned voffA[2], voffB[2];
#pragma unroll
    for (int i = 0; i < 2; ++i) { int R, C; stage_rc(tid * 16 + i * 8192, R, C); const int Rb = Epi::PERM ? ((R & ~31) + perm32(R & 31)) : R;
        voffA[i] = (unsigned)(R * lda + C) * 2u; voffB[i] = (unsigned)(Rb * K + C) * 2u; }
    const size_t kstep = (size_t)(BK * 2);
    const size_t hstepA = (size_t)HALF * lda * 2, hstepB = (size_t)HALF * K * 2;
    const unsigned ldsw = (unsigned)wid * 1024u;
    const int aoff = lds_byte(wr * 64 + fr, fq * 8), boff = lds_byte(wc * 32 + fr, fq * 8);
#define PG8_SA(b, h) (((b) * 2 + (h)) * HTB)
#define PG8_SB(b, h) ((4 + (b) * 2 + (h)) * HTB)
#define PG8_STAGE(bufoff, gbase, voff) do { _Pragma("unroll") for (int _i = 0; _i < 2; ++_i) \
        __builtin_amdgcn_global_load_lds((const unsigned*)((const char*)(gbase) + (voff)[_i]), (LAS unsigned*)(lds + (bufoff) + ldsw + _i * 8192), 16, 0, 0); } while (0)
#define PG8_LDA(dst, b, h) do { _Pragma("unroll") for (int m = 0; m < 4; ++m) _Pragma("unroll") for (int k = 0; k < 2; ++k) dst[m][k] = *(const LAS bf16x8*)(lds + PG8_SA(b, h) + aoff + m * 2048 + k * 1024); } while (0)
#define PG8_LDB(dst, b, h) do { _Pragma("unroll") for (int n = 0; n < 2; ++n) _Pragma("unroll") for (int k = 0; k < 2; ++k) dst[n][k] = *(const LAS bf16x8*)(lds + PG8_SB(b, h) + boff + n * 2048 + k * 1024); } while (0)
#define PG8_MMA(ai, bj, At, Bt) do { __builtin_amdgcn_s_setprio(1); _Pragma("unroll") for (int m = 0; m < 4; ++m) _Pragma("unroll") for (int n = 0; n < 2; ++n) _Pragma("unroll") for (int k = 0; k < 2; ++k) \
        acc[ai][bj][m][n] = __builtin_amdgcn_mfma_f32_16x16x32_bf16(Bt[n][k], At[m][k], acc[ai][bj][m][n], 0, 0, 0); __builtin_amdgcn_s_setprio(0); } while (0)
#define PG8_WAIT_V(n) asm volatile("s_waitcnt vmcnt(" #n ")" ::: "memory")
#define PG8_WAIT_L(n) asm volatile("s_waitcnt lgkmcnt(" #n ")" ::: "memory")
#define PG8_BAR __builtin_amdgcn_s_barrier()
#define PG8_SCHED __builtin_amdgcn_sched_barrier(0)
    Unit cur, nxt; int ui = 0;
    if (!S.next(0, cur)) return;
    Acc acc;
#pragma unroll
    for (int a = 0; a < 2; ++a)
#pragma unroll
        for (int b = 0; b < 2; ++b)
#pragma unroll
            for (int m = 0; m < 4; ++m)
#pragma unroll
                for (int n = 0; n < 2; ++n) acc[a][b][m][n] = (f32x4){0.f, 0.f, 0.f, 0.f};
    bf16x8 At[4][2], B0[2][2], B1[2][2];
    const char* cA = cur.A; const char* cB = cur.B;
    PG8_STAGE(PG8_SB(0, 0), cB, voffB); PG8_STAGE(PG8_SB(0, 1), cB + hstepB, voffB); PG8_STAGE(PG8_SA(0, 0), cA, voffA); PG8_STAGE(PG8_SA(0, 1), cA + hstepA, voffA);
    if (wr == 1) PG8_BAR;
    PG8_WAIT_V(2); PG8_BAR;
    PG8_STAGE(PG8_SB(1, 0), cB + kstep, voffB); PG8_STAGE(PG8_SA(1, 0), cA + kstep, voffA); PG8_STAGE(PG8_SB(1, 1), cB + hstepB + kstep, voffB);
    PG8_WAIT_V(6); PG8_BAR;
    for (;;) {
        const bool has_next = S.next(ui + 1, nxt);
        const char* nA = has_next ? nxt.A : cA; const char* nB = has_next ? nxt.B : cB;
        for (int t = 0; t < nt; t += 2) {
            const bool last = (t == nt - 2);
            const char* a1 = cA + (size_t)(t + 1) * kstep;
            const char* a2 = last ? nA : cA + (size_t)(t + 2) * kstep; const char* b2 = last ? nB : cB + (size_t)(t + 2) * kstep;
            const char* a3 = a2 + kstep; const char* b3 = b2 + kstep;
            PG8_LDB(B0, 0, 0); PG8_LDB(B1, 0, 1); PG8_SCHED; PG8_LDA(At, 0, 0); PG8_STAGE(PG8_SA(1, 1), a1 + hstepA, voffA);
            PG8_WAIT_V(8); PG8_WAIT_L(0); PG8_BAR; PG8_MMA(0, 0, At, B0); PG8_MMA(0, 1, At, B1); PG8_BAR; PG8_SCHED;
            PG8_LDA(At, 0, 1); PG8_STAGE(PG8_SB(0, 0), b2, voffB); PG8_STAGE(PG8_SB(0, 1), b2 + hstepB, voffB); PG8_STAGE(PG8_SA(0, 0), a2, voffA);
            PG8_WAIT_V(8); PG8_WAIT_L(0); PG8_BAR; PG8_MMA(1, 0, At, B0); PG8_MMA(1, 1, At, B1); PG8_BAR; PG8_SCHED;
            PG8_LDB(B0, 1, 0); PG8_LDB(B1, 1, 1); PG8_SCHED; PG8_LDA(At, 1, 0); PG8_STAGE(PG8_SA(0, 1), a2 + hstepA, voffA);
            PG8_WAIT_V(8); PG8_WAIT_L(0); PG8_BAR; PG8_MMA(0, 0, At, B0); PG8_MMA(0, 1, At, B1); PG8_BAR; PG8_SCHED;
            PG8_LDA(At, 1, 1); PG8_STAGE(PG8_SB(1, 0), b3, voffB); PG8_STAGE(PG8_SB(1, 1), b3 + hstepB, voffB); PG8_STAGE(PG8_SA(1, 0), a3, voffA);
            PG8_WAIT_V(8); PG8_WAIT_L(0); PG8_BAR; PG8_MMA(1, 0, At, B0); PG8_MMA(1, 1, At, B1); PG8_BAR; PG8_SCHED;
        }
        if (wr == 0) PG8_BAR;
        E(acc, cur, wr, wc, fr, fq);
        if (!has_next) break;
#pragma unroll
        for (int a = 0; a < 2; ++a)
#pragma unroll
            for (int b = 0; b < 2; ++b)
#pragma unroll
                for (int m = 0; m < 4; ++m)
#pragma unroll
                    for (int n = 0; n < 2; ++n) acc[a][b][m][n] = (f32x4){0.f, 0.f, 0.f, 0.f};
        cur = nxt; cA = nA; cB = nB; ++ui;
        if (wr == 1) PG8_BAR;
    }
    PG8_WAIT_V(0);
    PG8_BAR;
#undef PG8_SA
#undef PG8_SB
#undef PG8_STAGE
#undef PG8_LDA
#undef PG8_LDB
#undef PG8_MMA
#undef PG8_WAIT_V
#undef PG8_WAIT_L
#undef PG8_BAR
#undef PG8_SCHED
}
}

namespace att {
constexpr int NW = 8, QBLK = 32, KVBLK = 64;
constexpr float SCALE = 0.07216878364870322f;
constexpr float THR = 8.f;
#ifndef ATT_SDEPTH
#define ATT_SDEPTH 2
#endif
constexpr int SDEPTH = ATT_SDEPTH;
constexpr int KROW = 400;
constexpr int SHM_V = KVBLK * DV * 2, SHM_K = KVBLK * KROW;
#ifndef ATT_NQR
#define ATT_NQR 8
#endif
constexpr int NQR = ATT_NQR;
constexpr int QLROW = (12 - NQR) * 32 + 16;
constexpr int OFF_V = 0, OFF_K = 2 * SHM_V, OFF_WS = OFF_K + 2 * SHM_K, OFF_QL = OFF_WS + NW * 64 * 4, ATT_LDS = OFF_QL + NW * 32 * QLROW;
static_assert(ATT_LDS <= RING_BYTES, "attention LDS");
#define SBAR() __builtin_amdgcn_sched_barrier(0)
__device__ __forceinline__ int crow(int r, int hi) { return (r & 3) + 8 * (r >> 2) + 4 * hi; }
__device__ __forceinline__ void partialSM(f32x16& p0, f32x16& p1, float& m_reg, float& mn, float& alpha) {
    constexpr float C = SCALE * 1.4426950408889634f;
    float pmax = p0[0];
#pragma unroll
    for (int r = 1; r < 16; ++r) pmax = fmaxf(pmax, p0[r]);
#pragma unroll
    for (int r = 0; r < 16; ++r) pmax = fmaxf(pmax, p1[r]);
    { auto rr = __builtin_amdgcn_permlane32_swap(__float_as_uint(pmax), __float_as_uint(pmax), false, false);
      pmax = fmaxf(__uint_as_float(rr[0]), __uint_as_float(rr[1])); }
    if (__builtin_expect(__all(pmax - m_reg <= THR / SCALE), 1)) { mn = m_reg; alpha = 1.f; }
    else { mn = fmaxf(m_reg, pmax); alpha = __builtin_amdgcn_exp2f((m_reg - mn) * C); m_reg = mn; }
    const float mnC = -mn * C;
#pragma unroll
    for (int r = 0; r < 16; ++r) p0[r] = fmaf(p0[r], C, mnC);
#pragma unroll
    for (int r = 0; r < 16; ++r) p1[r] = fmaf(p1[r], C, mnC);
#pragma unroll
    for (int r = 0; r < 16; ++r) p0[r] = __builtin_amdgcn_exp2f(p0[r]);
}
__device__ __forceinline__ void finishSM(f32x16& p0, f32x16& p1, float alpha, float& l_reg, bf16x8& pa0, bf16x8& pa1, bf16x8& pa2, bf16x8& pa3) {
#pragma unroll
    for (int r = 0; r < 16; ++r) p1[r] = __builtin_amdgcn_exp2f(p1[r]);
    float ps = 0;
#pragma unroll
    for (int r = 0; r < 16; ++r) ps += p0[r];
#pragma unroll
    for (int r = 0; r < 16; ++r) ps += p1[r];
    { auto rr = __builtin_amdgcn_permlane32_swap(__float_as_uint(ps), __float_as_uint(ps), false, false);
      ps = __uint_as_float(rr[0]) + __uint_as_float(rr[1]); }
    l_reg = l_reg * alpha + ps;
#define PK4(P, BASE, OUT) do { unsigned a0 = cvt_pk_bf16(P[BASE + 0], P[BASE + 1]), a1 = cvt_pk_bf16(P[BASE + 2], P[BASE + 3]);   \
    unsigned b0 = cvt_pk_bf16(P[BASE + 4], P[BASE + 5]), b1 = cvt_pk_bf16(P[BASE + 6], P[BASE + 7]);                              \
    auto r0 = __builtin_amdgcn_permlane32_swap(a0, b0, false, false); auto r1 = __builtin_amdgcn_permlane32_swap(a1, b1, false, false); \
    u32x4 w = {r0[0], r1[0], r0[1], r1[1]}; OUT = *reinterpret_cast<bf16x8*>(&w); } while (0)
    PK4(p0, 0, pa0); PK4(p0, 8, pa1); PK4(p1, 0, pa2); PK4(p1, 8, pa3);
#undef PK4
}
__device__ __forceinline__ void qkt(f32x16& p0, f32x16& p1, const char* Ks, const bf16x8* qr, const char* ql, int r32, int hi) {
    p0 = f32x16{}; p1 = f32x16{};
#pragma unroll
    for (int d0 = 0; d0 < 12; ++d0) { const int cb = d0 * 32 + hi * 16;
        const bf16x8 b0 = *reinterpret_cast<const bf16x8*>(Ks + r32 * KROW + cb);
        const bf16x8 b1 = *reinterpret_cast<const bf16x8*>(Ks + (32 + r32) * KROW + cb);
        const bf16x8 qf = (d0 < NQR) ? qr[d0] : *reinterpret_cast<const bf16x8*>(ql + (d0 - NQR) * 32);
        p0 = __builtin_amdgcn_mfma_f32_32x32x16_bf16(b0, qf, p0, 0, 0, 0);
        p1 = __builtin_amdgcn_mfma_f32_32x32x16_bf16(b1, qf, p1, 0, 0, 0); }
}
__device__ __forceinline__ int v_st(int k, int c) { const int kk = (k & ~0xC) | ((k & 4) << 1) | ((k & 8) >> 1); return ((kk >> 3) * 4 + (c >> 5)) * 512 + ((kk & 7) * 32 + (c & 31)) * 2; }
__device__ __forceinline__ int v_rd_base(int lane) { return ((lane & 3) << 3) | (((lane >> 2) & 3) << 6) | (((lane >> 4) & 1) << 5) | (((lane >> 5) & 1) << 8); }
constexpr int v_rd_off(int d0, int ks, int half) { return d0 * 512 + ks * 4096 + half * 2048; }
template <int OFF> __device__ __forceinline__ s16x4 tr_read(int vb) {
    s16x4 r; asm volatile("ds_read_b64_tr_b16 %0, %1 offset:%2" : "=&v"(r) : "v"(vb), "i"(OFF) : "memory"); return r;
}
template <int D0> __device__ __forceinline__ void pv_one(f32x16& od, int vb, bf16x8 pa0, bf16x8 pa1, bf16x8 pa2, bf16x8 pa3) {
    const s16x4 l0 = tr_read<v_rd_off(D0, 0, 0)>(vb), h0 = tr_read<v_rd_off(D0, 0, 1)>(vb), l1 = tr_read<v_rd_off(D0, 1, 0)>(vb), h1 = tr_read<v_rd_off(D0, 1, 1)>(vb);
    const s16x4 l2 = tr_read<v_rd_off(D0, 2, 0)>(vb), h2 = tr_read<v_rd_off(D0, 2, 1)>(vb), l3 = tr_read<v_rd_off(D0, 3, 0)>(vb), h3 = tr_read<v_rd_off(D0, 3, 1)>(vb);
    asm volatile("s_waitcnt lgkmcnt(0)" ::: "memory"); SBAR();
#define PK(L, H) (bf16x8){L[0], L[1], L[2], L[3], H[0], H[1], H[2], H[3]}
    od = __builtin_amdgcn_mfma_f32_32x32x16_bf16(pa0, PK(l0, h0), od, 0, 0, 0);
    od = __builtin_amdgcn_mfma_f32_32x32x16_bf16(pa1, PK(l1, h1), od, 0, 0, 0);
    od = __builtin_amdgcn_mfma_f32_32x32x16_bf16(pa2, PK(l2, h2), od, 0, 0, 0);
    od = __builtin_amdgcn_mfma_f32_32x32x16_bf16(pa3, PK(l3, h3), od, 0, 0, 0);
#undef PK
}
__device__ __forceinline__ void pv_d0(f32x16* o, int vb, bf16x8 pa0, bf16x8 pa1, bf16x8 pa2, bf16x8 pa3) {
    pv_one<0>(o[0], vb, pa0, pa1, pa2, pa3); pv_one<1>(o[1], vb, pa0, pa1, pa2, pa3); pv_one<2>(o[2], vb, pa0, pa1, pa2, pa3); pv_one<3>(o[3], vb, pa0, pa1, pa2, pa3);
}
__device__ __forceinline__ void attn_unit(const bf16_t* __restrict__ Qb, const bf16_t* __restrict__ Kh, const bf16_t* __restrict__ Vh, bf16_t* __restrict__ Ob, char* lds, int tid) {
    const int wid = tid >> 6, lane = tid & 63, r32 = lane & 31, hi = lane >> 5;
    char* V_lds = lds + OFF_V; char* K_lds = lds + OFF_K;
    float* ws = (float*)(lds + OFF_WS) + wid * 64; float* li_l = ws; float* al_l = ws + 32;
    float m_reg = -1e30f, l_reg = 0; f32x16 o[4] = {}; bf16x8 qr[NQR];
    const bf16_t* Qw = Qb + (long)(wid * QBLK + r32) * DQK + hi * 8;
#pragma unroll
    for (int d0 = 0; d0 < NQR; ++d0) qr[d0] = *reinterpret_cast<const bf16x8*>(Qw + d0 * 16);
    char* ql = lds + OFF_QL + wid * (32 * QLROW) + r32 * QLROW + hi * 16;
#pragma unroll
    for (int d0 = NQR; d0 < 12; ++d0) *reinterpret_cast<bf16x8*>(ql + (d0 - NQR) * 32) = *reinterpret_cast<const bf16x8*>(Qw + d0 * 16);
    const int sr = tid >> 4, sc = (tid & 15) * 8, vst0 = v_st(sr, sc), vst1 = v_st(32 + sr, sc);
    int kst[3];
#pragma unroll
    for (int i = 0; i < 3; ++i) { const int q = tid + 512 * i; kst[i] = (q / 24) * KROW + (q % 24) * 16; }
    const int vb0 = (int)(uintptr_t)V_lds + v_rd_base(lane);
    struct { bf16x8 vs0, vs1, ks0, ks1, ks2; } sr_[SDEPTH];
#define SLOAD(i, k0) do { sr_[i].vs0 = *reinterpret_cast<const bf16x8*>(&Vh[(long)((k0) + sr) * DV + sc]); sr_[i].vs1 = *reinterpret_cast<const bf16x8*>(&Vh[(long)((k0) + 32 + sr) * DV + sc]); \
    const bf16_t* kp_ = Kh + (long)(k0) * DQK + tid * 8; sr_[i].ks0 = *reinterpret_cast<const bf16x8*>(kp_); sr_[i].ks1 = *reinterpret_cast<const bf16x8*>(kp_ + 4096); sr_[i].ks2 = *reinterpret_cast<const bf16x8*>(kp_ + 8192); } while (0)
#define SWRITE(b, i) do { *(bf16x8*)(V_lds + (b) * SHM_V + vst0) = sr_[i].vs0; *(bf16x8*)(V_lds + (b) * SHM_V + vst1) = sr_[i].vs1; \
    *(bf16x8*)(K_lds + (b) * SHM_K + kst[0]) = sr_[i].ks0; *(bf16x8*)(K_lds + (b) * SHM_K + kst[1]) = sr_[i].ks1; *(bf16x8*)(K_lds + (b) * SHM_K + kst[2]) = sr_[i].ks2; } while (0)
#define SWAIT() do { if constexpr (SDEPTH == 2) asm volatile("s_waitcnt vmcnt(5)" ::: "memory"); else asm volatile("s_waitcnt vmcnt(0)" ::: "memory"); } while (0)
#define RESC(a) do { if (__any((a) < 1.f)) { if (hi == 0) al_l[r32] = (a); asm volatile("s_waitcnt lgkmcnt(0)" ::: "memory"); \
    _Pragma("unroll") for (int d = 0; d < 4; ++d) _Pragma("unroll") for (int r = 0; r < 16; ++r) o[d][r] *= al_l[crow(r, hi)]; } } while (0)
    f32x16 pA0, pA1, pB0, pB1; float mnA, mnB, alA, alB; bf16x8 pa0, pa1, pa2, pa3; constexpr int NT = SEQ / KVBLK;
    constexpr int SE = 0, SO = SDEPTH - 1;
    SLOAD(SE, 0); asm volatile("s_waitcnt vmcnt(0)" ::: "memory"); SWRITE(0, SE); __syncthreads();
    qkt(pA0, pA1, K_lds, qr, ql, r32, hi); partialSM(pA0, pA1, m_reg, mnA, alA);
    SLOAD(SO, KVBLK); if constexpr (SDEPTH == 2) SLOAD(SE, 2 * KVBLK);
    SWAIT(); SWRITE(1, SO); __syncthreads();
    for (int j = 1; j + 1 < NT; j += 2) {
        SBAR(); qkt(pB0, pB1, K_lds + SHM_K, qr, ql, r32, hi);
        finishSM(pA0, pA1, alA, l_reg, pa0, pa1, pa2, pa3); SBAR();
        SLOAD(SO, (j + SDEPTH) * KVBLK); SBAR();
        pv_d0(o, vb0, pa0, pa1, pa2, pa3); partialSM(pB0, pB1, m_reg, mnB, alB);
        __syncthreads(); SWAIT(); SWRITE(0, SE);
        RESC(alB); __syncthreads();
        SBAR(); qkt(pA0, pA1, K_lds, qr, ql, r32, hi);
        finishSM(pB0, pB1, alB, l_reg, pa0, pa1, pa2, pa3); SBAR();
        if (SDEPTH == 1 || j + 3 < NT) SLOAD(SE, (j + 1 + SDEPTH) * KVBLK); SBAR();
        pv_d0(o, vb0 + SHM_V, pa0, pa1, pa2, pa3); partialSM(pA0, pA1, m_reg, mnA, alA);
        __syncthreads(); SWAIT(); SWRITE(1, SO);
        RESC(alA); __syncthreads();
    }
    SBAR(); qkt(pB0, pB1, K_lds + SHM_K, qr, ql, r32, hi);
    finishSM(pA0, pA1, alA, l_reg, pa0, pa1, pa2, pa3); SBAR();
    pv_d0(o, vb0, pa0, pa1, pa2, pa3); partialSM(pB0, pB1, m_reg, mnB, alB);
    __syncthreads(); RESC(alB);
    finishSM(pB0, pB1, alB, l_reg, pa0, pa1, pa2, pa3); SBAR();
    pv_d0(o, vb0 + SHM_V, pa0, pa1, pa2, pa3);
    if (hi == 0) li_l[r32] = l_reg; asm volatile("s_waitcnt lgkmcnt(0)" ::: "memory");
    float rli[16];
#pragma unroll
    for (int r = 0; r < 16; ++r) rli[r] = __builtin_amdgcn_rcpf(li_l[crow(r, hi)]);
    __syncthreads();
    bf16_t* ost = (bf16_t*)(lds + wid * 8192);
#pragma unroll
    for (int r = 0; r < 16; ++r) { const int orow = crow(r, hi);
#pragma unroll
        for (int d0 = 0; d0 < 4; ++d0) ost[orow * 128 + d0 * 32 + r32] = (bf16_t)f2bf(o[d0][r] * rli[r]); }
    asm volatile("s_waitcnt lgkmcnt(0)" ::: "memory");
    bf16_t* Ow = Ob + (long)(wid * QBLK) * DM;
#pragma unroll
    for (int i = 0; i < 8; ++i) { const int ch = lane + 64 * i, row = ch >> 4, c = ch & 15;
        const u32x4 v = *(const u32x4*)((const char*)ost + row * 256 + c * 16); *(u32x4*)(Ow + (long)row * DM + c * 8) = v; }
    __syncthreads();
#undef SLOAD
#undef SWRITE
#undef SWAIT
#undef RESC
}
}

struct Args { const void* in[23]; float* out; unsigned char* ws; int ph_lo, ph_hi; };
enum { I_X = 0, I_POS, I_CNW, I_CWIN, I_CK, I_CWOUT, I_MNW, I_MWDOWN, I_MQLN, I_MKVLN, I_MWQ, I_MWKV, I_MQHN, I_MKHN, I_MWO, I_FNW, I_RWG, I_RBG, I_RWE, I_RBE, I_EWG, I_EWU, I_EWD };

__device__ __forceinline__ void transpose_item(const float* W, int K, int N, bf16_t* WT, int drow0, const float* ksc, LAS float* scr, int kb, int nb, int lane) {
    const int k0 = 64 * kb, n0 = 32 * nb;
#pragma unroll 8
    for (int i = 0; i < 32; ++i) { const int kk = 2 * i + (lane >> 5); const float s = ksc ? ksc[k0 + kk] : 1.f; scr[kk * 33 + (lane & 31)] = W[(size_t)(k0 + kk) * N + n0 + (lane & 31)] * s; }
    LDS_WAIT(); asm volatile("" ::: "memory");
    const int c = lane & 7;
#pragma unroll
    for (int j = 0; j < 4; ++j) { const int n = (lane >> 3) + 8 * j; const LAS float* s = scr + (8 * c) * 33 + n;
        u32x4 o; o.x = pk2(s[0 * 33], s[1 * 33]); o.y = pk2(s[2 * 33], s[3 * 33]); o.z = pk2(s[4 * 33], s[5 * 33]); o.w = pk2(s[6 * 33], s[7 * 33]);
        *(GAS u32x4*)(WT + (size_t)(drow0 + n) * K + k0 + 8 * c) = o; }
    LDS_WAIT(); asm volatile("" ::: "memory");
}

__device__ __forceinline__ unsigned char* ldptr(int i);
__device__ __forceinline__ void prologue_phase(LAS unsigned char* lds, int gw, int NGW, int wave, int lane, int gtid, int NGT) {
    unsigned char* ws = ldptr(24);
    LAS float* scr = (LAS float*)(lds + wave * 16384);
    constexpr int PER_J = 1536 + 512 + 352 + 288 + 256 + 512;
    for (int it = gw; it < 2 * PER_J; it += NGW) {
        const int j = it / PER_J; int r = it - j * PER_J;
        const float* W; int K, N; bf16_t* WT; int drow0; const float* ksc; int kb, nb;
        if (r < 1536) { K = 1024; N = 3072; W = (const float*)ldptr(I_CWIN) + (size_t)j * K * N; WT = (bf16_t*)(ws + WS_WIN) + (size_t)j * 3072 * 1024; ksc = (const float*)ldptr(I_CNW) + j * 1024;
            kb = r / 96; nb = r % 96; const int n0 = nb * 32;
            if (n0 < 1024) drow0 = n0; else if (n0 < 2048) { const int c = n0 - 1024; drow0 = 1024 + (c >> 7) * 256 + (c & 127); } else { const int c = n0 - 2048; drow0 = 1024 + (c >> 7) * 256 + 128 + (c & 127); } }
        else if ((r -= 1536) < 512) { K = 1024; N = 1024; W = (const float*)ldptr(I_CWOUT) + (size_t)j * K * N; WT = (bf16_t*)(ws + WS_WOUTC) + (size_t)j * 1024 * 1024; ksc = nullptr; kb = r / 32; nb = r % 32; drow0 = nb * 32; }
        else if ((r -= 512) < 352) { K = 1024; N = LAT; W = (const float*)ldptr(I_MWDOWN) + (size_t)j * K * N; WT = (bf16_t*)(ws + WS_WDOWN) + (size_t)j * LATP * 1024; ksc = (const float*)ldptr(I_MNW) + j * 1024; kb = r / 22; nb = r % 22; drow0 = nb * 32; }
        else if ((r -= 352) < 288) { K = QLR; N = NH * DQK; W = (const float*)ldptr(I_MWQ) + (size_t)j * K * N; WT = (bf16_t*)(ws + WS_WQ + (size_t)j * 1536 * 1024); ksc = (const float*)ldptr(I_MQLN) + j * QLR; kb = r / 48; nb = r % 48; drow0 = nb * 32; }
        else if ((r -= 288) < 256) { K = KVLR; N = NH * 256; W = (const float*)ldptr(I_MWKV) + (size_t)j * K * N; WT = (bf16_t*)(ws + WS_WKV) + (size_t)j * 2048 * 256; ksc = (const float*)ldptr(I_MKVLN) + j * KVLR; kb = r / 64; nb = r % 64; drow0 = nb * 32; }
        else { r -= 256; K = 1024; N = 1024; W = (const float*)ldptr(I_MWO) + (size_t)j * K * N; WT = (bf16_t*)(ws + WS_WO) + (size_t)j * 1024 * 1024; ksc = nullptr; kb = r / 32; nb = r % 32; drow0 = nb * 32; }
        transpose_item(W, K, N, WT, drow0, ksc, scr, kb, nb, lane);
    }
#if MK_ENABLE_MOE
    for (int it = gw; it < 4 * NE * 576; it += NGW) {
        const int le = it / 576, q = it - le * 576, L = le >> 6; const int kind = q / 192, idx = q - kind * 192;
        const float* W; int K, N; bf16_t* WT; int drow0; const float* ksc; int kb, nb;
        if (kind < 2) { K = 1024; N = DFF; W = (const float*)ldptr(kind == 0 ? I_EWG : I_EWU) + (size_t)le * K * N; WT = (bf16_t*)(ws + WS_WE1) + (size_t)le * 768 * 1024; ksc = (const float*)ldptr(I_FNW) + L * 1024;
            kb = idx / 12; nb = idx % 12; const int n0 = nb * 32; drow0 = (n0 >> 7) * 256 + kind * 128 + (n0 & 127); }
        else { K = DFF; N = 1024; W = (const float*)ldptr(I_EWD) + (size_t)le * K * N; WT = (bf16_t*)(ws + WS_WE2) + (size_t)le * 1024 * DFF; ksc = nullptr; kb = idx / 32; nb = idx % 32; drow0 = nb * 32; }
        transpose_item(W, K, N, WT, drow0, ksc, scr, kb, nb, lane);
    }
    const float* fnw = (const float*)ldptr(I_FNW); const float* rwg = (const float*)ldptr(I_RWG); const float* rwe = (const float*)ldptr(I_RWE);
    for (int i = gtid; i < 4 * 256 * 128; i += NGT) {
        const int L = i >> 15, n = (i >> 7) & 255, k8 = (i & 127) * 8;
        u32x4 o = {0u, 0u, 0u, 0u};
        if (n < 72) { float v[8];
#pragma unroll
            for (int q = 0; q < 8; ++q) { const int k = k8 + q; const float g = fnw[L * 1024 + k];
                v[q] = g * (n < 8 ? rwg[((size_t)L * 1024 + k) * 8 + n] : rwe[((size_t)L * 1024 + k) * 64 + (n - 8)]); }
            o.x = pk2(v[0], v[1]); o.y = pk2(v[2], v[3]); o.z = pk2(v[4], v[5]); o.w = pk2(v[6], v[7]); }
        *(u32x4*)((bf16_t*)(ws + WS_WRT) + ((size_t)L * 256 + n) * 1024 + k8) = o;
    }
#endif
    for (int i = gtid; i < 2 * 64 * 128; i += NGT) { const int j = i >> 13, n = LAT + ((i >> 7) & 63), k8 = (i & 127) * 8;
        *(u32x4*)((bf16_t*)(ws + WS_WDOWN) + ((size_t)j * LATP + n) * 1024 + k8) = (u32x4){0u, 0u, 0u, 0u}; }
}

__device__ __forceinline__ void norm_phase(const float* xin, const bf16_t* Y, float* xout, bf16_t* H, int gw, int NGW, int lane) {
    for (int m = gw; m < T; m += NGW) {
        const f32x4* xr = (const f32x4*)(xin + (size_t)m * DM) + lane;
        f32x4 v[4];
#pragma unroll
        for (int j = 0; j < 4; ++j) v[j] = xr[64 * j];
        if (Y) { const u32x2* y0 = (const u32x2*)(Y + (size_t)(2 * m) * DM) + lane; const u32x2* y1 = y0 + 256;
#pragma unroll
            for (int j = 0; j < 4; ++j) { const u32x2 p = y0[64 * j], q = y1[64 * j];
                v[j].x += bflo(p.x) + bflo(q.x); v[j].y += bfhi(p.x) + bfhi(q.x); v[j].z += bflo(p.y) + bflo(q.y); v[j].w += bfhi(p.y) + bfhi(q.y); } }
        if (xout) { f32x4* xo = (f32x4*)(xout + (size_t)m * DM) + lane;
#pragma unroll
            for (int j = 0; j < 4; ++j) xo[64 * j] = v[j]; }
        if (H) { float s = 0.f;
#pragma unroll
            for (int j = 0; j < 4; ++j) s += (v[j].x * v[j].x + v[j].y * v[j].y) + (v[j].z * v[j].z + v[j].w * v[j].w);
            const float r = 1.0f / sqrtf(wave_sum(s, lane) * (1.f / DM) + EPS);
            u32x2* ho = (u32x2*)(H + (size_t)m * DM) + lane;
#pragma unroll
            for (int j = 0; j < 4; ++j) { u32x2 w; w.x = pk2(v[j].x * r, v[j].y * r); w.y = pk2(v[j].z * r, v[j].w * r); ho[64 * j] = w; } }
    }
}

__device__ __forceinline__ void conv_phase(const bf16_t* GBp, const bf16_t* Zp, const float* ck, bf16_t* YCp, int gtid, int NGT) {
    for (int i = gtid; i < T * 128; i += NGT) {
        const int t = i >> 7, c8 = (i & 127) * 8, s = t & (SEQ - 1);
        const u32x4 zc = *(const u32x4*)(Zp + (size_t)t * DM + c8), g = *(const u32x4*)(GBp + (size_t)t * DM + c8);
        u32x4 zm = {0u, 0u, 0u, 0u}, zp = {0u, 0u, 0u, 0u};
        if (s > 0) zm = *(const u32x4*)(Zp + (size_t)(t - 1) * DM + c8);
        if (s < SEQ - 1) zp = *(const u32x4*)(Zp + (size_t)(t + 1) * DM + c8);
        const f32x4 k0a = *(const f32x4*)(ck + c8), k0b = *(const f32x4*)(ck + c8 + 4), k1a = *(const f32x4*)(ck + DM + c8), k1b = *(const f32x4*)(ck + DM + c8 + 4), k2a = *(const f32x4*)(ck + 2 * DM + c8), k2b = *(const f32x4*)(ck + 2 * DM + c8 + 4);
        float y[8];
#define CV(q, W, KA, LOHI) y[q] = LOHI(g.W) * (LOHI(zm.W) * k0##KA + LOHI(zc.W) * k1##KA + LOHI(zp.W) * k2##KA)
        CV(0, x, a[0], bflo); CV(1, x, a[1], bfhi); CV(2, y, a[2], bflo); CV(3, y, a[3], bfhi); CV(4, z, b[0], bflo); CV(5, z, b[1], bfhi); CV(6, w, b[2], bflo); CV(7, w, b[3], bfhi);
#undef CV
        u32x4 o; o.x = pk2(y[0], y[1]); o.y = pk2(y[2], y[3]); o.z = pk2(y[4], y[5]); o.w = pk2(y[6], y[7]);
        *(u32x4*)(YCp + (size_t)t * DM + c8) = o;
    }
}

__device__ __forceinline__ void qkprep_phase(const bf16_t* LATb, const bf16_t* QRAW, const bf16_t* KVRAW, const int* pos, const float* qhn, const float* khn,
                                             bf16_t* Qo, bf16_t* Ko, bf16_t* Vo, LAS unsigned char* lds, int gw, int NGW, int wave, int lane) {
    LAS unsigned char* sq = lds + wave * 10240;
    LAS float* cs = (LAS float*)(sq + 8704);
    const int h = lane >> 3, i8 = lane & 7;
    float gq[24], gk[24];
#pragma unroll
    for (int q = 0; q < 16; ++q) { gq[q] = qhn[16 * i8 + q]; gk[q] = khn[16 * i8 + q]; }
#pragma unroll
    for (int q = 0; q < 4; ++q) { gq[16 + q] = qhn[128 + 4 * i8 + q]; gq[20 + q] = qhn[160 + 4 * i8 + q]; gk[16 + q] = khn[128 + 4 * i8 + q]; gk[20 + q] = khn[160 + 4 * i8 + q]; }
    for (int t = gw; t < T; t += NGW) {
        const int b = t >> 14, s = t & (SEQ - 1);
        const u32x4* qs = (const u32x4*)(QRAW + (size_t)t * 1536); const u32x4* ks = (const u32x4*)(KVRAW + (size_t)t * 2048); const u32x4* ls = (const u32x4*)(LATb + (size_t)t * LATP);
        const u32x4 q0 = qs[lane], q1 = qs[lane + 64], q2 = qs[lane + 128], k0 = ks[lane], k1 = ks[lane + 64], k2 = ks[lane + 128], k3 = ks[lane + 192];
        const u32x4 l0 = ls[lane]; u32x4 l1 = {0u, 0u, 0u, 0u}; if (lane < 24) l1 = ls[lane + 64];
        LAS u32x4* d = (LAS u32x4*)sq;
        d[lane] = q0; d[lane + 64] = q1; d[lane + 128] = q2; d[192 + lane] = k0; d[192 + lane + 64] = k1; d[192 + lane + 128] = k2; d[192 + lane + 192] = k3;
        d[448 + lane] = l0; if (lane < 24) d[448 + lane + 64] = l1;
        float s0 = 0.f;
#define SS4(V_) (bflo(V_.x) * bflo(V_.x) + bfhi(V_.x) * bfhi(V_.x) + bflo(V_.y) * bflo(V_.y) + bfhi(V_.y) * bfhi(V_.y) + bflo(V_.z) * bflo(V_.z) + bfhi(V_.z) * bfhi(V_.z) + bflo(V_.w) * bflo(V_.w) + bfhi(V_.w) * bfhi(V_.w))
        s0 = SS4(l0); const float s1 = SS4(l1);
        const float ssq_q = wave_sum(lane < 48 ? s0 : 0.f, lane), ssq_kv = wave_sum((lane >= 48 ? s0 : 0.f) + (lane < 16 ? s1 : 0.f), lane);
        const float r_q = 1.0f / sqrtf(ssq_q * (1.f / QLR) + EPS), r_kv = 1.0f / sqrtf(ssq_kv * (1.f / KVLR) + EPS);
        if (lane < 32) { const float invf = powf(10000.f, -(float)lane * (1.f / 32.f)); const float ang = (float)pos[t] * invf;
            const double rev = (double)ang * 0.15915494309189535; const float fr = (float)(rev - floor(rev));
            cs[lane] = __builtin_amdgcn_cosf(fr); cs[32 + lane] = __builtin_amdgcn_sinf(fr); }
        LDS_WAIT(); asm volatile("" ::: "memory");
        float cj[4], sj[4];
#pragma unroll
        for (int q = 0; q < 4; ++q) { cj[q] = cs[4 * i8 + q]; sj[q] = cs[32 + 4 * i8 + q]; }
        {   const LAS bf16_t* qh = (const LAS bf16_t*)sq + h * DQK;
            const u32x4 a0 = *(const LAS u32x4*)(qh + 16 * i8), a1 = *(const LAS u32x4*)(qh + 16 * i8 + 8);
            const u32x2 r1 = *(const LAS u32x2*)(qh + 128 + 4 * i8), r2 = *(const LAS u32x2*)(qh + 160 + 4 * i8);
            float v[24];
            v[0] = bflo(a0.x); v[1] = bfhi(a0.x); v[2] = bflo(a0.y); v[3] = bfhi(a0.y); v[4] = bflo(a0.z); v[5] = bfhi(a0.z); v[6] = bflo(a0.w); v[7] = bfhi(a0.w);
            v[8] = bflo(a1.x); v[9] = bfhi(a1.x); v[10] = bflo(a1.y); v[11] = bfhi(a1.y); v[12] = bflo(a1.z); v[13] = bfhi(a1.z); v[14] = bflo(a1.w); v[15] = bfhi(a1.w);
            v[16] = bflo(r1.x); v[17] = bfhi(r1.x); v[18] = bflo(r1.y); v[19] = bfhi(r1.y); v[20] = bflo(r2.x); v[21] = bfhi(r2.x); v[22] = bflo(r2.y); v[23] = bfhi(r2.y);
            float ss = 0.f;
#pragma unroll
            for (int q = 0; q < 24; ++q) ss += v[q] * v[q];
            ss += lane_xor_f(ss, 1, lane); ss += lane_xor_f(ss, 2, lane); ss += lane_xor_f(ss, 4, lane);
            const float sc = r_q / sqrtf(r_q * r_q * ss * (1.f / DQK) + EPS);
#pragma unroll
            for (int q = 0; q < 24; ++q) v[q] *= sc * gq[q];
            bf16_t* qo = Qo + ((size_t)(b * NH + h) * SEQ + s) * DQK;
            u32x4 w0, w1; w0.x = pk2(v[0], v[1]); w0.y = pk2(v[2], v[3]); w0.z = pk2(v[4], v[5]); w0.w = pk2(v[6], v[7]); w1.x = pk2(v[8], v[9]); w1.y = pk2(v[10], v[11]); w1.z = pk2(v[12], v[13]); w1.w = pk2(v[14], v[15]);
            *(u32x4*)(qo + 16 * i8) = w0; *(u32x4*)(qo + 16 * i8 + 8) = w1;
            float o1[4], o2[4];
#pragma unroll
            for (int q = 0; q < 4; ++q) { o1[q] = v[16 + q] * cj[q] - v[20 + q] * sj[q]; o2[q] = v[20 + q] * cj[q] + v[16 + q] * sj[q]; }
            u32x2 e1, e2; e1.x = pk2(o1[0], o1[1]); e1.y = pk2(o1[2], o1[3]); e2.x = pk2(o2[0], o2[1]); e2.y = pk2(o2[2], o2[3]);
            *(u32x2*)(qo + 128 + 4 * i8) = e1; *(u32x2*)(qo + 160 + 4 * i8) = e2; }
        {   const LAS bf16_t* kh = (const LAS bf16_t*)(sq + 3072) + h * 256; const LAS bf16_t* lr = (const LAS bf16_t*)(sq + 7168) + 640;
            const u32x4 a0 = *(const LAS u32x4*)(kh + 16 * i8), a1 = *(const LAS u32x4*)(kh + 16 * i8 + 8);
            const u32x4 b0 = *(const LAS u32x4*)(kh + 128 + 16 * i8), b1 = *(const LAS u32x4*)(kh + 128 + 16 * i8 + 8);
            const u32x2 r1 = *(const LAS u32x2*)(lr + 4 * i8), r2 = *(const LAS u32x2*)(lr + 32 + 4 * i8);
            float v[24];
            v[0] = bflo(a0.x); v[1] = bfhi(a0.x); v[2] = bflo(a0.y); v[3] = bfhi(a0.y); v[4] = bflo(a0.z); v[5] = bfhi(a0.z); v[6] = bflo(a0.w); v[7] = bfhi(a0.w);
            v[8] = bflo(a1.x); v[9] = bfhi(a1.x); v[10] = bflo(a1.y); v[11] = bfhi(a1.y); v[12] = bflo(a1.z); v[13] = bfhi(a1.z); v[14] = bflo(a1.w); v[15] = bfhi(a1.w);
#pragma unroll
            for (int q = 0; q < 16; ++q) v[q] *= r_kv;
            v[16] = bflo(r1.x); v[17] = bfhi(r1.x); v[18] = bflo(r1.y); v[19] = bfhi(r1.y); v[20] = bflo(r2.x); v[21] = bfhi(r2.x); v[22] = bflo(r2.y); v[23] = bfhi(r2.y);
            float ss = 0.f;
#pragma unroll
            for (int q = 0; q < 24; ++q) ss += v[q] * v[q];
            ss += lane_xor_f(ss, 1, lane); ss += lane_xor_f(ss, 2, lane); ss += lane_xor_f(ss, 4, lane);
            const float sc = 1.0f / sqrtf(ss * (1.f / DQK) + EPS);
#pragma unroll
            for (int q = 0; q < 24; ++q) v[q] *= sc * gk[q];
            bf16_t* ko = Ko + ((size_t)(b * NH + h) * SEQ + s) * DQK;
            u32x4 w0, w1; w0.x = pk2(v[0], v[1]); w0.y = pk2(v[2], v[3]); w0.z = pk2(v[4], v[5]); w0.w = pk2(v[6], v[7]); w1.x = pk2(v[8], v[9]); w1.y = pk2(v[10], v[11]); w1.z = pk2(v[12], v[13]); w1.w = pk2(v[14], v[15]);
            *(u32x4*)(ko + 16 * i8) = w0; *(u32x4*)(ko + 16 * i8 + 8) = w1;
            float o1[4], o2[4];
#pragma unroll
            for (int q = 0; q < 4; ++q) { o1[q] = v[16 + q] * cj[q] - v[20 + q] * sj[q]; o2[q] = v[20 + q] * cj[q] + v[16 + q] * sj[q]; }
            u32x2 e1, e2; e1.x = pk2(o1[0], o1[1]); e1.y = pk2(o1[2], o1[3]); e2.x = pk2(o2[0], o2[1]); e2.y = pk2(o2[2], o2[3]);
            *(u32x2*)(ko + 128 + 4 * i8) = e1; *(u32x2*)(ko + 160 + 4 * i8) = e2;
            bf16_t* vo = Vo + ((size_t)(b * NH + h) * SEQ + s) * DV;
            u32x4 x0, x1;
            x0.x = pk2(bflo(b0.x) * r_kv, bfhi(b0.x) * r_kv); x0.y = pk2(bflo(b0.y) * r_kv, bfhi(b0.y) * r_kv); x0.z = pk2(bflo(b0.z) * r_kv, bfhi(b0.z) * r_kv); x0.w = pk2(bflo(b0.w) * r_kv, bfhi(b0.w) * r_kv);
            x1.x = pk2(bflo(b1.x) * r_kv, bfhi(b1.x) * r_kv); x1.y = pk2(bflo(b1.y) * r_kv, bfhi(b1.y) * r_kv); x1.z = pk2(bflo(b1.z) * r_kv, bfhi(b1.z) * r_kv); x1.w = pk2(bflo(b1.w) * r_kv, bfhi(b1.w) * r_kv);
            *(u32x4*)(vo + 16 * i8) = x0; *(u32x4*)(vo + 16 * i8 + 8) = x1; }
        LDS_WAIT(); asm volatile("" ::: "memory");
    }
#undef SS4
}

__device__ __forceinline__ void route_phase(const float* LG, const float* bg, const float* be, gu32* cnt, int* eid, int* rank, float* gate, int gtid, int NGT) {
    for (int t = gtid; t < T; t += NGT) {
        const float* lg = LG + (size_t)t * 128;
        float gl[8];
        { const f32x4 a = *(const f32x4*)lg, b = *(const f32x4*)(lg + 4); gl[0] = a.x; gl[1] = a.y; gl[2] = a.z; gl[3] = a.w; gl[4] = b.x; gl[5] = b.y; gl[6] = b.z; gl[7] = b.w; }
        float gm = gl[0]; int gs = 0; float bm = gl[0] + bg[0];
#pragma unroll
        for (int q = 1; q < 8; ++q) { gm = fmaxf(gm, gl[q]); const float v = gl[q] + bg[q]; if (v > bm) { bm = v; gs = q; } }
        float gsum = 0.f, gsel = 0.f;
#pragma unroll
        for (int q = 0; q < 8; ++q) { const float e = __expf(gl[q] - gm); gsum += e; gsel = (q == gs) ? e : gsel; }
        const float g_gate = gsel / gsum;
        float el[8];
        { const f32x4 a = *(const f32x4*)(lg + 8 + gs * 8), b = *(const f32x4*)(lg + 12 + gs * 8); el[0] = a.x; el[1] = a.y; el[2] = a.z; el[3] = a.w; el[4] = b.x; el[5] = b.y; el[6] = b.z; el[7] = b.w; }
        int i0 = 0; float v0 = el[0] + be[gs * 8];
#pragma unroll
        for (int q = 1; q < 8; ++q) { const float v = el[q] + be[gs * 8 + q]; if (v > v0) { v0 = v; i0 = q; } }
        int i1 = -1; float v1 = -3.0e38f;
#pragma unroll
        for (int q = 0; q < 8; ++q) { const float v = el[q] + be[gs * 8 + q]; if (q != i0 && v > v1) { v1 = v; i1 = q; } }
        float l0 = 0.f, l1 = 0.f;
#pragma unroll
        for (int q = 0; q < 8; ++q) { l0 = (q == i0) ? el[q] : l0; l1 = (q == i1) ? el[q] : l1; }
        const float mm = fmaxf(l0, l1), p0 = __expf(l0 - mm), p1 = __expf(l1 - mm), inv = 1.f / (p0 + p1);
        const int e0 = gs * 8 + i0, e1 = gs * 8 + i1;
        const unsigned r0 = __hip_atomic_fetch_add(cnt + e0, 1u, RLX_AGENT), r1 = __hip_atomic_fetch_add(cnt + e1, 1u, RLX_AGENT);
        eid[2 * t] = e0; eid[2 * t + 1] = e1; rank[2 * t] = (int)r0; rank[2 * t + 1] = (int)r1; gate[2 * t] = g_gate * p0 * inv; gate[2 * t + 1] = g_gate * p1 * inv;
    }
}

__device__ __forceinline__ int build_tables(gu32* cnt, LAS int* tbl, LAS int* pstart, int tid) {
    if (tid < 64) {
        const int c = (int)__hip_atomic_load(cnt + tid, RLX_AGENT); const int pad = (c + 255) & ~255;
        int incl = pad;
#pragma unroll
        for (int o = 1; o < 64; o <<= 1) { const int v = __builtin_amdgcn_ds_bpermute((tid - o) << 2, incl); if (tid >= o) incl += v; }
        const int start = incl - pad; pstart[tid] = start; if (tid == 63) pstart[64] = incl;
        for (int q = start >> 8; q < (incl >> 8); ++q) tbl[q] = tid;
    }
    __syncthreads();
    return pstart[64] >> 8;
}

__device__ __forceinline__ void scatter_phase(const bf16_t* H, const int* eid, const int* rank, const float* gate, gu32* cnt, bf16_t* XS, int* sdest, float* sgate,
                                              const LAS int* pstart, int gw, int NGW, int lane, int gtid, int NGT) {
    for (int a = gw; a < NASSIGN; a += NGW) {
        const int e = eid[a], slot = pstart[e] + rank[a], t = a >> 1;
        const u32x4* src = (const u32x4*)(H + (size_t)t * DM); u32x4* dst = (u32x4*)(XS + (size_t)slot * DM);
        dst[lane] = src[lane]; dst[lane + 64] = src[lane + 64];
        if (lane == 0) { sdest[slot] = a; sgate[slot] = gate[a]; }
    }
    for (int i = gtid; i < NE * 256; i += NGT) { const int e = i >> 8, q = i & 255; const int c = (int)__hip_atomic_load(cnt + e, RLX_AGENT); const int pad = (c + 255) & ~255;
        if (c + q < pad) { sdest[pstart[e] + c + q] = -1; sgate[pstart[e] + c + q] = 0.f; } }
}

constexpr int PTAB_OFF = MISC_OFF + 128;
__device__ __forceinline__ unsigned char* ldptr(int i) {
    extern __shared__ __attribute__((aligned(16))) unsigned char lds_raw[];
    volatile LAS unsigned* pt = (volatile LAS unsigned*)((LAS unsigned char*)lds_raw + PTAB_OFF) + 2 * sgpr_now(i);
    const unsigned lo = __builtin_amdgcn_readfirstlane(pt[0]), hi = __builtin_amdgcn_readfirstlane(pt[1]);
    return (unsigned char*)(GAS unsigned char*)(((unsigned long long)hi << 32) | lo);
}
#define P_IN(i) ((const float*)ldptr(i))
#define P_OUT() ((float*)ldptr(23))
#define P_WS() (ldptr(24))
__device__ __forceinline__ void grid_barrier(int tid) {
    extern __shared__ __attribute__((aligned(16))) unsigned char lds_raw[];
    XcdBarrier b; b.bar = (unsigned*)(P_WS() + WS_CTL) + CW_BAR; b.x = xb_xcc_id(); b.st = (volatile LAS unsigned*)((LAS unsigned char*)lds_raw + MISC_OFF) + 8;
    xcd_barrier(b, tid == 0);
}

__global__ void __launch_bounds__(NWAVES * 64, 2) fwd(Args args) {
    extern __shared__ __attribute__((aligned(16))) unsigned char lds_raw[];
    LAS unsigned char* lds = (LAS unsigned char*)lds_raw;
    for (int u = threadIdx.x; u < (LDS_BYTES - LDSCTL_OFF) / 4; u += NWAVES * 64) ((LAS unsigned*)(lds + LDSCTL_OFF))[u] = 0u;
    __syncthreads();
    if (threadIdx.x == 0) { LAS unsigned long long* pt = (LAS unsigned long long*)(lds + PTAB_OFF);
#pragma unroll
        for (int i = 0; i < 23; ++i) pt[i] = (unsigned long long)args.in[i];
        pt[23] = (unsigned long long)args.out; pt[24] = (unsigned long long)args.ws; }
    __syncthreads();
    const int lo = args.ph_lo, hi = args.ph_hi;
    if (hi - lo > 1) (void)xcd_barrier_post((unsigned*)(P_WS() + WS_CTL) + CW_BAR, (volatile LAS unsigned*)(lds + MISC_OFF) + 8, threadIdx.x == 0);
    const int wave_s = __builtin_amdgcn_readfirstlane((int)threadIdx.x >> 6);
#define IN(k) (lo <= (k) && (k) < hi)
#define SEAM(k) do { if (hi > (k) + 1) grid_barrier(TID); } while (0)
#define TID (tid_now(wave_s))
#define LANE (tid_now(wave_s) & 63)
#define WAVE (sgpr_now(wave_s))
#define GRID (sgpr_now((int)gridDim.x))
#define BX (sgpr_now((int)blockIdx.x))
#define VCU ((GRID % 8 == 0) ? (BX % 8) * (GRID / 8) + BX / 8 : BX)
#define GW (VCU * NWAVES + WAVE)
#define NGW (GRID * NWAVES)
#define GTID (BX * (NWAVES * 64) + TID)
#define NGT (GRID * NWAVES * 64)
#define TBL ((LAS int*)(lds + TBL_OFF))
#define PSTART (TBL + 384)

    if (IN(0)) { for (int rep = 0; rep < REP_PRO; ++rep) prologue_phase(lds, GW, NGW, WAVE, LANE, GTID, NGT); SEAM(0); }

    for (int L = 0; L < 4; ++L) {
        const int pb = 1 + 12 * L;
        if ((L & 1) == 0) {
            if (IN(pb + 0)) { unsigned char* ws = P_WS(); const float* xsrc = (L == 0) ? P_IN(I_X) : P_OUT();
                norm_phase(xsrc, (L > 0 && MK_ENABLE_MOE) ? (const bf16_t*)(ws + WS_Y) : nullptr, (L == 0) ? nullptr : P_OUT(), (bf16_t*)(ws + WS_H), GW, NGW, LANE); SEAM(pb + 0); }
            if (IN(pb + 1)) { unsigned char* ws = P_WS(); const int j = L >> 1;
                pg8::Gemm g{DM, DM}; pg8::StaticOrder S; S.init(ws + WS_H, DM, (bf16_t*)(ws + WS_WIN) + (size_t)j * 3072 * 1024, DM, T, 3072, GRID, BX);
                pg8::EpiConvIn E{(bf16_t*)(ws + WS_GB), (bf16_t*)(ws + WS_Z)}; pg8::gemm_phase(lds, g, S, E, TID); SEAM(pb + 1); }
            if (IN(pb + 2)) { unsigned char* ws = P_WS(); const int j = L >> 1;
                conv_phase((const bf16_t*)(ws + WS_GB), (const bf16_t*)(ws + WS_Z), P_IN(I_CK) + j * 3 * DM, (bf16_t*)(ws + WS_YC), GTID, NGT); SEAM(pb + 2); }
            if (IN(pb + 3)) { unsigned char* ws = P_WS(); const int j = L >> 1; const float* xsrc = (L == 0) ? P_IN(I_X) : P_OUT();
                pg8::Gemm g{DM, DM}; pg8::StaticOrder S; S.init(ws + WS_YC, DM, (bf16_t*)(ws + WS_WOUTC) + (size_t)j * 1024 * 1024, DM, T, DM, GRID, BX);
                pg8::EpiResid E{xsrc, P_OUT()}; pg8::gemm_phase(lds, g, S, E, TID); SEAM(pb + 5); }
        } else {
#if MK_ENABLE_MLA
            if (IN(pb + 0)) { unsigned char* ws = P_WS();
                norm_phase(P_OUT(), MK_ENABLE_MOE ? (const bf16_t*)(ws + WS_Y) : nullptr, P_OUT(), (bf16_t*)(ws + WS_H), GW, NGW, LANE); SEAM(pb + 0); }
            if (IN(pb + 1)) { unsigned char* ws = P_WS(); const int j = L >> 1;
                pg8::Gemm g{DM, DM}; pg8::StaticOrder S; S.init(ws + WS_H, DM, (bf16_t*)(ws + WS_WDOWN) + (size_t)j * LATP * 1024, DM, T, LATP, GRID, BX);
                pg8::EpiBf16 E{(bf16_t*)(ws + WS_LAT), LATP}; pg8::gemm_phase(lds, g, S, E, TID); SEAM(pb + 1); }
            if (IN(pb + 2)) {
                { unsigned char* ws = P_WS(); const int j = L >> 1;
                  pg8::Gemm g{LATP, QLR}; pg8::StaticOrder S; S.init(ws + WS_LAT, LATP, ws + WS_WQ + (size_t)j * 1536 * 1024, QLR, T, 1536, GRID, BX);
                  pg8::EpiBf16 E{(bf16_t*)(ws + WS_QRAW), 1536}; pg8::gemm_phase(lds, g, S, E, TID); }
                { unsigned char* ws = P_WS(); const int j = L >> 1;
                  pg8::Gemm g{LATP, KVLR}; pg8::StaticOrder S; S.init((bf16_t*)(ws + WS_LAT) + QLR, LATP, (bf16_t*)(ws + WS_WKV) + (size_t)j * 2048 * 256, KVLR, T, 2048, GRID, BX);
                  pg8::EpiBf16 E{(bf16_t*)(ws + WS_KVRAW), 2048}; pg8::gemm_phase(lds, g, S, E, TID); }
                SEAM(pb + 2); }
            if (IN(pb + 3)) { unsigned char* ws = P_WS(); const int j = L >> 1;
                qkprep_phase((const bf16_t*)(ws + WS_LAT), (const bf16_t*)(ws + WS_QRAW), (const bf16_t*)(ws + WS_KVRAW), (const int*)P_IN(I_POS),
                             P_IN(I_MQHN) + j * DQK, P_IN(I_MKHN) + j * DQK, (bf16_t*)(ws + WS_Q), (bf16_t*)(ws + WS_K), (bf16_t*)(ws + WS_V), lds, GW, NGW, WAVE, LANE); SEAM(pb + 3); }
            if (IN(pb + 4)) {
              for (int rep = 0; rep < REP_ATT; ++rep)
                for (int i = 0;; ++i) {
                    int bh, qb;
                    if (GRID == 256) { if (i >= 4) break; const int idx = i * 32 + (VCU & 31); bh = 2 * (VCU >> 5) + (idx >> 6); qb = idx & 63; }
                    else { const int k = i * GRID + BX; if (k >= NB * NH * 64) break; bh = k >> 6; qb = k & 63; }
                    const int b = bh >> 3, h = bh & 7; unsigned char* ws = P_WS();
                    att::attn_unit((const bf16_t*)(ws + WS_Q) + ((size_t)bh * SEQ + qb * 256) * DQK, (const bf16_t*)(ws + WS_K) + (size_t)bh * SEQ * DQK, (const bf16_t*)(ws + WS_V) + (size_t)bh * SEQ * DV,
                                   (bf16_t*)(ws + WS_O) + ((size_t)(b * SEQ + qb * 256)) * DM + h * DV, (char*)lds_raw, TID);
                }
                SEAM(pb + 4); }
            if (IN(pb + 5)) { unsigned char* ws = P_WS(); const int j = L >> 1;
                pg8::Gemm g{DM, DM}; pg8::StaticOrder S; S.init(ws + WS_O, DM, (bf16_t*)(ws + WS_WO) + (size_t)j * 1024 * 1024, DM, T, DM, GRID, BX);
                pg8::EpiResid E{P_OUT(), P_OUT()}; pg8::gemm_phase(lds, g, S, E, TID); SEAM(pb + 5); }
#else
            if (IN(pb + 0)) { unsigned char* ws = P_WS(); norm_phase(P_OUT(), MK_ENABLE_MOE ? (const bf16_t*)(ws + WS_Y) : nullptr, P_OUT(), nullptr, GW, NGW, LANE); SEAM(pb + 5); }
#endif
        }
#if MK_ENABLE_MOE
#define CNT ((gu32*)(ws + WS_CTL) + CW_CNT + L * 64)
#define EID ((int*)(ws + WS_RT + RT_EID))
#define RANK ((int*)(ws + WS_RT + RT_RANK))
#define GATE ((float*)(ws + WS_RT + RT_GATE))
#define SDEST ((int*)(ws + WS_RT + RT_SDEST))
#define SGATE ((float*)(ws + WS_RT + RT_SGATE))
        if (IN(pb + 6)) { unsigned char* ws = P_WS(); norm_phase(P_OUT(), nullptr, nullptr, (bf16_t*)(ws + WS_H), GW, NGW, LANE); SEAM(pb + 6); }
        if (IN(pb + 7)) { unsigned char* ws = P_WS();
            pg8::Gemm g{DM, DM}; pg8::StaticOrder S; S.init(ws + WS_H, DM, (bf16_t*)(ws + WS_WRT) + (size_t)L * 256 * 1024, DM, T, 256, GRID, BX);
            pg8::EpiLogits E{(float*)(ws + WS_LG)}; pg8::gemm_phase(lds, g, S, E, TID); SEAM(pb + 7); }
        if (IN(pb + 8)) { unsigned char* ws = P_WS();
            route_phase((const float*)(ws + WS_LG), P_IN(I_RBG) + L * 8, P_IN(I_RBE) + L * 64, CNT, EID, RANK, GATE, GTID, NGT); SEAM(pb + 8); }
        if (IN(pb + 9)) { unsigned char* ws = P_WS(); build_tables(CNT, TBL, PSTART, TID);
            scatter_phase((const bf16_t*)(ws + WS_H), EID, RANK, GATE, CNT, (bf16_t*)(ws + WS_XS), SDEST, SGATE, PSTART, GW, NGW, LANE, GTID, NGT); SEAM(pb + 9); }
        if (IN(pb + 10)) { unsigned char* ws = P_WS(); const int ntiles = build_tables(CNT, TBL, PSTART, TID);
            pg8::Gemm g{DM, DM}; pg8::GroupedOrder S{ntiles * 3, 3, GRID, VCU, (const char*)(ws + WS_XS), (const char*)(ws + WS_WE1) + (size_t)L * NE * 768 * 1024 * 2, (size_t)256 * DM * 2, (size_t)768 * 1024 * 2, (size_t)256 * 1024 * 2, TBL};
            pg8::EpiSwiGLU E{(bf16_t*)(ws + WS_HID)}; pg8::gemm_phase(lds, g, S, E, TID); SEAM(pb + 10); }
        if (IN(pb + 11)) { unsigned char* ws = P_WS(); const int ntiles = build_tables(CNT, TBL, PSTART, TID);
            pg8::Gemm g{DFF, DFF}; pg8::GroupedOrder S{ntiles * 4, 4, GRID, VCU, (const char*)(ws + WS_HID), (const char*)(ws + WS_WE2) + (size_t)L * NE * 1024 * DFF * 2, (size_t)256 * DFF * 2, (size_t)1024 * DFF * 2, (size_t)256 * DFF * 2, TBL};
            pg8::EpiScatterY E{(bf16_t*)(ws + WS_Y), SDEST, SGATE}; pg8::gemm_phase(lds, g, S, E, TID); SEAM(pb + 11); }
#endif
    }
    if (IN(49)) {
#if MK_ENABLE_MOE
        unsigned char* ws = P_WS(); norm_phase(P_OUT(), (const bf16_t*)(ws + WS_Y), P_OUT(), nullptr, GW, NGW, LANE);
#endif
    }
#undef IN
#undef SEAM
}

extern "C" void kernel_launch(void* const* d_in, const int* in_sizes, int n_in, void* d_out, int out_size, void* d_ws, size_t ws_size, hipStream_t stream) {
    static int grid = 0;
    if (grid == 0) {
        if (n_in != 23 || out_size != T * DM || ws_size < WS_END) { fprintf(stderr, "kernel_launch: unexpected shapes: n_in %d out %d ws %zu (need %zu)\n", n_in, out_size, ws_size, (size_t)WS_END); grid = -1; return; }
        int dev = 0, cus = 0, per_cu = 0;
        if (hipGetDevice(&dev) != hipSuccess || hipDeviceGetAttribute(&cus, hipDeviceAttributeMultiprocessorCount, dev) != hipSuccess) { grid = -1; return; }
        if (hipFuncSetAttribute((const void*)fwd, hipFuncAttributeMaxDynamicSharedMemorySize, LDS_BYTES) != hipSuccess) { fprintf(stderr, "kernel_launch: hipFuncSetAttribute failed\n"); grid = -1; return; }
        if (hipOccupancyMaxActiveBlocksPerMultiprocessor(&per_cu, (const void*)fwd, NWAVES * 64, LDS_BYTES) != hipSuccess || per_cu < 1) fprintf(stderr, "kernel_launch: occupancy query says %d\n", per_cu);
        (void)hipGetLastError();
        grid = cus;
    }
    if (grid < 0) return;
    if (hipMemsetAsync((char*)d_ws + WS_CTL, 0, CTL_ZERO_BYTES, stream) != hipSuccess) return;
    Args a{};
    for (int i = 0; i < 23; ++i) a.in[i] = d_in[i];
    a.out = (float*)d_out; a.ws = (unsigned char*)d_ws;
#if MK_ONE_LAUNCH
    a.ph_lo = 0; a.ph_hi = 50;
    hipLaunchKernelGGL(fwd, dim3(grid), dim3(NWAVES * 64), LDS_BYTES, stream, a);
#else
    for (int p = 0; p < 50; ++p) {
        if (p >= 1 && p < 49) { const int L = (p - 1) / 12, k = (p - 1) % 12;
            if (k < 6) { if ((L & 1) == 0) { if (k > 3) continue; } else { if (!MK_ENABLE_MLA && k > 0) continue; } }
            else if (!MK_ENABLE_MOE) continue; }
        if (p == 49 && !MK_ENABLE_MOE) continue;
        a.ph_lo = p; a.ph_hi = p + 1;
        hipLaunchKernelGGL(fwd, dim3(grid), dim3(NWAVES * 64), LDS_BYTES, stream, a);
    }
#endif
    const hipError_t le = hipPeekAtLastError();
    if (le != hipSuccess) fprintf(stderr, "kernel_launch: launch failed: %s\n", hipGetErrorName(le));
}
```

```cpp
#include <hip/hip_runtime.h>
#include <cstdio>
#include <cstdint>

#ifndef MK_ONE_LAUNCH
#define MK_ONE_LAUNCH 1
#endif
#ifndef REP_ATT
#define REP_ATT 1
#endif
#ifndef REP_PRO
#define REP_PRO 1
#endif
#ifndef MK_ENABLE_MLA
#define MK_ENABLE_MLA 1
#endif
#ifndef MK_ENABLE_MOE
#define MK_ENABLE_MOE 1
#endif

#define GAS __attribute__((address_space(1)))
#define LAS __attribute__((address_space(3)))
typedef unsigned short bf16_t;
typedef short bf16x8 __attribute__((ext_vector_type(8)));
typedef short s16x4 __attribute__((ext_vector_type(4)));
typedef float f32x2 __attribute__((ext_vector_type(2)));
typedef float f32x4 __attribute__((ext_vector_type(4)));
typedef float f32x16 __attribute__((ext_vector_type(16)));
typedef unsigned u32x2 __attribute__((ext_vector_type(2)));
typedef unsigned u32x4 __attribute__((ext_vector_type(4)));
typedef GAS unsigned gu32;

constexpr int DM = 1024, NB = 2, SEQ = 16384, T = NB * SEQ;
constexpr int NH = 8, QLR = 384, KVLR = 256, DNOPE = 128, DROPE = 64, DQK = 192, DV = 128, LAT = 704, LATP = 768;
constexpr int NE = 64, DFF = 384;
constexpr int NASSIGN = 2 * T;
constexpr int NSLOT = NASSIGN + NE * 256;
constexpr int MAXTILES = NSLOT / 256;
constexpr float EPS = 1e-6f;
constexpr int NWAVES = 8;

constexpr size_t MiB = 1u << 20;
constexpr size_t WS_CTL = 0, CTL_ZERO_BYTES = 1 * MiB;
constexpr size_t WS_WIN = 2 * MiB;
constexpr size_t WS_WOUTC = 14 * MiB;
constexpr size_t WS_WDOWN = 18 * MiB;
constexpr size_t WS_WQ = 21 * MiB;
constexpr size_t WS_WKV = 24 * MiB;
constexpr size_t WS_WO = 26 * MiB;
constexpr size_t WS_WRT = 30 * MiB;
constexpr size_t WS_WE1 = 32 * MiB;
constexpr size_t WS_WE2 = 416 * MiB;
constexpr size_t WS_H = 608 * MiB;
constexpr size_t WS_S = 672 * MiB;
constexpr size_t WS_GB = WS_S, WS_Z = WS_S + 64 * MiB, WS_YC = WS_S + 128 * MiB;
constexpr size_t WS_LAT = WS_S, WS_QRAW = WS_S + 48 * MiB, WS_KVRAW = WS_S + 144 * MiB;
constexpr size_t WS_Q = WS_S + 272 * MiB, WS_K = WS_S + 368 * MiB, WS_V = WS_S + 464 * MiB, WS_O = WS_QRAW;
constexpr size_t WS_XS = WS_S, WS_HID = WS_S + 160 * MiB, WS_Y = WS_S + 224 * MiB, WS_LG = WS_S + 352 * MiB;
constexpr size_t WS_RT = WS_S + 368 * MiB;
constexpr size_t WS_END = WS_S + 528 * MiB;
constexpr size_t RT_EID = 0, RT_RANK = 256 * 1024, RT_GATE = 512 * 1024, RT_SDEST = 768 * 1024, RT_SGATE = 768 * 1024 + 327680;
static_assert(RT_SGATE + 327680 <= 2 * MiB, "routing arrays");
constexpr int CW_TMO = 0, CW_CODE = 1, CW_BAR = 4096, CW_CNT = 8192  , CW_CHK = 12288;

constexpr int RING_BYTES = 131072;
constexpr int LDSCTL_OFF = RING_BYTES, MISC_OFF = LDSCTL_OFF + 320;
constexpr int TBL_OFF = LDSCTL_OFF + 1024;
constexpr int LDS_BYTES = 147456;

#define RLX_AGENT __ATOMIC_RELAXED, __HIP_MEMORY_SCOPE_AGENT
#define LDS_WAIT() asm volatile("s_waitcnt lgkmcnt(0)" ::: "memory")
#define VM_WAIT() asm volatile("s_waitcnt vmcnt(0)" ::: "memory")
__device__ __forceinline__ unsigned f2bf(float f) { unsigned u = __builtin_bit_cast(unsigned, f); return (u + 0x7fffu + ((u >> 16) & 1u)) >> 16; }
__device__ __forceinline__ unsigned pk2(float lo, float hi) { return f2bf(lo) | (f2bf(hi) << 16); }
__device__ __forceinline__ float bflo(unsigned w) { return __builtin_bit_cast(float, w << 16); }
__device__ __forceinline__ float bfhi(unsigned w) { return __builtin_bit_cast(float, w & 0xffff0000u); }
__device__ __forceinline__ float bf2f(bf16_t h) { return __builtin_bit_cast(float, (unsigned)h << 16); }
__device__ __forceinline__ unsigned cvt_pk_bf16(float lo, float hi) { unsigned r; asm volatile("v_cvt_pk_bf16_f32 %0, %1, %2" : "=v"(r) : "v"(lo), "v"(hi)); return r; }
__device__ __forceinline__ int tid_now(int wave_s) { int l; asm volatile("v_mbcnt_lo_u32_b32 %0, -1, 0\n\tv_mbcnt_hi_u32_b32 %0, -1, %0" : "=v"(l)); return wave_s * 64 + l; }
__device__ __forceinline__ int sgpr_now(int v) { asm volatile("" : "+s"(v)); return v; }
__device__ __forceinline__ float lane_xor_f(float v, int m, int lane) { return __builtin_bit_cast(float, __builtin_amdgcn_ds_bpermute((lane ^ m) << 2, __builtin_bit_cast(int, v))); }
__device__ __forceinline__ float wave_sum(float v, int lane) {
#pragma unroll
    for (int o = 1; o < 64; o <<= 1) v += lane_xor_f(v, o, lane);
    return v;
}

#define XB_TMO      128
#define XB_XCNT(j)  (256  + 64 * (j))
#define XB_XSUB(j)  (1280 + 64 * (j))
#define XB_XGEN(j)  (2304 + 64 * (j))
#define XB_TOP      3328
#define XB_TOPGEN   3392
#define XCD_BAR_WORDS 3456
#define XB_SPIN_CAP (1u << 18)
__device__ __forceinline__ unsigned xb_ld(unsigned* p)              { return __hip_atomic_load(p, __ATOMIC_RELAXED, __HIP_MEMORY_SCOPE_AGENT); }
__device__ __forceinline__ unsigned xb_add(unsigned* p, unsigned v) { return __hip_atomic_fetch_add(p, v, __ATOMIC_RELAXED, __HIP_MEMORY_SCOPE_AGENT); }
__device__ __forceinline__ unsigned xb_xcc_id() { return (unsigned)__builtin_amdgcn_s_getreg((3 << 11) | 20) & 0xFu; }
#define XB_SPIN(cond, bar) do { unsigned _sp = 0; while (cond) { __builtin_amdgcn_s_sleep(1); \
    if ((++_sp & 255u) == 0u) { if (xb_ld(&(bar)[XB_TMO])) break; if (_sp > XB_SPIN_CAP) { atomicAdd(&(bar)[XB_TMO], 1u); break; } } } } while (0)
struct XcdBarrier { unsigned* bar; unsigned x; volatile LAS unsigned* st; };
__device__ __forceinline__ XcdBarrier xcd_barrier_post(unsigned* bar, volatile LAS unsigned* st, bool leader) {
    XcdBarrier b; b.bar = bar; b.x = xb_xcc_id(); b.st = st;
    if (leader) (void)xb_add(&bar[XB_XCNT(b.x)], 1u);
    return b;
}
__device__ __forceinline__ void xcd_barrier_complete(unsigned* bar, unsigned x, unsigned& nloc, unsigned& nx) {
    const unsigned G = gridDim.x * gridDim.y * gridDim.z;
    unsigned sum, cnt, mine, sp = 0u;
    for (;;) {
        sum = 0u; cnt = 0u; mine = 0u;
#pragma unroll
        for (unsigned j = 0; j < 16; ++j) { const unsigned c = xb_ld(&bar[XB_XCNT(j)]); sum += c; cnt += (c > 0u) ? 1u : 0u; mine = (j == x) ? c : mine; }
        if (sum == G) break;
        __builtin_amdgcn_s_sleep(1);
        if ((++sp & 255u) == 0u) { if (xb_ld(&bar[XB_TMO])) break; if (sp > XB_SPIN_CAP) { atomicAdd(&bar[XB_TMO], 1u); break; } }
    }
    nloc = mine > 0u ? mine : 1u; nx = cnt > 0u ? cnt : 1u;
}
__device__ __forceinline__ void xcd_barrier(const XcdBarrier& b, bool leader) {
    asm volatile("s_waitcnt vmcnt(0)" ::: "memory");
    __syncthreads();
    if (leader) {
        unsigned* bar = b.bar;
        __builtin_amdgcn_s_waitcnt(0);
        unsigned nloc = b.st[0], nx = b.st[1];
        if (nloc == 0u) { xcd_barrier_complete(bar, b.x, nloc, nx); b.st[0] = nloc; b.st[1] = nx; }
        const unsigned old = xb_add(&bar[XB_XSUB(b.x)], 1u);
        const unsigned gen = old / nloc;
        if (old + 1u == (gen + 1u) * nloc) {
            __builtin_amdgcn_fence(__ATOMIC_RELEASE, "agent");
            asm volatile("s_waitcnt vmcnt(0)" ::: "memory");
            const unsigned og = xb_add(&bar[XB_TOP], 1u);
            const unsigned tg = og / nx;
            if (og + 1u == (tg + 1u) * nx) xb_add(&bar[XB_TOPGEN], 1u);
            else XB_SPIN(xb_ld(&bar[XB_TOPGEN]) == tg, bar);
            __builtin_amdgcn_fence(__ATOMIC_ACQUIRE, "agent");
            xb_add(&bar[XB_XGEN(b.x)], 1u);
            asm volatile("s_waitcnt vmcnt(0)" ::: "memory");
        } else {
            XB_SPIN(xb_ld(&bar[XB_XGEN(b.x)]) == gen, bar);
            __builtin_amdgcn_fence(__ATOMIC_ACQUIRE, "agent");
            asm volatile("s_waitcnt vmcnt(0)" ::: "memory");
        }
    }
    __syncthreads();
}

namespace pg8 {
constexpr int BM = 256, BK = 64, HALF = 128, HTB = HALF * BK * 2, NXCD = 8, WGM = 8;
__host__ __device__ __forceinline__ int lds_byte(int r, int c) { const int st = (r >> 4) * 2 + (c >> 5), rr = r & 15, cc = c & 31, ob = rr * 64 + cc * 2; return st * 1024 + (ob ^ (((ob >> 9) & 1) << 5)); }
__host__ __device__ __forceinline__ void stage_rc(int b, int& R, int& C) { const int st = b / 1024, sb = b % 1024, swz = sb ^ (((sb >> 9) & 1) << 5); R = (st >> 1) * 16 + swz / 64; C = (st & 1) * 32 + (swz % 64) / 2; }
__host__ __device__ __forceinline__ int perm32(int rho) { const int n = rho >> 4, i = rho & 15; return 8 * (i >> 2) + 4 * n + (i & 3); }

struct Unit { const char* A; const char* B; int pm, pn; };
struct Gemm { int lda, K; };

struct StaticOrder {
    int nM, nN, nwg, G, c; const char* A; const char* B; size_t astep, bstep;
    __device__ void init(const void* A_, int lda, const void* B_, int K, int M, int N, int G_, int c_) { nM = M / BM; nN = N / BM; nwg = nM * nN; G = G_; c = c_; A = (const char*)A_; B = (const char*)B_; astep = (size_t)BM * lda * 2; bstep = (size_t)BM * K * 2; }
    __device__ __forceinline__ bool next(int i, Unit& u) const {
        const long L = (long)i * G + c; if (L >= nwg) return false;
        int wgid = (int)L; { const int q = nwg / NXCD, r = nwg % NXCD, xcd = wgid % NXCD, off = wgid / NXCD; wgid = (xcd < r ? xcd * (q + 1) : r * (q + 1) + (xcd - r) * q) + off; }
        const int nig = WGM * nN, gid = wgid / nig, fm = gid * WGM, gsz = (nM - fm) < WGM ? (nM - fm) : WGM;
        u.pm = fm + ((wgid % nig) % gsz); u.pn = (wgid % nig) / gsz; u.A = A + (size_t)u.pm * astep; u.B = B + (size_t)u.pn * bstep; return true;
    }
};
struct GroupedOrder {
    int n_units, nN, G, c; const char* A; const char* B; size_t astep, bexp, bstep; const LAS int* tbl;
    __device__ __forceinline__ bool next(int i, Unit& u) const {
        const int L = i * G + c; if (L >= n_units) return false;
        const int tile = L / nN, pn = L - tile * nN; const int e = __builtin_amdgcn_readfirstlane(tbl[tile]);
        u.pm = tile; u.pn = pn; u.A = A + (size_t)tile * astep; u.B = B + (size_t)e * bexp + (size_t)pn * bstep; return true;
    }
};

typedef f32x4 Acc[2][2][4][2];

struct EpiBf16 {
    static constexpr bool PERM = true;
    bf16_t* O; int ldc;
    __device__ __forceinline__ void operator()(const Acc& acc, const Unit& u, int wr, int wc, int fr, int fq) const {
        const int row0 = u.pm * BM + wr * 64 + fr, col0 = u.pn * BM + wc * 32 + 8 * fq;
#pragma unroll
        for (int ai = 0; ai < 2; ++ai)
#pragma unroll
            for (int m = 0; m < 4; ++m) { bf16_t* rowp = O + (size_t)(row0 + ai * HALF + m * 16) * ldc + col0;
#pragma unroll
                for (int bj = 0; bj < 2; ++bj) { const f32x4 v0 = acc[ai][bj][m][0], v1 = acc[ai][bj][m][1];
                    u32x4 w; w.x = cvt_pk_bf16(v0[0], v0[1]); w.y = cvt_pk_bf16(v0[2], v0[3]); w.z = cvt_pk_bf16(v1[0], v1[1]); w.w = cvt_pk_bf16(v1[2], v1[3]);
                    *(u32x4*)(rowp + bj * HALF) = w; } }
    }
};
struct EpiConvIn {
    static constexpr bool PERM = true;
    bf16_t* GBp; bf16_t* Zp;
    __device__ __forceinline__ void operator()(const Acc& acc, const Unit& u, int wr, int wc, int fr, int fq) const {
        const int row0 = u.pm * BM + wr * 64 + fr;
        if (u.pn < 4) {
            const int col0 = u.pn * BM + wc * 32 + 8 * fq;
#pragma unroll
            for (int ai = 0; ai < 2; ++ai)
#pragma unroll
                for (int m = 0; m < 4; ++m) { bf16_t* rowp = GBp + (size_t)(row0 + ai * HALF + m * 16) * DM + col0;
#pragma unroll
                    for (int bj = 0; bj < 2; ++bj) { const f32x4 v0 = acc[ai][bj][m][0], v1 = acc[ai][bj][m][1];
                        u32x4 w; w.x = cvt_pk_bf16(v0[0], v0[1]); w.y = cvt_pk_bf16(v0[2], v0[3]); w.z = cvt_pk_bf16(v1[0], v1[1]); w.w = cvt_pk_bf16(v1[2], v1[3]);
                        *(u32x4*)(rowp + bj * HALF) = w; } }
        } else {
            const int col0 = (u.pn - 4) * HALF + wc * 32 + 8 * fq;
#pragma unroll
            for (int ai = 0; ai < 2; ++ai)
#pragma unroll
                for (int m = 0; m < 4; ++m) { bf16_t* rowp = Zp + (size_t)(row0 + ai * HALF + m * 16) * DM + col0;
                    const f32x4 v0 = acc[ai][0][m][0] * acc[ai][1][m][0], v1 = acc[ai][0][m][1] * acc[ai][1][m][1];
                    u32x4 w; w.x = cvt_pk_bf16(v0[0], v0[1]); w.y = cvt_pk_bf16(v0[2], v0[3]); w.z = cvt_pk_bf16(v1[0], v1[1]); w.w = cvt_pk_bf16(v1[2], v1[3]);
                    *(u32x4*)rowp = w; }
        }
    }
};
__device__ __forceinline__ float silu_mul(float g, float u) { return g * __builtin_amdgcn_rcpf(1.f + __expf(-g)) * u; }
struct EpiSwiGLU {
    static constexpr bool PERM = true;
    bf16_t* Hd;
    __device__ __forceinline__ void operator()(const Acc& acc, const Unit& u, int wr, int wc, int fr, int fq) const {
        const int row0 = u.pm * BM + wr * 64 + fr, col0 = u.pn * HALF + wc * 32 + 8 * fq;
#pragma unroll
        for (int ai = 0; ai < 2; ++ai)
#pragma unroll
            for (int m = 0; m < 4; ++m) { bf16_t* rowp = Hd + (size_t)(row0 + ai * HALF + m * 16) * DFF + col0;
                f32x4 v0, v1;
#pragma unroll
                for (int q = 0; q < 4; ++q) { v0[q] = silu_mul(acc[ai][0][m][0][q], acc[ai][1][m][0][q]); v1[q] = silu_mul(acc[ai][0][m][1][q], acc[ai][1][m][1][q]); }
                u32x4 w; w.x = cvt_pk_bf16(v0[0], v0[1]); w.y = cvt_pk_bf16(v0[2], v0[3]); w.z = cvt_pk_bf16(v1[0], v1[1]); w.w = cvt_pk_bf16(v1[2], v1[3]);
                *(u32x4*)rowp = w; }
    }
};
struct EpiResid {
    static constexpr bool PERM = false;
    const float* xin; float* xout;
    __device__ __forceinline__ void operator()(const Acc& acc, const Unit& u, int wr, int wc, int fr, int fq) const {
        const int row0 = u.pm * BM + wr * 64 + fr, col0 = u.pn * BM + wc * 32 + 4 * fq;
#pragma unroll
        for (int ai = 0; ai < 2; ++ai)
#pragma unroll
            for (int m = 0; m < 4; ++m) { const size_t off = (size_t)(row0 + ai * HALF + m * 16) * DM + col0;
#pragma unroll
                for (int bj = 0; bj < 2; ++bj)
#pragma unroll
                    for (int n = 0; n < 2; ++n) { const f32x4 xv = *(const f32x4*)(xin + off + bj * HALF + n * 16); *(f32x4*)(xout + off + bj * HALF + n * 16) = xv + acc[ai][bj][m][n]; } }
    }
};
struct EpiLogits {
    static constexpr bool PERM = false;
    float* LG;
    __device__ __forceinline__ void operator()(const Acc& acc, const Unit& u, int wr, int wc, int fr, int fq) const {
        const int row0 = u.pm * BM + wr * 64 + fr, col0 = wc * 32 + 4 * fq;
#pragma unroll
        for (int ai = 0; ai < 2; ++ai)
#pragma unroll
            for (int m = 0; m < 4; ++m) { const size_t off = (size_t)(row0 + ai * HALF + m * 16) * 128 + col0;
#pragma unroll
                for (int n = 0; n < 2; ++n) *(f32x4*)(LG + off + n * 16) = acc[ai][0][m][n]; }
    }
};
struct EpiScatterY {
    static constexpr bool PERM = true;
    bf16_t* Y; const int* sdest; const float* sgate;
    __device__ __forceinline__ void operator()(const Acc& acc, const Unit& u, int wr, int wc, int fr, int fq) const {
        const int row0 = u.pm * BM + wr * 64 + fr, col0 = u.pn * BM + wc * 32 + 8 * fq;
#pragma unroll
        for (int ai = 0; ai < 2; ++ai)
#pragma unroll
            for (int m = 0; m < 4; ++m) { const int slot = row0 + ai * HALF + m * 16; const int d = sdest[slot]; const float g = sgate[slot];
                if (d >= 0) { bf16_t* rowp = Y + (size_t)d * DM + col0;
#pragma unroll
                    for (int bj = 0; bj < 2; ++bj) { const f32x4 v0 = acc[ai][bj][m][0] * g, v1 = acc[ai][bj][m][1] * g;
                        u32x4 w; w.x = cvt_pk_bf16(v0[0], v0[1]); w.y = cvt_pk_bf16(v0[2], v0[3]); w.z = cvt_pk_bf16(v1[0], v1[1]); w.w = cvt_pk_bf16(v1[2], v1[3]);
                        *(u32x4*)(rowp + bj * HALF) = w; } }
                asm volatile("" ::: "memory"); }
    }
};

template <class Epi, class Sched>
__device__ __forceinline__ void gemm_phase(LAS unsigned char* lds, const Gemm g, const Sched& S, const Epi& E, int tid) {
    const int wid = __builtin_amdgcn_readfirstlane(tid >> 6), lane = tid & 63, wr = wid >> 2, wc = wid & 3, fr = lane & 15, fq = lane >> 4;
    const int K = g.K, lda = g.lda, nt = K / BK;
    unsigned voffA[2], voffB[2];
#pragma unroll
    for (int i = 0; i < 2; ++i) { int R, C; stage_rc(tid * 16 + i * 8192, R, C); const int Rb = Epi::PERM ? ((R & ~31) + perm32(R & 31)) : R;
        voffA[i] = (unsigned)(R * lda + C) * 2u; voffB[i] = (unsigned)(Rb * K + C) * 2u; }
    const size_t kstep = (size_t)(BK * 2);
    const size_t hstepA = (size_t)HALF * lda * 2, hstepB = (size_t)HALF * K * 2;
    const unsigned ldsw = (unsigned)wid * 1024u;
    const int aoff = lds_byte(wr * 64 + fr, fq * 8), boff = lds_byte(wc * 32 + fr, fq * 8);
#define PG8_SA(b, h) (((b) * 2 + (h)) * HTB)
#define PG8_SB(b, h) ((4 + (b) * 2 + (h)) * HTB)
#define PG8_STAGE(bufoff, gbase, voff) do { _Pragma("unroll") for (int _i = 0; _i < 2; ++_i) \
        __builtin_amdgcn_global_load_lds((const unsigned*)((const char*)(gbase) + (voff)[_i]), (LAS unsigned*)(lds + (bufoff) + ldsw + _i * 8192), 16, 0, 0); } while (0)
#define PG8_LDA(dst, b, h) do { _Pragma("unroll") for (int m = 0; m < 4; ++m) _Pragma("unroll") for (int k = 0; k < 2; ++k) dst[m][k] = *(const LAS bf16x8*)(lds + PG8_SA(b, h) + aoff + m * 2048 + k * 1024); } while (0)
#define PG8_LDB(dst, b, h) do { _Pragma("unroll") for (int n = 0; n < 2; ++n) _Pragma("unroll") for (int k = 0; k < 2; ++k) dst[n][k] = *(const LAS bf16x8*)(lds + PG8_SB(b, h) + boff + n * 2048 + k * 1024); } while (0)
#define PG8_MMA(ai, bj, At, Bt) do { __builtin_amdgcn_s_setprio(1); _Pragma("unroll") for (int m = 0; m < 4; ++m) _Pragma("unroll") for (int n = 0; n < 2; ++n) _Pragma("unroll") for (int k = 0; k < 2; ++k) \
        acc[ai][bj][m][n] = __builtin_amdgcn_mfma_f32_16x16x32_bf16(Bt[n][k], At[m][k], acc[ai][bj][m][n], 0, 0, 0); __builtin_amdgcn_s_setprio(0); } while (0)
#define PG8_WAIT_V(n) asm volatile("s_waitcnt vmcnt(" #n ")" ::: "memory")
#define PG8_WAIT_L(n) asm volatile("s_waitcnt lgkmcnt(" #n ")" ::: "memory")
#define PG8_BAR __builtin_amdgcn_s_barrier()
#define PG8_SCHED __builtin_amdgcn_sched_barrier(0)
    Unit cur, nxt; int ui = 0;
    if (!S.next(0, cur)) return;
    Acc acc;
#pragma unroll
    for (int a = 0; a < 2; ++a)
#pragma unroll
        for (int b = 0; b < 2; ++b)
#pragma unroll
            for (int m = 0; m < 4; ++m)
#pragma unroll
                for (int n = 0; n < 2; ++n) acc[a][b][m][n] = (f32x4){0.f, 0.f, 0.f, 0.f};
    bf16x8 At[4][2], B0[2][2], B1[2][2];
    const char* cA = cur.A; const char* cB = cur.B;
    PG8_STAGE(PG8_SB(0, 0), cB, voffB); PG8_STAGE(PG8_SB(0, 1), cB + hstepB, voffB); PG8_STAGE(PG8_SA(0, 0), cA, voffA); PG8_STAGE(PG8_SA(0, 1), cA + hstepA, voffA);
    if (wr == 1) PG8_BAR;
    PG8_WAIT_V(2); PG8_BAR;
    PG8_STAGE(PG8_SB(1, 0), cB + kstep, voffB); PG8_STAGE(PG8_SA(1, 0), cA + kstep, voffA); PG8_STAGE(PG8_SB(1, 1), cB + hstepB + kstep, voffB);
    PG8_WAIT_V(6); PG8_BAR;
    for (;;) {
        const bool has_next = S.next(ui + 1, nxt);
        const char* nA = has_next ? nxt.A : cA; const char* nB = has_next ? nxt.B : cB;
        for (int t = 0; t < nt; t += 2) {
            const bool last = (t == nt - 2);
            const char* a1 = cA + (size_t)(t + 1) * kstep;
            const char* a2 = last ? nA : cA + (size_t)(t + 2) * kstep; const char* b2 = last ? nB : cB + (size_t)(t + 2) * kstep;
            const char* a3 = a2 + kstep; const char* b3 = b2 + kstep;
            PG8_LDB(B0, 0, 0); PG8_LDB(B1, 0, 1); PG8_SCHED; PG8_LDA(At, 0, 0); PG8_STAGE(PG8_SA(1, 1), a1 + hstepA, voffA);
            PG8_WAIT_V(8); PG8_WAIT_L(0); PG8_BAR; PG8_MMA(0, 0, At, B0); PG8_MMA(0, 1, At, B1); PG8_BAR; PG8_SCHED;
            PG8_LDA(At, 0, 1); PG8_STAGE(PG8_SB(0, 0), b2, voffB); PG8_STAGE(PG8_SB(0, 1), b2 + hstepB, voffB); PG8_STAGE(PG8_SA(0, 0), a2, voffA);
            PG8_WAIT_V(8); PG8_WAIT_L(0); PG8_BAR; PG8_MMA(1, 0, At, B0); PG8_MMA(1, 1, At, B1); PG8_BAR; PG8_SCHED;
            PG8_LDB(B0, 1, 0); PG8_LDB(B1, 1, 1); PG8_SCHED; PG8_LDA(At, 1, 0); PG8_STAGE(PG8_SA(0, 1), a2 + hstepA, voffA);
            PG8_WAIT_V(8); PG8_WAIT_L(0); PG8_BAR; PG8_MMA(0, 0, At, B0); PG8_MMA(0, 1, At, B1); PG8_BAR; PG8_SCHED;
            PG8_LDA(At, 1, 1); PG8_STAGE(PG8_SB(1, 0), b3, voffB); PG8_STAGE(PG8_SB(1, 1), b3 + hstepB, voffB); PG8_STAGE(PG8_SA(1, 0), a3, voffA);
            PG8_WAIT_V(8); PG8_WAIT_L(0); PG8_BAR; PG8_MMA(1, 0, At, B0); PG8_MMA(1, 1, At, B1); PG8_BAR; PG8_SCHED;
        }
        if (wr == 0) PG8_BAR;
        E(acc, cur, wr, wc, fr, fq);
        if (!has_next) break;
#pragma unroll
        for (int a = 0; a < 2; ++a)
#pragma unroll
            for (int b = 0; b < 2; ++b)
#pragma unroll
                for (int m = 0; m < 4; ++m)
#pragma unroll
                    for (int n = 0; n < 2; ++n) acc[a][b][m][n] = (f32x4){0.f, 0.f, 0.f, 0.f};
        cur = nxt; cA = nA; cB = nB; ++ui;
        if (wr == 1) PG8_BAR;
    }
    PG8_WAIT_V(0);
    PG8_BAR;
#undef PG8_SA
#undef PG8_SB
#undef PG8_STAGE
#undef PG8_LDA
#undef PG8_LDB
#undef PG8_MMA
#undef PG8_WAIT_V
#undef PG8_WAIT_L
#undef PG8_BAR
#undef PG8_SCHED
}
}

namespace att {
constexpr int NW = 8, QBLK = 32, KVBLK = 64;
constexpr float SCALE = 0.07216878364870322f;
constexpr float THR = 8.f;
#ifndef ATT_SDEPTH
#define ATT_SDEPTH 2
#endif
constexpr int SDEPTH = ATT_SDEPTH;
constexpr int KROW = 400;
constexpr int SHM_V = KVBLK * DV * 2, SHM_K = KVBLK * KROW;
#ifndef ATT_NQR
#define ATT_NQR 8
#endif
constexpr int NQR = ATT_NQR;
constexpr int QLROW = (12 - NQR) * 32 + 16;
constexpr int OFF_V = 0, OFF_K = 2 * SHM_V, OFF_WS = OFF_K + 2 * SHM_K, OFF_QL = OFF_WS + NW * 64 * 4, ATT_LDS = OFF_QL + NW * 32 * QLROW;
static_assert(ATT_LDS <= RING_BYTES, "attention LDS");
#define SBAR() __builtin_amdgcn_sched_barrier(0)
__device__ __forceinline__ int crow(int r, int hi) { return (r & 3) + 8 * (r >> 2) + 4 * hi; }
__device__ __forceinline__ void partialSM(f32x16& p0, f32x16& p1, float& m_reg, float& mn, float& alpha) {
    constexpr float C = SCALE * 1.4426950408889634f;
    float pmax = p0[0];
#pragma unroll
    for (int r = 1; r < 16; ++r) pmax = fmaxf(pmax, p0[r]);
#pragma unroll
    for (int r = 0; r < 16; ++r) pmax = fmaxf(pmax, p1[r]);
    { auto rr = __builtin_amdgcn_permlane32_swap(__float_as_uint(pmax), __float_as_uint(pmax), false, false);
      pmax = fmaxf(__uint_as_float(rr[0]), __uint_as_float(rr[1])); }
    if (__builtin_expect(__all(pmax - m_reg <= THR / SCALE), 1)) { mn = m_reg; alpha = 1.f; }
    else { mn = fmaxf(m_reg, pmax); alpha = __builtin_amdgcn_exp2f((m_reg - mn) * C); m_reg = mn; }
    const float mnC = -mn * C;
#pragma unroll
    for (int r = 0; r < 16; ++r) p0[r] = fmaf(p0[r], C, mnC);
#pragma unroll
    for (int r = 0; r < 16; ++r) p1[r] = fmaf(p1[r], C, mnC);
#pragma unroll
    for (int r = 0; r < 16; ++r) p0[r] = __builtin_amdgcn_exp2f(p0[r]);
}
__device__ __forceinline__ void finishSM(f32x16& p0, f32x16& p1, float alpha, float& l_reg, bf16x8& pa0, bf16x8& pa1, bf16x8& pa2, bf16x8& pa3) {
#pragma unroll
    for (int r = 0; r < 16; ++r) p1[r] = __builtin_amdgcn_exp2f(p1[r]);
    float ps = 0;
#pragma unroll
    for (int r = 0; r < 16; ++r) ps += p0[r];
#pragma unroll
    for (int r = 0; r < 16; ++r) ps += p1[r];
    { auto rr = __builtin_amdgcn_permlane32_swap(__float_as_uint(ps), __float_as_uint(ps), false, false);
      ps = __uint_as_float(rr[0]) + __uint_as_float(rr[1]); }
    l_reg = l_reg * alpha + ps;
#define PK4(P, BASE, OUT) do { unsigned a0 = cvt_pk_bf16(P[BASE + 0], P[BASE + 1]), a1 = cvt_pk_bf16(P[BASE + 2], P[BASE + 3]);   \
    unsigned b0 = cvt_pk_bf16(P[BASE + 4], P[BASE + 5]), b1 = cvt_pk_bf16(P[BASE + 6], P[BASE + 7]);                              \
    auto r0 = __builtin_amdgcn_permlane32_swap(a0, b0, false, false); auto r1 = __builtin_amdgcn_permlane32_swap(a1, b1, false, false); \
    u32x4 w = {r0[0], r1[0], r0[1], r1[1]}; OUT = *reinterpret_cast<bf16x8*>(&w); } while (0)
    PK4(p0, 0, pa0); PK4(p0, 8, pa1); PK4(p1, 0, pa2); PK4(p1, 8, pa3);
#undef PK4
}
__device__ __forceinline__ void qkt(f32x16& p0, f32x16& p1, const char* Ks, const bf16x8* qr, const char* ql, int r32, int hi) {
    p0 = f32x16{}; p1 = f32x16{};
#pragma unroll
    for (int d0 = 0; d0 < 12; ++d0) { const int cb = d0 * 32 + hi * 16;
        const bf16x8 b0 = *reinterpret_cast<const bf16x8*>(Ks + r32 * KROW + cb);
        const bf16x8 b1 = *reinterpret_cast<const bf16x8*>(Ks + (32 + r32) * KROW + cb);
        const bf16x8 qf = (d0 < NQR) ? qr[d0] : *reinterpret_cast<const bf16x8*>(ql + (d0 - NQR) * 32);
        p0 = __builtin_amdgcn_mfma_f32_32x32x16_bf16(b0, qf, p0, 0, 0, 0);
        p1 = __builtin_amdgcn_mfma_f32_32x32x16_bf16(b1, qf, p1, 0, 0, 0); }
}
__device__ __forceinline__ int v_st(int k, int c) { const int kk = (k & ~0xC) | ((k & 4) << 1) | ((k & 8) >> 1); return ((kk >> 3) * 4 + (c >> 5)) * 512 + ((kk & 7) * 32 + (c & 31)) * 2; }
__device__ __forceinline__ int v_rd_base(int lane) { return ((lane & 3) << 3) | (((lane >> 2) & 3) << 6) | (((lane >> 4) & 1) << 5) | (((lane >> 5) & 1) << 8); }
constexpr int v_rd_off(int d0, int ks, int half) { return d0 * 512 + ks * 4096 + half * 2048; }
template <int OFF> __device__ __forceinline__ s16x4 tr_read(int vb) {
    s16x4 r; asm volatile("ds_read_b64_tr_b16 %0, %1 offset:%2" : "=&v"(r) : "v"(vb), "i"(OFF) : "memory"); return r;
}
template <int D0> __device__ __forceinline__ void pv_one(f32x16& od, int vb, bf16x8 pa0, bf16x8 pa1, bf16x8 pa2, bf16x8 pa3) {
    const s16x4 l0 = tr_read<v_rd_off(D0, 0, 0)>(vb), h0 = tr_read<v_rd_off(D0, 0, 1)>(vb), l1 = tr_read<v_rd_off(D0, 1, 0)>(vb), h1 = tr_read<v_rd_off(D0, 1, 1)>(vb);
    const s16x4 l2 = tr_read<v_rd_off(D0, 2, 0)>(vb), h2 = tr_read<v_rd_off(D0, 2, 1)>(vb), l3 = tr_read<v_rd_off(D0, 3, 0)>(vb), h3 = tr_read<v_rd_off(D0, 3, 1)>(vb);
    asm volatile("s_waitcnt lgkmcnt(0)" ::: "memory"); SBAR();
#define PK(L, H) (bf16x8){L[0], L[1], L[2], L[3], H[0], H[1], H[2], H[3]}
    od = __builtin_amdgcn_mfma_f32_32x32x16_bf16(pa0, PK(l0, h0), od, 0, 0, 0);
    od = __builtin_amdgcn_mfma_f32_32x32x16_bf16(pa1, PK(l1, h1), od, 0, 0, 0);
    od = __builtin_amdgcn_mfma_f32_32x32x16_bf16(pa2, PK(l2, h2), od, 0, 0, 0);
    od = __builtin_amdgcn_mfma_f32_32x32x16_bf16(pa3, PK(l3, h3), od, 0, 0, 0);
#undef PK
}
__device__ __forceinline__ void pv_d0(f32x16* o, int vb, bf16x8 pa0, bf16x8 pa1, bf16x8 pa2, bf16x8 pa3) {
    pv_one<0>(o[0], vb, pa0, pa1, pa2, pa3); pv_one<1>(o[1], vb, pa0, pa1, pa2, pa3); pv_one<2>(o[2], vb, pa0, pa1, pa2, pa3); pv_one<3>(o[3], vb, pa0, pa1, pa2, pa3);
}
__device__ __forceinline__ void attn_unit(const bf16_t* __restrict__ Qb, const bf16_t* __restrict__ Kh, const bf16_t* __restrict__ Vh, bf16_t* __restrict__ Ob, char* lds, int tid) {
    const int wid = tid >> 6, lane = tid & 63, r32 = lane & 31, hi = lane >> 5;
    char* V_lds = lds + OFF_V; char* K_lds = lds + OFF_K;
    float* ws = (float*)(lds + OFF_WS) + wid * 64; float* li_l = ws; float* al_l = ws + 32;
    float m_reg = -1e30f, l_reg = 0; f32x16 o[4] = {}; bf16x8 qr[NQR];
    const bf16_t* Qw = Qb + (long)(wid * QBLK + r32) * DQK + hi * 8;
#pragma unroll
    for (int d0 = 0; d0 < NQR; ++d0) qr[d0] = *reinterpret_cast<const bf16x8*>(Qw + d0 * 16);
    char* ql = lds + OFF_QL + wid * (32 * QLROW) + r32 * QLROW + hi * 16;
#pragma unroll
    for (int d0 = NQR; d0 < 12; ++d0) *reinterpret_cast<bf16x8*>(ql + (d0 - NQR) * 32) = *reinterpret_cast<const bf16x8*>(Qw + d0 * 16);
    const int sr = tid >> 4, sc = (tid & 15) * 8, vst0 = v_st(sr, sc), vst1 = v_st(32 + sr, sc);
    int kst[3];
#pragma unroll
    for (int i = 0; i < 3; ++i) { const int q = tid + 512 * i; kst[i] = (q / 24) * KROW + (q % 24) * 16; }
    const int vb0 = (int)(uintptr_t)V_lds + v_rd_base(lane);
    struct { bf16x8 vs0, vs1, ks0, ks1, ks2; } sr_[SDEPTH];
#define SLOAD(i, k0) do { sr_[i].vs0 = *reinterpret_cast<const bf16x8*>(&Vh[(long)((k0) + sr) * DV + sc]); sr_[i].vs1 = *reinterpret_cast<const bf16x8*>(&Vh[(long)((k0) + 32 + sr) * DV + sc]); \
    const bf16_t* kp_ = Kh + (long)(k0) * DQK + tid * 8; sr_[i].ks0 = *reinterpret_cast<const bf16x8*>(kp_); sr_[i].ks1 = *reinterpret_cast<const bf16x8*>(kp_ + 4096); sr_[i].ks2 = *reinterpret_cast<const bf16x8*>(kp_ + 8192); } while (0)
#define SWRITE(b, i) do { *(bf16x8*)(V_lds + (b) * SHM_V + vst0) = sr_[i].vs0; *(bf16x8*)(V_lds + (b) * SHM_V + vst1) = sr_[i].vs1; \
    *(bf16x8*)(K_lds + (b) * SHM_K + kst[0]) = sr_[i].ks0; *(bf16x8*)(K_lds + (b) * SHM_K + kst[1]) = sr_[i].ks1; *(bf16x8*)(K_lds + (b) * SHM_K + kst[2]) = sr_[i].ks2; } while (0)
#define SWAIT() do { if constexpr (SDEPTH == 2) asm volatile("s_waitcnt vmcnt(5)" ::: "memory"); else asm volatile("s_waitcnt vmcnt(0)" ::: "memory"); } while (0)
#define RESC(a) do { if (__any((a) < 1.f)) { if (hi == 0) al_l[r32] = (a); asm volatile("s_waitcnt lgkmcnt(0)" ::: "memory"); \
    _Pragma("unroll") for (int d = 0; d < 4; ++d) _Pragma("unroll") for (int r = 0; r < 16; ++r) o[d][r] *= al_l[crow(r, hi)]; } } while (0)
    f32x16 pA0, pA1, pB0, pB1; float mnA, mnB, alA, alB; bf16x8 pa0, pa1, pa2, pa3; constexpr int NT = SEQ / KVBLK;
    constexpr int SE = 0, SO = SDEPTH - 1;
    SLOAD(SE, 0); asm volatile("s_waitcnt vmcnt(0)" ::: "memory"); SWRITE(0, SE); __syncthreads();
    qkt(pA0, pA1, K_lds, qr, ql, r32, hi); partialSM(pA0, pA1, m_reg, mnA, alA);
    SLOAD(SO, KVBLK); if constexpr (SDEPTH == 2) SLOAD(SE, 2 * KVBLK);
    SWAIT(); SWRITE(1, SO); __syncthreads();
    for (int j = 1; j + 1 < NT; j += 2) {
        SBAR(); qkt(pB0, pB1, K_lds + SHM_K, qr, ql, r32, hi);
        finishSM(pA0, pA1, alA, l_reg, pa0, pa1, pa2, pa3); SBAR();
        SLOAD(SO, (j + SDEPTH) * KVBLK); SBAR();
        pv_d0(o, vb0, pa0, pa1, pa2, pa3); partialSM(pB0, pB1, m_reg, mnB, alB);
        __syncthreads(); SWAIT(); SWRITE(0, SE);
        RESC(alB); __syncthreads();
        SBAR(); qkt(pA0, pA1, K_lds, qr, ql, r32, hi);
        finishSM(pB0, pB1, alB, l_reg, pa0, pa1, pa2, pa3); SBAR();
        if (SDEPTH == 1 || j + 3 < NT) SLOAD(SE, (j + 1 + SDEPTH) * KVBLK); SBAR();
        pv_d0(o, vb0 + SHM_V, pa0, pa1, pa2, pa3); partialSM(pA0, pA1, m_reg, mnA, alA);
        __syncthreads(); SWAIT(); SWRITE(1, SO);
        RESC(alA); __syncthreads();
    }
    SBAR(); qkt(pB0, pB1, K_lds + SHM_K, qr, ql, r32, hi);
    finishSM(pA0, pA1, alA, l_reg, pa0, pa1, pa2, pa3); SBAR();
    pv_d0(o, vb0, pa0, pa1, pa2, pa3); partialSM(pB0, pB1, m_reg, mnB, alB);
    __syncthreads(); RESC(alB);
    finishSM(pB0, pB1, alB, l_reg, pa0, pa1, pa2, pa3); SBAR();
    pv_d0(o, vb0 + SHM_V, pa0, pa1, pa2, pa3);
    if (hi == 0) li_l[r32] = l_reg; asm volatile("s_waitcnt lgkmcnt(0)" ::: "memory");
    float rli[16];
#pragma unroll
    for (int r = 0; r < 16; ++r) rli[r] = __builtin_amdgcn_rcpf(li_l[crow(r, hi)]);
    __syncthreads();
    bf16_t* ost = (bf16_t*)(lds + wid * 8192);
#pragma unroll
    for (int r = 0; r < 16; ++r) { const int orow = crow(r, hi);
#pragma unroll
        for (int d0 = 0; d0 < 4; ++d0) ost[orow * 128 + d0 * 32 + r32] = (bf16_t)f2bf(o[d0][r] * rli[r]); }
    asm volatile("s_waitcnt lgkmcnt(0)" ::: "memory");
    bf16_t* Ow = Ob + (long)(wid * QBLK) * DM;
#pragma unroll
    for (int i = 0; i < 8; ++i) { const int ch = lane + 64 * i, row = ch >> 4, c = ch & 15;
        const u32x4 v = *(const u32x4*)((const char*)ost + row * 256 + c * 16); *(u32x4*)(Ow + (long)row * DM + c * 8) = v; }
    __syncthreads();
#undef SLOAD
#undef SWRITE
#undef SWAIT
#undef RESC
}
}

struct Args { const void* in[23]; float* out; unsigned char* ws; int ph_lo, ph_hi; };
enum { I_X = 0, I_POS, I_CNW, I_CWIN, I_CK, I_CWOUT, I_MNW, I_MWDOWN, I_MQLN, I_MKVLN, I_MWQ, I_MWKV, I_MQHN, I_MKHN, I_MWO, I_FNW, I_RWG, I_RBG, I_RWE, I_RBE, I_EWG, I_EWU, I_EWD };

struct CvtItem { const float* W; bf16_t* WT; const float* ksc; int K, N, k0, n0, drow0; };
__device__ __forceinline__ unsigned char* ldptr(int i);
constexpr int CVT_PER_J = 768 + 256 + 176 + 144 + 128 + 256;
constexpr int CVT_MIX = 2 * CVT_PER_J, CVT_EXP = MK_ENABLE_MOE ? 4 * NE * 288 : 0, CVT_ITEMS = CVT_MIX + CVT_EXP;
__device__ __forceinline__ void cvt_decode(int it, CvtItem& c, unsigned char* ws) {
    if (it < CVT_MIX) {
        const int j = it / CVT_PER_J; int r = it - j * CVT_PER_J; int kb, nb;
        if (r < 768) { c.K = 1024; c.N = 3072; c.W = (const float*)ldptr(I_CWIN) + (size_t)j * 1024 * 3072; c.WT = (bf16_t*)(ws + WS_WIN) + (size_t)j * 3072 * 1024; c.ksc = (const float*)ldptr(I_CNW) + j * 1024;
            kb = r / 48; nb = r % 48; const int n0 = nb * 64;
            if (n0 < 1024) c.drow0 = n0; else if (n0 < 2048) { const int q = n0 - 1024; c.drow0 = 1024 + (q >> 7) * 256 + (q & 127); } else { const int q = n0 - 2048; c.drow0 = 1024 + (q >> 7) * 256 + 128 + (q & 127); } }
        else if ((r -= 768) < 256) { c.K = 1024; c.N = 1024; c.W = (const float*)ldptr(I_CWOUT) + (size_t)j * 1024 * 1024; c.WT = (bf16_t*)(ws + WS_WOUTC) + (size_t)j * 1024 * 1024; c.ksc = nullptr; kb = r / 16; nb = r % 16; c.drow0 = nb * 64; }
        else if ((r -= 256) < 176) { c.K = 1024; c.N = LAT; c.W = (const float*)ldptr(I_MWDOWN) + (size_t)j * 1024 * LAT; c.WT = (bf16_t*)(ws + WS_WDOWN) + (size_t)j * LATP * 1024; c.ksc = (const float*)ldptr(I_MNW) + j * 1024; kb = r / 11; nb = r % 11; c.drow0 = nb * 64; }
        else if ((r -= 176) < 144) { c.K = QLR; c.N = NH * DQK; c.W = (const float*)ldptr(I_MWQ) + (size_t)j * QLR * NH * DQK; c.WT = (bf16_t*)(ws + WS_WQ + (size_t)j * 1536 * 1024); c.ksc = (const float*)ldptr(I_MQLN) + j * QLR; kb = r / 24; nb = r % 24; c.drow0 = nb * 64; }
        else if ((r -= 144) < 128) { c.K = KVLR; c.N = NH * 256; c.W = (const float*)ldptr(I_MWKV) + (size_t)j * KVLR * NH * 256; c.WT = (bf16_t*)(ws + WS_WKV) + (size_t)j * 2048 * 256; c.ksc = (const float*)ldptr(I_MKVLN) + j * KVLR; kb = r / 32; nb = r % 32; c.drow0 = nb * 64; }
        else { r -= 128; c.K = 1024; c.N = 1024; c.W = (const float*)ldptr(I_MWO) + (size_t)j * 1024 * 1024; c.WT = (bf16_t*)(ws + WS_WO) + (size_t)j * 1024 * 1024; c.ksc = nullptr; kb = r / 16; nb = r % 16; c.drow0 = nb * 64; }
        c.k0 = kb * 64; c.n0 = nb * 64;
    } else {
        const int r = it - CVT_MIX; const int le = r / 288, q = r - le * 288, L = le >> 6; const int kind = q / 96, idx = q - kind * 96; int kb, nb;
        if (kind < 2) { c.K = 1024; c.N = DFF; c.W = (const float*)ldptr(kind == 0 ? I_EWG : I_EWU) + (size_t)le * 1024 * DFF; c.WT = (bf16_t*)(ws + WS_WE1) + (size_t)le * 768 * 1024; c.ksc = (const float*)ldptr(I_FNW) + L * 1024;
            kb = idx / 6; nb = idx % 6; const int n0 = nb * 64; c.drow0 = (n0 >> 7) * 256 + kind * 128 + (n0 & 127); }
        else { c.K = DFF; c.N = 1024; c.W = (const float*)ldptr(I_EWD) + (size_t)le * DFF * 1024; c.WT = (bf16_t*)(ws + WS_WE2) + (size_t)le * 1024 * DFF; c.ksc = nullptr; kb = idx / 16; nb = idx % 16; c.drow0 = nb * 64; }
        c.k0 = kb * 64; c.n0 = nb * 64;
    }
}
__device__ __forceinline__ void cvt_load(const CvtItem& c, f32x4 (&v)[16], int lane) {
    const float* p = c.W + (size_t)(c.k0 + (lane >> 4)) * c.N + c.n0 + 4 * (lane & 15);
#pragma unroll
    for (int i = 0; i < 16; ++i) v[i] = *(const f32x4*)(p + (size_t)(4 * i) * c.N);
}
__device__ __forceinline__ void cvt_lds_write(LAS float* tile, const f32x4 (&v)[16], int lane) {
#pragma unroll
    for (int i = 0; i < 16; ++i) { const int r = 4 * i + (lane >> 4), n = 4 * (lane & 15), x = r & 31; LAS float* row = tile + r * 64;
        row[(n + 0) ^ x] = v[i].x; row[(n + 1) ^ x] = v[i].y; row[(n + 2) ^ x] = v[i].z; row[(n + 3) ^ x] = v[i].w; }
}
__device__ __forceinline__ void cvt_out(const CvtItem& c, const LAS float* tile, int lane) {
    const int cc = lane & 7, np = lane >> 3;
    f32x4 s0 = {1.f, 1.f, 1.f, 1.f}, s1 = {1.f, 1.f, 1.f, 1.f};
    if (c.ksc) { s0 = *(const f32x4*)(c.ksc + c.k0 + 8 * cc); s1 = *(const f32x4*)(c.ksc + c.k0 + 8 * cc + 4); }
#pragma unroll
    for (int jj = 0; jj < 8; ++jj) { const int n = np + 8 * jj; float t[8];
#pragma unroll
        for (int q = 0; q < 8; ++q) { const int k = 8 * cc + q; t[q] = tile[k * 64 + (n ^ (k & 31))]; }
        u32x4 o; o.x = pk2(t[0] * s0.x, t[1] * s0.y); o.y = pk2(t[2] * s0.z, t[3] * s0.w); o.z = pk2(t[4] * s1.x, t[5] * s1.y); o.w = pk2(t[6] * s1.z, t[7] * s1.w);
        *(GAS u32x4*)(c.WT + (size_t)(c.drow0 + n) * c.K + c.k0 + 8 * cc) = o; }
}

__device__ __forceinline__ void prologue_phase(LAS unsigned char* lds, int gw, int NGW, int wave, int lane, int gtid, int NGT) {
    unsigned char* ws = ldptr(24);
    LAS float* tile = (LAS float*)(lds + wave * 16384);
    {   CvtItem cur, nxt; f32x4 v[16]; int it = gw;
        if (it < CVT_ITEMS) { cvt_decode(it, cur, ws); cvt_load(cur, v, lane); }
        while (it < CVT_ITEMS) {
            cvt_lds_write(tile, v, lane);
            const int itn = it + NGW;
            if (itn < CVT_ITEMS) { cvt_decode(itn, nxt, ws); cvt_load(nxt, v, lane); }
            LDS_WAIT(); asm volatile("" ::: "memory");
            cvt_out(cur, tile, lane);
            LDS_WAIT(); asm volatile("" ::: "memory");
            cur = nxt; it = itn;
        }
    }
#if MK_ENABLE_MOE
    const float* fnw = (const float*)ldptr(I_FNW); const float* rwg = (const float*)ldptr(I_RWG); const float* rwe = (const float*)ldptr(I_RWE);
    for (int i = gtid; i < 4 * 256 * 128; i += NGT) {
        const int L = i >> 15, n = (i >> 7) & 255, k8 = (i & 127) * 8;
        u32x4 o = {0u, 0u, 0u, 0u};
        if (n < 72) { float v[8];
#pragma unroll
            for (int q = 0; q < 8; ++q) { const int k = k8 + q; const float g = fnw[L * 1024 + k];
                v[q] = g * (n < 8 ? rwg[((size_t)L * 1024 + k) * 8 + n] : rwe[((size_t)L * 1024 + k) * 64 + (n - 8)]); }
            o.x = pk2(v[0], v[1]); o.y = pk2(v[2], v[3]); o.z = pk2(v[4], v[5]); o.w = pk2(v[6], v[7]); }
        *(u32x4*)((bf16_t*)(ws + WS_WRT) + ((size_t)L * 256 + n) * 1024 + k8) = o;
    }
#endif
    for (int i = gtid; i < 2 * 64 * 128; i += NGT) { const int j = i >> 13, n = LAT + ((i >> 7) & 63), k8 = (i & 127) * 8;
        *(u32x4*)((bf16_t*)(ws + WS_WDOWN) + ((size_t)j * LATP + n) * 1024 + k8) = (u32x4){0u, 0u, 0u, 0u}; }
}

__device__ __forceinline__ void norm_phase(const float* xin, const bf16_t* Y, float* xout, bf16_t* H, int gw, int NGW, int lane) {
    for (int m = gw; m < T; m += NGW) {
        const f32x4* xr = (const f32x4*)(xin + (size_t)m * DM) + lane;
        f32x4 v[4];
#pragma unroll
        for (int j = 0; j < 4; ++j) v[j] = xr[64 * j];
        if (Y) { const u32x2* y0 = (const u32x2*)(Y + (size_t)(2 * m) * DM) + lane; const u32x2* y1 = y0 + 256;
#pragma unroll
            for (int j = 0; j < 4; ++j) { const u32x2 p = y0[64 * j], q = y1[64 * j];
                v[j].x += bflo(p.x) + bflo(q.x); v[j].y += bfhi(p.x) + bfhi(q.x); v[j].z += bflo(p.y) + bflo(q.y); v[j].w += bfhi(p.y) + bfhi(q.y); } }
        if (xout) { f32x4* xo = (f32x4*)(xout + (size_t)m * DM) + lane;
#pragma unroll
            for (int j = 0; j < 4; ++j) xo[64 * j] = v[j]; }
        if (H) { float s = 0.f;
#pragma unroll
            for (int j = 0; j < 4; ++j) s += (v[j].x * v[j].x + v[j].y * v[j].y) + (v[j].z * v[j].z + v[j].w * v[j].w);
            const float r = 1.0f / sqrtf(wave_sum(s, lane) * (1.f / DM) + EPS);
            u32x2* ho = (u32x2*)(H + (size_t)m * DM) + lane;
#pragma unroll
            for (int j = 0; j < 4; ++j) { u32x2 w; w.x = pk2(v[j].x * r, v[j].y * r); w.y = pk2(v[j].z * r, v[j].w * r); ho[64 * j] = w; } }
    }
}

__device__ __forceinline__ void conv_phase(const bf16_t* GBp, const bf16_t* Zp, const float* ck, bf16_t* YCp, int gtid, int NGT) {
    for (int i = gtid; i < T * 128; i += NGT) {
        const int t = i >> 7, c8 = (i & 127) * 8, s = t & (SEQ - 1);
        const u32x4 zc = *(const u32x4*)(Zp + (size_t)t * DM + c8), g = *(const u32x4*)(GBp + (size_t)t * DM + c8);
        u32x4 zm = {0u, 0u, 0u, 0u}, zp = {0u, 0u, 0u, 0u};
        if (s > 0) zm = *(const u32x4*)(Zp + (size_t)(t - 1) * DM + c8);
        if (s < SEQ - 1) zp = *(const u32x4*)(Zp + (size_t)(t + 1) * DM + c8);
        const f32x4 k0a = *(const f32x4*)(ck + c8), k0b = *(const f32x4*)(ck + c8 + 4), k1a = *(const f32x4*)(ck + DM + c8), k1b = *(const f32x4*)(ck + DM + c8 + 4), k2a = *(const f32x4*)(ck + 2 * DM + c8), k2b = *(const f32x4*)(ck + 2 * DM + c8 + 4);
        float y[8];
#define CV(q, W, KA, LOHI) y[q] = LOHI(g.W) * (LOHI(zm.W) * k0##KA + LOHI(zc.W) * k1##KA + LOHI(zp.W) * k2##KA)
        CV(0, x, a[0], bflo); CV(1, x, a[1], bfhi); CV(2, y, a[2], bflo); CV(3, y, a[3], bfhi); CV(4, z, b[0], bflo); CV(5, z, b[1], bfhi); CV(6, w, b[2], bflo); CV(7, w, b[3], bfhi);
#undef CV
        u32x4 o; o.x = pk2(y[0], y[1]); o.y = pk2(y[2], y[3]); o.z = pk2(y[4], y[5]); o.w = pk2(y[6], y[7]);
        *(u32x4*)(YCp + (size_t)t * DM + c8) = o;
    }
}

__device__ __forceinline__ void qkprep_phase(const bf16_t* LATb, const bf16_t* QRAW, const bf16_t* KVRAW, const int* pos, const float* qhn, const float* khn,
                                             bf16_t* Qo, bf16_t* Ko, bf16_t* Vo, LAS unsigned char* lds, int gw, int NGW, int wave, int lane) {
    LAS unsigned char* sq = lds + wave * 10240;
    LAS float* cs = (LAS float*)(sq + 8704);
    const int h = lane >> 3, i8 = lane & 7;
    float gq[24], gk[24];
#pragma unroll
    for (int q = 0; q < 16; ++q) { gq[q] = qhn[16 * i8 + q]; gk[q] = khn[16 * i8 + q]; }
#pragma unroll
    for (int q = 0; q < 4; ++q) { gq[16 + q] = qhn[128 + 4 * i8 + q]; gq[20 + q] = qhn[160 + 4 * i8 + q]; gk[16 + q] = khn[128 + 4 * i8 + q]; gk[20 + q] = khn[160 + 4 * i8 + q]; }
    for (int t = gw; t < T; t += NGW) {
        const int b = t >> 14, s = t & (SEQ - 1);
        const u32x4* qs = (const u32x4*)(QRAW + (size_t)t * 1536); const u32x4* ks = (const u32x4*)(KVRAW + (size_t)t * 2048); const u32x4* ls = (const u32x4*)(LATb + (size_t)t * LATP);
        const u32x4 q0 = qs[lane], q1 = qs[lane + 64], q2 = qs[lane + 128], k0 = ks[lane], k1 = ks[lane + 64], k2 = ks[lane + 128], k3 = ks[lane + 192];
        const u32x4 l0 = ls[lane]; u32x4 l1 = {0u, 0u, 0u, 0u}; if (lane < 24) l1 = ls[lane + 64];
        LAS u32x4* d = (LAS u32x4*)sq;
        d[lane] = q0; d[lane + 64] = q1; d[lane + 128] = q2; d[192 + lane] = k0; d[192 + lane + 64] = k1; d[192 + lane + 128] = k2; d[192 + lane + 192] = k3;
        d[448 + lane] = l0; if (lane < 24) d[448 + lane + 64] = l1;
        float s0 = 0.f;
#define SS4(V_) (bflo(V_.x) * bflo(V_.x) + bfhi(V_.x) * bfhi(V_.x) + bflo(V_.y) * bflo(V_.y) + bfhi(V_.y) * bfhi(V_.y) + bflo(V_.z) * bflo(V_.z) + bfhi(V_.z) * bfhi(V_.z) + bflo(V_.w) * bflo(V_.w) + bfhi(V_.w) * bfhi(V_.w))
        s0 = SS4(l0); const float s1 = SS4(l1);
        const float ssq_q = wave_sum(lane < 48 ? s0 : 0.f, lane), ssq_kv = wave_sum((lane >= 48 ? s0 : 0.f) + (lane < 16 ? s1 : 0.f), lane);
        const float r_q = 1.0f / sqrtf(ssq_q * (1.f / QLR) + EPS), r_kv = 1.0f / sqrtf(ssq_kv * (1.f / KVLR) + EPS);
        if (lane < 32) { const float invf = powf(10000.f, -(float)lane * (1.f / 32.f)); const float ang = (float)pos[t] * invf;
            const double rev = (double)ang * 0.15915494309189535; const float fr = (float)(rev - floor(rev));
            cs[lane] = __builtin_amdgcn_cosf(fr); cs[32 + lane] = __builtin_amdgcn_sinf(fr); }
        LDS_WAIT(); asm volatile("" ::: "memory");
        float cj[4], sj[4];
#pragma unroll
        for (int q = 0; q < 4; ++q) { cj[q] = cs[4 * i8 + q]; sj[q] = cs[32 + 4 * i8 + q]; }
        {   const LAS bf16_t* qh = (const LAS bf16_t*)sq + h * DQK;
            const u32x4 a0 = *(const LAS u32x4*)(qh + 16 * i8), a1 = *(const LAS u32x4*)(qh + 16 * i8 + 8);
            const u32x2 r1 = *(const LAS u32x2*)(qh + 128 + 4 * i8), r2 = *(const LAS u32x2*)(qh + 160 + 4 * i8);
            float v[24];
            v[0] = bflo(a0.x); v[1] = bfhi(a0.x); v[2] = bflo(a0.y); v[3] = bfhi(a0.y); v[4] = bflo(a0.z); v[5] = bfhi(a0.z); v[6] = bflo(a0.w); v[7] = bfhi(a0.w);
            v[8] = bflo(a1.x); v[9] = bfhi(a1.x); v[10] = bflo(a1.y); v[11] = bfhi(a1.y); v[12] = bflo(a1.z); v[13] = bfhi(a1.z); v[14] = bflo(a1.w); v[15] = bfhi(a1.w);
            v[16] = bflo(r1.x); v[17] = bfhi(r1.x); v[18] = bflo(r1.y); v[19] = bfhi(r1.y); v[20] = bflo(r2.x); v[21] = bfhi(r2.x); v[22] = bflo(r2.y); v[23] = bfhi(r2.y);
            float ss = 0.f;
#pragma unroll
            for (int q = 0; q < 24; ++q) ss += v[q] * v[q];
            ss += lane_xor_f(ss, 1, lane); ss += lane_xor_f(ss, 2, lane); ss += lane_xor_f(ss, 4, lane);
            const float sc = r_q / sqrtf(r_q * r_q * ss * (1.f / DQK) + EPS);
#pragma unroll
            for (int q = 0; q < 24; ++q) v[q] *= sc * gq[q];
            bf16_t* qo = Qo + ((size_t)(b * NH + h) * SEQ + s) * DQK;
            u32x4 w0, w1; w0.x = pk2(v[0], v[1]); w0.y = pk2(v[2], v[3]); w0.z = pk2(v[4], v[5]); w0.w = pk2(v[6], v[7]); w1.x = pk2(v[8], v[9]); w1.y = pk2(v[10], v[11]); w1.z = pk2(v[12], v[13]); w1.w = pk2(v[14], v[15]);
            *(u32x4*)(qo + 16 * i8) = w0; *(u32x4*)(qo + 16 * i8 + 8) = w1;
            float o1[4], o2[4];
#pragma unroll
            for (int q = 0; q < 4; ++q) { o1[q] = v[16 + q] * cj[q] - v[20 + q] * sj[q]; o2[q] = v[20 + q] * cj[q] + v[16 + q] * sj[q]; }
            u32x2 e1, e2; e1.x = pk2(o1[0], o1[1]); e1.y = pk2(o1[2], o1[3]); e2.x = pk2(o2[0], o2[1]); e2.y = pk2(o2[2], o2[3]);
            *(u32x2*)(qo + 128 + 4 * i8) = e1; *(u32x2*)(qo + 160 + 4 * i8) = e2; }
        {   const LAS bf16_t* kh = (const LAS bf16_t*)(sq + 3072) + h * 256; const LAS bf16_t* lr = (const LAS bf16_t*)(sq + 7168) + 640;
            const u32x4 a0 = *(const LAS u32x4*)(kh + 16 * i8), a1 = *(const LAS u32x4*)(kh + 16 * i8 + 8);
            const u32x4 b0 = *(const LAS u32x4*)(kh + 128 + 16 * i8), b1 = *(const LAS u32x4*)(kh + 128 + 16 * i8 + 8);
            const u32x2 r1 = *(const LAS u32x2*)(lr + 4 * i8), r2 = *(const LAS u32x2*)(lr + 32 + 4 * i8);
            float v[24];
            v[0] = bflo(a0.x); v[1] = bfhi(a0.x); v[2] = bflo(a0.y); v[3] = bfhi(a0.y); v[4] = bflo(a0.z); v[5] = bfhi(a0.z); v[6] = bflo(a0.w); v[7] = bfhi(a0.w);
            v[8] = bflo(a1.x); v[9] = bfhi(a1.x); v[10] = bflo(a1.y); v[11] = bfhi(a1.y); v[12] = bflo(a1.z); v[13] = bfhi(a1.z); v[14] = bflo(a1.w); v[15] = bfhi(a1.w);
#pragma unroll
            for (int q = 0; q < 16; ++q) v[q] *= r_kv;
            v[16] = bflo(r1.x); v[17] = bfhi(r1.x); v[18] = bflo(r1.y); v[19] = bfhi(r1.y); v[20] = bflo(r2.x); v[21] = bfhi(r2.x); v[22] = bflo(r2.y); v[23] = bfhi(r2.y);
            float ss = 0.f;
#pragma unroll
            for (int q = 0; q < 24; ++q) ss += v[q] * v[q];
            ss += lane_xor_f(ss, 1, lane); ss += lane_xor_f(ss, 2, lane); ss += lane_xor_f(ss, 4, lane);
            const float sc = 1.0f / sqrtf(ss * (1.f / DQK) + EPS);
#pragma unroll
            for (int q = 0; q < 24; ++q) v[q] *= sc * gk[q];
            bf16_t* ko = Ko + ((size_t)(b * NH + h) * SEQ + s) * DQK;
            u32x4 w0, w1; w0.x = pk2(v[0], v[1]); w0.y = pk2(v[2], v[3]); w0.z = pk2(v[4], v[5]); w0.w = pk2(v[6], v[7]); w1.x = pk2(v[8], v[9]); w1.y = pk2(v[10], v[11]); w1.z = pk2(v[12], v[13]); w1.w = pk2(v[14], v[15]);
            *(u32x4*)(ko + 16 * i8) = w0; *(u32x4*)(ko + 16 * i8 + 8) = w1;
            float o1[4], o2[4];
#pragma unroll
            for (int q = 0; q < 4; ++q) { o1[q] = v[16 + q] * cj[q] - v[20 + q] * sj[q]; o2[q] = v[20 + q] * cj[q] + v[16 + q] * sj[q]; }
            u32x2 e1, e2; e1.x = pk2(o1[0], o1[1]); e1.y = pk2(o1[2], o1[3]); e2.x = pk2(o2[0], o2[1]); e2.y = pk2(o2[2], o2[3]);
            *(u32x2*)(ko + 128 + 4 * i8) = e1; *(u32x2*)(ko + 160 + 4 * i8) = e2;
            bf16_t* vo = Vo + ((size_t)(b * NH + h) * SEQ + s) * DV;
            u32x4 x0, x1;
            x0.x = pk2(bflo(b0.x) * r_kv, bfhi(b0.x) * r_kv); x0.y = pk2(bflo(b0.y) * r_kv, bfhi(b0.y) * r_kv); x0.z = pk2(bflo(b0.z) * r_kv, bfhi(b0.z) * r_kv); x0.w = pk2(bflo(b0.w) * r_kv, bfhi(b0.w) * r_kv);
            x1.x = pk2(bflo(b1.x) * r_kv, bfhi(b1.x) * r_kv); x1.y = pk2(bflo(b1.y) * r_kv, bfhi(b1.y) * r_kv); x1.z = pk2(bflo(b1.z) * r_kv, bfhi(b1.z) * r_kv); x1.w = pk2(bflo(b1.w) * r_kv, bfhi(b1.w) * r_kv);
            *(u32x4*)(vo + 16 * i8) = x0; *(u32x4*)(vo + 16 * i8 + 8) = x1; }
        LDS_WAIT(); asm volatile("" ::: "memory");
    }
#undef SS4
}

__device__ __forceinline__ void route_phase(const float* LG, const float* bg, const float* be, gu32* cnt, int* eid, int* rank, float* gate, int gtid, int NGT) {
    for (int t = gtid; t < T; t += NGT) {
        const float* lg = LG + (size_t)t * 128;
        float gl[8];
        { const f32x4 a = *(const f32x4*)lg, b = *(const f32x4*)(lg + 4); gl[0] = a.x; gl[1] = a.y; gl[2] = a.z; gl[3] = a.w; gl[4] = b.x; gl[5] = b.y; gl[6] = b.z; gl[7] = b.w; }
        float gm = gl[0]; int gs = 0; float bm = gl[0] + bg[0];
#pragma unroll
        for (int q = 1; q < 8; ++q) { gm = fmaxf(gm, gl[q]); const float v = gl[q] + bg[q]; if (v > bm) { bm = v; gs = q; } }
        float gsum = 0.f, gsel = 0.f;
#pragma unroll
        for (int q = 0; q < 8; ++q) { const float e = __expf(gl[q] - gm); gsum += e; gsel = (q == gs) ? e : gsel; }
        const float g_gate = gsel / gsum;
        float el[8];
        { const f32x4 a = *(const f32x4*)(lg + 8 + gs * 8), b = *(const f32x4*)(lg + 12 + gs * 8); el[0] = a.x; el[1] = a.y; el[2] = a.z; el[3] = a.w; el[4] = b.x; el[5] = b.y; el[6] = b.z; el[7] = b.w; }
        int i0 = 0; float v0 = el[0] + be[gs * 8];
#pragma unroll
        for (int q = 1; q < 8; ++q) { const float v = el[q] + be[gs * 8 + q]; if (v > v0) { v0 = v; i0 = q; } }
        int i1 = -1; float v1 = -3.0e38f;
#pragma unroll
        for (int q = 0; q < 8; ++q) { const float v = el[q] + be[gs * 8 + q]; if (q != i0 && v > v1) { v1 = v; i1 = q; } }
        float l0 = 0.f, l1 = 0.f;
#pragma unroll
        for (int q = 0; q < 8; ++q) { l0 = (q == i0) ? el[q] : l0; l1 = (q == i1) ? el[q] : l1; }
        const float mm = fmaxf(l0, l1), p0 = __expf(l0 - mm), p1 = __expf(l1 - mm), inv = 1.f / (p0 + p1);
        const int e0 = gs * 8 + i0, e1 = gs * 8 + i1;
        const unsigned r0 = __hip_atomic_fetch_add(cnt + e0, 1u, RLX_AGENT), r1 = __hip_atomic_fetch_add(cnt + e1, 1u, RLX_AGENT);
        eid[2 * t] = e0; eid[2 * t + 1] = e1; rank[2 * t] = (int)r0; rank[2 * t + 1] = (int)r1; gate[2 * t] = g_gate * p0 * inv; gate[2 * t + 1] = g_gate * p1 * inv;
    }
}

__device__ __forceinline__ int build_tables(gu32* cnt, LAS int* tbl, LAS int* pstart, int tid) {
    if (tid < 64) {
        const int c = (int)__hip_atomic_load(cnt + tid, RLX_AGENT); const int pad = (c + 255) & ~255;
        int incl = pad;
#pragma unroll
        for (int o = 1; o < 64; o <<= 1) { const int v = __builtin_amdgcn_ds_bpermute((tid - o) << 2, incl); if (tid >= o) incl += v; }
        const int start = incl - pad; pstart[tid] = start; if (tid == 63) pstart[64] = incl;
        for (int q = start >> 8; q < (incl >> 8); ++q) tbl[q] = tid;
    }
    __syncthreads();
    return pstart[64] >> 8;
}

__device__ __forceinline__ void scatter_phase(const bf16_t* H, const int* eid, const int* rank, const float* gate, gu32* cnt, bf16_t* XS, int* sdest, float* sgate,
                                              const LAS int* pstart, int gw, int NGW, int lane, int gtid, int NGT) {
    for (int a = gw; a < NASSIGN; a += NGW) {
        const int e = eid[a], slot = pstart[e] + rank[a], t = a >> 1;
        const u32x4* src = (const u32x4*)(H + (size_t)t * DM); u32x4* dst = (u32x4*)(XS + (size_t)slot * DM);
        dst[lane] = src[lane]; dst[lane + 64] = src[lane + 64];
        if (lane == 0) { sdest[slot] = a; sgate[slot] = gate[a]; }
    }
    for (int i = gtid; i < NE * 256; i += NGT) { const int e = i >> 8, q = i & 255; const int c = (int)__hip_atomic_load(cnt + e, RLX_AGENT); const int pad = (c + 255) & ~255;
        if (c + q < pad) { sdest[pstart[e] + c + q] = -1; sgate[pstart[e] + c + q] = 0.f; } }
}

constexpr int PTAB_OFF = MISC_OFF + 128;
__device__ __forceinline__ unsigned char* ldptr(int i) {
    extern __shared__ __attribute__((aligned(16))) unsigned char lds_raw[];
    volatile LAS unsigned* pt = (volatile LAS unsigned*)((LAS unsigned char*)lds_raw + PTAB_OFF) + 2 * sgpr_now(i);
    const unsigned lo = __builtin_amdgcn_readfirstlane(pt[0]), hi = __builtin_amdgcn_readfirstlane(pt[1]);
    return (unsigned char*)(GAS unsigned char*)(((unsigned long long)hi << 32) | lo);
}
#define P_IN(i) ((const float*)ldptr(i))
#define P_OUT() ((float*)ldptr(23))
#define P_WS() (ldptr(24))
__device__ __forceinline__ void grid_barrier(int tid) {
    extern __shared__ __attribute__((aligned(16))) unsigned char lds_raw[];
    XcdBarrier b; b.bar = (unsigned*)(P_WS() + WS_CTL) + CW_BAR; b.x = xb_xcc_id(); b.st = (volatile LAS unsigned*)((LAS unsigned char*)lds_raw + MISC_OFF) + 8;
    xcd_barrier(b, tid == 0);
}

__global__ void __launch_bounds__(NWAVES * 64, 2) fwd(Args args) {
    extern __shared__ __attribute__((aligned(16))) unsigned char lds_raw[];
    LAS unsigned char* lds = (LAS unsigned char*)lds_raw;
    for (int u = threadIdx.x; u < (LDS_BYTES - LDSCTL_OFF) / 4; u += NWAVES * 64) ((LAS unsigned*)(lds + LDSCTL_OFF))[u] = 0u;
    __syncthreads();
    if (threadIdx.x == 0) { LAS unsigned long long* pt = (LAS unsigned long long*)(lds + PTAB_OFF);
#pragma unroll
        for (int i = 0; i < 23; ++i) pt[i] = (unsigned long long)args.in[i];
        pt[23] = (unsigned long long)args.out; pt[24] = (unsigned long long)args.ws; }
    __syncthreads();
    const int lo = args.ph_lo, hi = args.ph_hi;
    if (hi - lo > 1) (void)xcd_barrier_post((unsigned*)(P_WS() + WS_CTL) + CW_BAR, (volatile LAS unsigned*)(lds + MISC_OFF) + 8, threadIdx.x == 0);
    const int wave_s = __builtin_amdgcn_readfirstlane((int)threadIdx.x >> 6);
#define IN(k) (lo <= (k) && (k) < hi)
#define SEAM(k) do { if (hi > (k) + 1) grid_barrier(TID); } while (0)
#define TID (tid_now(wave_s))
#define LANE (tid_now(wave_s) & 63)
#define WAVE (sgpr_now(wave_s))
#define GRID (sgpr_now((int)gridDim.x))
#define BX (sgpr_now((int)blockIdx.x))
#define VCU ((GRID % 8 == 0) ? (BX % 8) * (GRID / 8) + BX / 8 : BX)
#define GW (VCU * NWAVES + WAVE)
#define NGW (GRID * NWAVES)
#define GTID (BX * (NWAVES * 64) + TID)
#define NGT (GRID * NWAVES * 64)
#define TBL ((LAS int*)(lds + TBL_OFF))
#define PSTART (TBL + 384)

    if (IN(0)) { for (int rep = 0; rep < REP_PRO; ++rep) prologue_phase(lds, GW, NGW, WAVE, LANE, GTID, NGT); SEAM(0); }

    for (int L = 0; L < 4; ++L) {
        const int pb = 1 + 12 * L;
        if ((L & 1) == 0) {
            if (IN(pb + 0)) { unsigned char* ws = P_WS(); const float* xsrc = (L == 0) ? P_IN(I_X) : P_OUT();
                norm_phase(xsrc, (L > 0 && MK_ENABLE_MOE) ? (const bf16_t*)(ws + WS_Y) : nullptr, (L == 0) ? nullptr : P_OUT(), (bf16_t*)(ws + WS_H), GW, NGW, LANE); SEAM(pb + 0); }
            if (IN(pb + 1)) { unsigned char* ws = P_WS(); const int j = L >> 1;
                pg8::Gemm g{DM, DM}; pg8::StaticOrder S; S.init(ws + WS_H, DM, (bf16_t*)(ws + WS_WIN) + (size_t)j * 3072 * 1024, DM, T, 3072, GRID, BX);
                pg8::EpiConvIn E{(bf16_t*)(ws + WS_GB), (bf16_t*)(ws + WS_Z)}; pg8::gemm_phase(lds, g, S, E, TID); SEAM(pb + 1); }
            if (IN(pb + 2)) { unsigned char* ws = P_WS(); const int j = L >> 1;
                conv_phase((const bf16_t*)(ws + WS_GB), (const bf16_t*)(ws + WS_Z), P_IN(I_CK) + j * 3 * DM, (bf16_t*)(ws + WS_YC), GTID, NGT); SEAM(pb + 2); }
            if (IN(pb + 3)) { unsigned char* ws = P_WS(); const int j = L >> 1; const float* xsrc = (L == 0) ? P_IN(I_X) : P_OUT();
                pg8::Gemm g{DM, DM}; pg8::StaticOrder S; S.init(ws + WS_YC, DM, (bf16_t*)(ws + WS_WOUTC) + (size_t)j * 1024 * 1024, DM, T, DM, GRID, BX);
                pg8::EpiResid E{xsrc, P_OUT()}; pg8::gemm_phase(lds, g, S, E, TID); SEAM(pb + 5); }
        } else {
#if MK_ENABLE_MLA
            if (IN(pb + 0)) { unsigned char* ws = P_WS();
                norm_phase(P_OUT(), MK_ENABLE_MOE ? (const bf16_t*)(ws + WS_Y) : nullptr, P_OUT(), (bf16_t*)(ws + WS_H), GW, NGW, LANE); SEAM(pb + 0); }
            if (IN(pb + 1)) { unsigned char* ws = P_WS(); const int j = L >> 1;
                pg8::Gemm g{DM, DM}; pg8::StaticOrder S; S.init(ws + WS_H, DM, (bf16_t*)(ws + WS_WDOWN) + (size_t)j * LATP * 1024, DM, T, LATP, GRID, BX);
                pg8::EpiBf16 E{(bf16_t*)(ws + WS_LAT), LATP}; pg8::gemm_phase(lds, g, S, E, TID); SEAM(pb + 1); }
            if (IN(pb + 2)) {
                { unsigned char* ws = P_WS(); const int j = L >> 1;
                  pg8::Gemm g{LATP, QLR}; pg8::StaticOrder S; S.init(ws + WS_LAT, LATP, ws + WS_WQ + (size_t)j * 1536 * 1024, QLR, T, 1536, GRID, BX);
                  pg8::EpiBf16 E{(bf16_t*)(ws + WS_QRAW), 1536}; pg8::gemm_phase(lds, g, S, E, TID); }
                { unsigned char* ws = P_WS(); const int j = L >> 1;
                  pg8::Gemm g{LATP, KVLR}; pg8::StaticOrder S; S.init((bf16_t*)(ws + WS_LAT) + QLR, LATP, (bf16_t*)(ws + WS_WKV) + (size_t)j * 2048 * 256, KVLR, T, 2048, GRID, BX);
                  pg8::EpiBf16 E{(bf16_t*)(ws + WS_KVRAW), 2048}; pg8::gemm_phase(lds, g, S, E, TID); }
                SEAM(pb + 2); }
            if (IN(pb + 3)) { unsigned char* ws = P_WS(); const int j = L >> 1;
                qkprep_phase((const bf16_t*)(ws + WS_LAT), (const bf16_t*)(ws + WS_QRAW), (const bf16_t*)(ws + WS_KVRAW), (const int*)P_IN(I_POS),
                             P_IN(I_MQHN) + j * DQK, P_IN(I_MKHN) + j * DQK, (bf16_t*)(ws + WS_Q), (bf16_t*)(ws + WS_K), (bf16_t*)(ws + WS_V), lds, GW, NGW, WAVE, LANE); SEAM(pb + 3); }
            if (IN(pb + 4)) {
              for (int rep = 0; rep < REP_ATT; ++rep)
                for (int i = 0;; ++i) {
                    int bh, qb;
                    if (GRID == 256) { if (i >= 4) break; const int idx = i * 32 + (VCU & 31); bh = 2 * (VCU >> 5) + (idx >> 6); qb = idx & 63; }
                    else { const int k = i * GRID + BX; if (k >= NB * NH * 64) break; bh = k >> 6; qb = k & 63; }
                    const int b = bh >> 3, h = bh & 7; unsigned char* ws = P_WS();
                    att::attn_unit((const bf16_t*)(ws + WS_Q) + ((size_t)bh * SEQ + qb * 256) * DQK, (const bf16_t*)(ws + WS_K) + (size_t)bh * SEQ * DQK, (const bf16_t*)(ws + WS_V) + (size_t)bh * SEQ * DV,
                                   (bf16_t*)(ws + WS_O) + ((size_t)(b * SEQ + qb * 256)) * DM + h * DV, (char*)lds_raw, TID);
                }
                SEAM(pb + 4); }
            if (IN(pb + 5)) { unsigned char* ws = P_WS(); const int j = L >> 1;
                pg8::Gemm g{DM, DM}; pg8::StaticOrder S; S.init(ws + WS_O, DM, (bf16_t*)(ws + WS_WO) + (size_t)j * 1024 * 1024, DM, T, DM, GRID, BX);
                pg8::EpiResid E{P_OUT(), P_OUT()}; pg8::gemm_phase(lds, g, S, E, TID); SEAM(pb + 5); }
#else
            if (IN(pb + 0)) { unsigned char* ws = P_WS(); norm_phase(P_OUT(), MK_ENABLE_MOE ? (const bf16_t*)(ws + WS_Y) : nullptr, P_OUT(), nullptr, GW, NGW, LANE); SEAM(pb + 5); }
#endif
        }
#if MK_ENABLE_MOE
#define CNT ((gu32*)(ws + WS_CTL) + CW_CNT + L * 64)
#define EID ((int*)(ws + WS_RT + RT_EID))
#define RANK ((int*)(ws + WS_RT + RT_RANK))
#define GATE ((float*)(ws + WS_RT + RT_GATE))
#define SDEST ((int*)(ws + WS_RT + RT_SDEST))
#define SGATE ((float*)(ws + WS_RT + RT_SGATE))
        if (IN(pb + 6)) { unsigned char* ws = P_WS(); norm_phase(P_OUT(), nullptr, nullptr, (bf16_t*)(ws + WS_H), GW, NGW, LANE); SEAM(pb + 6); }
        if (IN(pb + 7)) { unsigned char* ws = P_WS();
            pg8::Gemm g{DM, DM}; pg8::StaticOrder S; S.init(ws + WS_H, DM, (bf16_t*)(ws + WS_WRT) + (size_t)L * 256 * 1024, DM, T, 256, GRID, BX);
            pg8::EpiLogits E{(float*)(ws + WS_LG)}; pg8::gemm_phase(lds, g, S, E, TID); SEAM(pb + 7); }
        if (IN(pb + 8)) { unsigned char* ws = P_WS();
            route_phase((const float*)(ws + WS_LG), P_IN(I_RBG) + L * 8, P_IN(I_RBE) + L * 64, CNT, EID, RANK, GATE, GTID, NGT); SEAM(pb + 8); }
        if (IN(pb + 9)) { unsigned char* ws = P_WS(); build_tables(CNT, TBL, PSTART, TID);
            scatter_phase((const bf16_t*)(ws + WS_H), EID, RANK, GATE, CNT, (bf16_t*)(ws + WS_XS), SDEST, SGATE, PSTART, GW, NGW, LANE, GTID, NGT); SEAM(pb + 9); }
        if (IN(pb + 10)) { unsigned char* ws = P_WS(); const int ntiles = build_tables(CNT, TBL, PSTART, TID);
            pg8::Gemm g{DM, DM}; pg8::GroupedOrder S{ntiles * 3, 3, GRID, VCU, (const char*)(ws + WS_XS), (const char*)(ws + WS_WE1) + (size_t)L * NE * 768 * 1024 * 2, (size_t)256 * DM * 2, (size_t)768 * 1024 * 2, (size_t)256 * 1024 * 2, TBL};
            pg8::EpiSwiGLU E{(bf16_t*)(ws + WS_HID)}; pg8::gemm_phase(lds, g, S, E, TID); SEAM(pb + 10); }
        if (IN(pb + 11)) { unsigned char* ws = P_WS(); const int ntiles = build_tables(CNT, TBL, PSTART, TID);
            pg8::Gemm g{DFF, DFF}; pg8::GroupedOrder S{ntiles * 4, 4, GRID, VCU, (const char*)(ws + WS_HID), (const char*)(ws + WS_WE2) + (size_t)L * NE * 1024 * DFF * 2, (size_t)256 * DFF * 2, (size_t)1024 * DFF * 2, (size_t)256 * DFF * 2, TBL};
            pg8::EpiScatterY E{(bf16_t*)(ws + WS_Y), SDEST, SGATE}; pg8::gemm_phase(lds, g, S, E, TID); SEAM(pb + 11); }
#endif
    }
    if (IN(49)) {
#if MK_ENABLE_MOE
        unsigned char* ws = P_WS(); norm_phase(P_OUT(), (const bf16_t*)(ws + WS_Y), P_OUT(), nullptr, GW, NGW, LANE);
#endif
    }
#undef IN
#undef SEAM
}

extern "C" void kernel_launch(void* const* d_in, const int* in_sizes, int n_in, void* d_out, int out_size, void* d_ws, size_t ws_size, hipStream_t stream) {
    static int grid = 0;
    if (grid == 0) {
        if (n_in != 23 || out_size != T * DM || ws_size < WS_END) { fprintf(stderr, "kernel_launch: unexpected shapes: n_in %d out %d ws %zu (need %zu)\n", n_in, out_size, ws_size, (size_t)WS_END); grid = -1; return; }
        int dev = 0, cus = 0, per_cu = 0;
        if (hipGetDevice(&dev) != hipSuccess || hipDeviceGetAttribute(&cus, hipDeviceAttributeMultiprocessorCount, dev) != hipSuccess) { grid = -1; return; }
        if (hipFuncSetAttribute((const void*)fwd, hipFuncAttributeMaxDynamicSharedMemorySize, LDS_BYTES) != hipSuccess) { fprintf(stderr, "kernel_launch: hipFuncSetAttribute failed\n"); grid = -1; return; }
        if (hipOccupancyMaxActiveBlocksPerMultiprocessor(&per_cu, (const void*)fwd, NWAVES * 64, LDS_BYTES) != hipSuccess || per_cu < 1) fprintf(stderr, "kernel_launch: occupancy query says %d\n", per_cu);
        (void)hipGetLastError();
        grid = cus;
    }
    if (grid < 0) return;
    if (hipMemsetAsync((char*)d_ws + WS_CTL, 0, CTL_ZERO_BYTES, stream) != hipSuccess) return;
    Args a{};
    for (int i = 0; i < 23; ++i) a.in[i] = d_in[i];
    a.out = (float*)d_out; a.ws = (unsigned char*)d_ws;
#if MK_ONE_LAUNCH
    a.ph_lo = 0; a.ph_hi = 50;
    hipLaunchKernelGGL(fwd, dim3(grid), dim3(NWAVES * 64), LDS_BYTES, stream, a);
#else
    for (int p = 0; p < 50; ++p) {
        if (p >= 1 && p < 49) { const int L = (p - 1) / 12, k = (p - 1) % 12;
            if (k < 6) { if ((L & 1) == 0) { if (k > 3) continue; } else { if (!MK_ENABLE_MLA && k > 0) continue; } }
            else if (!MK_ENABLE_MOE) continue; }
        if (p == 49 && !MK_ENABLE_MOE) continue;
        a.ph_lo = p; a.ph_hi = p + 1;
        hipLaunchKernelGGL(fwd, dim3(grid), dim3(NWAVES * 64), LDS_BYTES, stream, a);
    }
#endif
    const hipError_t le = hipPeekAtLastError();
    if (le != hipSuccess) fprintf(stderr, "kernel_launch: launch failed: %s\n", hipGetErrorName(le));
}
```

```cpp
#include <hip/hip_runtime.h>
#include <cstdio>
#include <cstdint>

#ifndef MK_ONE_LAUNCH
#define MK_ONE_LAUNCH 1
#endif
#ifndef REP_ATT
#define REP_ATT 1
#endif
#ifndef REP_PRO
#define REP_PRO 1
#endif
#ifndef ATT_FP8
#define ATT_FP8 1
#endif
#ifndef MK_ENABLE_MLA
#define MK_ENABLE_MLA 1
#endif
#ifndef MK_ENABLE_MOE
#define MK_ENABLE_MOE 1
#endif

#define GAS __attribute__((address_space(1)))
#define LAS __attribute__((address_space(3)))
typedef unsigned short bf16_t;
typedef short bf16x8 __attribute__((ext_vector_type(8)));
typedef short s16x4 __attribute__((ext_vector_type(4)));
typedef float f32x2 __attribute__((ext_vector_type(2)));
typedef float f32x4 __attribute__((ext_vector_type(4)));
typedef float f32x16 __attribute__((ext_vector_type(16)));
typedef unsigned u32x2 __attribute__((ext_vector_type(2)));
typedef unsigned u32x4 __attribute__((ext_vector_type(4)));
typedef GAS unsigned gu32;

constexpr int DM = 1024, NB = 2, SEQ = 16384, T = NB * SEQ;
constexpr int NH = 8, QLR = 384, KVLR = 256, DNOPE = 128, DROPE = 64, DQK = 192, DV = 128, LAT = 704, LATP = 768;
constexpr int NE = 64, DFF = 384;
constexpr int NASSIGN = 2 * T;
constexpr int NSLOT = NASSIGN + NE * 256;
constexpr int MAXTILES = NSLOT / 256;
constexpr float EPS = 1e-6f;
constexpr int NWAVES = 8;

constexpr size_t MiB = 1u << 20;
constexpr size_t WS_CTL = 0, CTL_ZERO_BYTES = 1 * MiB;
constexpr size_t WS_WIN = 2 * MiB;
constexpr size_t WS_WOUTC = 14 * MiB;
constexpr size_t WS_WDOWN = 18 * MiB;
constexpr size_t WS_WQ = 21 * MiB;
constexpr size_t WS_WKV = 24 * MiB;
constexpr size_t WS_WO = 26 * MiB;
constexpr size_t WS_WRT = 30 * MiB;
constexpr size_t WS_WE1 = 32 * MiB;
constexpr size_t WS_WE2 = 416 * MiB;
constexpr size_t WS_H = 608 * MiB;
constexpr size_t WS_S = 672 * MiB;
constexpr size_t WS_GB = WS_S, WS_Z = WS_S + 64 * MiB, WS_YC = WS_S + 128 * MiB;
constexpr size_t WS_LAT = WS_S, WS_QRAW = WS_S + 48 * MiB, WS_KVRAW = WS_S + 144 * MiB;
constexpr size_t WS_Q = WS_S + 272 * MiB, WS_K = WS_S + 368 * MiB, WS_V = WS_S + 464 * MiB, WS_O = WS_QRAW;
constexpr size_t WS_XS = WS_S, WS_HID = WS_S + 160 * MiB, WS_Y = WS_S + 224 * MiB, WS_LG = WS_S + 352 * MiB;
constexpr size_t WS_RT = WS_S + 368 * MiB;
constexpr size_t WS_END = WS_S + 528 * MiB;
constexpr size_t RT_EID = 0, RT_RANK = 256 * 1024, RT_GATE = 512 * 1024, RT_SDEST = 768 * 1024, RT_SGATE = 768 * 1024 + 327680;
static_assert(RT_SGATE + 327680 <= 2 * MiB, "routing arrays");
constexpr int CW_TMO = 0, CW_CODE = 1, CW_BAR = 4096, CW_CNT = 8192  , CW_CHK = 12288;

constexpr int RING_BYTES = 131072;
constexpr int LDSCTL_OFF = RING_BYTES, MISC_OFF = LDSCTL_OFF + 320;
constexpr int TBL_OFF = LDSCTL_OFF + 1024;
constexpr int LDS_BYTES = 147456;

#define RLX_AGENT __ATOMIC_RELAXED, __HIP_MEMORY_SCOPE_AGENT
#define LDS_WAIT() asm volatile("s_waitcnt lgkmcnt(0)" ::: "memory")
#define VM_WAIT() asm volatile("s_waitcnt vmcnt(0)" ::: "memory")
__device__ __forceinline__ unsigned f2bf(float f) { unsigned u = __builtin_bit_cast(unsigned, f); return (u + 0x7fffu + ((u >> 16) & 1u)) >> 16; }
__device__ __forceinline__ unsigned pk2(float lo, float hi) { return f2bf(lo) | (f2bf(hi) << 16); }
__device__ __forceinline__ float bflo(unsigned w) { return __builtin_bit_cast(float, w << 16); }
__device__ __forceinline__ float bfhi(unsigned w) { return __builtin_bit_cast(float, w & 0xffff0000u); }
__device__ __forceinline__ float bf2f(bf16_t h) { return __builtin_bit_cast(float, (unsigned)h << 16); }
__device__ __forceinline__ unsigned cvt_pk_bf16(float lo, float hi) { unsigned r; asm volatile("v_cvt_pk_bf16_f32 %0, %1, %2" : "=v"(r) : "v"(lo), "v"(hi)); return r; }
__device__ __forceinline__ int tid_now(int wave_s) { int l; asm volatile("v_mbcnt_lo_u32_b32 %0, -1, 0\n\tv_mbcnt_hi_u32_b32 %0, -1, %0" : "=v"(l)); return wave_s * 64 + l; }
__device__ __forceinline__ int sgpr_now(int v) { asm volatile("" : "+s"(v)); return v; }
__device__ __forceinline__ float lane_xor_f(float v, int m, int lane) { return __builtin_bit_cast(float, __builtin_amdgcn_ds_bpermute((lane ^ m) << 2, __builtin_bit_cast(int, v))); }
__device__ __forceinline__ float wave_sum(float v, int lane) {
#pragma unroll
    for (int o = 1; o < 64; o <<= 1) v += lane_xor_f(v, o, lane);
    return v;
}

#define XB_TMO      128
#define XB_XCNT(j)  (256  + 64 * (j))
#define XB_XSUB(j)  (1280 + 64 * (j))
#define XB_XGEN(j)  (2304 + 64 * (j))
#define XB_TOP      3328
#define XB_TOPGEN   3392
#define XCD_BAR_WORDS 3456
#define XB_SPIN_CAP (1u << 18)
__device__ __forceinline__ unsigned xb_ld(unsigned* p)              { return __hip_atomic_load(p, __ATOMIC_RELAXED, __HIP_MEMORY_SCOPE_AGENT); }
__device__ __forceinline__ unsigned xb_add(unsigned* p, unsigned v) { return __hip_atomic_fetch_add(p, v, __ATOMIC_RELAXED, __HIP_MEMORY_SCOPE_AGENT); }
__device__ __forceinline__ unsigned xb_xcc_id() { return (unsigned)__builtin_amdgcn_s_getreg((3 << 11) | 20) & 0xFu; }
#define XB_SPIN(cond, bar) do { unsigned _sp = 0; while (cond) { __builtin_amdgcn_s_sleep(1); \
    if ((++_sp & 255u) == 0u) { if (xb_ld(&(bar)[XB_TMO])) break; if (_sp > XB_SPIN_CAP) { atomicAdd(&(bar)[XB_TMO], 1u); break; } } } } while (0)
struct XcdBarrier { unsigned* bar; unsigned x; volatile LAS unsigned* st; };
__device__ __forceinline__ XcdBarrier xcd_barrier_post(unsigned* bar, volatile LAS unsigned* st, bool leader) {
    XcdBarrier b; b.bar = bar; b.x = xb_xcc_id(); b.st = st;
    if (leader) (void)xb_add(&bar[XB_XCNT(b.x)], 1u);
    return b;
}
__device__ __forceinline__ void xcd_barrier_complete(unsigned* bar, unsigned x, unsigned& nloc, unsigned& nx) {
    const unsigned G = gridDim.x * gridDim.y * gridDim.z;
    unsigned sum, cnt, mine, sp = 0u;
    for (;;) {
        sum = 0u; cnt = 0u; mine = 0u;
#pragma unroll
        for (unsigned j = 0; j < 16; ++j) { const unsigned c = xb_ld(&bar[XB_XCNT(j)]); sum += c; cnt += (c > 0u) ? 1u : 0u; mine = (j == x) ? c : mine; }
        if (sum == G) break;
        __builtin_amdgcn_s_sleep(1);
        if ((++sp & 255u) == 0u) { if (xb_ld(&bar[XB_TMO])) break; if (sp > XB_SPIN_CAP) { atomicAdd(&bar[XB_TMO], 1u); break; } }
    }
    nloc = mine > 0u ? mine : 1u; nx = cnt > 0u ? cnt : 1u;
}
__device__ __forceinline__ void xcd_barrier(const XcdBarrier& b, bool leader) {
    asm volatile("s_waitcnt vmcnt(0)" ::: "memory");
    __syncthreads();
    if (leader) {
        unsigned* bar = b.bar;
        __builtin_amdgcn_s_waitcnt(0);
        unsigned nloc = b.st[0], nx = b.st[1];
        if (nloc == 0u) { xcd_barrier_complete(bar, b.x, nloc, nx); b.st[0] = nloc; b.st[1] = nx; }
        const unsigned old = xb_add(&bar[XB_XSUB(b.x)], 1u);
        const unsigned gen = old / nloc;
        if (old + 1u == (gen + 1u) * nloc) {
            __builtin_amdgcn_fence(__ATOMIC_RELEASE, "agent");
            asm volatile("s_waitcnt vmcnt(0)" ::: "memory");
            const unsigned og = xb_add(&bar[XB_TOP], 1u);
            const unsigned tg = og / nx;
            if (og + 1u == (tg + 1u) * nx) xb_add(&bar[XB_TOPGEN], 1u);
            else XB_SPIN(xb_ld(&bar[XB_TOPGEN]) == tg, bar);
            __builtin_amdgcn_fence(__ATOMIC_ACQUIRE, "agent");
            xb_add(&bar[XB_XGEN(b.x)], 1u);
            asm volatile("s_waitcnt vmcnt(0)" ::: "memory");
        } else {
            XB_SPIN(xb_ld(&bar[XB_XGEN(b.x)]) == gen, bar);
            __builtin_amdgcn_fence(__ATOMIC_ACQUIRE, "agent");
            asm volatile("s_waitcnt vmcnt(0)" ::: "memory");
        }
    }
    __syncthreads();
}

namespace pg8 {
constexpr int BM = 256, BK = 64, HALF = 128, HTB = HALF * BK * 2, NXCD = 8, WGM = 8;
__host__ __device__ __forceinline__ int lds_byte(int r, int c) { const int st = (r >> 4) * 2 + (c >> 5), rr = r & 15, cc = c & 31, ob = rr * 64 + cc * 2; return st * 1024 + (ob ^ (((ob >> 9) & 1) << 5)); }
__host__ __device__ __forceinline__ void stage_rc(int b, int& R, int& C) { const int st = b / 1024, sb = b % 1024, swz = sb ^ (((sb >> 9) & 1) << 5); R = (st >> 1) * 16 + swz / 64; C = (st & 1) * 32 + (swz % 64) / 2; }
__host__ __device__ __forceinline__ int perm32(int rho) { const int n = rho >> 4, i = rho & 15; return 8 * (i >> 2) + 4 * n + (i & 3); }

struct Unit { const char* A; const char* B; int pm, pn; };
struct Gemm { int lda, K; };

struct StaticOrder {
    int nM, nN, nwg, G, c; const char* A; const char* B; size_t astep, bstep;
    __device__ void init(const void* A_, int lda, const void* B_, int K, int M, int N, int G_, int c_) { nM = M / BM; nN = N / BM; nwg = nM * nN; G = G_; c = c_; A = (const char*)A_; B = (const char*)B_; astep = (size_t)BM * lda * 2; bstep = (size_t)BM * K * 2; }
    __device__ __forceinline__ bool next(int i, Unit& u) const {
        const long L = (long)i * G + c; if (L >= nwg) return false;
        int wgid = (int)L; { const int q = nwg / NXCD, r = nwg % NXCD, xcd = wgid % NXCD, off = wgid / NXCD; wgid = (xcd < r ? xcd * (q + 1) : r * (q + 1) + (xcd - r) * q) + off; }
        const int nig = WGM * nN, gid = wgid / nig, fm = gid * WGM, gsz = (nM - fm) < WGM ? (nM - fm) : WGM;
        u.pm = fm + ((wgid % nig) % gsz); u.pn = (wgid % nig) / gsz; u.A = A + (size_t)u.pm * astep; u.B = B + (size_t)u.pn * bstep; return true;
    }
};
struct GroupedOrder {
    int n_units, nN, G, c; const char* A; const char* B; size_t astep, bexp, bstep; const LAS int* tbl;
    __device__ __forceinline__ bool next(int i, Unit& u) const {
        const int L = i * G + c; if (L >= n_units) return false;
        const int tile = L / nN, pn = L - tile * nN; const int e = __builtin_amdgcn_readfirstlane(tbl[tile]);
        u.pm = tile; u.pn = pn; u.A = A + (size_t)tile * astep; u.B = B + (size_t)e * bexp + (size_t)pn * bstep; return true;
    }
};

typedef f32x4 Acc[2][2][4][2];

struct EpiBf16 {
    static constexpr bool PERM = true;
    bf16_t* O; int ldc;
    __device__ __forceinline__ void operator()(const Acc& acc, const Unit& u, int wr, int wc, int fr, int fq) const {
        const int row0 = u.pm * BM + wr * 64 + fr, col0 = u.pn * BM + wc * 32 + 8 * fq;
#pragma unroll
        for (int ai = 0; ai < 2; ++ai)
#pragma unroll
            for (int m = 0; m < 4; ++m) { bf16_t* rowp = O + (size_t)(row0 + ai * HALF + m * 16) * ldc + col0;
#pragma unroll
                for (int bj = 0; bj < 2; ++bj) { const f32x4 v0 = acc[ai][bj][m][0], v1 = acc[ai][bj][m][1];
                    u32x4 w; w.x = cvt_pk_bf16(v0[0], v0[1]); w.y = cvt_pk_bf16(v0[2], v0[3]); w.z = cvt_pk_bf16(v1[0], v1[1]); w.w = cvt_pk_bf16(v1[2], v1[3]);
                    *(u32x4*)(rowp + bj * HALF) = w; } }
    }
};
struct EpiConvIn {
    static constexpr bool PERM = true;
    bf16_t* GBp; bf16_t* Zp;
    __device__ __forceinline__ void operator()(const Acc& acc, const Unit& u, int wr, int wc, int fr, int fq) const {
        const int row0 = u.pm * BM + wr * 64 + fr;
        if (u.pn < 4) {
            const int col0 = u.pn * BM + wc * 32 + 8 * fq;
#pragma unroll
            for (int ai = 0; ai < 2; ++ai)
#pragma unroll
                for (int m = 0; m < 4; ++m) { bf16_t* rowp = GBp + (size_t)(row0 + ai * HALF + m * 16) * DM + col0;
#pragma unroll
                    for (int bj = 0; bj < 2; ++bj) { const f32x4 v0 = acc[ai][bj][m][0], v1 = acc[ai][bj][m][1];
                        u32x4 w; w.x = cvt_pk_bf16(v0[0], v0[1]); w.y = cvt_pk_bf16(v0[2], v0[3]); w.z = cvt_pk_bf16(v1[0], v1[1]); w.w = cvt_pk_bf16(v1[2], v1[3]);
                        *(u32x4*)(rowp + bj * HALF) = w; } }
        } else {
            const int col0 = (u.pn - 4) * HALF + wc * 32 + 8 * fq;
#pragma unroll
            for (int ai = 0; ai < 2; ++ai)
#pragma unroll
                for (int m = 0; m < 4; ++m) { bf16_t* rowp = Zp + (size_t)(row0 + ai * HALF + m * 16) * DM + col0;
                    const f32x4 v0 = acc[ai][0][m][0] * acc[ai][1][m][0], v1 = acc[ai][0][m][1] * acc[ai][1][m][1];
                    u32x4 w; w.x = cvt_pk_bf16(v0[0], v0[1]); w.y = cvt_pk_bf16(v0[2], v0[3]); w.z = cvt_pk_bf16(v1[0], v1[1]); w.w = cvt_pk_bf16(v1[2], v1[3]);
                    *(u32x4*)rowp = w; }
        }
    }
};
__device__ __forceinline__ float silu_mul(float g, float u) { return g * __builtin_amdgcn_rcpf(1.f + __expf(-g)) * u; }
struct EpiSwiGLU {
    static constexpr bool PERM = true;
    bf16_t* Hd;
    __device__ __forceinline__ void operator()(const Acc& acc, const Unit& u, int wr, int wc, int fr, int fq) const {
        const int row0 = u.pm * BM + wr * 64 + fr, col0 = u.pn * HALF + wc * 32 + 8 * fq;
#pragma unroll
        for (int ai = 0; ai < 2; ++ai)
#pragma unroll
            for (int m = 0; m < 4; ++m) { bf16_t* rowp = Hd + (size_t)(row0 + ai * HALF + m * 16) * DFF + col0;
                f32x4 v0, v1;
#pragma unroll
                for (int q = 0; q < 4; ++q) { v0[q] = silu_mul(acc[ai][0][m][0][q], acc[ai][1][m][0][q]); v1[q] = silu_mul(acc[ai][0][m][1][q], acc[ai][1][m][1][q]); }
                u32x4 w; w.x = cvt_pk_bf16(v0[0], v0[1]); w.y = cvt_pk_bf16(v0[2], v0[3]); w.z = cvt_pk_bf16(v1[0], v1[1]); w.w = cvt_pk_bf16(v1[2], v1[3]);
                *(u32x4*)rowp = w; }
    }
};
struct EpiResid {
    static constexpr bool PERM = false;
    const float* xin; float* xout;
    __device__ __forceinline__ void operator()(const Acc& acc, const Unit& u, int wr, int wc, int fr, int fq) const {
        const int row0 = u.pm * BM + wr * 64 + fr, col0 = u.pn * BM + wc * 32 + 4 * fq;
#pragma unroll
        for (int ai = 0; ai < 2; ++ai)
#pragma unroll
            for (int m = 0; m < 4; ++m) { const size_t off = (size_t)(row0 + ai * HALF + m * 16) * DM + col0;
#pragma unroll
                for (int bj = 0; bj < 2; ++bj)
#pragma unroll
                    for (int n = 0; n < 2; ++n) { const f32x4 xv = *(const f32x4*)(xin + off + bj * HALF + n * 16); *(f32x4*)(xout + off + bj * HALF + n * 16) = xv + acc[ai][bj][m][n]; } }
    }
};
struct EpiLogits {
    static constexpr bool PERM = false;
    float* LG;
    __device__ __forceinline__ void operator()(const Acc& acc, const Unit& u, int wr, int wc, int fr, int fq) const {
        const int row0 = u.pm * BM + wr * 64 + fr, col0 = wc * 32 + 4 * fq;
#pragma unroll
        for (int ai = 0; ai < 2; ++ai)
#pragma unroll
            for (int m = 0; m < 4; ++m) { const size_t off = (size_t)(row0 + ai * HALF + m * 16) * 128 + col0;
#pragma unroll
                for (int n = 0; n < 2; ++n) *(f32x4*)(LG + off + n * 16) = acc[ai][0][m][n]; }
    }
};
struct EpiScatterY {
    static constexpr bool PERM = true;
    bf16_t* Y; const int* sdest; const float* sgate;
    __device__ __forceinline__ void operator()(const Acc& acc, const Unit& u, int wr, int wc, int fr, int fq) const {
        const int row0 = u.pm * BM + wr * 64 + fr, col0 = u.pn * BM + wc * 32 + 8 * fq;
#pragma unroll
        for (int ai = 0; ai < 2; ++ai)
#pragma unroll
            for (int m = 0; m < 4; ++m) { const int slot = row0 + ai * HALF + m * 16; const int d = sdest[slot]; const float g = sgate[slot];
                if (d >= 0) { bf16_t* rowp = Y + (size_t)d * DM + col0;
#pragma unroll
                    for (int bj = 0; bj < 2; ++bj) { const f32x4 v0 = acc[ai][bj][m][0] * g, v1 = acc[ai][bj][m][1] * g;
                        u32x4 w; w.x = cvt_pk_bf16(v0[0], v0[1]); w.y = cvt_pk_bf16(v0[2], v0[3]); w.z = cvt_pk_bf16(v1[0], v1[1]); w.w = cvt_pk_bf16(v1[2], v1[3]);
                        *(u32x4*)(rowp + bj * HALF) = w; } }
                asm volatile("" ::: "memory"); }
    }
};

template <class Epi, class Sched>
__device__ __forceinline__ void gemm_phase(LAS unsigned char* lds, const Gemm g, const Sched& S, const Epi& E, int tid) {
    const int wid = __builtin_amdgcn_readfirstlane(tid >> 6), lane = tid & 63, wr = wid >> 2, wc = wid & 3, fr = lane & 15, fq = lane >> 4;
    const int K = g.K, lda = g.lda, nt = K / BK;
    unsigned voffA[2], voffB[2];
#pragma unroll
    for (int i = 0; i < 2; ++i) { int R, C; stage_rc(tid * 16 + i * 8192, R, C); const int Rb = Epi::PERM ? ((R & ~31) + perm32(R & 31)) : R;
        voffA[i] = (unsigned)(R * lda + C) * 2u; voffB[i] = (unsigned)(Rb * K + C) * 2u; }
    const size_t kstep = (size_t)(BK * 2);
    const size_t hstepA = (size_t)HALF * lda * 2, hstepB = (size_t)HALF * K * 2;
    const unsigned ldsw = (unsigned)wid * 1024u;
    const int aoff = lds_byte(wr * 64 + fr, fq * 8), boff = lds_byte(wc * 32 + fr, fq * 8);
#define PG8_SA(b, h) (((b) * 2 + (h)) * HTB)
#define PG8_SB(b, h) ((4 + (b) * 2 + (h)) * HTB)
#define PG8_STAGE(bufoff, gbase, voff) do { _Pragma("unroll") for (int _i = 0; _i < 2; ++_i) \
        __builtin_amdgcn_global_load_lds((const unsigned*)((const char*)(gbase) + (voff)[_i]), (LAS unsigned*)(lds + (bufoff) + ldsw + _i * 8192), 16, 0, 0); } while (0)
#define PG8_LDA(dst, b, h) do { _Pragma("unroll") for (int m = 0; m < 4; ++m) _Pragma("unroll") for (int k = 0; k < 2; ++k) dst[m][k] = *(const LAS bf16x8*)(lds + PG8_SA(b, h) + aoff + m * 2048 + k * 1024); } while (0)
#define PG8_LDB(dst, b, h) do { _Pragma("unroll") for (int n = 0; n < 2; ++n) _Pragma("unroll") for (int k = 0; k < 2; ++k) dst[n][k] = *(const LAS bf16x8*)(lds + PG8_SB(b, h) + boff + n * 2048 + k * 1024); } while (0)
#define PG8_MMA(ai, bj, At, Bt) do { __builtin_amdgcn_s_setprio(1); _Pragma("unroll") for (int m = 0; m < 4; ++m) _Pragma("unroll") for (int n = 0; n < 2; ++n) _Pragma("unroll") for (int k = 0; k < 2; ++k) \
        acc[ai][bj][m][n] = __builtin_amdgcn_mfma_f32_16x16x32_bf16(Bt[n][k], At[m][k], acc[ai][bj][m][n], 0, 0, 0); __builtin_amdgcn_s_setprio(0); } while (0)
#define PG8_WAIT_V(n) asm volatile("s_waitcnt vmcnt(" #n ")" ::: "memory")
#define PG8_WAIT_L(n) asm volatile("s_waitcnt lgkmcnt(" #n ")" ::: "memory")
#define PG8_BAR __builtin_amdgcn_s_barrier()
#define PG8_SCHED __builtin_amdgcn_sched_barrier(0)
    Unit cur, nxt; int ui = 0;
    if (!S.next(0, cur)) return;
    Acc acc;
#pragma unroll
    for (int a = 0; a < 2; ++a)
#pragma unroll
        for (int b = 0; b < 2; ++b)
#pragma unroll
            for (int m = 0; m < 4; ++m)
#pragma unroll
                for (int n = 0; n < 2; ++n) acc[a][b][m][n] = (f32x4){0.f, 0.f, 0.f, 0.f};
    bf16x8 At[4][2], B0[2][2], B1[2][2];
    const char* cA = cur.A; const char* cB = cur.B;
    PG8_STAGE(PG8_SB(0, 0), cB, voffB); PG8_STAGE(PG8_SB(0, 1), cB + hstepB, voffB); PG8_STAGE(PG8_SA(0, 0), cA, voffA); PG8_STAGE(PG8_SA(0, 1), cA + hstepA, voffA);
    if (wr == 1) PG8_BAR;
    PG8_WAIT_V(2); PG8_BAR;
    PG8_STAGE(PG8_SB(1, 0), cB + kstep, voffB); PG8_STAGE(PG8_SA(1, 0), cA + kstep, voffA); PG8_STAGE(PG8_SB(1, 1), cB + hstepB + kstep, voffB);
    PG8_WAIT_V(6); PG8_BAR;
    for (;;) {
        const bool has_next = S.next(ui + 1, nxt);
        const char* nA = has_next ? nxt.A : cA; const char* nB = has_next ? nxt.B : cB;
        for (int t = 0; t < nt; t += 2) {
            const bool last = (t == nt - 2);
            const char* a1 = cA + (size_t)(t + 1) * kstep;
            const char* a2 = last ? nA : cA + (size_t)(t + 2) * kstep; const char* b2 = last ? nB : cB + (size_t)(t + 2) * kstep;
            const char* a3 = a2 + kstep; const char* b3 = b2 + kstep;
            PG8_LDB(B0, 0, 0); PG8_LDB(B1, 0, 1); PG8_SCHED; PG8_LDA(At, 0, 0); PG8_STAGE(PG8_SA(1, 1), a1 + hstepA, voffA);
            PG8_WAIT_V(8); PG8_WAIT_L(0); PG8_BAR; PG8_MMA(0, 0, At, B0); PG8_MMA(0, 1, At, B1); PG8_BAR; PG8_SCHED;
            PG8_LDA(At, 0, 1); PG8_STAGE(PG8_SB(0, 0), b2, voffB); PG8_STAGE(PG8_SB(0, 1), b2 + hstepB, voffB); PG8_STAGE(PG8_SA(0, 0), a2, voffA);
            PG8_WAIT_V(8); PG8_WAIT_L(0); PG8_BAR; PG8_MMA(1, 0, At, B0); PG8_MMA(1, 1, At, B1); PG8_BAR; PG8_SCHED;
            PG8_LDB(B0, 1, 0); PG8_LDB(B1, 1, 1); PG8_SCHED; PG8_LDA(At, 1, 0); PG8_STAGE(PG8_SA(0, 1), a2 + hstepA, voffA);
            PG8_WAIT_V(8); PG8_WAIT_L(0); PG8_BAR; PG8_MMA(0, 0, At, B0); PG8_MMA(0, 1, At, B1); PG8_BAR; PG8_SCHED;
            PG8_LDA(At, 1, 1); PG8_STAGE(PG8_SB(1, 0), b3, voffB); PG8_STAGE(PG8_SB(1, 1), b3 + hstepB, voffB); PG8_STAGE(PG8_SA(1, 0), a3, voffA);
            PG8_WAIT_V(8); PG8_WAIT_L(0); PG8_BAR; PG8_MMA(1, 0, At, B0); PG8_MMA(1, 1, At, B1); PG8_BAR; PG8_SCHED;
        }
        if (wr == 0) PG8_BAR;
        E(acc, cur, wr, wc, fr, fq);
        if (!has_next) break;
#pragma unroll
        for (int a = 0; a < 2; ++a)
#pragma unroll
            for (int b = 0; b < 2; ++b)
#pragma unroll
                for (int m = 0; m < 4; ++m)
#pragma unroll
                    for (int n = 0; n < 2; ++n) acc[a][b][m][n] = (f32x4){0.f, 0.f, 0.f, 0.f};
        cur = nxt; cA = nA; cB = nB; ++ui;
        if (wr == 1) PG8_BAR;
    }
    PG8_WAIT_V(0);
    PG8_BAR;
#undef PG8_SA
#undef PG8_SB
#undef PG8_STAGE
#undef PG8_LDA
#undef PG8_LDB
#undef PG8_MMA
#undef PG8_WAIT_V
#undef PG8_WAIT_L
#undef PG8_BAR
#undef PG8_SCHED
}
}

namespace att {
constexpr int NW = 8, QBLK = 32, KVBLK = 64;
constexpr float SCALE = 0.07216878364870322f;
constexpr float THR = 8.f;
#ifndef ATT_SDEPTH
#define ATT_SDEPTH 2
#endif
constexpr int SDEPTH = ATT_SDEPTH;
constexpr int KROW = 400;
constexpr int SHM_V = KVBLK * DV * 2, SHM_K = KVBLK * KROW;
#ifndef ATT_NQR
#define ATT_NQR 8
#endif
constexpr int NQR = ATT_NQR;
constexpr int QLROW = (12 - NQR) * 32 + 16;
constexpr int OFF_V = 0, OFF_K = 2 * SHM_V, OFF_WS = OFF_K + 2 * SHM_K, OFF_QL = OFF_WS + NW * 64 * 4, ATT_LDS = OFF_QL + NW * 32 * QLROW;
static_assert(ATT_LDS <= RING_BYTES, "attention LDS");
#define SBAR() __builtin_amdgcn_sched_barrier(0)
__device__ __forceinline__ int crow(int r, int hi) { return (r & 3) + 8 * (r >> 2) + 4 * hi; }
__device__ __forceinline__ void partialSM(f32x16& p0, f32x16& p1, float& m_reg, float& mn, float& alpha) {
    constexpr float C = SCALE * 1.4426950408889634f;
    float pmax = p0[0];
#pragma unroll
    for (int r = 1; r < 16; ++r) pmax = fmaxf(pmax, p0[r]);
#pragma unroll
    for (int r = 0; r < 16; ++r) pmax = fmaxf(pmax, p1[r]);
    { auto rr = __builtin_amdgcn_permlane32_swap(__float_as_uint(pmax), __float_as_uint(pmax), false, false);
      pmax = fmaxf(__uint_as_float(rr[0]), __uint_as_float(rr[1])); }
    if (__builtin_expect(__all(pmax - m_reg <= THR / SCALE), 1)) { mn = m_reg; alpha = 1.f; }
    else { mn = fmaxf(m_reg, pmax); alpha = __builtin_amdgcn_exp2f((m_reg - mn) * C); m_reg = mn; }
    const float mnC = -mn * C;
#pragma unroll
    for (int r = 0; r < 16; ++r) p0[r] = fmaf(p0[r], C, mnC);
#pragma unroll
    for (int r = 0; r < 16; ++r) p1[r] = fmaf(p1[r], C, mnC);
#pragma unroll
    for (int r = 0; r < 16; ++r) p0[r] = __builtin_amdgcn_exp2f(p0[r]);
}
__device__ __forceinline__ void finishSM(f32x16& p0, f32x16& p1, float alpha, float& l_reg, bf16x8& pa0, bf16x8& pa1, bf16x8& pa2, bf16x8& pa3) {
#pragma unroll
    for (int r = 0; r < 16; ++r) p1[r] = __builtin_amdgcn_exp2f(p1[r]);
    float ps = 0;
#pragma unroll
    for (int r = 0; r < 16; ++r) ps += p0[r];
#pragma unroll
    for (int r = 0; r < 16; ++r) ps += p1[r];
    { auto rr = __builtin_amdgcn_permlane32_swap(__float_as_uint(ps), __float_as_uint(ps), false, false);
      ps = __uint_as_float(rr[0]) + __uint_as_float(rr[1]); }
    l_reg = l_reg * alpha + ps;
#define PK4(P, BASE, OUT) do { unsigned a0 = cvt_pk_bf16(P[BASE + 0], P[BASE + 1]), a1 = cvt_pk_bf16(P[BASE + 2], P[BASE + 3]);   \
    unsigned b0 = cvt_pk_bf16(P[BASE + 4], P[BASE + 5]), b1 = cvt_pk_bf16(P[BASE + 6], P[BASE + 7]);                              \
    auto r0 = __builtin_amdgcn_permlane32_swap(a0, b0, false, false); auto r1 = __builtin_amdgcn_permlane32_swap(a1, b1, false, false); \
    u32x4 w = {r0[0], r1[0], r0[1], r1[1]}; OUT = *reinterpret_cast<bf16x8*>(&w); } while (0)
    PK4(p0, 0, pa0); PK4(p0, 8, pa1); PK4(p1, 0, pa2); PK4(p1, 8, pa3);
#undef PK4
}
__device__ __forceinline__ void qkt(f32x16& p0, f32x16& p1, const char* Ks, const bf16x8* qr, const char* ql, int r32, int hi) {
    p0 = f32x16{}; p1 = f32x16{};
#pragma unroll
    for (int d0 = 0; d0 < 12; ++d0) { const int cb = d0 * 32 + hi * 16;
        const bf16x8 b0 = *reinterpret_cast<const bf16x8*>(Ks + r32 * KROW + cb);
        const bf16x8 b1 = *reinterpret_cast<const bf16x8*>(Ks + (32 + r32) * KROW + cb);
        const bf16x8 qf = (d0 < NQR) ? qr[d0] : *reinterpret_cast<const bf16x8*>(ql + (d0 - NQR) * 32);
        p0 = __builtin_amdgcn_mfma_f32_32x32x16_bf16(b0, qf, p0, 0, 0, 0);
        p1 = __builtin_amdgcn_mfma_f32_32x32x16_bf16(b1, qf, p1, 0, 0, 0); }
}
__device__ __forceinline__ int v_st(int k, int c) { const int kk = (k & ~0xC) | ((k & 4) << 1) | ((k & 8) >> 1); return ((kk >> 3) * 4 + (c >> 5)) * 512 + ((kk & 7) * 32 + (c & 31)) * 2; }
__device__ __forceinline__ int v_rd_base(int lane) { return ((lane & 3) << 3) | (((lane >> 2) & 3) << 6) | (((lane >> 4) & 1) << 5) | (((lane >> 5) & 1) << 8); }
constexpr int v_rd_off(int d0, int ks, int half) { return d0 * 512 + ks * 4096 + half * 2048; }
template <int OFF> __device__ __forceinline__ s16x4 tr_read(int vb) {
    s16x4 r; asm volatile("ds_read_b64_tr_b16 %0, %1 offset:%2" : "=&v"(r) : "v"(vb), "i"(OFF) : "memory"); return r;
}
template <int D0> __device__ __forceinline__ void pv_one(f32x16& od, int vb, bf16x8 pa0, bf16x8 pa1, bf16x8 pa2, bf16x8 pa3) {
    const s16x4 l0 = tr_read<v_rd_off(D0, 0, 0)>(vb), h0 = tr_read<v_rd_off(D0, 0, 1)>(vb), l1 = tr_read<v_rd_off(D0, 1, 0)>(vb), h1 = tr_read<v_rd_off(D0, 1, 1)>(vb);
    const s16x4 l2 = tr_read<v_rd_off(D0, 2, 0)>(vb), h2 = tr_read<v_rd_off(D0, 2, 1)>(vb), l3 = tr_read<v_rd_off(D0, 3, 0)>(vb), h3 = tr_read<v_rd_off(D0, 3, 1)>(vb);
    asm volatile("s_waitcnt lgkmcnt(0)" ::: "memory"); SBAR();
#define PK(L, H) (bf16x8){L[0], L[1], L[2], L[3], H[0], H[1], H[2], H[3]}
    od = __builtin_amdgcn_mfma_f32_32x32x16_bf16(pa0, PK(l0, h0), od, 0, 0, 0);
    od = __builtin_amdgcn_mfma_f32_32x32x16_bf16(pa1, PK(l1, h1), od, 0, 0, 0);
    od = __builtin_amdgcn_mfma_f32_32x32x16_bf16(pa2, PK(l2, h2), od, 0, 0, 0);
    od = __builtin_amdgcn_mfma_f32_32x32x16_bf16(pa3, PK(l3, h3), od, 0, 0, 0);
#undef PK
}
__device__ __forceinline__ void pv_d0(f32x16* o, int vb, bf16x8 pa0, bf16x8 pa1, bf16x8 pa2, bf16x8 pa3) {
    pv_one<0>(o[0], vb, pa0, pa1, pa2, pa3); pv_one<1>(o[1], vb, pa0, pa1, pa2, pa3); pv_one<2>(o[2], vb, pa0, pa1, pa2, pa3); pv_one<3>(o[3], vb, pa0, pa1, pa2, pa3);
}
__device__ __forceinline__ void attn_unit(const bf16_t* __restrict__ Qb, const bf16_t* __restrict__ Kh, const bf16_t* __restrict__ Vh, bf16_t* __restrict__ Ob, char* lds, int tid) {
    const int wid = tid >> 6, lane = tid & 63, r32 = lane & 31, hi = lane >> 5;
    char* V_lds = lds + OFF_V; char* K_lds = lds + OFF_K;
    float* ws = (float*)(lds + OFF_WS) + wid * 64; float* li_l = ws; float* al_l = ws + 32;
    float m_reg = -1e30f, l_reg = 0; f32x16 o[4] = {}; bf16x8 qr[NQR];
    const bf16_t* Qw = Qb + (long)(wid * QBLK + r32) * DQK + hi * 8;
#pragma unroll
    for (int d0 = 0; d0 < NQR; ++d0) qr[d0] = *reinterpret_cast<const bf16x8*>(Qw + d0 * 16);
    char* ql = lds + OFF_QL + wid * (32 * QLROW) + r32 * QLROW + hi * 16;
#pragma unroll
    for (int d0 = NQR; d0 < 12; ++d0) *reinterpret_cast<bf16x8*>(ql + (d0 - NQR) * 32) = *reinterpret_cast<const bf16x8*>(Qw + d0 * 16);
    const int sr = tid >> 4, sc = (tid & 15) * 8, vst0 = v_st(sr, sc), vst1 = v_st(32 + sr, sc);
    int kst[3];
#pragma unroll
    for (int i = 0; i < 3; ++i) { const int q = tid + 512 * i; kst[i] = (q / 24) * KROW + (q % 24) * 16; }
    const int vb0 = (int)(uintptr_t)V_lds + v_rd_base(lane);
    struct { bf16x8 vs0, vs1, ks0, ks1, ks2; } sr_[SDEPTH];
#define SLOAD(i, k0) do { sr_[i].vs0 = *reinterpret_cast<const bf16x8*>(&Vh[(long)((k0) + sr) * DV + sc]); sr_[i].vs1 = *reinterpret_cast<const bf16x8*>(&Vh[(long)((k0) + 32 + sr) * DV + sc]); \
    const bf16_t* kp_ = Kh + (long)(k0) * DQK + tid * 8; sr_[i].ks0 = *reinterpret_cast<const bf16x8*>(kp_); sr_[i].ks1 = *reinterpret_cast<const bf16x8*>(kp_ + 4096); sr_[i].ks2 = *reinterpret_cast<const bf16x8*>(kp_ + 8192); } while (0)
#define SWRITE(b, i) do { *(bf16x8*)(V_lds + (b) * SHM_V + vst0) = sr_[i].vs0; *(bf16x8*)(V_lds + (b) * SHM_V + vst1) = sr_[i].vs1; \
    *(bf16x8*)(K_lds + (b) * SHM_K + kst[0]) = sr_[i].ks0; *(bf16x8*)(K_lds + (b) * SHM_K + kst[1]) = sr_[i].ks1; *(bf16x8*)(K_lds + (b) * SHM_K + kst[2]) = sr_[i].ks2; } while (0)
#define SWAIT() do { if constexpr (SDEPTH == 2) asm volatile("s_waitcnt vmcnt(5)" ::: "memory"); else asm volatile("s_waitcnt vmcnt(0)" ::: "memory"); } while (0)
#define RESC(a) do { if (__any((a) < 1.f)) { if (hi == 0) al_l[r32] = (a); asm volatile("s_waitcnt lgkmcnt(0)" ::: "memory"); \
    _Pragma("unroll") for (int d = 0; d < 4; ++d) _Pragma("unroll") for (int r = 0; r < 16; ++r) o[d][r] *= al_l[crow(r, hi)]; } } while (0)
    f32x16 pA0, pA1, pB0, pB1; float mnA, mnB, alA, alB; bf16x8 pa0, pa1, pa2, pa3; constexpr int NT = SEQ / KVBLK;
    constexpr int SE = 0, SO = SDEPTH - 1;
    SLOAD(SE, 0); asm volatile("s_waitcnt vmcnt(0)" ::: "memory"); SWRITE(0, SE); __syncthreads();
    qkt(pA0, pA1, K_lds, qr, ql, r32, hi); partialSM(pA0, pA1, m_reg, mnA, alA);
    SLOAD(SO, KVBLK); if constexpr (SDEPTH == 2) SLOAD(SE, 2 * KVBLK);
    SWAIT(); SWRITE(1, SO); __syncthreads();
    for (int j = 1; j + 1 < NT; j += 2) {
        SBAR(); qkt(pB0, pB1, K_lds + SHM_K, qr, ql, r32, hi);
        finishSM(pA0, pA1, alA, l_reg, pa0, pa1, pa2, pa3); SBAR();
        SLOAD(SO, (j + SDEPTH) * KVBLK); SBAR();
        pv_d0(o, vb0, pa0, pa1, pa2, pa3); partialSM(pB0, pB1, m_reg, mnB, alB);
        __syncthreads(); SWAIT(); SWRITE(0, SE);
        RESC(alB); __syncthreads();
        SBAR(); qkt(pA0, pA1, K_lds, qr, ql, r32, hi);
        finishSM(pB0, pB1, alB, l_reg, pa0, pa1, pa2, pa3); SBAR();
        if (SDEPTH == 1 || j + 3 < NT) SLOAD(SE, (j + 1 + SDEPTH) * KVBLK); SBAR();
        pv_d0(o, vb0 + SHM_V, pa0, pa1, pa2, pa3); partialSM(pA0, pA1, m_reg, mnA, alA);
        __syncthreads(); SWAIT(); SWRITE(1, SO);
        RESC(alA); __syncthreads();
    }
    SBAR(); qkt(pB0, pB1, K_lds + SHM_K, qr, ql, r32, hi);
    finishSM(pA0, pA1, alA, l_reg, pa0, pa1, pa2, pa3); SBAR();
    pv_d0(o, vb0, pa0, pa1, pa2, pa3); partialSM(pB0, pB1, m_reg, mnB, alB);
    __syncthreads(); RESC(alB);
    finishSM(pB0, pB1, alB, l_reg, pa0, pa1, pa2, pa3); SBAR();
    pv_d0(o, vb0 + SHM_V, pa0, pa1, pa2, pa3);
    if (hi == 0) li_l[r32] = l_reg; asm volatile("s_waitcnt lgkmcnt(0)" ::: "memory");
    float rli[16];
#pragma unroll
    for (int r = 0; r < 16; ++r) rli[r] = __builtin_amdgcn_rcpf(li_l[crow(r, hi)]);
    __syncthreads();
    bf16_t* ost = (bf16_t*)(lds + wid * 8192);
#pragma unroll
    for (int r = 0; r < 16; ++r) { const int orow = crow(r, hi);
#pragma unroll
        for (int d0 = 0; d0 < 4; ++d0) ost[orow * 128 + d0 * 32 + r32] = (bf16_t)f2bf(o[d0][r] * rli[r]); }
    asm volatile("s_waitcnt lgkmcnt(0)" ::: "memory");
    bf16_t* Ow = Ob + (long)(wid * QBLK) * DM;
#pragma unroll
    for (int i = 0; i < 8; ++i) { const int ch = lane + 64 * i, row = ch >> 4, c = ch & 15;
        const u32x4 v = *(const u32x4*)((const char*)ost + row * 256 + c * 16); *(u32x4*)(Ow + (long)row * DM + c * 8) = v; }
    __syncthreads();
#undef SLOAD
#undef SWRITE
#undef SWAIT
#undef RESC
#undef SBAR
}
}


namespace att8 {
typedef int i32x8 __attribute__((ext_vector_type(8)));
constexpr int NW = 8, QBLK = 32, KVBLK = 64;
constexpr float SCALE = 0.07216878364870322f;
constexpr float THR = 3.f;
constexpr float POFF = 4.f;
constexpr int KROW = 208, VROW = 80;
constexpr int SHM_K = KVBLK * KROW, SHM_V = DV * VROW;
constexpr int OFF_V = 0, OFF_K = 2 * SHM_V, OFF_WS = OFF_K + 2 * SHM_K, ATT_LDS = OFF_WS + NW * 64 * 4;
static_assert(ATT_LDS <= 65536, "O staging reuses [0, 64 KiB)");
#define SBAR() __builtin_amdgcn_sched_barrier(0)
__device__ __forceinline__ int crow(int r, int hi) { return (r & 3) + 8 * (r >> 2) + 4 * hi; }
__device__ __forceinline__ f32x16 mfma8(i32x8 a, i32x8 b, f32x16 c) { return __builtin_amdgcn_mfma_scale_f32_32x32x64_f8f6f4(a, b, c, 0, 0, 0, 0x7F7F7F7F, 0, 0x7F7F7F7F); }
__device__ __forceinline__ i32x8 ld32(const char* p) { const u32x4 a = *reinterpret_cast<const u32x4*>(p), b = *reinterpret_cast<const u32x4*>(p + 16); return (i32x8){(int)a.x, (int)a.y, (int)a.z, (int)a.w, (int)b.x, (int)b.y, (int)b.z, (int)b.w}; }
__device__ __forceinline__ void partialSM(f32x16& p0, f32x16& p1, float& m_reg, float& mn, float& alpha) {
    constexpr float C = SCALE * 1.4426950408889634f;
    float pmax = p0[0];
#pragma unroll
    for (int r = 1; r < 16; ++r) pmax = fmaxf(pmax, p0[r]);
#pragma unroll
    for (int r = 0; r < 16; ++r) pmax = fmaxf(pmax, p1[r]);
    { auto rr = __builtin_amdgcn_permlane32_swap(__float_as_uint(pmax), __float_as_uint(pmax), false, false);
      pmax = fmaxf(__uint_as_float(rr[0]), __uint_as_float(rr[1])); }
    if (__builtin_expect(__all(pmax - m_reg <= THR / SCALE), 1)) { mn = m_reg; alpha = 1.f; }
    else { mn = fmaxf(m_reg, pmax); alpha = __builtin_amdgcn_exp2f((m_reg - mn) * C); m_reg = mn; }
    const float mnC = POFF - mn * C;
#pragma unroll
    for (int r = 0; r < 16; ++r) p0[r] = fmaf(p0[r], C, mnC);
#pragma unroll
    for (int r = 0; r < 16; ++r) p1[r] = fmaf(p1[r], C, mnC);
#pragma unroll
    for (int r = 0; r < 16; ++r) p0[r] = __builtin_amdgcn_exp2f(p0[r]);
}
__device__ __forceinline__ void finishSM(f32x16& p0, f32x16& p1, float alpha, float& l_reg, i32x8& pa) {
#pragma unroll
    for (int r = 0; r < 16; ++r) p1[r] = __builtin_amdgcn_exp2f(p1[r]);
    float ps = 0;
#pragma unroll
    for (int r = 0; r < 16; ++r) ps += p0[r];
#pragma unroll
    for (int r = 0; r < 16; ++r) ps += p1[r];
    { auto rr = __builtin_amdgcn_permlane32_swap(__float_as_uint(ps), __float_as_uint(ps), false, false);
      ps = __uint_as_float(rr[0]) + __uint_as_float(rr[1]); }
    l_reg = l_reg * alpha + ps;
#pragma unroll
    for (int g = 0; g < 4; ++g) { int w = 0; w = __builtin_amdgcn_cvt_pk_fp8_f32(p0[4 * g], p0[4 * g + 1], w, false); w = __builtin_amdgcn_cvt_pk_fp8_f32(p0[4 * g + 2], p0[4 * g + 3], w, true); pa[g] = w; }
#pragma unroll
    for (int g = 0; g < 4; ++g) { int w = 0; w = __builtin_amdgcn_cvt_pk_fp8_f32(p1[4 * g], p1[4 * g + 1], w, false); w = __builtin_amdgcn_cvt_pk_fp8_f32(p1[4 * g + 2], p1[4 * g + 3], w, true); pa[4 + g] = w; }
}
__device__ __forceinline__ void qkt(f32x16& p0, f32x16& p1, const char* Ks, const i32x8* qr, int r32, int hi) {
    p0 = f32x16{}; p1 = f32x16{};
#pragma unroll
    for (int ks = 0; ks < 3; ++ks) { const int cb = ks * 64 + hi * 32;
        const i32x8 a0 = ld32(Ks + r32 * KROW + cb), a1 = ld32(Ks + (32 + r32) * KROW + cb);
        p0 = mfma8(a0, qr[ks], p0); p1 = mfma8(a1, qr[ks], p1); }
}
__device__ __forceinline__ void pv(f32x16* o, const char* Vs, i32x8 pa, int r32, int hi) {
#pragma unroll
    for (int d0 = 0; d0 < 4; ++d0) { const i32x8 b = ld32(Vs + (32 * d0 + r32) * VROW + hi * 32); o[d0] = mfma8(pa, b, o[d0]); }
}
__device__ __forceinline__ void attn_unit(const unsigned char* __restrict__ Qb, const unsigned char* __restrict__ Kh, const unsigned char* __restrict__ Vt, bf16_t* __restrict__ Ob, char* lds, int tid) {
    const int wid = tid >> 6, lane = tid & 63, r32 = lane & 31, hi = lane >> 5;
    char* V_lds = lds + OFF_V; char* K_lds = lds + OFF_K;
    float* ws = (float*)(lds + OFF_WS) + wid * 64; float* li_l = ws; float* al_l = ws + 32;
    float m_reg = -1e30f, l_reg = 0; f32x16 o[4] = {}; i32x8 qr[3];
    const unsigned char* Qw = Qb + (long)(wid * QBLK + r32) * DQK + hi * 32;
#pragma unroll
    for (int ks = 0; ks < 3; ++ks) qr[ks] = ld32((const char*)Qw + ks * 64);
    const int kst0 = (tid / 12) * KROW + (tid % 12) * 16, kst1 = ((tid + 512) / 12) * KROW + ((tid + 512) % 12) * 16, vst = (tid >> 2) * VROW + (tid & 3) * 16;
    const bool k2 = tid < 256;
    struct { u32x4 v, k0, k1; } sr_[2];
#define SLOAD(i, t) do { sr_[i].v = *reinterpret_cast<const u32x4*>(Vt + (long)(t) * 8192 + tid * 16); const unsigned char* kp_ = Kh + (long)(t) * 12288 + tid * 16; \
    sr_[i].k0 = *reinterpret_cast<const u32x4*>(kp_); if (k2) sr_[i].k1 = *reinterpret_cast<const u32x4*>(kp_ + 8192); } while (0)
#define SWRITE(b, i) do { *(u32x4*)(V_lds + (b) * SHM_V + vst) = sr_[i].v; *(u32x4*)(K_lds + (b) * SHM_K + kst0) = sr_[i].k0; if (k2) *(u32x4*)(K_lds + (b) * SHM_K + kst1) = sr_[i].k1; } while (0)
#define RESC(a) do { if (__any((a) < 1.f)) { if (hi == 0) al_l[r32] = (a); asm volatile("s_waitcnt lgkmcnt(0)" ::: "memory"); \
    _Pragma("unroll") for (int d = 0; d < 4; ++d) _Pragma("unroll") for (int r = 0; r < 16; ++r) o[d][r] *= al_l[crow(r, hi)]; } } while (0)
    f32x16 pA0, pA1, pB0, pB1; float mnA, mnB, alA, alB; i32x8 pa; constexpr int NT = SEQ / KVBLK;
    SLOAD(0, 0); asm volatile("s_waitcnt vmcnt(0)" ::: "memory"); SWRITE(0, 0); __syncthreads();
    qkt(pA0, pA1, K_lds, qr, r32, hi); partialSM(pA0, pA1, m_reg, mnA, alA);
    SLOAD(1, 1); SLOAD(0, 2);
    SWRITE(1, 1); __syncthreads();
    for (int j = 1; j + 1 < NT; j += 2) {
        SBAR(); qkt(pB0, pB1, K_lds + SHM_K, qr, r32, hi);
        finishSM(pA0, pA1, alA, l_reg, pa); SBAR();
        SLOAD(1, j + 2); SBAR();
        pv(o, V_lds, pa, r32, hi); partialSM(pB0, pB1, m_reg, mnB, alB);
        __syncthreads(); SWRITE(0, 0);
        RESC(alB); __syncthreads();
        SBAR(); qkt(pA0, pA1, K_lds, qr, r32, hi);
        finishSM(pB0, pB1, alB, l_reg, pa); SBAR();
        if (j + 3 < NT) SLOAD(0, j + 3); SBAR();
        pv(o, V_lds + SHM_V, pa, r32, hi); partialSM(pA0, pA1, m_reg, mnA, alA);
        __syncthreads(); SWRITE(1, 1);
        RESC(alA); __syncthreads();
    }
    SBAR(); qkt(pB0, pB1, K_lds + SHM_K, qr, r32, hi);
    finishSM(pA0, pA1, alA, l_reg, pa); SBAR();
    pv(o, V_lds, pa, r32, hi); partialSM(pB0, pB1, m_reg, mnB, alB);
    __syncthreads(); RESC(alB);
    finishSM(pB0, pB1, alB, l_reg, pa); SBAR();
    pv(o, V_lds + SHM_V, pa, r32, hi);
    if (hi == 0) li_l[r32] = l_reg; asm volatile("s_waitcnt lgkmcnt(0)" ::: "memory");
    float rli[16];
#pragma unroll
    for (int r = 0; r < 16; ++r) rli[r] = __builtin_amdgcn_rcpf(li_l[crow(r, hi)]);
    __syncthreads();
    bf16_t* ost = (bf16_t*)(lds + wid * 8192);
#pragma unroll
    for (int r = 0; r < 16; ++r) { const int orow = crow(r, hi);
#pragma unroll
        for (int d0 = 0; d0 < 4; ++d0) ost[orow * 128 + d0 * 32 + r32] = (bf16_t)f2bf(o[d0][r] * rli[r]); }
    asm volatile("s_waitcnt lgkmcnt(0)" ::: "memory");
    bf16_t* Ow = Ob + (long)(wid * QBLK) * DM;
#pragma unroll
    for (int i = 0; i < 8; ++i) { const int ch = lane + 64 * i, row = ch >> 4, c = ch & 15;
        const u32x4 v = *(const u32x4*)((const char*)ost + row * 256 + c * 16); *(u32x4*)(Ow + (long)row * DM + c * 8) = v; }
    __syncthreads();
#undef SLOAD
#undef SWRITE
#undef RESC
#undef SBAR
}
}

struct Args { const void* in[23]; float* out; unsigned char* ws; int ph_lo, ph_hi; };
enum { I_X = 0, I_POS, I_CNW, I_CWIN, I_CK, I_CWOUT, I_MNW, I_MWDOWN, I_MQLN, I_MKVLN, I_MWQ, I_MWKV, I_MQHN, I_MKHN, I_MWO, I_FNW, I_RWG, I_RBG, I_RWE, I_RBE, I_EWG, I_EWU, I_EWD };

struct CvtItem { const float* W; bf16_t* WT; const float* ksc; int K, N, k0, n0, drow0; };
__device__ __forceinline__ unsigned char* ldptr(int i);
constexpr int CVT_PER_J = 768 + 256 + 176 + 144 + 128 + 256;
constexpr int CVT_MIX = 2 * CVT_PER_J, CVT_EXP = MK_ENABLE_MOE ? 4 * NE * 288 : 0, CVT_ITEMS = CVT_MIX + CVT_EXP;
__device__ __forceinline__ void cvt_decode(int it, CvtItem& c, unsigned char* ws) {
    if (it < CVT_MIX) {
        const int j = it / CVT_PER_J; int r = it - j * CVT_PER_J; int kb, nb;
        if (r < 768) { c.K = 1024; c.N = 3072; c.W = (const float*)ldptr(I_CWIN) + (size_t)j * 1024 * 3072; c.WT = (bf16_t*)(ws + WS_WIN) + (size_t)j * 3072 * 1024; c.ksc = (const float*)ldptr(I_CNW) + j * 1024;
            kb = r / 48; nb = r % 48; const int n0 = nb * 64;
            if (n0 < 1024) c.drow0 = n0; else if (n0 < 2048) { const int q = n0 - 1024; c.drow0 = 1024 + (q >> 7) * 256 + (q & 127); } else { const int q = n0 - 2048; c.drow0 = 1024 + (q >> 7) * 256 + 128 + (q & 127); } }
        else if ((r -= 768) < 256) { c.K = 1024; c.N = 1024; c.W = (const float*)ldptr(I_CWOUT) + (size_t)j * 1024 * 1024; c.WT = (bf16_t*)(ws + WS_WOUTC) + (size_t)j * 1024 * 1024; c.ksc = nullptr; kb = r / 16; nb = r % 16; c.drow0 = nb * 64; }
        else if ((r -= 256) < 176) { c.K = 1024; c.N = LAT; c.W = (const float*)ldptr(I_MWDOWN) + (size_t)j * 1024 * LAT; c.WT = (bf16_t*)(ws + WS_WDOWN) + (size_t)j * LATP * 1024; c.ksc = (const float*)ldptr(I_MNW) + j * 1024; kb = r / 11; nb = r % 11; c.drow0 = nb * 64; }
        else if ((r -= 176) < 144) { c.K = QLR; c.N = NH * DQK; c.W = (const float*)ldptr(I_MWQ) + (size_t)j * QLR * NH * DQK; c.WT = (bf16_t*)(ws + WS_WQ + (size_t)j * 1536 * 1024); c.ksc = (const float*)ldptr(I_MQLN) + j * QLR; kb = r / 24; nb = r % 24; c.drow0 = nb * 64; }
        else if ((r -= 144) < 128) { c.K = KVLR; c.N = NH * 256; c.W = (const float*)ldptr(I_MWKV) + (size_t)j * KVLR * NH * 256; c.WT = (bf16_t*)(ws + WS_WKV) + (size_t)j * 2048 * 256; c.ksc = (const float*)ldptr(I_MKVLN) + j * KVLR; kb = r / 32; nb = r % 32; c.drow0 = nb * 64; }
        else { r -= 128; c.K = 1024; c.N = 1024; c.W = (const float*)ldptr(I_MWO) + (size_t)j * 1024 * 1024; c.WT = (bf16_t*)(ws + WS_WO) + (size_t)j * 1024 * 1024; c.ksc = nullptr; kb = r / 16; nb = r % 16; c.drow0 = nb * 64; }
        c.k0 = kb * 64; c.n0 = nb * 64;
    } else {
        const int r = it - CVT_MIX; const int le = r / 288, q = r - le * 288, L = le >> 6; const int kind = q / 96, idx = q - kind * 96; int kb, nb;
        if (kind < 2) { c.K = 1024; c.N = DFF; c.W = (const float*)ldptr(kind == 0 ? I_EWG : I_EWU) + (size_t)le * 1024 * DFF; c.WT = (bf16_t*)(ws + WS_WE1) + (size_t)le * 768 * 1024; c.ksc = (const float*)ldptr(I_FNW) + L * 1024;
            kb = idx / 6; nb = idx % 6; const int n0 = nb * 64; c.drow0 = (n0 >> 7) * 256 + kind * 128 + (n0 & 127); }
        else { c.K = DFF; c.N = 1024; c.W = (const float*)ldptr(I_EWD) + (size_t)le * DFF * 1024; c.WT = (bf16_t*)(ws + WS_WE2) + (size_t)le * 1024 * DFF; c.ksc = nullptr; kb = idx / 16; nb = idx % 16; c.drow0 = nb * 64; }
        c.k0 = kb * 64; c.n0 = nb * 64;
    }
}
__device__ __forceinline__ void cvt_load(const CvtItem& c, f32x4 (&v)[16], int lane) {
    const float* p = c.W + (size_t)(c.k0 + (lane >> 4)) * c.N + c.n0 + 4 * (lane & 15);
#pragma unroll
    for (int i = 0; i < 16; ++i) v[i] = *(const f32x4*)(p + (size_t)(4 * i) * c.N);
}
__device__ __forceinline__ void cvt_lds_write(LAS float* tile, const f32x4 (&v)[16], int lane) {
#pragma unroll
    for (int i = 0; i < 16; ++i) { const int r = 4 * i + (lane >> 4), n = 4 * (lane & 15), x = r & 31; LAS float* row = tile + r * 64;
        row[(n + 0) ^ x] = v[i].x; row[(n + 1) ^ x] = v[i].y; row[(n + 2) ^ x] = v[i].z; row[(n + 3) ^ x] = v[i].w; }
}
__device__ __forceinline__ void cvt_out(const CvtItem& c, const LAS float* tile, int lane) {
    const int cc = lane & 7, np = lane >> 3;
    f32x4 s0 = {1.f, 1.f, 1.f, 1.f}, s1 = {1.f, 1.f, 1.f, 1.f};
    if (c.ksc) { s0 = *(const f32x4*)(c.ksc + c.k0 + 8 * cc); s1 = *(const f32x4*)(c.ksc + c.k0 + 8 * cc + 4); }
#pragma unroll
    for (int jj = 0; jj < 8; ++jj) { const int n = np + 8 * jj; float t[8];
#pragma unroll
        for (int q = 0; q < 8; ++q) { const int k = 8 * cc + q; t[q] = tile[k * 64 + (n ^ (k & 31))]; }
        u32x4 o; o.x = pk2(t[0] * s0.x, t[1] * s0.y); o.y = pk2(t[2] * s0.z, t[3] * s0.w); o.z = pk2(t[4] * s1.x, t[5] * s1.y); o.w = pk2(t[6] * s1.z, t[7] * s1.w);
        *(GAS u32x4*)(c.WT + (size_t)(c.drow0 + n) * c.K + c.k0 + 8 * cc) = o; }
}

__device__ __forceinline__ void prologue_phase(LAS unsigned char* lds, int gw, int NGW, int wave, int lane, int gtid, int NGT) {
    unsigned char* ws = ldptr(24);
    LAS float* tile = (LAS float*)(lds + wave * 16384);
    {   CvtItem cur, nxt; f32x4 v[16]; int it = gw;
        if (it < CVT_ITEMS) { cvt_decode(it, cur, ws); cvt_load(cur, v, lane); }
        while (it < CVT_ITEMS) {
            cvt_lds_write(tile, v, lane);
            const int itn = it + NGW;
            if (itn < CVT_ITEMS) { cvt_decode(itn, nxt, ws); cvt_load(nxt, v, lane); }
            LDS_WAIT(); asm volatile("" ::: "memory");
            cvt_out(cur, tile, lane);
            LDS_WAIT(); asm volatile("" ::: "memory");
            cur = nxt; it = itn;
        }
    }
#if MK_ENABLE_MOE
    const float* fnw = (const float*)ldptr(I_FNW); const float* rwg = (const float*)ldptr(I_RWG); const float* rwe = (const float*)ldptr(I_RWE);
    for (int i = gtid; i < 4 * 256 * 128; i += NGT) {
        const int L = i >> 15, n = (i >> 7) & 255, k8 = (i & 127) * 8;
        u32x4 o = {0u, 0u, 0u, 0u};
        if (n < 72) { float v[8];
#pragma unroll
            for (int q = 0; q < 8; ++q) { const int k = k8 + q; const float g = fnw[L * 1024 + k];
                v[q] = g * (n < 8 ? rwg[((size_t)L * 1024 + k) * 8 + n] : rwe[((size_t)L * 1024 + k) * 64 + (n - 8)]); }
            o.x = pk2(v[0], v[1]); o.y = pk2(v[2], v[3]); o.z = pk2(v[4], v[5]); o.w = pk2(v[6], v[7]); }
        *(u32x4*)((bf16_t*)(ws + WS_WRT) + ((size_t)L * 256 + n) * 1024 + k8) = o;
    }
#endif
    for (int i = gtid; i < 2 * 64 * 128; i += NGT) { const int j = i >> 13, n = LAT + ((i >> 7) & 63), k8 = (i & 127) * 8;
        *(u32x4*)((bf16_t*)(ws + WS_WDOWN) + ((size_t)j * LATP + n) * 1024 + k8) = (u32x4){0u, 0u, 0u, 0u}; }
}

__device__ __forceinline__ void norm_phase(const float* xin, const bf16_t* Y, float* xout, bf16_t* H, int gw, int NGW, int lane) {
    for (int m = gw; m < T; m += NGW) {
        const f32x4* xr = (const f32x4*)(xin + (size_t)m * DM) + lane;
        f32x4 v[4];
#pragma unroll
        for (int j = 0; j < 4; ++j) v[j] = xr[64 * j];
        if (Y) { const u32x2* y0 = (const u32x2*)(Y + (size_t)(2 * m) * DM) + lane; const u32x2* y1 = y0 + 256;
#pragma unroll
            for (int j = 0; j < 4; ++j) { const u32x2 p = y0[64 * j], q = y1[64 * j];
                v[j].x += bflo(p.x) + bflo(q.x); v[j].y += bfhi(p.x) + bfhi(q.x); v[j].z += bflo(p.y) + bflo(q.y); v[j].w += bfhi(p.y) + bfhi(q.y); } }
        if (xout) { f32x4* xo = (f32x4*)(xout + (size_t)m * DM) + lane;
#pragma unroll
            for (int j = 0; j < 4; ++j) xo[64 * j] = v[j]; }
        if (H) { float s = 0.f;
#pragma unroll
            for (int j = 0; j < 4; ++j) s += (v[j].x * v[j].x + v[j].y * v[j].y) + (v[j].z * v[j].z + v[j].w * v[j].w);
            const float r = 1.0f / sqrtf(wave_sum(s, lane) * (1.f / DM) + EPS);
            u32x2* ho = (u32x2*)(H + (size_t)m * DM) + lane;
#pragma unroll
            for (int j = 0; j < 4; ++j) { u32x2 w; w.x = pk2(v[j].x * r, v[j].y * r); w.y = pk2(v[j].z * r, v[j].w * r); ho[64 * j] = w; } }
    }
}

__device__ __forceinline__ void conv_phase(const bf16_t* GBp, const bf16_t* Zp, const float* ck, bf16_t* YCp, int gtid, int NGT) {
    for (int i = gtid; i < T * 128; i += NGT) {
        const int t = i >> 7, c8 = (i & 127) * 8, s = t & (SEQ - 1);
        const u32x4 zc = *(const u32x4*)(Zp + (size_t)t * DM + c8), g = *(const u32x4*)(GBp + (size_t)t * DM + c8);
        u32x4 zm = {0u, 0u, 0u, 0u}, zp = {0u, 0u, 0u, 0u};
        if (s > 0) zm = *(const u32x4*)(Zp + (size_t)(t - 1) * DM + c8);
        if (s < SEQ - 1) zp = *(const u32x4*)(Zp + (size_t)(t + 1) * DM + c8);
        const f32x4 k0a = *(const f32x4*)(ck + c8), k0b = *(const f32x4*)(ck + c8 + 4), k1a = *(const f32x4*)(ck + DM + c8), k1b = *(const f32x4*)(ck + DM + c8 + 4), k2a = *(const f32x4*)(ck + 2 * DM + c8), k2b = *(const f32x4*)(ck + 2 * DM + c8 + 4);
        float y[8];
#define CV(q, W, KA, LOHI) y[q] = LOHI(g.W) * (LOHI(zm.W) * k0##KA + LOHI(zc.W) * k1##KA + LOHI(zp.W) * k2##KA)
        CV(0, x, a[0], bflo); CV(1, x, a[1], bfhi); CV(2, y, a[2], bflo); CV(3, y, a[3], bfhi); CV(4, z, b[0], bflo); CV(5, z, b[1], bfhi); CV(6, w, b[2], bflo); CV(7, w, b[3], bfhi);
#undef CV
        u32x4 o; o.x = pk2(y[0], y[1]); o.y = pk2(y[2], y[3]); o.z = pk2(y[4], y[5]); o.w = pk2(y[6], y[7]);
        *(u32x4*)(YCp + (size_t)t * DM + c8) = o;
    }
}

__device__ __forceinline__ void qkprep_phase(const bf16_t* LATb, const bf16_t* QRAW, const bf16_t* KVRAW, const int* pos, const float* qhn, const float* khn,
                                             bf16_t* Qo, bf16_t* Ko, bf16_t* Vo, LAS unsigned char* lds, int gw, int NGW, int wave, int lane) {
    LAS unsigned char* sq = lds + wave * 10240;
    LAS float* cs = (LAS float*)(sq + 8704);
    const int h = lane >> 3, i8 = lane & 7;
    float gq[24], gk[24];
#pragma unroll
    for (int q = 0; q < 16; ++q) { gq[q] = qhn[16 * i8 + q]; gk[q] = khn[16 * i8 + q]; }
#pragma unroll
    for (int q = 0; q < 4; ++q) { gq[16 + q] = qhn[128 + 4 * i8 + q]; gq[20 + q] = qhn[160 + 4 * i8 + q]; gk[16 + q] = khn[128 + 4 * i8 + q]; gk[20 + q] = khn[160 + 4 * i8 + q]; }
    for (int t = gw; t < T; t += NGW) {
        const int b = t >> 14, s = t & (SEQ - 1);
        const u32x4* qs = (const u32x4*)(QRAW + (size_t)t * 1536); const u32x4* ks = (const u32x4*)(KVRAW + (size_t)t * 2048); const u32x4* ls = (const u32x4*)(LATb + (size_t)t * LATP);
        const u32x4 q0 = qs[lane], q1 = qs[lane + 64], q2 = qs[lane + 128], k0 = ks[lane], k1 = ks[lane + 64], k2 = ks[lane + 128], k3 = ks[lane + 192];
        const u32x4 l0 = ls[lane]; u32x4 l1 = {0u, 0u, 0u, 0u}; if (lane < 24) l1 = ls[lane + 64];
        LAS u32x4* d = (LAS u32x4*)sq;
        d[lane] = q0; d[lane + 64] = q1; d[lane + 128] = q2; d[192 + lane] = k0; d[192 + lane + 64] = k1; d[192 + lane + 128] = k2; d[192 + lane + 192] = k3;
        d[448 + lane] = l0; if (lane < 24) d[448 + lane + 64] = l1;
        float s0 = 0.f;
#define SS4(V_) (bflo(V_.x) * bflo(V_.x) + bfhi(V_.x) * bfhi(V_.x) + bflo(V_.y) * bflo(V_.y) + bfhi(V_.y) * bfhi(V_.y) + bflo(V_.z) * bflo(V_.z) + bfhi(V_.z) * bfhi(V_.z) + bflo(V_.w) * bflo(V_.w) + bfhi(V_.w) * bfhi(V_.w))
        s0 = SS4(l0); const float s1 = SS4(l1);
        const float ssq_q = wave_sum(lane < 48 ? s0 : 0.f, lane), ssq_kv = wave_sum((lane >= 48 ? s0 : 0.f) + (lane < 16 ? s1 : 0.f), lane);
        const float r_q = 1.0f / sqrtf(ssq_q * (1.f / QLR) + EPS), r_kv = 1.0f / sqrtf(ssq_kv * (1.f / KVLR) + EPS);
        if (lane < 32) { const float invf = powf(10000.f, -(float)lane * (1.f / 32.f)); const float ang = (float)pos[t] * invf;
            const double rev = (double)ang * 0.15915494309189535; const float fr = (float)(rev - floor(rev));
            cs[lane] = __builtin_amdgcn_cosf(fr); cs[32 + lane] = __builtin_amdgcn_sinf(fr); }
        LDS_WAIT(); asm volatile("" ::: "memory");
        float cj[4], sj[4];
#pragma unroll
        for (int q = 0; q < 4; ++q) { cj[q] = cs[4 * i8 + q]; sj[q] = cs[32 + 4 * i8 + q]; }
        {   const LAS bf16_t* qh = (const LAS bf16_t*)sq + h * DQK;
            const u32x4 a0 = *(const LAS u32x4*)(qh + 16 * i8), a1 = *(const LAS u32x4*)(qh + 16 * i8 + 8);
            const u32x2 r1 = *(const LAS u32x2*)(qh + 128 + 4 * i8), r2 = *(const LAS u32x2*)(qh + 160 + 4 * i8);
            float v[24];
            v[0] = bflo(a0.x); v[1] = bfhi(a0.x); v[2] = bflo(a0.y); v[3] = bfhi(a0.y); v[4] = bflo(a0.z); v[5] = bfhi(a0.z); v[6] = bflo(a0.w); v[7] = bfhi(a0.w);
            v[8] = bflo(a1.x); v[9] = bfhi(a1.x); v[10] = bflo(a1.y); v[11] = bfhi(a1.y); v[12] = bflo(a1.z); v[13] = bfhi(a1.z); v[14] = bflo(a1.w); v[15] = bfhi(a1.w);
            v[16] = bflo(r1.x); v[17] = bfhi(r1.x); v[18] = bflo(r1.y); v[19] = bfhi(r1.y); v[20] = bflo(r2.x); v[21] = bfhi(r2.x); v[22] = bflo(r2.y); v[23] = bfhi(r2.y);
            float ss = 0.f;
#pragma unroll
            for (int q = 0; q < 24; ++q) ss += v[q] * v[q];
            ss += lane_xor_f(ss, 1, lane); ss += lane_xor_f(ss, 2, lane); ss += lane_xor_f(ss, 4, lane);
            const float sc = r_q / sqrtf(r_q * r_q * ss * (1.f / DQK) + EPS);
#pragma unroll
            for (int q = 0; q < 24; ++q) v[q] *= sc * gq[q];
            bf16_t* qo = Qo + ((size_t)(b * NH + h) * SEQ + s) * DQK;
            u32x4 w0, w1; w0.x = pk2(v[0], v[1]); w0.y = pk2(v[2], v[3]); w0.z = pk2(v[4], v[5]); w0.w = pk2(v[6], v[7]); w1.x = pk2(v[8], v[9]); w1.y = pk2(v[10], v[11]); w1.z = pk2(v[12], v[13]); w1.w = pk2(v[14], v[15]);
            *(u32x4*)(qo + 16 * i8) = w0; *(u32x4*)(qo + 16 * i8 + 8) = w1;
            float o1[4], o2[4];
#pragma unroll
            for (int q = 0; q < 4; ++q) { o1[q] = v[16 + q] * cj[q] - v[20 + q] * sj[q]; o2[q] = v[20 + q] * cj[q] + v[16 + q] * sj[q]; }
            u32x2 e1, e2; e1.x = pk2(o1[0], o1[1]); e1.y = pk2(o1[2], o1[3]); e2.x = pk2(o2[0], o2[1]); e2.y = pk2(o2[2], o2[3]);
            *(u32x2*)(qo + 128 + 4 * i8) = e1; *(u32x2*)(qo + 160 + 4 * i8) = e2; }
        {   const LAS bf16_t* kh = (const LAS bf16_t*)(sq + 3072) + h * 256; const LAS bf16_t* lr = (const LAS bf16_t*)(sq + 7168) + 640;
            const u32x4 a0 = *(const LAS u32x4*)(kh + 16 * i8), a1 = *(const LAS u32x4*)(kh + 16 * i8 + 8);
            const u32x4 b0 = *(const LAS u32x4*)(kh + 128 + 16 * i8), b1 = *(const LAS u32x4*)(kh + 128 + 16 * i8 + 8);
            const u32x2 r1 = *(const LAS u32x2*)(lr + 4 * i8), r2 = *(const LAS u32x2*)(lr + 32 + 4 * i8);
            float v[24];
            v[0] = bflo(a0.x); v[1] = bfhi(a0.x); v[2] = bflo(a0.y); v[3] = bfhi(a0.y); v[4] = bflo(a0.z); v[5] = bfhi(a0.z); v[6] = bflo(a0.w); v[7] = bfhi(a0.w);
            v[8] = bflo(a1.x); v[9] = bfhi(a1.x); v[10] = bflo(a1.y); v[11] = bfhi(a1.y); v[12] = bflo(a1.z); v[13] = bfhi(a1.z); v[14] = bflo(a1.w); v[15] = bfhi(a1.w);
#pragma unroll
            for (int q = 0; q < 16; ++q) v[q] *= r_kv;
            v[16] = bflo(r1.x); v[17] = bfhi(r1.x); v[18] = bflo(r1.y); v[19] = bfhi(r1.y); v[20] = bflo(r2.x); v[21] = bfhi(r2.x); v[22] = bflo(r2.y); v[23] = bfhi(r2.y);
            float ss = 0.f;
#pragma unroll
            for (int q = 0; q < 24; ++q) ss += v[q] * v[q];
            ss += lane_xor_f(ss, 1, lane); ss += lane_xor_f(ss, 2, lane); ss += lane_xor_f(ss, 4, lane);
            const float sc = 1.0f / sqrtf(ss * (1.f / DQK) + EPS);
#pragma unroll
            for (int q = 0; q < 24; ++q) v[q] *= sc * gk[q];
            bf16_t* ko = Ko + ((size_t)(b * NH + h) * SEQ + s) * DQK;
            u32x4 w0, w1; w0.x = pk2(v[0], v[1]); w0.y = pk2(v[2], v[3]); w0.z = pk2(v[4], v[5]); w0.w = pk2(v[6], v[7]); w1.x = pk2(v[8], v[9]); w1.y = pk2(v[10], v[11]); w1.z = pk2(v[12], v[13]); w1.w = pk2(v[14], v[15]);
            *(u32x4*)(ko + 16 * i8) = w0; *(u32x4*)(ko + 16 * i8 + 8) = w1;
            float o1[4], o2[4];
#pragma unroll
            for (int q = 0; q < 4; ++q) { o1[q] = v[16 + q] * cj[q] - v[20 + q] * sj[q]; o2[q] = v[20 + q] * cj[q] + v[16 + q] * sj[q]; }
            u32x2 e1, e2; e1.x = pk2(o1[0], o1[1]); e1.y = pk2(o1[2], o1[3]); e2.x = pk2(o2[0], o2[1]); e2.y = pk2(o2[2], o2[3]);
            *(u32x2*)(ko + 128 + 4 * i8) = e1; *(u32x2*)(ko + 160 + 4 * i8) = e2;
            bf16_t* vo = Vo + ((size_t)(b * NH + h) * SEQ + s) * DV;
            u32x4 x0, x1;
            x0.x = pk2(bflo(b0.x) * r_kv, bfhi(b0.x) * r_kv); x0.y = pk2(bflo(b0.y) * r_kv, bfhi(b0.y) * r_kv); x0.z = pk2(bflo(b0.z) * r_kv, bfhi(b0.z) * r_kv); x0.w = pk2(bflo(b0.w) * r_kv, bfhi(b0.w) * r_kv);
            x1.x = pk2(bflo(b1.x) * r_kv, bfhi(b1.x) * r_kv); x1.y = pk2(bflo(b1.y) * r_kv, bfhi(b1.y) * r_kv); x1.z = pk2(bflo(b1.z) * r_kv, bfhi(b1.z) * r_kv); x1.w = pk2(bflo(b1.w) * r_kv, bfhi(b1.w) * r_kv);
            *(u32x4*)(vo + 16 * i8) = x0; *(u32x4*)(vo + 16 * i8 + 8) = x1; }
        LDS_WAIT(); asm volatile("" ::: "memory");
    }
#undef SS4
}


__device__ __forceinline__ unsigned pk4_fp8(float a, float b, float c, float d) { int w = 0; w = __builtin_amdgcn_cvt_pk_fp8_f32(a, b, w, false); w = __builtin_amdgcn_cvt_pk_fp8_f32(c, d, w, true); return (unsigned)w; }
__device__ __forceinline__ void ld16bf(const bf16_t* p, float* v) { const u32x4 a = *(const u32x4*)p, b = *(const u32x4*)(p + 8);
    v[0] = bflo(a.x); v[1] = bfhi(a.x); v[2] = bflo(a.y); v[3] = bfhi(a.y); v[4] = bflo(a.z); v[5] = bfhi(a.z); v[6] = bflo(a.w); v[7] = bfhi(a.w);
    v[8] = bflo(b.x); v[9] = bfhi(b.x); v[10] = bflo(b.y); v[11] = bfhi(b.y); v[12] = bflo(b.z); v[13] = bfhi(b.z); v[14] = bflo(b.w); v[15] = bfhi(b.w); }
__device__ __forceinline__ void ld4bf(const bf16_t* p, float* v) { const u32x2 a = *(const u32x2*)p; v[0] = bflo(a.x); v[1] = bfhi(a.x); v[2] = bflo(a.y); v[3] = bfhi(a.y); }
__device__ __forceinline__ void qkprep8_phase(const bf16_t* LATb, const bf16_t* QRAW, const bf16_t* KVRAW, const int* pos, const float* qhn, const float* khn,
                                              unsigned char* Q8, unsigned char* K8, unsigned char* VT8, LAS unsigned char* lds, int vcu, int G, int wave, int lane, int tid) {
    const int h = lane >> 3, i8 = lane & 7;
    float gq[24], gk[24], invf[4];
#pragma unroll
    for (int q = 0; q < 16; ++q) { gq[q] = qhn[16 * i8 + q]; gk[q] = khn[16 * i8 + q]; }
#pragma unroll
    for (int q = 0; q < 4; ++q) { gq[16 + q] = qhn[128 + 4 * i8 + q]; gq[20 + q] = qhn[160 + 4 * i8 + q]; gk[16 + q] = khn[128 + 4 * i8 + q]; gk[20 + q] = khn[160 + 4 * i8 + q];
        invf[q] = powf(10000.f, -(float)(4 * i8 + q) * (1.f / 32.f)); }
    for (int tile = vcu; tile < T / 64; tile += G) {
        for (int tt = 0; tt < 8; ++tt) {
            const int kk = wave * 8 + tt, t = tile * 64 + kk, b = t >> 14, s = t & (SEQ - 1);
            const u32x4* ls = (const u32x4*)(LATb + (size_t)t * LATP);
            const u32x4 l0 = ls[lane]; u32x4 l1 = {0u, 0u, 0u, 0u}; if (lane < 24) l1 = ls[lane + 64];
#define SS4(V_) (bflo(V_.x) * bflo(V_.x) + bfhi(V_.x) * bfhi(V_.x) + bflo(V_.y) * bflo(V_.y) + bfhi(V_.y) * bfhi(V_.y) + bflo(V_.z) * bflo(V_.z) + bfhi(V_.z) * bfhi(V_.z) + bflo(V_.w) * bflo(V_.w) + bfhi(V_.w) * bfhi(V_.w))
            const float s0 = SS4(l0), s1 = SS4(l1);
#undef SS4
            const float ssq_q = wave_sum(lane < 48 ? s0 : 0.f, lane), ssq_kv = wave_sum((lane >= 48 ? s0 : 0.f) + (lane < 16 ? s1 : 0.f), lane);
            const float r_q = 1.0f / sqrtf(ssq_q * (1.f / QLR) + EPS), r_kv = 1.0f / sqrtf(ssq_kv * (1.f / KVLR) + EPS);
            float cj[4], sj[4]; const float fpos = (float)pos[t];
#pragma unroll
            for (int q = 0; q < 4; ++q) { const float ang = fpos * invf[q]; const double rev = (double)ang * 0.15915494309189535; const float fr = (float)(rev - floor(rev));
                cj[q] = __builtin_amdgcn_cosf(fr); sj[q] = __builtin_amdgcn_sinf(fr); }
            const size_t orow = ((size_t)(b * NH + h) * SEQ + s) * DQK;
            {
                const bf16_t* qh = QRAW + (size_t)t * 1536 + h * DQK; float v[24];
                ld16bf(qh + 16 * i8, v); ld4bf(qh + 128 + 4 * i8, v + 16); ld4bf(qh + 160 + 4 * i8, v + 20);
                float ss = 0.f;
#pragma unroll
                for (int q = 0; q < 24; ++q) ss += v[q] * v[q];
                ss += lane_xor_f(ss, 1, lane); ss += lane_xor_f(ss, 2, lane); ss += lane_xor_f(ss, 4, lane);
                const float sc = r_q / sqrtf(r_q * r_q * ss * (1.f / DQK) + EPS);
#pragma unroll
                for (int q = 0; q < 24; ++q) v[q] *= sc * gq[q];
                u32x4 w; w.x = pk4_fp8(v[0], v[1], v[2], v[3]); w.y = pk4_fp8(v[4], v[5], v[6], v[7]); w.z = pk4_fp8(v[8], v[9], v[10], v[11]); w.w = pk4_fp8(v[12], v[13], v[14], v[15]);
                *(u32x4*)(Q8 + orow + 16 * i8) = w;
                float o1[4], o2[4];
#pragma unroll
                for (int q = 0; q < 4; ++q) { o1[q] = v[16 + q] * cj[q] - v[20 + q] * sj[q]; o2[q] = v[20 + q] * cj[q] + v[16 + q] * sj[q]; }
                *(unsigned*)(Q8 + orow + 128 + 4 * i8) = pk4_fp8(o1[0], o1[1], o1[2], o1[3]); *(unsigned*)(Q8 + orow + 160 + 4 * i8) = pk4_fp8(o2[0], o2[1], o2[2], o2[3]); }
            {
                const bf16_t* kh = KVRAW + (size_t)t * 2048 + h * 256; const bf16_t* lr = LATb + (size_t)t * LATP + 640; float v[24], vv[16];
                ld16bf(kh + 16 * i8, v); ld4bf(lr + 4 * i8, v + 16); ld4bf(lr + 32 + 4 * i8, v + 20); ld16bf(kh + 128 + 16 * i8, vv);
#pragma unroll
                for (int q = 0; q < 16; ++q) v[q] *= r_kv;
                float ss = 0.f;
#pragma unroll
                for (int q = 0; q < 24; ++q) ss += v[q] * v[q];
                ss += lane_xor_f(ss, 1, lane); ss += lane_xor_f(ss, 2, lane); ss += lane_xor_f(ss, 4, lane);
                const float sc = 1.0f / sqrtf(ss * (1.f / DQK) + EPS);
#pragma unroll
                for (int q = 0; q < 24; ++q) v[q] *= sc * gk[q];
                u32x4 w; w.x = pk4_fp8(v[0], v[1], v[2], v[3]); w.y = pk4_fp8(v[4], v[5], v[6], v[7]); w.z = pk4_fp8(v[8], v[9], v[10], v[11]); w.w = pk4_fp8(v[12], v[13], v[14], v[15]);
                *(u32x4*)(K8 + orow + 16 * i8) = w;
                float o1[4], o2[4];
#pragma unroll
                for (int q = 0; q < 4; ++q) { o1[q] = v[16 + q] * cj[q] - v[20 + q] * sj[q]; o2[q] = v[20 + q] * cj[q] + v[16 + q] * sj[q]; }
                *(unsigned*)(K8 + orow + 128 + 4 * i8) = pk4_fp8(o1[0], o1[1], o1[2], o1[3]); *(unsigned*)(K8 + orow + 160 + 4 * i8) = pk4_fp8(o2[0], o2[1], o2[2], o2[3]);
                const int low5 = kk & 31, hh = (low5 >> 2) & 1, rr = (low5 & 3) + 4 * (low5 >> 3), posb = hh * 32 + rr + 16 * (kk >> 5);
                LAS unsigned char* vt = lds + h * 8192 + (16 * i8) * 64 + posb;
#pragma unroll
                for (int q = 0; q < 4; ++q) { const unsigned w4 = pk4_fp8(vv[4 * q] * r_kv, vv[4 * q + 1] * r_kv, vv[4 * q + 2] * r_kv, vv[4 * q + 3] * r_kv);
                    vt[(4 * q) * 64] = (unsigned char)w4; vt[(4 * q + 1) * 64] = (unsigned char)(w4 >> 8); vt[(4 * q + 2) * 64] = (unsigned char)(w4 >> 16); vt[(4 * q + 3) * 64] = (unsigned char)(w4 >> 24); } }
        }
        __syncthreads();
        {   const int t0 = tile * 64, b = t0 >> 14, st = (t0 & (SEQ - 1)) >> 6;
#pragma unroll
            for (int i = 0; i < 8; ++i) { const int ch = tid + 512 * i, hh = ch >> 9, off = (ch & 511) * 16;
                *(u32x4*)(VT8 + ((size_t)(b * NH + hh) * (SEQ / 64) + st) * 8192 + off) = *(const LAS u32x4*)(lds + hh * 8192 + off); } }
        __syncthreads();
    }
}

__device__ __forceinline__ void route_phase(const float* LG, const float* bg, const float* be, gu32* cnt, int* eid, int* rank, float* gate, int gtid, int NGT) {
    for (int t = gtid; t < T; t += NGT) {
        const float* lg = LG + (size_t)t * 128;
        float gl[8];
        { const f32x4 a = *(const f32x4*)lg, b = *(const f32x4*)(lg + 4); gl[0] = a.x; gl[1] = a.y; gl[2] = a.z; gl[3] = a.w; gl[4] = b.x; gl[5] = b.y; gl[6] = b.z; gl[7] = b.w; }
        float gm = gl[0]; int gs = 0; float bm = gl[0] + bg[0];
#pragma unroll
        for (int q = 1; q < 8; ++q) { gm = fmaxf(gm, gl[q]); const float v = gl[q] + bg[q]; if (v > bm) { bm = v; gs = q; } }
        float gsum = 0.f, gsel = 0.f;
#pragma unroll
        for (int q = 0; q < 8; ++q) { const float e = __expf(gl[q] - gm); gsum += e; gsel = (q == gs) ? e : gsel; }
        const float g_gate = gsel / gsum;
        float el[8];
        { const f32x4 a = *(const f32x4*)(lg + 8 + gs * 8), b = *(const f32x4*)(lg + 12 + gs * 8); el[0] = a.x; el[1] = a.y; el[2] = a.z; el[3] = a.w; el[4] = b.x; el[5] = b.y; el[6] = b.z; el[7] = b.w; }
        int i0 = 0; float v0 = el[0] + be[gs * 8];
#pragma unroll
        for (int q = 1; q < 8; ++q) { const float v = el[q] + be[gs * 8 + q]; if (v > v0) { v0 = v; i0 = q; } }
        int i1 = -1; float v1 = -3.0e38f;
#pragma unroll
        for (int q = 0; q < 8; ++q) { const float v = el[q] + be[gs * 8 + q]; if (q != i0 && v > v1) { v1 = v; i1 = q; } }
        float l0 = 0.f, l1 = 0.f;
#pragma unroll
        for (int q = 0; q < 8; ++q) { l0 = (q == i0) ? el[q] : l0; l1 = (q == i1) ? el[q] : l1; }
        const float mm = fmaxf(l0, l1), p0 = __expf(l0 - mm), p1 = __expf(l1 - mm), inv = 1.f / (p0 + p1);
        const int e0 = gs * 8 + i0, e1 = gs * 8 + i1;
        const unsigned r0 = __hip_atomic_fetch_add(cnt + e0, 1u, RLX_AGENT), r1 = __hip_atomic_fetch_add(cnt + e1, 1u, RLX_AGENT);
        eid[2 * t] = e0; eid[2 * t + 1] = e1; rank[2 * t] = (int)r0; rank[2 * t + 1] = (int)r1; gate[2 * t] = g_gate * p0 * inv; gate[2 * t + 1] = g_gate * p1 * inv;
    }
}

__device__ __forceinline__ int build_tables(gu32* cnt, LAS int* tbl, LAS int* pstart, int tid) {
    if (tid < 64) {
        const int c = (int)__hip_atomic_load(cnt + tid, RLX_AGENT); const int pad = (c + 255) & ~255;
        int incl = pad;
#pragma unroll
        for (int o = 1; o < 64; o <<= 1) { const int v = __builtin_amdgcn_ds_bpermute((tid - o) << 2, incl); if (tid >= o) incl += v; }
        const int start = incl - pad; pstart[tid] = start; if (tid == 63) pstart[64] = incl;
        for (int q = start >> 8; q < (incl >> 8); ++q) tbl[q] = tid;
    }
    __syncthreads();
    return pstart[64] >> 8;
}

__device__ __forceinline__ void scatter_phase(const bf16_t* H, const int* eid, const int* rank, const float* gate, gu32* cnt, bf16_t* XS, int* sdest, float* sgate,
                                              const LAS int* pstart, int gw, int NGW, int lane, int gtid, int NGT) {
    for (int a = gw; a < NASSIGN; a += NGW) {
        const int e = eid[a], slot = pstart[e] + rank[a], t = a >> 1;
        const u32x4* src = (const u32x4*)(H + (size_t)t * DM); u32x4* dst = (u32x4*)(XS + (size_t)slot * DM);
        dst[lane] = src[lane]; dst[lane + 64] = src[lane + 64];
        if (lane == 0) { sdest[slot] = a; sgate[slot] = gate[a]; }
    }
    for (int i = gtid; i < NE * 256; i += NGT) { const int e = i >> 8, q = i & 255; const int c = (int)__hip_atomic_load(cnt + e, RLX_AGENT); const int pad = (c + 255) & ~255;
        if (c + q < pad) { sdest[pstart[e] + c + q] = -1; sgate[pstart[e] + c + q] = 0.f; } }
}

constexpr int PTAB_OFF = MISC_OFF + 128;
__device__ __forceinline__ unsigned char* ldptr(int i) {
    extern __shared__ __attribute__((aligned(16))) unsigned char lds_raw[];
    volatile LAS unsigned* pt = (volatile LAS unsigned*)((LAS unsigned char*)lds_raw + PTAB_OFF) + 2 * sgpr_now(i);
    const unsigned lo = __builtin_amdgcn_readfirstlane(pt[0]), hi = __builtin_amdgcn_readfirstlane(pt[1]);
    return (unsigned char*)(GAS unsigned char*)(((unsigned long long)hi << 32) | lo);
}
#define P_IN(i) ((const float*)ldptr(i))
#define P_OUT() ((float*)ldptr(23))
#define P_WS() (ldptr(24))
__device__ __forceinline__ void grid_barrier(int tid) {
    extern __shared__ __attribute__((aligned(16))) unsigned char lds_raw[];
    XcdBarrier b; b.bar = (unsigned*)(P_WS() + WS_CTL) + CW_BAR; b.x = xb_xcc_id(); b.st = (volatile LAS unsigned*)((LAS unsigned char*)lds_raw + MISC_OFF) + 8;
    xcd_barrier(b, tid == 0);
}

__global__ void __launch_bounds__(NWAVES * 64, 2) fwd(Args args) {
    extern __shared__ __attribute__((aligned(16))) unsigned char lds_raw[];
    LAS unsigned char* lds = (LAS unsigned char*)lds_raw;
    for (int u = threadIdx.x; u < (LDS_BYTES - LDSCTL_OFF) / 4; u += NWAVES * 64) ((LAS unsigned*)(lds + LDSCTL_OFF))[u] = 0u;
    __syncthreads();
    if (threadIdx.x == 0) { LAS unsigned long long* pt = (LAS unsigned long long*)(lds + PTAB_OFF);
#pragma unroll
        for (int i = 0; i < 23; ++i) pt[i] = (unsigned long long)args.in[i];
        pt[23] = (unsigned long long)args.out; pt[24] = (unsigned long long)args.ws; }
    __syncthreads();
    const int lo = args.ph_lo, hi = args.ph_hi;
    if (hi - lo > 1) (void)xcd_barrier_post((unsigned*)(P_WS() + WS_CTL) + CW_BAR, (volatile LAS unsigned*)(lds + MISC_OFF) + 8, threadIdx.x == 0);
    const int wave_s = __builtin_amdgcn_readfirstlane((int)threadIdx.x >> 6);
#define IN(k) (lo <= (k) && (k) < hi)
#define SEAM(k) do { if (hi > (k) + 1) grid_barrier(TID); } while (0)
#define TID (tid_now(wave_s))
#define LANE (tid_now(wave_s) & 63)
#define WAVE (sgpr_now(wave_s))
#define GRID (sgpr_now((int)gridDim.x))
#define BX (sgpr_now((int)blockIdx.x))
#define VCU ((GRID % 8 == 0) ? (BX % 8) * (GRID / 8) + BX / 8 : BX)
#define GW (VCU * NWAVES + WAVE)
#define NGW (GRID * NWAVES)
#define GTID (BX * (NWAVES * 64) + TID)
#define NGT (GRID * NWAVES * 64)
#define TBL ((LAS int*)(lds + TBL_OFF))
#define PSTART (TBL + 384)

    if (IN(0)) { for (int rep = 0; rep < REP_PRO; ++rep) prologue_phase(lds, GW, NGW, WAVE, LANE, GTID, NGT); SEAM(0); }

    for (int L = 0; L < 4; ++L) {
        const int pb = 1 + 12 * L;
        if ((L & 1) == 0) {
            if (IN(pb + 0)) { unsigned char* ws = P_WS(); const float* xsrc = (L == 0) ? P_IN(I_X) : P_OUT();
                norm_phase(xsrc, (L > 0 && MK_ENABLE_MOE) ? (const bf16_t*)(ws + WS_Y) : nullptr, (L == 0) ? nullptr : P_OUT(), (bf16_t*)(ws + WS_H), GW, NGW, LANE); SEAM(pb + 0); }
            if (IN(pb + 1)) { unsigned char* ws = P_WS(); const int j = L >> 1;
                pg8::Gemm g{DM, DM}; pg8::StaticOrder S; S.init(ws + WS_H, DM, (bf16_t*)(ws + WS_WIN) + (size_t)j * 3072 * 1024, DM, T, 3072, GRID, BX);
                pg8::EpiConvIn E{(bf16_t*)(ws + WS_GB), (bf16_t*)(ws + WS_Z)}; pg8::gemm_phase(lds, g, S, E, TID); SEAM(pb + 1); }
            if (IN(pb + 2)) { unsigned char* ws = P_WS(); const int j = L >> 1;
                conv_phase((const bf16_t*)(ws + WS_GB), (const bf16_t*)(ws + WS_Z), P_IN(I_CK) + j * 3 * DM, (bf16_t*)(ws + WS_YC), GTID, NGT); SEAM(pb + 2); }
            if (IN(pb + 3)) { unsigned char* ws = P_WS(); const int j = L >> 1; const float* xsrc = (L == 0) ? P_IN(I_X) : P_OUT();
                pg8::Gemm g{DM, DM}; pg8::StaticOrder S; S.init(ws + WS_YC, DM, (bf16_t*)(ws + WS_WOUTC) + (size_t)j * 1024 * 1024, DM, T, DM, GRID, BX);
                pg8::EpiResid E{xsrc, P_OUT()}; pg8::gemm_phase(lds, g, S, E, TID); SEAM(pb + 5); }
        } else {
#if MK_ENABLE_MLA
            if (IN(pb + 0)) { unsigned char* ws = P_WS();
                norm_phase(P_OUT(), MK_ENABLE_MOE ? (const bf16_t*)(ws + WS_Y) : nullptr, P_OUT(), (bf16_t*)(ws + WS_H), GW, NGW, LANE); SEAM(pb + 0); }
            if (IN(pb + 1)) { unsigned char* ws = P_WS(); const int j = L >> 1;
                pg8::Gemm g{DM, DM}; pg8::StaticOrder S; S.init(ws + WS_H, DM, (bf16_t*)(ws + WS_WDOWN) + (size_t)j * LATP * 1024, DM, T, LATP, GRID, BX);
                pg8::EpiBf16 E{(bf16_t*)(ws + WS_LAT), LATP}; pg8::gemm_phase(lds, g, S, E, TID); SEAM(pb + 1); }
            if (IN(pb + 2)) {
                { unsigned char* ws = P_WS(); const int j = L >> 1;
                  pg8::Gemm g{LATP, QLR}; pg8::StaticOrder S; S.init(ws + WS_LAT, LATP, ws + WS_WQ + (size_t)j * 1536 * 1024, QLR, T, 1536, GRID, BX);
                  pg8::EpiBf16 E{(bf16_t*)(ws + WS_QRAW), 1536}; pg8::gemm_phase(lds, g, S, E, TID); }
                { unsigned char* ws = P_WS(); const int j = L >> 1;
                  pg8::Gemm g{LATP, KVLR}; pg8::StaticOrder S; S.init((bf16_t*)(ws + WS_LAT) + QLR, LATP, (bf16_t*)(ws + WS_WKV) + (size_t)j * 2048 * 256, KVLR, T, 2048, GRID, BX);
                  pg8::EpiBf16 E{(bf16_t*)(ws + WS_KVRAW), 2048}; pg8::gemm_phase(lds, g, S, E, TID); }
                SEAM(pb + 2); }
#if ATT_FP8
            if (IN(pb + 3)) { unsigned char* ws = P_WS(); const int j = L >> 1;
                qkprep8_phase((const bf16_t*)(ws + WS_LAT), (const bf16_t*)(ws + WS_QRAW), (const bf16_t*)(ws + WS_KVRAW), (const int*)P_IN(I_POS),
                              P_IN(I_MQHN) + j * DQK, P_IN(I_MKHN) + j * DQK, ws + WS_Q, ws + WS_K, ws + WS_V, lds, VCU, GRID, WAVE, LANE, TID); SEAM(pb + 3); }
#else
            if (IN(pb + 3)) { unsigned char* ws = P_WS(); const int j = L >> 1;
                qkprep_phase((const bf16_t*)(ws + WS_LAT), (const bf16_t*)(ws + WS_QRAW), (const bf16_t*)(ws + WS_KVRAW), (const int*)P_IN(I_POS),
                             P_IN(I_MQHN) + j * DQK, P_IN(I_MKHN) + j * DQK, (bf16_t*)(ws + WS_Q), (bf16_t*)(ws + WS_K), (bf16_t*)(ws + WS_V), lds, GW, NGW, WAVE, LANE); SEAM(pb + 3); }
#endif
            if (IN(pb + 4)) {
              for (int rep = 0; rep < REP_ATT; ++rep)
                for (int i = 0;; ++i) {
                    int bh, qb;
                    if (GRID == 256) { if (i >= 4) break; const int idx = i * 32 + (VCU & 31); bh = 2 * (VCU >> 5) + (idx >> 6); qb = idx & 63; }
                    else { const int k = i * GRID + BX; if (k >= NB * NH * 64) break; bh = k >> 6; qb = k & 63; }
                    const int b = bh >> 3, h = bh & 7; unsigned char* ws = P_WS();
#if ATT_FP8
                    att8::attn_unit(ws + WS_Q + ((size_t)bh * SEQ + qb * 256) * DQK, ws + WS_K + (size_t)bh * SEQ * DQK, ws + WS_V + (size_t)bh * SEQ * DV,
                                    (bf16_t*)(ws + WS_O) + ((size_t)(b * SEQ + qb * 256)) * DM + h * DV, (char*)lds_raw, TID);
#else
                    att::attn_unit((const bf16_t*)(ws + WS_Q) + ((size_t)bh * SEQ + qb * 256) * DQK, (const bf16_t*)(ws + WS_K) + (size_t)bh * SEQ * DQK, (const bf16_t*)(ws + WS_V) + (size_t)bh * SEQ * DV,
                                   (bf16_t*)(ws + WS_O) + ((size_t)(b * SEQ + qb * 256)) * DM + h * DV, (char*)lds_raw, TID);
#endif
                }
                SEAM(pb + 4); }
            if (IN(pb + 5)) { unsigned char* ws = P_WS(); const int j = L >> 1;
                pg8::Gemm g{DM, DM}; pg8::StaticOrder S; S.init(ws + WS_O, DM, (bf16_t*)(ws + WS_WO) + (size_t)j * 1024 * 1024, DM, T, DM, GRID, BX);
                pg8::EpiResid E{P_OUT(), P_OUT()}; pg8::gemm_phase(lds, g, S, E, TID); SEAM(pb + 5); }
#else
            if (IN(pb + 0)) { unsigned char* ws = P_WS(); norm_phase(P_OUT(), MK_ENABLE_MOE ? (const bf16_t*)(ws + WS_Y) : nullptr, P_OUT(), nullptr, GW, NGW, LANE); SEAM(pb + 5); }
#endif
        }
#if MK_ENABLE_MOE
#define CNT ((gu32*)(ws + WS_CTL) + CW_CNT + L * 64)
#define EID ((int*)(ws + WS_RT + RT_EID))
#define RANK ((int*)(ws + WS_RT + RT_RANK))
#define GATE ((float*)(ws + WS_RT + RT_GATE))
#define SDEST ((int*)(ws + WS_RT + RT_SDEST))
#define SGATE ((float*)(ws + WS_RT + RT_SGATE))
        if (IN(pb + 6)) { unsigned char* ws = P_WS(); norm_phase(P_OUT(), nullptr, nullptr, (bf16_t*)(ws + WS_H), GW, NGW, LANE); SEAM(pb + 6); }
        if (IN(pb + 7)) { unsigned char* ws = P_WS();
            pg8::Gemm g{DM, DM}; pg8::StaticOrder S; S.init(ws + WS_H, DM, (bf16_t*)(ws + WS_WRT) + (size_t)L * 256 * 1024, DM, T, 256, GRID, BX);
            pg8::EpiLogits E{(float*)(ws + WS_LG)}; pg8::gemm_phase(lds, g, S, E, TID); SEAM(pb + 7); }
        if (IN(pb + 8)) { unsigned char* ws = P_WS();
            route_phase((const float*)(ws + WS_LG), P_IN(I_RBG) + L * 8, P_IN(I_RBE) + L * 64, CNT, EID, RANK, GATE, GTID, NGT); SEAM(pb + 8); }
        if (IN(pb + 9)) { unsigned char* ws = P_WS(); build_tables(CNT, TBL, PSTART, TID);
            scatter_phase((const bf16_t*)(ws + WS_H), EID, RANK, GATE, CNT, (bf16_t*)(ws + WS_XS), SDEST, SGATE, PSTART, GW, NGW, LANE, GTID, NGT); SEAM(pb + 9); }
        if (IN(pb + 10)) { unsigned char* ws = P_WS(); const int ntiles = build_tables(CNT, TBL, PSTART, TID);
            pg8::Gemm g{DM, DM}; pg8::GroupedOrder S{ntiles * 3, 3, GRID, VCU, (const char*)(ws + WS_XS), (const char*)(ws + WS_WE1) + (size_t)L * NE * 768 * 1024 * 2, (size_t)256 * DM * 2, (size_t)768 * 1024 * 2, (size_t)256 * 1024 * 2, TBL};
            pg8::EpiSwiGLU E{(bf16_t*)(ws + WS_HID)}; pg8::gemm_phase(lds, g, S, E, TID); SEAM(pb + 10); }
        if (IN(pb + 11)) { unsigned char* ws = P_WS(); const int ntiles = build_tables(CNT, TBL, PSTART, TID);
            pg8::Gemm g{DFF, DFF}; pg8::GroupedOrder S{ntiles * 4, 4, GRID, VCU, (const char*)(ws + WS_HID), (const char*)(ws + WS_WE2) + (size_t)L * NE * 1024 * DFF * 2, (size_t)256 * DFF * 2, (size_t)1024 * DFF * 2, (size_t)256 * DFF * 2, TBL};
            pg8::EpiScatterY E{(bf16_t*)(ws + WS_Y), SDEST, SGATE}; pg8::gemm_phase(lds, g, S, E, TID); SEAM(pb + 11); }
#endif
    }
    if (IN(49)) {
#if MK_ENABLE_MOE
        unsigned char* ws = P_WS(); norm_phase(P_OUT(), (const bf16_t*)(ws + WS_Y), P_OUT(), nullptr, GW, NGW, LANE);
#endif
    }
#undef IN
#undef SEAM
}

extern "C" void kernel_launch(void* const* d_in, const int* in_sizes, int n_in, void* d_out, int out_size, void* d_ws, size_t ws_size, hipStream_t stream) {
    static int grid = 0;
    if (grid == 0) {
        if (n_in != 23 || out_size != T * DM || ws_size < WS_END) { fprintf(stderr, "kernel_launch: unexpected shapes: n_in %d out %d ws %zu (need %zu)\n", n_in, out_size, ws_size, (size_t)WS_END); grid = -1; return; }
        int dev = 0, cus = 0, per_cu = 0;
        if (hipGetDevice(&dev) != hipSuccess || hipDeviceGetAttribute(&cus, hipDeviceAttributeMultiprocessorCount, dev) != hipSuccess) { grid = -1; return; }
        if (hipFuncSetAttribute((const void*)fwd, hipFuncAttributeMaxDynamicSharedMemorySize, LDS_BYTES) != hipSuccess) { fprintf(stderr, "kernel_launch: hipFuncSetAttribute failed\n"); grid = -1; return; }
        if (hipOccupancyMaxActiveBlocksPerMultiprocessor(&per_cu, (const void*)fwd, NWAVES * 64, LDS_BYTES) != hipSuccess || per_cu < 1) fprintf(stderr, "kernel_launch: occupancy query says %d\n", per_cu);
        (void)hipGetLastError();
        grid = cus;
    }
    if (grid < 0) return;
    if (hipMemsetAsync((char*)d_ws + WS_CTL, 0, CTL_ZERO_BYTES, stream) != hipSuccess) return;
    Args a{};
    for (int i = 0; i < 23; ++i) a.in[i] = d_in[i];
    a.out = (float*)d_out; a.ws = (unsigned char*)d_ws;
#if MK_ONE_LAUNCH
    a.ph_lo = 0; a.ph_hi = 50;
    hipLaunchKernelGGL(fwd, dim3(grid), dim3(NWAVES * 64), LDS_BYTES, stream, a);
#else
    for (int p = 0; p < 50; ++p) {
        if (p >= 1 && p < 49) { const int L = (p - 1) / 12, k = (p - 1) % 12;
            if (k < 6) { if ((L & 1) == 0) { if (k > 3) continue; } else { if (!MK_ENABLE_MLA && k > 0) continue; } }
            else if (!MK_ENABLE_MOE) continue; }
        if (p == 49 && !MK_ENABLE_MOE) continue;
        a.ph_lo = p; a.ph_hi = p + 1;
        hipLaunchKernelGGL(fwd, dim3(grid), dim3(NWAVES * 64), LDS_BYTES, stream, a);
    }
#endif
    const hipError_t le = hipPeekAtLastError();
    if (le != hipSuccess) fprintf(stderr, "kernel_launch: launch failed: %s\n", hipGetErrorName(le));
}
```

```cpp
#include <hip/hip_runtime.h>
#include <cstdio>
#include <cstdint>

#ifndef MK_ONE_LAUNCH
#define MK_ONE_LAUNCH 1
#endif
#ifndef REP_ATT
#define REP_ATT 1
#endif
#ifndef REP_PRO
#define REP_PRO 1
#endif
#ifndef ATT_FP8
#define ATT_FP8 1
#endif
#ifndef ATT_PP
#define ATT_PP 1
#endif
#ifndef MK_ENABLE_MLA
#define MK_ENABLE_MLA 1
#endif
#ifndef MK_ENABLE_MOE
#define MK_ENABLE_MOE 1
#endif

#define GAS __attribute__((address_space(1)))
#define LAS __attribute__((address_space(3)))
typedef unsigned short bf16_t;
typedef short bf16x8 __attribute__((ext_vector_type(8)));
typedef short s16x4 __attribute__((ext_vector_type(4)));
typedef float f32x2 __attribute__((ext_vector_type(2)));
typedef float f32x4 __attribute__((ext_vector_type(4)));
typedef float f32x16 __attribute__((ext_vector_type(16)));
typedef unsigned u32x2 __attribute__((ext_vector_type(2)));
typedef unsigned u32x4 __attribute__((ext_vector_type(4)));
typedef GAS unsigned gu32;

constexpr int DM = 1024, NB = 2, SEQ = 16384, T = NB * SEQ;
constexpr int NH = 8, QLR = 384, KVLR = 256, DNOPE = 128, DROPE = 64, DQK = 192, DV = 128, LAT = 704, LATP = 768;
constexpr int NE = 64, DFF = 384;
constexpr int NASSIGN = 2 * T;
constexpr int NSLOT = NASSIGN + NE * 256;
constexpr int MAXTILES = NSLOT / 256;
constexpr float EPS = 1e-6f;
constexpr int NWAVES = 8;

constexpr size_t MiB = 1u << 20;
constexpr size_t WS_CTL = 0, CTL_ZERO_BYTES = 1 * MiB;
constexpr size_t WS_WIN = 2 * MiB;
constexpr size_t WS_WOUTC = 14 * MiB;
constexpr size_t WS_WDOWN = 18 * MiB;
constexpr size_t WS_WQ = 21 * MiB;
constexpr size_t WS_WKV = 24 * MiB;
constexpr size_t WS_WO = 26 * MiB;
constexpr size_t WS_WRT = 30 * MiB;
constexpr size_t WS_WE1 = 32 * MiB;
constexpr size_t WS_WE2 = 416 * MiB;
constexpr size_t WS_H = 608 * MiB;
constexpr size_t WS_S = 672 * MiB;
constexpr size_t WS_GB = WS_S, WS_Z = WS_S + 64 * MiB, WS_YC = WS_S + 128 * MiB;
constexpr size_t WS_LAT = WS_S, WS_QRAW = WS_S + 48 * MiB, WS_KVRAW = WS_S + 144 * MiB;
constexpr size_t WS_Q = WS_S + 272 * MiB, WS_K = WS_S + 368 * MiB, WS_V = WS_S + 464 * MiB, WS_O = WS_QRAW;
constexpr size_t WS_XS = WS_S, WS_HID = WS_S + 160 * MiB, WS_Y = WS_S + 224 * MiB, WS_LG = WS_S + 352 * MiB;
constexpr size_t WS_RT = WS_S + 368 * MiB;
constexpr size_t WS_END = WS_S + 528 * MiB;
constexpr size_t RT_EID = 0, RT_RANK = 256 * 1024, RT_GATE = 512 * 1024, RT_SDEST = 768 * 1024, RT_SGATE = 768 * 1024 + 327680;
static_assert(RT_SGATE + 327680 <= 2 * MiB, "routing arrays");
constexpr int CW_TMO = 0, CW_CODE = 1, CW_BAR = 4096, CW_CNT = 8192  , CW_CHK = 12288;

constexpr int RING_BYTES = 131072;
constexpr int LDSCTL_OFF = RING_BYTES, MISC_OFF = LDSCTL_OFF + 320;
constexpr int TBL_OFF = LDSCTL_OFF + 1024;
constexpr int LDS_BYTES = 147456;

#define RLX_AGENT __ATOMIC_RELAXED, __HIP_MEMORY_SCOPE_AGENT
#define LDS_WAIT() asm volatile("s_waitcnt lgkmcnt(0)" ::: "memory")
#define VM_WAIT() asm volatile("s_waitcnt vmcnt(0)" ::: "memory")
__device__ __forceinline__ unsigned f2bf(float f) { unsigned u = __builtin_bit_cast(unsigned, f); return (u + 0x7fffu + ((u >> 16) & 1u)) >> 16; }
__device__ __forceinline__ unsigned pk2(float lo, float hi) { return f2bf(lo) | (f2bf(hi) << 16); }
__device__ __forceinline__ float bflo(unsigned w) { return __builtin_bit_cast(float, w << 16); }
__device__ __forceinline__ float bfhi(unsigned w) { return __builtin_bit_cast(float, w & 0xffff0000u); }
__device__ __forceinline__ float bf2f(bf16_t h) { return __builtin_bit_cast(float, (unsigned)h << 16); }
__device__ __forceinline__ unsigned cvt_pk_bf16(float lo, float hi) { unsigned r; asm volatile("v_cvt_pk_bf16_f32 %0, %1, %2" : "=v"(r) : "v"(lo), "v"(hi)); return r; }
__device__ __forceinline__ int tid_now(int wave_s) { int l; asm volatile("v_mbcnt_lo_u32_b32 %0, -1, 0\n\tv_mbcnt_hi_u32_b32 %0, -1, %0" : "=v"(l)); return wave_s * 64 + l; }
__device__ __forceinline__ int sgpr_now(int v) { asm volatile("" : "+s"(v)); return v; }
__device__ __forceinline__ float lane_xor_f(float v, int m, int lane) { return __builtin_bit_cast(float, __builtin_amdgcn_ds_bpermute((lane ^ m) << 2, __builtin_bit_cast(int, v))); }
__device__ __forceinline__ float wave_sum(float v, int lane) {
#pragma unroll
    for (int o = 1; o < 64; o <<= 1) v += lane_xor_f(v, o, lane);
    return v;
}

#define XB_TMO      128
#define XB_XCNT(j)  (256  + 64 * (j))
#define XB_XSUB(j)  (1280 + 64 * (j))
#define XB_XGEN(j)  (2304 + 64 * (j))
#define XB_TOP      3328
#define XB_TOPGEN   3392
#define XCD_BAR_WORDS 3456
#define XB_SPIN_CAP (1u << 18)
__device__ __forceinline__ unsigned xb_ld(unsigned* p)              { return __hip_atomic_load(p, __ATOMIC_RELAXED, __HIP_MEMORY_SCOPE_AGENT); }
__device__ __forceinline__ unsigned xb_add(unsigned* p, unsigned v) { return __hip_atomic_fetch_add(p, v, __ATOMIC_RELAXED, __HIP_MEMORY_SCOPE_AGENT); }
__device__ __forceinline__ unsigned xb_xcc_id() { return (unsigned)__builtin_amdgcn_s_getreg((3 << 11) | 20) & 0xFu; }
#define XB_SPIN(cond, bar) do { unsigned _sp = 0; while (cond) { __builtin_amdgcn_s_sleep(1); \
    if ((++_sp & 255u) == 0u) { if (xb_ld(&(bar)[XB_TMO])) break; if (_sp > XB_SPIN_CAP) { atomicAdd(&(bar)[XB_TMO], 1u); break; } } } } while (0)
struct XcdBarrier { unsigned* bar; unsigned x; volatile LAS unsigned* st; };
__device__ __forceinline__ XcdBarrier xcd_barrier_post(unsigned* bar, volatile LAS unsigned* st, bool leader) {
    XcdBarrier b; b.bar = bar; b.x = xb_xcc_id(); b.st = st;
    if (leader) (void)xb_add(&bar[XB_XCNT(b.x)], 1u);
    return b;
}
__device__ __forceinline__ void xcd_barrier_complete(unsigned* bar, unsigned x, unsigned& nloc, unsigned& nx) {
    const unsigned G = gridDim.x * gridDim.y * gridDim.z;
    unsigned sum, cnt, mine, sp = 0u;
    for (;;) {
        sum = 0u; cnt = 0u; mine = 0u;
#pragma unroll
        for (unsigned j = 0; j < 16; ++j) { const unsigned c = xb_ld(&bar[XB_XCNT(j)]); sum += c; cnt += (c > 0u) ? 1u : 0u; mine = (j == x) ? c : mine; }
        if (sum == G) break;
        __builtin_amdgcn_s_sleep(1);
        if ((++sp & 255u) == 0u) { if (xb_ld(&bar[XB_TMO])) break; if (sp > XB_SPIN_CAP) { atomicAdd(&bar[XB_TMO], 1u); break; } }
    }
    nloc = mine > 0u ? mine : 1u; nx = cnt > 0u ? cnt : 1u;
}
__device__ __forceinline__ void xcd_barrier(const XcdBarrier& b, bool leader) {
    asm volatile("s_waitcnt vmcnt(0)" ::: "memory");
    __syncthreads();
    if (leader) {
        unsigned* bar = b.bar;
        __builtin_amdgcn_s_waitcnt(0);
        unsigned nloc = b.st[0], nx = b.st[1];
        if (nloc == 0u) { xcd_barrier_complete(bar, b.x, nloc, nx); b.st[0] = nloc; b.st[1] = nx; }
        const unsigned old = xb_add(&bar[XB_XSUB(b.x)], 1u);
        const unsigned gen = old / nloc;
        if (old + 1u == (gen + 1u) * nloc) {
            __builtin_amdgcn_fence(__ATOMIC_RELEASE, "agent");
            asm volatile("s_waitcnt vmcnt(0)" ::: "memory");
            const unsigned og = xb_add(&bar[XB_TOP], 1u);
            const unsigned tg = og / nx;
            if (og + 1u == (tg + 1u) * nx) xb_add(&bar[XB_TOPGEN], 1u);
            else XB_SPIN(xb_ld(&bar[XB_TOPGEN]) == tg, bar);
            __builtin_amdgcn_fence(__ATOMIC_ACQUIRE, "agent");
            xb_add(&bar[XB_XGEN(b.x)], 1u);
            asm volatile("s_waitcnt vmcnt(0)" ::: "memory");
        } else {
            XB_SPIN(xb_ld(&bar[XB_XGEN(b.x)]) == gen, bar);
            __builtin_amdgcn_fence(__ATOMIC_ACQUIRE, "agent");
            asm volatile("s_waitcnt vmcnt(0)" ::: "memory");
        }
    }
    __syncthreads();
}

namespace pg8 {
constexpr int BM = 256, BK = 64, HALF = 128, HTB = HALF * BK * 2, NXCD = 8, WGM = 8;
__host__ __device__ __forceinline__ int lds_byte(int r, int c) { const int st = (r >> 4) * 2 + (c >> 5), rr = r & 15, cc = c & 31, ob = rr * 64 + cc * 2; return st * 1024 + (ob ^ (((ob >> 9) & 1) << 5)); }
__host__ __device__ __forceinline__ void stage_rc(int b, int& R, int& C) { const int st = b / 1024, sb = b % 1024, swz = sb ^ (((sb >> 9) & 1) << 5); R = (st >> 1) * 16 + swz / 64; C = (st & 1) * 32 + (swz % 64) / 2; }
__host__ __device__ __forceinline__ int perm32(int rho) { const int n = rho >> 4, i = rho & 15; return 8 * (i >> 2) + 4 * n + (i & 3); }

struct Unit { const char* A; const char* B; int pm, pn; };
struct Gemm { int lda, K; };

struct StaticOrder {
    int nM, nN, nwg, G, c; const char* A; const char* B; size_t astep, bstep;
    __device__ void init(const void* A_, int lda, const void* B_, int K, int M, int N, int G_, int c_) { nM = M / BM; nN = N / BM; nwg = nM * nN; G = G_; c = c_; A = (const char*)A_; B = (const char*)B_; astep = (size_t)BM * lda * 2; bstep = (size_t)BM * K * 2; }
    __device__ __forceinline__ bool next(int i, Unit& u) const {
        const long L = (long)i * G + c; if (L >= nwg) return false;
        int wgid = (int)L; { const int q = nwg / NXCD, r = nwg % NXCD, xcd = wgid % NXCD, off = wgid / NXCD; wgid = (xcd < r ? xcd * (q + 1) : r * (q + 1) + (xcd - r) * q) + off; }
        const int nig = WGM * nN, gid = wgid / nig, fm = gid * WGM, gsz = (nM - fm) < WGM ? (nM - fm) : WGM;
        u.pm = fm + ((wgid % nig) % gsz); u.pn = (wgid % nig) / gsz; u.A = A + (size_t)u.pm * astep; u.B = B + (size_t)u.pn * bstep; return true;
    }
};
struct GroupedOrder {
    int n_units, nN, G, c; const char* A; const char* B; size_t astep, bexp, bstep; const LAS int* tbl;
    __device__ __forceinline__ bool next(int i, Unit& u) const {
        const int L = i * G + c; if (L >= n_units) return false;
        const int tile = L / nN, pn = L - tile * nN; const int e = __builtin_amdgcn_readfirstlane(tbl[tile]);
        u.pm = tile; u.pn = pn; u.A = A + (size_t)tile * astep; u.B = B + (size_t)e * bexp + (size_t)pn * bstep; return true;
    }
};

typedef f32x4 Acc[2][2][4][2];

struct EpiBf16 {
    static constexpr bool PERM = true;
    bf16_t* O; int ldc;
    __device__ __forceinline__ void operator()(const Acc& acc, const Unit& u, int wr, int wc, int fr, int fq) const {
        const int row0 = u.pm * BM + wr * 64 + fr, col0 = u.pn * BM + wc * 32 + 8 * fq;
#pragma unroll
        for (int ai = 0; ai < 2; ++ai)
#pragma unroll
            for (int m = 0; m < 4; ++m) { bf16_t* rowp = O + (size_t)(row0 + ai * HALF + m * 16) * ldc + col0;
#pragma unroll
                for (int bj = 0; bj < 2; ++bj) { const f32x4 v0 = acc[ai][bj][m][0], v1 = acc[ai][bj][m][1];
                    u32x4 w; w.x = cvt_pk_bf16(v0[0], v0[1]); w.y = cvt_pk_bf16(v0[2], v0[3]); w.z = cvt_pk_bf16(v1[0], v1[1]); w.w = cvt_pk_bf16(v1[2], v1[3]);
                    *(u32x4*)(rowp + bj * HALF) = w; } }
    }
};
struct EpiConvIn {
    static constexpr bool PERM = true;
    bf16_t* GBp; bf16_t* Zp;
    __device__ __forceinline__ void operator()(const Acc& acc, const Unit& u, int wr, int wc, int fr, int fq) const {
        const int row0 = u.pm * BM + wr * 64 + fr;
        if (u.pn < 4) {
            const int col0 = u.pn * BM + wc * 32 + 8 * fq;
#pragma unroll
            for (int ai = 0; ai < 2; ++ai)
#pragma unroll
                for (int m = 0; m < 4; ++m) { bf16_t* rowp = GBp + (size_t)(row0 + ai * HALF + m * 16) * DM + col0;
#pragma unroll
                    for (int bj = 0; bj < 2; ++bj) { const f32x4 v0 = acc[ai][bj][m][0], v1 = acc[ai][bj][m][1];
                        u32x4 w; w.x = cvt_pk_bf16(v0[0], v0[1]); w.y = cvt_pk_bf16(v0[2], v0[3]); w.z = cvt_pk_bf16(v1[0], v1[1]); w.w = cvt_pk_bf16(v1[2], v1[3]);
                        *(u32x4*)(rowp + bj * HALF) = w; } }
        } else {
            const int col0 = (u.pn - 4) * HALF + wc * 32 + 8 * fq;
#pragma unroll
            for (int ai = 0; ai < 2; ++ai)
#pragma unroll
                for (int m = 0; m < 4; ++m) { bf16_t* rowp = Zp + (size_t)(row0 + ai * HALF + m * 16) * DM + col0;
                    const f32x4 v0 = acc[ai][0][m][0] * acc[ai][1][m][0], v1 = acc[ai][0][m][1] * acc[ai][1][m][1];
                    u32x4 w; w.x = cvt_pk_bf16(v0[0], v0[1]); w.y = cvt_pk_bf16(v0[2], v0[3]); w.z = cvt_pk_bf16(v1[0], v1[1]); w.w = cvt_pk_bf16(v1[2], v1[3]);
                    *(u32x4*)rowp = w; }
        }
    }
};
__device__ __forceinline__ float silu_mul(float g, float u) { return g * __builtin_amdgcn_rcpf(1.f + __expf(-g)) * u; }
struct EpiSwiGLU {
    static constexpr bool PERM = true;
    bf16_t* Hd;
    __device__ __forceinline__ void operator()(const Acc& acc, const Unit& u, int wr, int wc, int fr, int fq) const {
        const int row0 = u.pm * BM + wr * 64 + fr, col0 = u.pn * HALF + wc * 32 + 8 * fq;
#pragma unroll
        for (int ai = 0; ai < 2; ++ai)
#pragma unroll
            for (int m = 0; m < 4; ++m) { bf16_t* rowp = Hd + (size_t)(row0 + ai * HALF + m * 16) * DFF + col0;
                f32x4 v0, v1;
#pragma unroll
                for (int q = 0; q < 4; ++q) { v0[q] = silu_mul(acc[ai][0][m][0][q], acc[ai][1][m][0][q]); v1[q] = silu_mul(acc[ai][0][m][1][q], acc[ai][1][m][1][q]); }
                u32x4 w; w.x = cvt_pk_bf16(v0[0], v0[1]); w.y = cvt_pk_bf16(v0[2], v0[3]); w.z = cvt_pk_bf16(v1[0], v1[1]); w.w = cvt_pk_bf16(v1[2], v1[3]);
                *(u32x4*)rowp = w; }
    }
};
struct EpiResid {
    static constexpr bool PERM = false;
    const float* xin; float* xout;
    __device__ __forceinline__ void operator()(const Acc& acc, const Unit& u, int wr, int wc, int fr, int fq) const {
        const int row0 = u.pm * BM + wr * 64 + fr, col0 = u.pn * BM + wc * 32 + 4 * fq;
#pragma unroll
        for (int ai = 0; ai < 2; ++ai)
#pragma unroll
            for (int m = 0; m < 4; ++m) { const size_t off = (size_t)(row0 + ai * HALF + m * 16) * DM + col0;
#pragma unroll
                for (int bj = 0; bj < 2; ++bj)
#pragma unroll
                    for (int n = 0; n < 2; ++n) { const f32x4 xv = *(const f32x4*)(xin + off + bj * HALF + n * 16); *(f32x4*)(xout + off + bj * HALF + n * 16) = xv + acc[ai][bj][m][n]; } }
    }
};
struct EpiLogits {
    static constexpr bool PERM = false;
    float* LG;
    __device__ __forceinline__ void operator()(const Acc& acc, const Unit& u, int wr, int wc, int fr, int fq) const {
        const int row0 = u.pm * BM + wr * 64 + fr, col0 = wc * 32 + 4 * fq;
#pragma unroll
        for (int ai = 0; ai < 2; ++ai)
#pragma unroll
            for (int m = 0; m < 4; ++m) { const size_t off = (size_t)(row0 + ai * HALF + m * 16) * 128 + col0;
#pragma unroll
                for (int n = 0; n < 2; ++n) *(f32x4*)(LG + off + n * 16) = acc[ai][0][m][n]; }
    }
};
struct EpiScatterY {
    static constexpr bool PERM = true;
    bf16_t* Y; const int* sdest; const float* sgate;
    __device__ __forceinline__ void operator()(const Acc& acc, const Unit& u, int wr, int wc, int fr, int fq) const {
        const int row0 = u.pm * BM + wr * 64 + fr, col0 = u.pn * BM + wc * 32 + 8 * fq;
#pragma unroll
        for (int ai = 0; ai < 2; ++ai)
#pragma unroll
            for (int m = 0; m < 4; ++m) { const int slot = row0 + ai * HALF + m * 16; const int d = sdest[slot]; const float g = sgate[slot];
                if (d >= 0) { bf16_t* rowp = Y + (size_t)d * DM + col0;
#pragma unroll
                    for (int bj = 0; bj < 2; ++bj) { const f32x4 v0 = acc[ai][bj][m][0] * g, v1 = acc[ai][bj][m][1] * g;
                        u32x4 w; w.x = cvt_pk_bf16(v0[0], v0[1]); w.y = cvt_pk_bf16(v0[2], v0[3]); w.z = cvt_pk_bf16(v1[0], v1[1]); w.w = cvt_pk_bf16(v1[2], v1[3]);
                        *(u32x4*)(rowp + bj * HALF) = w; } }
                asm volatile("" ::: "memory"); }
    }
};

template <class Epi, class Sched>
__device__ __forceinline__ void gemm_phase(LAS unsigned char* lds, const Gemm g, const Sched& S, const Epi& E, int tid) {
    const int wid = __builtin_amdgcn_readfirstlane(tid >> 6), lane = tid & 63, wr = wid >> 2, wc = wid & 3, fr = lane & 15, fq = lane >> 4;
    const int K = g.K, lda = g.lda, nt = K / BK;
    unsigned voffA[2], voffB[2];
#pragma unroll
    for (int i = 0; i < 2; ++i) { int R, C; stage_rc(tid * 16 + i * 8192, R, C); const int Rb = Epi::PERM ? ((R & ~31) + perm32(R & 31)) : R;
        voffA[i] = (unsigned)(R * lda + C) * 2u; voffB[i] = (unsigned)(Rb * K + C) * 2u; }
    const size_t kstep = (size_t)(BK * 2);
    const size_t hstepA = (size_t)HALF * lda * 2, hstepB = (size_t)HALF * K * 2;
    const unsigned ldsw = (unsigned)wid * 1024u;
    const int aoff = lds_byte(wr * 64 + fr, fq * 8), boff = lds_byte(wc * 32 + fr, fq * 8);
#define PG8_SA(b, h) (((b) * 2 + (h)) * HTB)
#define PG8_SB(b, h) ((4 + (b) * 2 + (h)) * HTB)
#define PG8_STAGE(bufoff, gbase, voff) do { _Pragma("unroll") for (int _i = 0; _i < 2; ++_i) \
        __builtin_amdgcn_global_load_lds((const unsigned*)((const char*)(gbase) + (voff)[_i]), (LAS unsigned*)(lds + (bufoff) + ldsw + _i * 8192), 16, 0, 0); } while (0)
#define PG8_LDA(dst, b, h) do { _Pragma("unroll") for (int m = 0; m < 4; ++m) _Pragma("unroll") for (int k = 0; k < 2; ++k) dst[m][k] = *(const LAS bf16x8*)(lds + PG8_SA(b, h) + aoff + m * 2048 + k * 1024); } while (0)
#define PG8_LDB(dst, b, h) do { _Pragma("unroll") for (int n = 0; n < 2; ++n) _Pragma("unroll") for (int k = 0; k < 2; ++k) dst[n][k] = *(const LAS bf16x8*)(lds + PG8_SB(b, h) + boff + n * 2048 + k * 1024); } while (0)
#define PG8_MMA(ai, bj, At, Bt) do { __builtin_amdgcn_s_setprio(1); _Pragma("unroll") for (int m = 0; m < 4; ++m) _Pragma("unroll") for (int n = 0; n < 2; ++n) _Pragma("unroll") for (int k = 0; k < 2; ++k) \
        acc[ai][bj][m][n] = __builtin_amdgcn_mfma_f32_16x16x32_bf16(Bt[n][k], At[m][k], acc[ai][bj][m][n], 0, 0, 0); __builtin_amdgcn_s_setprio(0); } while (0)
#define PG8_WAIT_V(n) asm volatile("s_waitcnt vmcnt(" #n ")" ::: "memory")
#define PG8_WAIT_L(n) asm volatile("s_waitcnt lgkmcnt(" #n ")" ::: "memory")
#define PG8_BAR __builtin_amdgcn_s_barrier()
#define PG8_SCHED __builtin_amdgcn_sched_barrier(0)
    Unit cur, nxt; int ui = 0;
    if (!S.next(0, cur)) return;
    Acc acc;
#pragma unroll
    for (int a = 0; a < 2; ++a)
#pragma unroll
        for (int b = 0; b < 2; ++b)
#pragma unroll
            for (int m = 0; m < 4; ++m)
#pragma unroll
                for (int n = 0; n < 2; ++n) acc[a][b][m][n] = (f32x4){0.f, 0.f, 0.f, 0.f};
    bf16x8 At[4][2], B0[2][2], B1[2][2];
    const char* cA = cur.A; const char* cB = cur.B;
    PG8_STAGE(PG8_SB(0, 0), cB, voffB); PG8_STAGE(PG8_SB(0, 1), cB + hstepB, voffB); PG8_STAGE(PG8_SA(0, 0), cA, voffA); PG8_STAGE(PG8_SA(0, 1), cA + hstepA, voffA);
    if (wr == 1) PG8_BAR;
    PG8_WAIT_V(2); PG8_BAR;
    PG8_STAGE(PG8_SB(1, 0), cB + kstep, voffB); PG8_STAGE(PG8_SA(1, 0), cA + kstep, voffA); PG8_STAGE(PG8_SB(1, 1), cB + hstepB + kstep, voffB);
    PG8_WAIT_V(6); PG8_BAR;
    for (;;) {
        const bool has_next = S.next(ui + 1, nxt);
        const char* nA = has_next ? nxt.A : cA; const char* nB = has_next ? nxt.B : cB;
        for (int t = 0; t < nt; t += 2) {
            const bool last = (t == nt - 2);
            const char* a1 = cA + (size_t)(t + 1) * kstep;
            const char* a2 = last ? nA : cA + (size_t)(t + 2) * kstep; const char* b2 = last ? nB : cB + (size_t)(t + 2) * kstep;
            const char* a3 = a2 + kstep; const char* b3 = b2 + kstep;
            PG8_LDB(B0, 0, 0); PG8_LDB(B1, 0, 1); PG8_SCHED; PG8_LDA(At, 0, 0); PG8_STAGE(PG8_SA(1, 1), a1 + hstepA, voffA);
            PG8_WAIT_V(8); PG8_WAIT_L(0); PG8_BAR; PG8_MMA(0, 0, At, B0); PG8_MMA(0, 1, At, B1); PG8_BAR; PG8_SCHED;
            PG8_LDA(At, 0, 1); PG8_STAGE(PG8_SB(0, 0), b2, voffB); PG8_STAGE(PG8_SB(0, 1), b2 + hstepB, voffB); PG8_STAGE(PG8_SA(0, 0), a2, voffA);
            PG8_WAIT_V(8); PG8_WAIT_L(0); PG8_BAR; PG8_MMA(1, 0, At, B0); PG8_MMA(1, 1, At, B1); PG8_BAR; PG8_SCHED;
            PG8_LDB(B0, 1, 0); PG8_LDB(B1, 1, 1); PG8_SCHED; PG8_LDA(At, 1, 0); PG8_STAGE(PG8_SA(0, 1), a2 + hstepA, voffA);
            PG8_WAIT_V(8); PG8_WAIT_L(0); PG8_BAR; PG8_MMA(0, 0, At, B0); PG8_MMA(0, 1, At, B1); PG8_BAR; PG8_SCHED;
            PG8_LDA(At, 1, 1); PG8_STAGE(PG8_SB(1, 0), b3, voffB); PG8_STAGE(PG8_SB(1, 1), b3 + hstepB, voffB); PG8_STAGE(PG8_SA(1, 0), a3, voffA);
            PG8_WAIT_V(8); PG8_WAIT_L(0); PG8_BAR; PG8_MMA(1, 0, At, B0); PG8_MMA(1, 1, At, B1); PG8_BAR; PG8_SCHED;
        }
        if (wr == 0) PG8_BAR;
        E(acc, cur, wr, wc, fr, fq);
        if (!has_next) break;
#pragma unroll
        for (int a = 0; a < 2; ++a)
#pragma unroll
            for (int b = 0; b < 2; ++b)
#pragma unroll
                for (int m = 0; m < 4; ++m)
#pragma unroll
                    for (int n = 0; n < 2; ++n) acc[a][b][m][n] = (f32x4){0.f, 0.f, 0.f, 0.f};
        cur = nxt; cA = nA; cB = nB; ++ui;
        if (wr == 1) PG8_BAR;
    }
    PG8_WAIT_V(0);
    PG8_BAR;
#undef PG8_SA
#undef PG8_SB
#undef PG8_STAGE
#undef PG8_LDA
#undef PG8_LDB
#undef PG8_MMA
#undef PG8_WAIT_V
#undef PG8_WAIT_L
#undef PG8_BAR
#undef PG8_SCHED
}
}

namespace att {
constexpr int NW = 8, QBLK = 32, KVBLK = 64;
constexpr float SCALE = 0.07216878364870322f;
constexpr float THR = 8.f;
#ifndef ATT_SDEPTH
#define ATT_SDEPTH 2
#endif
constexpr int SDEPTH = ATT_SDEPTH;
constexpr int KROW = 400;
constexpr int SHM_V = KVBLK * DV * 2, SHM_K = KVBLK * KROW;
#ifndef ATT_NQR
#define ATT_NQR 8
#endif
constexpr int NQR = ATT_NQR;
constexpr int QLROW = (12 - NQR) * 32 + 16;
constexpr int OFF_V = 0, OFF_K = 2 * SHM_V, OFF_WS = OFF_K + 2 * SHM_K, OFF_QL = OFF_WS + NW * 64 * 4, ATT_LDS = OFF_QL + NW * 32 * QLROW;
static_assert(ATT_LDS <= RING_BYTES, "attention LDS");
#define SBAR() __builtin_amdgcn_sched_barrier(0)
__device__ __forceinline__ int crow(int r, int hi) { return (r & 3) + 8 * (r >> 2) + 4 * hi; }
__device__ __forceinline__ void partialSM(f32x16& p0, f32x16& p1, float& m_reg, float& mn, float& alpha) {
    constexpr float C = SCALE * 1.4426950408889634f;
    float pmax = p0[0];
#pragma unroll
    for (int r = 1; r < 16; ++r) pmax = fmaxf(pmax, p0[r]);
#pragma unroll
    for (int r = 0; r < 16; ++r) pmax = fmaxf(pmax, p1[r]);
    { auto rr = __builtin_amdgcn_permlane32_swap(__float_as_uint(pmax), __float_as_uint(pmax), false, false);
      pmax = fmaxf(__uint_as_float(rr[0]), __uint_as_float(rr[1])); }
    if (__builtin_expect(__all(pmax - m_reg <= THR / SCALE), 1)) { mn = m_reg; alpha = 1.f; }
    else { mn = fmaxf(m_reg, pmax); alpha = __builtin_amdgcn_exp2f((m_reg - mn) * C); m_reg = mn; }
    const float mnC = -mn * C;
#pragma unroll
    for (int r = 0; r < 16; ++r) p0[r] = fmaf(p0[r], C, mnC);
#pragma unroll
    for (int r = 0; r < 16; ++r) p1[r] = fmaf(p1[r], C, mnC);
#pragma unroll
    for (int r = 0; r < 16; ++r) p0[r] = __builtin_amdgcn_exp2f(p0[r]);
}
__device__ __forceinline__ void finishSM(f32x16& p0, f32x16& p1, float alpha, float& l_reg, bf16x8& pa0, bf16x8& pa1, bf16x8& pa2, bf16x8& pa3) {
#pragma unroll
    for (int r = 0; r < 16; ++r) p1[r] = __builtin_amdgcn_exp2f(p1[r]);
    float ps = 0;
#pragma unroll
    for (int r = 0; r < 16; ++r) ps += p0[r];
#pragma unroll
    for (int r = 0; r < 16; ++r) ps += p1[r];
    { auto rr = __builtin_amdgcn_permlane32_swap(__float_as_uint(ps), __float_as_uint(ps), false, false);
      ps = __uint_as_float(rr[0]) + __uint_as_float(rr[1]); }
    l_reg = l_reg * alpha + ps;
#define PK4(P, BASE, OUT) do { unsigned a0 = cvt_pk_bf16(P[BASE + 0], P[BASE + 1]), a1 = cvt_pk_bf16(P[BASE + 2], P[BASE + 3]);   \
    unsigned b0 = cvt_pk_bf16(P[BASE + 4], P[BASE + 5]), b1 = cvt_pk_bf16(P[BASE + 6], P[BASE + 7]);                              \
    auto r0 = __builtin_amdgcn_permlane32_swap(a0, b0, false, false); auto r1 = __builtin_amdgcn_permlane32_swap(a1, b1, false, false); \
    u32x4 w = {r0[0], r1[0], r0[1], r1[1]}; OUT = *reinterpret_cast<bf16x8*>(&w); } while (0)
    PK4(p0, 0, pa0); PK4(p0, 8, pa1); PK4(p1, 0, pa2); PK4(p1, 8, pa3);
#undef PK4
}
__device__ __forceinline__ void qkt(f32x16& p0, f32x16& p1, const char* Ks, const bf16x8* qr, const char* ql, int r32, int hi) {
    p0 = f32x16{}; p1 = f32x16{};
#pragma unroll
    for (int d0 = 0; d0 < 12; ++d0) { const int cb = d0 * 32 + hi * 16;
        const bf16x8 b0 = *reinterpret_cast<const bf16x8*>(Ks + r32 * KROW + cb);
        const bf16x8 b1 = *reinterpret_cast<const bf16x8*>(Ks + (32 + r32) * KROW + cb);
        const bf16x8 qf = (d0 < NQR) ? qr[d0] : *reinterpret_cast<const bf16x8*>(ql + (d0 - NQR) * 32);
        p0 = __builtin_amdgcn_mfma_f32_32x32x16_bf16(b0, qf, p0, 0, 0, 0);
        p1 = __builtin_amdgcn_mfma_f32_32x32x16_bf16(b1, qf, p1, 0, 0, 0); }
}
__device__ __forceinline__ int v_st(int k, int c) { const int kk = (k & ~0xC) | ((k & 4) << 1) | ((k & 8) >> 1); return ((kk >> 3) * 4 + (c >> 5)) * 512 + ((kk & 7) * 32 + (c & 31)) * 2; }
__device__ __forceinline__ int v_rd_base(int lane) { return ((lane & 3) << 3) | (((lane >> 2) & 3) << 6) | (((lane >> 4) & 1) << 5) | (((lane >> 5) & 1) << 8); }
constexpr int v_rd_off(int d0, int ks, int half) { return d0 * 512 + ks * 4096 + half * 2048; }
template <int OFF> __device__ __forceinline__ s16x4 tr_read(int vb) {
    s16x4 r; asm volatile("ds_read_b64_tr_b16 %0, %1 offset:%2" : "=&v"(r) : "v"(vb), "i"(OFF) : "memory"); return r;
}
template <int D0> __device__ __forceinline__ void pv_one(f32x16& od, int vb, bf16x8 pa0, bf16x8 pa1, bf16x8 pa2, bf16x8 pa3) {
    const s16x4 l0 = tr_read<v_rd_off(D0, 0, 0)>(vb), h0 = tr_read<v_rd_off(D0, 0, 1)>(vb), l1 = tr_read<v_rd_off(D0, 1, 0)>(vb), h1 = tr_read<v_rd_off(D0, 1, 1)>(vb);
    const s16x4 l2 = tr_read<v_rd_off(D0, 2, 0)>(vb), h2 = tr_read<v_rd_off(D0, 2, 1)>(vb), l3 = tr_read<v_rd_off(D0, 3, 0)>(vb), h3 = tr_read<v_rd_off(D0, 3, 1)>(vb);
    asm volatile("s_waitcnt lgkmcnt(0)" ::: "memory"); SBAR();
#define PK(L, H) (bf16x8){L[0], L[1], L[2], L[3], H[0], H[1], H[2], H[3]}
    od = __builtin_amdgcn_mfma_f32_32x32x16_bf16(pa0, PK(l0, h0), od, 0, 0, 0);
    od = __builtin_amdgcn_mfma_f32_32x32x16_bf16(pa1, PK(l1, h1), od, 0, 0, 0);
    od = __builtin_amdgcn_mfma_f32_32x32x16_bf16(pa2, PK(l2, h2), od, 0, 0, 0);
    od = __builtin_amdgcn_mfma_f32_32x32x16_bf16(pa3, PK(l3, h3), od, 0, 0, 0);
#undef PK
}
__device__ __forceinline__ void pv_d0(f32x16* o, int vb, bf16x8 pa0, bf16x8 pa1, bf16x8 pa2, bf16x8 pa3) {
    pv_one<0>(o[0], vb, pa0, pa1, pa2, pa3); pv_one<1>(o[1], vb, pa0, pa1, pa2, pa3); pv_one<2>(o[2], vb, pa0, pa1, pa2, pa3); pv_one<3>(o[3], vb, pa0, pa1, pa2, pa3);
}
__device__ __forceinline__ void attn_unit(const bf16_t* __restrict__ Qb, const bf16_t* __restrict__ Kh, const bf16_t* __restrict__ Vh, bf16_t* __restrict__ Ob, char* lds, int tid) {
    const int wid = tid >> 6, lane = tid & 63, r32 = lane & 31, hi = lane >> 5;
    char* V_lds = lds + OFF_V; char* K_lds = lds + OFF_K;
    float* ws = (float*)(lds + OFF_WS) + wid * 64; float* li_l = ws; float* al_l = ws + 32;
    float m_reg = -1e30f, l_reg = 0; f32x16 o[4] = {}; bf16x8 qr[NQR];
    const bf16_t* Qw = Qb + (long)(wid * QBLK + r32) * DQK + hi * 8;
#pragma unroll
    for (int d0 = 0; d0 < NQR; ++d0) qr[d0] = *reinterpret_cast<const bf16x8*>(Qw + d0 * 16);
    char* ql = lds + OFF_QL + wid * (32 * QLROW) + r32 * QLROW + hi * 16;
#pragma unroll
    for (int d0 = NQR; d0 < 12; ++d0) *reinterpret_cast<bf16x8*>(ql + (d0 - NQR) * 32) = *reinterpret_cast<const bf16x8*>(Qw + d0 * 16);
    const int sr = tid >> 4, sc = (tid & 15) * 8, vst0 = v_st(sr, sc), vst1 = v_st(32 + sr, sc);
    int kst[3];
#pragma unroll
    for (int i = 0; i < 3; ++i) { const int q = tid + 512 * i; kst[i] = (q / 24) * KROW + (q % 24) * 16; }
    const int vb0 = (int)(uintptr_t)V_lds + v_rd_base(lane);
    struct { bf16x8 vs0, vs1, ks0, ks1, ks2; } sr_[SDEPTH];
#define SLOAD(i, k0) do { sr_[i].vs0 = *reinterpret_cast<const bf16x8*>(&Vh[(long)((k0) + sr) * DV + sc]); sr_[i].vs1 = *reinterpret_cast<const bf16x8*>(&Vh[(long)((k0) + 32 + sr) * DV + sc]); \
    const bf16_t* kp_ = Kh + (long)(k0) * DQK + tid * 8; sr_[i].ks0 = *reinterpret_cast<const bf16x8*>(kp_); sr_[i].ks1 = *reinterpret_cast<const bf16x8*>(kp_ + 4096); sr_[i].ks2 = *reinterpret_cast<const bf16x8*>(kp_ + 8192); } while (0)
#define SWRITE(b, i) do { *(bf16x8*)(V_lds + (b) * SHM_V + vst0) = sr_[i].vs0; *(bf16x8*)(V_lds + (b) * SHM_V + vst1) = sr_[i].vs1; \
    *(bf16x8*)(K_lds + (b) * SHM_K + kst[0]) = sr_[i].ks0; *(bf16x8*)(K_lds + (b) * SHM_K + kst[1]) = sr_[i].ks1; *(bf16x8*)(K_lds + (b) * SHM_K + kst[2]) = sr_[i].ks2; } while (0)
#define SWAIT() do { if constexpr (SDEPTH == 2) asm volatile("s_waitcnt vmcnt(5)" ::: "memory"); else asm volatile("s_waitcnt vmcnt(0)" ::: "memory"); } while (0)
#define RESC(a) do { if (__any((a) < 1.f)) { if (hi == 0) al_l[r32] = (a); asm volatile("s_waitcnt lgkmcnt(0)" ::: "memory"); \
    _Pragma("unroll") for (int d = 0; d < 4; ++d) _Pragma("unroll") for (int r = 0; r < 16; ++r) o[d][r] *= al_l[crow(r, hi)]; } } while (0)
    f32x16 pA0, pA1, pB0, pB1; float mnA, mnB, alA, alB; bf16x8 pa0, pa1, pa2, pa3; constexpr int NT = SEQ / KVBLK;
    constexpr int SE = 0, SO = SDEPTH - 1;
    SLOAD(SE, 0); asm volatile("s_waitcnt vmcnt(0)" ::: "memory"); SWRITE(0, SE); __syncthreads();
    qkt(pA0, pA1, K_lds, qr, ql, r32, hi); partialSM(pA0, pA1, m_reg, mnA, alA);
    SLOAD(SO, KVBLK); if constexpr (SDEPTH == 2) SLOAD(SE, 2 * KVBLK);
    SWAIT(); SWRITE(1, SO); __syncthreads();
    for (int j = 1; j + 1 < NT; j += 2) {
        SBAR(); qkt(pB0, pB1, K_lds + SHM_K, qr, ql, r32, hi);
        finishSM(pA0, pA1, alA, l_reg, pa0, pa1, pa2, pa3); SBAR();
        SLOAD(SO, (j + SDEPTH) * KVBLK); SBAR();
        pv_d0(o, vb0, pa0, pa1, pa2, pa3); partialSM(pB0, pB1, m_reg, mnB, alB);
        __syncthreads(); SWAIT(); SWRITE(0, SE);
        RESC(alB); __syncthreads();
        SBAR(); qkt(pA0, pA1, K_lds, qr, ql, r32, hi);
        finishSM(pB0, pB1, alB, l_reg, pa0, pa1, pa2, pa3); SBAR();
        if (SDEPTH == 1 || j + 3 < NT) SLOAD(SE, (j + 1 + SDEPTH) * KVBLK); SBAR();
        pv_d0(o, vb0 + SHM_V, pa0, pa1, pa2, pa3); partialSM(pA0, pA1, m_reg, mnA, alA);
        __syncthreads(); SWAIT(); SWRITE(1, SO);
        RESC(alA); __syncthreads();
    }
    SBAR(); qkt(pB0, pB1, K_lds + SHM_K, qr, ql, r32, hi);
    finishSM(pA0, pA1, alA, l_reg, pa0, pa1, pa2, pa3); SBAR();
    pv_d0(o, vb0, pa0, pa1, pa2, pa3); partialSM(pB0, pB1, m_reg, mnB, alB);
    __syncthreads(); RESC(alB);
    finishSM(pB0, pB1, alB, l_reg, pa0, pa1, pa2, pa3); SBAR();
    pv_d0(o, vb0 + SHM_V, pa0, pa1, pa2, pa3);
    if (hi == 0) li_l[r32] = l_reg; asm volatile("s_waitcnt lgkmcnt(0)" ::: "memory");
    float rli[16];
#pragma unroll
    for (int r = 0; r < 16; ++r) rli[r] = __builtin_amdgcn_rcpf(li_l[crow(r, hi)]);
    __syncthreads();
    bf16_t* ost = (bf16_t*)(lds + wid * 8192);
#pragma unroll
    for (int r = 0; r < 16; ++r) { const int orow = crow(r, hi);
#pragma unroll
        for (int d0 = 0; d0 < 4; ++d0) ost[orow * 128 + d0 * 32 + r32] = (bf16_t)f2bf(o[d0][r] * rli[r]); }
    asm volatile("s_waitcnt lgkmcnt(0)" ::: "memory");
    bf16_t* Ow = Ob + (long)(wid * QBLK) * DM;
#pragma unroll
    for (int i = 0; i < 8; ++i) { const int ch = lane + 64 * i, row = ch >> 4, c = ch & 15;
        const u32x4 v = *(const u32x4*)((const char*)ost + row * 256 + c * 16); *(u32x4*)(Ow + (long)row * DM + c * 8) = v; }
    __syncthreads();
#undef SLOAD
#undef SWRITE
#undef SWAIT
#undef RESC
#undef SBAR
}
}


namespace att8 {
typedef int i32x8 __attribute__((ext_vector_type(8)));
constexpr int NW = 8, QBLK = 32, KVBLK = 64;
constexpr float SCALE = 0.07216878364870322f;
constexpr float THR = 3.f;
constexpr float POFF = 4.f;
constexpr int KROW = 208, VROW = 80;
constexpr int SHM_K = KVBLK * KROW, SHM_V = DV * VROW;
constexpr int OFF_V = 0, OFF_K = 2 * SHM_V, OFF_WS = OFF_K + 2 * SHM_K, ATT_LDS = OFF_WS + NW * 64 * 4;
static_assert(ATT_LDS <= 65536, "O staging reuses [0, 64 KiB)");
#define SBAR() __builtin_amdgcn_sched_barrier(0)
__device__ __forceinline__ int crow(int r, int hi) { return (r & 3) + 8 * (r >> 2) + 4 * hi; }
__device__ __forceinline__ f32x16 mfma8(i32x8 a, i32x8 b, f32x16 c) { return __builtin_amdgcn_mfma_scale_f32_32x32x64_f8f6f4(a, b, c, 0, 0, 0, 0x7F7F7F7F, 0, 0x7F7F7F7F); }
__device__ __forceinline__ i32x8 ld32(const char* p) { const u32x4 a = *reinterpret_cast<const u32x4*>(p), b = *reinterpret_cast<const u32x4*>(p + 16); return (i32x8){(int)a.x, (int)a.y, (int)a.z, (int)a.w, (int)b.x, (int)b.y, (int)b.z, (int)b.w}; }
__device__ __forceinline__ void partialSM(f32x16& p0, f32x16& p1, float& m_reg, float& mn, float& alpha) {
    constexpr float C = SCALE * 1.4426950408889634f;
    float pmax = p0[0];
#pragma unroll
    for (int r = 1; r < 16; ++r) pmax = fmaxf(pmax, p0[r]);
#pragma unroll
    for (int r = 0; r < 16; ++r) pmax = fmaxf(pmax, p1[r]);
    { auto rr = __builtin_amdgcn_permlane32_swap(__float_as_uint(pmax), __float_as_uint(pmax), false, false);
      pmax = fmaxf(__uint_as_float(rr[0]), __uint_as_float(rr[1])); }
    if (__builtin_expect(__all(pmax - m_reg <= THR / SCALE), 1)) { mn = m_reg; alpha = 1.f; }
    else { mn = fmaxf(m_reg, pmax); alpha = __builtin_amdgcn_exp2f((m_reg - mn) * C); m_reg = mn; }
    const float mnC = POFF - mn * C;
#pragma unroll
    for (int r = 0; r < 16; ++r) p0[r] = fmaf(p0[r], C, mnC);
#pragma unroll
    for (int r = 0; r < 16; ++r) p1[r] = fmaf(p1[r], C, mnC);
#pragma unroll
    for (int r = 0; r < 16; ++r) p0[r] = __builtin_amdgcn_exp2f(p0[r]);
}
__device__ __forceinline__ void finishSM(f32x16& p0, f32x16& p1, float alpha, float& l_reg, i32x8& pa) {
#pragma unroll
    for (int r = 0; r < 16; ++r) p1[r] = __builtin_amdgcn_exp2f(p1[r]);
    float ps = 0;
#pragma unroll
    for (int r = 0; r < 16; ++r) ps += p0[r];
#pragma unroll
    for (int r = 0; r < 16; ++r) ps += p1[r];
    { auto rr = __builtin_amdgcn_permlane32_swap(__float_as_uint(ps), __float_as_uint(ps), false, false);
      ps = __uint_as_float(rr[0]) + __uint_as_float(rr[1]); }
    l_reg = l_reg * alpha + ps;
#pragma unroll
    for (int g = 0; g < 4; ++g) { int w = 0; w = __builtin_amdgcn_cvt_pk_fp8_f32(p0[4 * g], p0[4 * g + 1], w, false); w = __builtin_amdgcn_cvt_pk_fp8_f32(p0[4 * g + 2], p0[4 * g + 3], w, true); pa[g] = w; }
#pragma unroll
    for (int g = 0; g < 4; ++g) { int w = 0; w = __builtin_amdgcn_cvt_pk_fp8_f32(p1[4 * g], p1[4 * g + 1], w, false); w = __builtin_amdgcn_cvt_pk_fp8_f32(p1[4 * g + 2], p1[4 * g + 3], w, true); pa[4 + g] = w; }
}
__device__ __forceinline__ void qkt(f32x16& p0, f32x16& p1, const char* Ks, const i32x8* qr, int r32, int hi) {
    p0 = f32x16{}; p1 = f32x16{};
#pragma unroll
    for (int ks = 0; ks < 3; ++ks) { const int cb = ks * 64 + hi * 32;
        const i32x8 a0 = ld32(Ks + r32 * KROW + cb), a1 = ld32(Ks + (32 + r32) * KROW + cb);
        p0 = mfma8(a0, qr[ks], p0); p1 = mfma8(a1, qr[ks], p1); }
}
__device__ __forceinline__ void pv(f32x16* o, const char* Vs, i32x8 pa, int r32, int hi) {
#pragma unroll
    for (int d0 = 0; d0 < 4; ++d0) { const i32x8 b = ld32(Vs + (32 * d0 + r32) * VROW + hi * 32); o[d0] = mfma8(pa, b, o[d0]); }
}
__device__ __forceinline__ void attn_unit(const unsigned char* __restrict__ Qb, const unsigned char* __restrict__ Kh, const unsigned char* __restrict__ Vt, bf16_t* __restrict__ Ob, char* lds, int tid) {
    const int wid = tid >> 6, lane = tid & 63, r32 = lane & 31, hi = lane >> 5;
    char* V_lds = lds + OFF_V; char* K_lds = lds + OFF_K;
    float* ws = (float*)(lds + OFF_WS) + wid * 64; float* li_l = ws; float* al_l = ws + 32;
    float m_reg = -1e30f, l_reg = 0; f32x16 o[4] = {}; i32x8 qr[3];
    const unsigned char* Qw = Qb + (long)(wid * QBLK + r32) * DQK + hi * 32;
#pragma unroll
    for (int ks = 0; ks < 3; ++ks) qr[ks] = ld32((const char*)Qw + ks * 64);
    const int kst0 = (tid / 12) * KROW + (tid % 12) * 16, kst1 = ((tid + 512) / 12) * KROW + ((tid + 512) % 12) * 16, vst = (tid >> 2) * VROW + (tid & 3) * 16;
    const bool k2 = tid < 256;
    struct { u32x4 v, k0, k1; } sr_[2];
#define SLOAD(i, t) do { sr_[i].v = *reinterpret_cast<const u32x4*>(Vt + (long)(t) * 8192 + tid * 16); const unsigned char* kp_ = Kh + (long)(t) * 12288 + tid * 16; \
    sr_[i].k0 = *reinterpret_cast<const u32x4*>(kp_); if (k2) sr_[i].k1 = *reinterpret_cast<const u32x4*>(kp_ + 8192); } while (0)
#define SWRITE(b, i) do { *(u32x4*)(V_lds + (b) * SHM_V + vst) = sr_[i].v; *(u32x4*)(K_lds + (b) * SHM_K + kst0) = sr_[i].k0; if (k2) *(u32x4*)(K_lds + (b) * SHM_K + kst1) = sr_[i].k1; } while (0)
#define RESC(a) do { if (__any((a) < 1.f)) { if (hi == 0) al_l[r32] = (a); asm volatile("s_waitcnt lgkmcnt(0)" ::: "memory"); \
    _Pragma("unroll") for (int d = 0; d < 4; ++d) _Pragma("unroll") for (int r = 0; r < 16; ++r) o[d][r] *= al_l[crow(r, hi)]; } } while (0)
    f32x16 pA0, pA1, pB0, pB1; float mnA, mnB, alA, alB; i32x8 pa; constexpr int NT = SEQ / KVBLK;
    SLOAD(0, 0); asm volatile("s_waitcnt vmcnt(0)" ::: "memory"); SWRITE(0, 0); __syncthreads();
    qkt(pA0, pA1, K_lds, qr, r32, hi); partialSM(pA0, pA1, m_reg, mnA, alA);
    SLOAD(1, 1); SLOAD(0, 2);
    SWRITE(1, 1); __syncthreads();
    for (int j = 1; j + 1 < NT; j += 2) {
        SBAR(); qkt(pB0, pB1, K_lds + SHM_K, qr, r32, hi);
        finishSM(pA0, pA1, alA, l_reg, pa); SBAR();
        SLOAD(1, j + 2); SBAR();
        pv(o, V_lds, pa, r32, hi); partialSM(pB0, pB1, m_reg, mnB, alB);
        __syncthreads(); SWRITE(0, 0);
        RESC(alB); __syncthreads();
        SBAR(); qkt(pA0, pA1, K_lds, qr, r32, hi);
        finishSM(pB0, pB1, alB, l_reg, pa); SBAR();
        if (j + 3 < NT) SLOAD(0, j + 3); SBAR();
        pv(o, V_lds + SHM_V, pa, r32, hi); partialSM(pA0, pA1, m_reg, mnA, alA);
        __syncthreads(); SWRITE(1, 1);
        RESC(alA); __syncthreads();
    }
    SBAR(); qkt(pB0, pB1, K_lds + SHM_K, qr, r32, hi);
    finishSM(pA0, pA1, alA, l_reg, pa); SBAR();
    pv(o, V_lds, pa, r32, hi); partialSM(pB0, pB1, m_reg, mnB, alB);
    __syncthreads(); RESC(alB);
    finishSM(pB0, pB1, alB, l_reg, pa); SBAR();
    pv(o, V_lds + SHM_V, pa, r32, hi);
    if (hi == 0) li_l[r32] = l_reg; asm volatile("s_waitcnt lgkmcnt(0)" ::: "memory");
    float rli[16];
#pragma unroll
    for (int r = 0; r < 16; ++r) rli[r] = __builtin_amdgcn_rcpf(li_l[crow(r, hi)]);
    __syncthreads();
    bf16_t* ost = (bf16_t*)(lds + wid * 8192);
#pragma unroll
    for (int r = 0; r < 16; ++r) { const int orow = crow(r, hi);
#pragma unroll
        for (int d0 = 0; d0 < 4; ++d0) ost[orow * 128 + d0 * 32 + r32] = (bf16_t)f2bf(o[d0][r] * rli[r]); }
    asm volatile("s_waitcnt lgkmcnt(0)" ::: "memory");
    bf16_t* Ow = Ob + (long)(wid * QBLK) * DM;
#pragma unroll
    for (int i = 0; i < 8; ++i) { const int ch = lane + 64 * i, row = ch >> 4, c = ch & 15;
        const u32x4 v = *(const u32x4*)((const char*)ost + row * 256 + c * 16); *(u32x4*)(Ow + (long)row * DM + c * 8) = v; }
    __syncthreads();
#undef SLOAD
#undef SWRITE
#undef RESC
}

__device__ __forceinline__ float max3f(float a, float b, float c) { float r; asm("v_max3_f32 %0, %1, %2, %3" : "=v"(r) : "v"(a), "v"(b), "v"(c)); return r; }
__device__ __forceinline__ float max2f(float a, float b) { float r; asm("v_max_f32_e32 %0, %1, %2" : "=v"(r) : "v"(a), "v"(b)); return r; }
constexpr float THR2 = THR * 1.4426950408889634f;
__device__ __forceinline__ void softmax_seg(f32x16& p0, f32x16& p1, f32x16& negm, float& l_reg, f32x16* o, i32x8& pa, float* al_l, int r32, int hi) {
    float pmax = max3f(p0[0], p0[1], p0[2]);
#pragma unroll
    for (int r = 3; r < 15; r += 2) pmax = max3f(pmax, p0[r], p0[r + 1]);
    pmax = max3f(pmax, p0[15], p1[0]);
#pragma unroll
    for (int r = 1; r < 15; r += 2) pmax = max3f(pmax, p1[r], p1[r + 1]);
    pmax = max2f(pmax, p1[15]);
    { auto rr = __builtin_amdgcn_permlane32_swap(__float_as_uint(pmax), __float_as_uint(pmax), false, false);
      pmax = max2f(__uint_as_float(rr[0]), __uint_as_float(rr[1])); }
    float alpha = 1.f;
    if (!__builtin_expect(__all(pmax <= POFF + THR2), 1)) {
        const float d = fmaxf(pmax - POFF, 0.f);
        alpha = __builtin_amdgcn_exp2f(-d);
#pragma unroll
        for (int r = 0; r < 16; ++r) { p0[r] -= d; p1[r] -= d; negm[r] -= d; }
        if (hi == 0) al_l[r32] = alpha; asm volatile("s_waitcnt lgkmcnt(0)" ::: "memory");
#pragma unroll
        for (int dd = 0; dd < 4; ++dd)
#pragma unroll
            for (int r = 0; r < 16; ++r) o[dd][r] *= al_l[crow(r, hi)];
    }
    float ps = 0;
#pragma unroll
    for (int r = 0; r < 16; ++r) { p0[r] = __builtin_amdgcn_exp2f(p0[r]); ps += p0[r]; }
#pragma unroll
    for (int r = 0; r < 16; ++r) { p1[r] = __builtin_amdgcn_exp2f(p1[r]); ps += p1[r]; }
    { auto rr = __builtin_amdgcn_permlane32_swap(__float_as_uint(ps), __float_as_uint(ps), false, false);
      ps = __uint_as_float(rr[0]) + __uint_as_float(rr[1]); }
    l_reg = l_reg * alpha + ps;
#pragma unroll
    for (int g = 0; g < 4; ++g) { int w = 0; w = __builtin_amdgcn_cvt_pk_fp8_f32(p0[4 * g], p0[4 * g + 1], w, false); w = __builtin_amdgcn_cvt_pk_fp8_f32(p0[4 * g + 2], p0[4 * g + 3], w, true); pa[g] = w; }
#pragma unroll
    for (int g = 0; g < 4; ++g) { int w = 0; w = __builtin_amdgcn_cvt_pk_fp8_f32(p1[4 * g], p1[4 * g + 1], w, false); w = __builtin_amdgcn_cvt_pk_fp8_f32(p1[4 * g + 2], p1[4 * g + 3], w, true); pa[4 + g] = w; }
}
__device__ __forceinline__ f32x16 mfma8q(i32x8 a, i32x8 b, f32x16 c) { return __builtin_amdgcn_mfma_scale_f32_32x32x64_f8f6f4(a, b, c, 0, 0, 0, 0x7F7F7F7F, 0, 0x7C7C7C7C); }
template <bool DO_QK, bool DO_PV>
__device__ __forceinline__ void mfma_seg(f32x16& p0, f32x16& p1, const f32x16& negm, f32x16* o, const char* Ks, const char* Vs, const i32x8* qr, i32x8 pa, int r32, int hi) {
    i32x8 ka[3][2], vb[4];
    if (DO_QK) {
#pragma unroll
        for (int ks = 0; ks < 3; ++ks) { const int cb = ks * 64 + hi * 32; ka[ks][0] = ld32(Ks + r32 * KROW + cb); ka[ks][1] = ld32(Ks + (32 + r32) * KROW + cb); } }
    if (DO_PV) {
#pragma unroll
        for (int d0 = 0; d0 < 4; ++d0) vb[d0] = ld32(Vs + (32 * d0 + r32) * VROW + hi * 32); }
    SBAR();
    if (DO_QK) {
        p0 = mfma8q(ka[0][0], qr[0], negm); p1 = mfma8q(ka[0][1], qr[0], negm);
        p0 = mfma8q(ka[1][0], qr[1], p0); p1 = mfma8q(ka[1][1], qr[1], p1);
        p0 = mfma8q(ka[2][0], qr[2], p0); p1 = mfma8q(ka[2][1], qr[2], p1); }
    if (DO_PV) {
#pragma unroll
        for (int d0 = 0; d0 < 4; ++d0) o[d0] = mfma8(pa, vb[d0], o[d0]); }
}
__device__ __forceinline__ void attn_unit_pp(const unsigned char* __restrict__ Qb, const unsigned char* __restrict__ Kh, const unsigned char* __restrict__ Vt, bf16_t* __restrict__ Ob, char* lds, int tid) {
    const int wid = __builtin_amdgcn_readfirstlane(tid >> 6), lane = tid & 63, r32 = lane & 31, hi = lane >> 5;
    const bool halfB = wid >= 4;
    char* V_lds = lds + OFF_V; char* K_lds = lds + OFF_K;
    float* ws = (float*)(lds + OFF_WS) + wid * 64; float* li_l = ws; float* al_l = ws + 32;
    float l_reg = 0; f32x16 o[4] = {}; i32x8 qr[3]; f32x16 negm;
#pragma unroll
    for (int r = 0; r < 16; ++r) negm[r] = 60.f;
    const unsigned char* Qw = Qb + (long)(wid * QBLK + r32) * DQK + hi * 32;
#pragma unroll
    for (int ks = 0; ks < 3; ++ks) qr[ks] = ld32((const char*)Qw + ks * 64);
    const int kst0 = (tid / 12) * KROW + (tid % 12) * 16, kst1 = ((tid + 512) / 12) * KROW + ((tid + 512) % 12) * 16, vst = (tid >> 2) * VROW + (tid & 3) * 16;
    const bool k2 = wid < 4;
    constexpr int NT = SEQ / KVBLK;
    u32x4 sv, sk0, sk1 = {0u, 0u, 0u, 0u};
#define LOADK(t) do { const unsigned char* kp_ = Kh + (long)((t) < NT ? (t) : NT - 1) * 12288 + tid * 16; sk0 = *reinterpret_cast<const u32x4*>(kp_); if (k2) sk1 = *reinterpret_cast<const u32x4*>(kp_ + 8192); } while (0)
#define LOADV(t) do { sv = *reinterpret_cast<const u32x4*>(Vt + (long)((t) < NT ? (t) : NT - 1) * 8192 + tid * 16); } while (0)
#define WRITEK(b) do { *(u32x4*)(K_lds + (b) * SHM_K + kst0) = sk0; if (k2) *(u32x4*)(K_lds + (b) * SHM_K + kst1) = sk1; } while (0)
#define WRITEV(b) do { *(u32x4*)(V_lds + (b) * SHM_V + vst) = sv; } while (0)
#define BAR() do { SBAR(); __syncthreads(); SBAR(); } while (0)
    f32x16 p0, p1; i32x8 pa = {};
    LOADK(0); WRITEK(0); __syncthreads();
    LOADK(1); LOADV(0);
    if (halfB) BAR();
    WRITEK(1); WRITEV(0); LOADK(2); LOADV(1);
    mfma_seg<true, false>(p0, p1, negm, o, K_lds, V_lds, qr, pa, r32, hi);
    BAR();
    softmax_seg(p0, p1, negm, l_reg, o, pa, al_l, r32, hi);
    BAR();
    for (int t = 0; t < NT - 1; ++t) {
        const int b1 = (t + 1) & 1, b0 = t & 1;
        WRITEK(b0); WRITEV(b1); LOADK(t + 3); LOADV(t + 2);
        mfma_seg<true, true>(p0, p1, negm, o, K_lds + b1 * SHM_K, V_lds + b0 * SHM_V, qr, pa, r32, hi);
        BAR();
        softmax_seg(p0, p1, negm, l_reg, o, pa, al_l, r32, hi);
        BAR();
    }
    mfma_seg<false, true>(p0, p1, negm, o, K_lds, V_lds + ((NT - 1) & 1) * SHM_V, qr, pa, r32, hi);
    if (!halfB) BAR();
    if (hi == 0) li_l[r32] = l_reg; asm volatile("s_waitcnt lgkmcnt(0)" ::: "memory");
    float rli[16];
#pragma unroll
    for (int r = 0; r < 16; ++r) rli[r] = __builtin_amdgcn_rcpf(li_l[crow(r, hi)]);
    __syncthreads();
    bf16_t* ost = (bf16_t*)(lds + wid * 8192);
#pragma unroll
    for (int r = 0; r < 16; ++r) { const int orow = crow(r, hi);
#pragma unroll
        for (int d0 = 0; d0 < 4; ++d0) ost[orow * 128 + d0 * 32 + r32] = (bf16_t)f2bf(o[d0][r] * rli[r]); }
    asm volatile("s_waitcnt lgkmcnt(0)" ::: "memory");
    bf16_t* Ow = Ob + (long)(wid * QBLK) * DM;
#pragma unroll
    for (int i = 0; i < 8; ++i) { const int ch = lane + 64 * i, row = ch >> 4, c = ch & 15;
        const u32x4 v = *(const u32x4*)((const char*)ost + row * 256 + c * 16); *(u32x4*)(Ow + (long)row * DM + c * 8) = v; }
    __syncthreads();
#undef LOADK
#undef LOADV
#undef WRITEK
#undef WRITEV
#undef BAR
}
#undef SBAR
}

struct Args { const void* in[23]; float* out; unsigned char* ws; int ph_lo, ph_hi; };
enum { I_X = 0, I_POS, I_CNW, I_CWIN, I_CK, I_CWOUT, I_MNW, I_MWDOWN, I_MQLN, I_MKVLN, I_MWQ, I_MWKV, I_MQHN, I_MKHN, I_MWO, I_FNW, I_RWG, I_RBG, I_RWE, I_RBE, I_EWG, I_EWU, I_EWD };

struct CvtItem { const float* W; bf16_t* WT; const float* ksc; int K, N, k0, n0, drow0; };
__device__ __forceinline__ unsigned char* ldptr(int i);
constexpr int CVT_PER_J = 768 + 256 + 176 + 144 + 128 + 256;
constexpr int CVT_MIX = 2 * CVT_PER_J, CVT_EXP = MK_ENABLE_MOE ? 4 * NE * 288 : 0, CVT_ITEMS = CVT_MIX + CVT_EXP;
__device__ __forceinline__ void cvt_decode(int it, CvtItem& c, unsigned char* ws) {
    if (it < CVT_MIX) {
        const int j = it / CVT_PER_J; int r = it - j * CVT_PER_J; int kb, nb;
        if (r < 768) { c.K = 1024; c.N = 3072; c.W = (const float*)ldptr(I_CWIN) + (size_t)j * 1024 * 3072; c.WT = (bf16_t*)(ws + WS_WIN) + (size_t)j * 3072 * 1024; c.ksc = (const float*)ldptr(I_CNW) + j * 1024;
            kb = r / 48; nb = r % 48; const int n0 = nb * 64;
            if (n0 < 1024) c.drow0 = n0; else if (n0 < 2048) { const int q = n0 - 1024; c.drow0 = 1024 + (q >> 7) * 256 + (q & 127); } else { const int q = n0 - 2048; c.drow0 = 1024 + (q >> 7) * 256 + 128 + (q & 127); } }
        else if ((r -= 768) < 256) { c.K = 1024; c.N = 1024; c.W = (const float*)ldptr(I_CWOUT) + (size_t)j * 1024 * 1024; c.WT = (bf16_t*)(ws + WS_WOUTC) + (size_t)j * 1024 * 1024; c.ksc = nullptr; kb = r / 16; nb = r % 16; c.drow0 = nb * 64; }
        else if ((r -= 256) < 176) { c.K = 1024; c.N = LAT; c.W = (const float*)ldptr(I_MWDOWN) + (size_t)j * 1024 * LAT; c.WT = (bf16_t*)(ws + WS_WDOWN) + (size_t)j * LATP * 1024; c.ksc = (const float*)ldptr(I_MNW) + j * 1024; kb = r / 11; nb = r % 11; c.drow0 = nb * 64; }
        else if ((r -= 176) < 144) { c.K = QLR; c.N = NH * DQK; c.W = (const float*)ldptr(I_MWQ) + (size_t)j * QLR * NH * DQK; c.WT = (bf16_t*)(ws + WS_WQ + (size_t)j * 1536 * 1024); c.ksc = (const float*)ldptr(I_MQLN) + j * QLR; kb = r / 24; nb = r % 24; c.drow0 = nb * 64; }
        else if ((r -= 144) < 128) { c.K = KVLR; c.N = NH * 256; c.W = (const float*)ldptr(I_MWKV) + (size_t)j * KVLR * NH * 256; c.WT = (bf16_t*)(ws + WS_WKV) + (size_t)j * 2048 * 256; c.ksc = (const float*)ldptr(I_MKVLN) + j * KVLR; kb = r / 32; nb = r % 32; c.drow0 = nb * 64; }
        else { r -= 128; c.K = 1024; c.N = 1024; c.W = (const float*)ldptr(I_MWO) + (size_t)j * 1024 * 1024; c.WT = (bf16_t*)(ws + WS_WO) + (size_t)j * 1024 * 1024; c.ksc = nullptr; kb = r / 16; nb = r % 16; c.drow0 = nb * 64; }
        c.k0 = kb * 64; c.n0 = nb * 64;
    } else {
        const int r = it - CVT_MIX; const int le = r / 288, q = r - le * 288, L = le >> 6; const int kind = q / 96, idx = q - kind * 96; int kb, nb;
        if (kind < 2) { c.K = 1024; c.N = DFF; c.W = (const float*)ldptr(kind == 0 ? I_EWG : I_EWU) + (size_t)le * 1024 * DFF; c.WT = (bf16_t*)(ws + WS_WE1) + (size_t)le * 768 * 1024; c.ksc = (const float*)ldptr(I_FNW) + L * 1024;
            kb = idx / 6; nb = idx % 6; const int n0 = nb * 64; c.drow0 = (n0 >> 7) * 256 + kind * 128 + (n0 & 127); }
        else { c.K = DFF; c.N = 1024; c.W = (const float*)ldptr(I_EWD) + (size_t)le * DFF * 1024; c.WT = (bf16_t*)(ws + WS_WE2) + (size_t)le * 1024 * DFF; c.ksc = nullptr; kb = idx / 16; nb = idx % 16; c.drow0 = nb * 64; }
        c.k0 = kb * 64; c.n0 = nb * 64;
    }
}
__device__ __forceinline__ void cvt_load(const CvtItem& c, f32x4 (&v)[16], int lane) {
    const float* p = c.W + (size_t)(c.k0 + (lane >> 4)) * c.N + c.n0 + 4 * (lane & 15);
#pragma unroll
    for (int i = 0; i < 16; ++i) v[i] = *(const f32x4*)(p + (size_t)(4 * i) * c.N);
}
__device__ __forceinline__ void cvt_lds_write(LAS float* tile, const f32x4 (&v)[16], int lane) {
#pragma unroll
    for (int i = 0; i < 16; ++i) { const int r = 4 * i + (lane >> 4), n = 4 * (lane & 15), x = r & 31; LAS float* row = tile + r * 64;
        row[(n + 0) ^ x] = v[i].x; row[(n + 1) ^ x] = v[i].y; row[(n + 2) ^ x] = v[i].z; row[(n + 3) ^ x] = v[i].w; }
}
__device__ __forceinline__ void cvt_out(const CvtItem& c, const LAS float* tile, int lane) {
    const int cc = lane & 7, np = lane >> 3;
    f32x4 s0 = {1.f, 1.f, 1.f, 1.f}, s1 = {1.f, 1.f, 1.f, 1.f};
    if (c.ksc) { s0 = *(const f32x4*)(c.ksc + c.k0 + 8 * cc); s1 = *(const f32x4*)(c.ksc + c.k0 + 8 * cc + 4); }
#pragma unroll
    for (int jj = 0; jj < 8; ++jj) { const int n = np + 8 * jj; float t[8];
#pragma unroll
        for (int q = 0; q < 8; ++q) { const int k = 8 * cc + q; t[q] = tile[k * 64 + (n ^ (k & 31))]; }
        u32x4 o; o.x = pk2(t[0] * s0.x, t[1] * s0.y); o.y = pk2(t[2] * s0.z, t[3] * s0.w); o.z = pk2(t[4] * s1.x, t[5] * s1.y); o.w = pk2(t[6] * s1.z, t[7] * s1.w);
        *(GAS u32x4*)(c.WT + (size_t)(c.drow0 + n) * c.K + c.k0 + 8 * cc) = o; }
}

__device__ __forceinline__ void prologue_phase(LAS unsigned char* lds, int gw, int NGW, int wave, int lane, int gtid, int NGT) {
    unsigned char* ws = ldptr(24);
    LAS float* tile = (LAS float*)(lds + wave * 16384);
    {   CvtItem cur, nxt; f32x4 v[16]; int it = gw;
        if (it < CVT_ITEMS) { cvt_decode(it, cur, ws); cvt_load(cur, v, lane); }
        while (it < CVT_ITEMS) {
            cvt_lds_write(tile, v, lane);
            const int itn = it + NGW;
            if (itn < CVT_ITEMS) { cvt_decode(itn, nxt, ws); cvt_load(nxt, v, lane); }
            LDS_WAIT(); asm volatile("" ::: "memory");
            cvt_out(cur, tile, lane);
            LDS_WAIT(); asm volatile("" ::: "memory");
            cur = nxt; it = itn;
        }
    }
#if MK_ENABLE_MOE
    const float* fnw = (const float*)ldptr(I_FNW); const float* rwg = (const float*)ldptr(I_RWG); const float* rwe = (const float*)ldptr(I_RWE);
    for (int i = gtid; i < 4 * 256 * 128; i += NGT) {
        const int L = i >> 15, n = (i >> 7) & 255, k8 = (i & 127) * 8;
        u32x4 o = {0u, 0u, 0u, 0u};
        if (n < 72) { float v[8];
#pragma unroll
            for (int q = 0; q < 8; ++q) { const int k = k8 + q; const float g = fnw[L * 1024 + k];
                v[q] = g * (n < 8 ? rwg[((size_t)L * 1024 + k) * 8 + n] : rwe[((size_t)L * 1024 + k) * 64 + (n - 8)]); }
            o.x = pk2(v[0], v[1]); o.y = pk2(v[2], v[3]); o.z = pk2(v[4], v[5]); o.w = pk2(v[6], v[7]); }
        *(u32x4*)((bf16_t*)(ws + WS_WRT) + ((size_t)L * 256 + n) * 1024 + k8) = o;
    }
#endif
    for (int i = gtid; i < 2 * 64 * 128; i += NGT) { const int j = i >> 13, n = LAT + ((i >> 7) & 63), k8 = (i & 127) * 8;
        *(u32x4*)((bf16_t*)(ws + WS_WDOWN) + ((size_t)j * LATP + n) * 1024 + k8) = (u32x4){0u, 0u, 0u, 0u}; }
}

__device__ __forceinline__ void norm_phase(const float* xin, const bf16_t* Y, float* xout, bf16_t* H, int gw, int NGW, int lane) {
    for (int m = gw; m < T; m += NGW) {
        const f32x4* xr = (const f32x4*)(xin + (size_t)m * DM) + lane;
        f32x4 v[4];
#pragma unroll
        for (int j = 0; j < 4; ++j) v[j] = xr[64 * j];
        if (Y) { const u32x2* y0 = (const u32x2*)(Y + (size_t)(2 * m) * DM) + lane; const u32x2* y1 = y0 + 256;
#pragma unroll
            for (int j = 0; j < 4; ++j) { const u32x2 p = y0[64 * j], q = y1[64 * j];
                v[j].x += bflo(p.x) + bflo(q.x); v[j].y += bfhi(p.x) + bfhi(q.x); v[j].z += bflo(p.y) + bflo(q.y); v[j].w += bfhi(p.y) + bfhi(q.y); } }
        if (xout) { f32x4* xo = (f32x4*)(xout + (size_t)m * DM) + lane;
#pragma unroll
            for (int j = 0; j < 4; ++j) xo[64 * j] = v[j]; }
        if (H) { float s = 0.f;
#pragma unroll
            for (int j = 0; j < 4; ++j) s += (v[j].x * v[j].x + v[j].y * v[j].y) + (v[j].z * v[j].z + v[j].w * v[j].w);
            const float r = 1.0f / sqrtf(wave_sum(s, lane) * (1.f / DM) + EPS);
            u32x2* ho = (u32x2*)(H + (size_t)m * DM) + lane;
#pragma unroll
            for (int j = 0; j < 4; ++j) { u32x2 w; w.x = pk2(v[j].x * r, v[j].y * r); w.y = pk2(v[j].z * r, v[j].w * r); ho[64 * j] = w; } }
    }
}

__device__ __forceinline__ void conv_phase(const bf16_t* GBp, const bf16_t* Zp, const float* ck, bf16_t* YCp, int gtid, int NGT) {
    for (int i = gtid; i < T * 128; i += NGT) {
        const int t = i >> 7, c8 = (i & 127) * 8, s = t & (SEQ - 1);
        const u32x4 zc = *(const u32x4*)(Zp + (size_t)t * DM + c8), g = *(const u32x4*)(GBp + (size_t)t * DM + c8);
        u32x4 zm = {0u, 0u, 0u, 0u}, zp = {0u, 0u, 0u, 0u};
        if (s > 0) zm = *(const u32x4*)(Zp + (size_t)(t - 1) * DM + c8);
        if (s < SEQ - 1) zp = *(const u32x4*)(Zp + (size_t)(t + 1) * DM + c8);
        const f32x4 k0a = *(const f32x4*)(ck + c8), k0b = *(const f32x4*)(ck + c8 + 4), k1a = *(const f32x4*)(ck + DM + c8), k1b = *(const f32x4*)(ck + DM + c8 + 4), k2a = *(const f32x4*)(ck + 2 * DM + c8), k2b = *(const f32x4*)(ck + 2 * DM + c8 + 4);
        float y[8];
#define CV(q, W, KA, LOHI) y[q] = LOHI(g.W) * (LOHI(zm.W) * k0##KA + LOHI(zc.W) * k1##KA + LOHI(zp.W) * k2##KA)
        CV(0, x, a[0], bflo); CV(1, x, a[1], bfhi); CV(2, y, a[2], bflo); CV(3, y, a[3], bfhi); CV(4, z, b[0], bflo); CV(5, z, b[1], bfhi); CV(6, w, b[2], bflo); CV(7, w, b[3], bfhi);
#undef CV
        u32x4 o; o.x = pk2(y[0], y[1]); o.y = pk2(y[2], y[3]); o.z = pk2(y[4], y[5]); o.w = pk2(y[6], y[7]);
        *(u32x4*)(YCp + (size_t)t * DM + c8) = o;
    }
}

__device__ __forceinline__ void qkprep_phase(const bf16_t* LATb, const bf16_t* QRAW, const bf16_t* KVRAW, const int* pos, const float* qhn, const float* khn,
                                             bf16_t* Qo, bf16_t* Ko, bf16_t* Vo, LAS unsigned char* lds, int gw, int NGW, int wave, int lane) {
    LAS unsigned char* sq = lds + wave * 10240;
    LAS float* cs = (LAS float*)(sq + 8704);
    const int h = lane >> 3, i8 = lane & 7;
    float gq[24], gk[24];
#pragma unroll
    for (int q = 0; q < 16; ++q) { gq[q] = qhn[16 * i8 + q]; gk[q] = khn[16 * i8 + q]; }
#pragma unroll
    for (int q = 0; q < 4; ++q) { gq[16 + q] = qhn[128 + 4 * i8 + q]; gq[20 + q] = qhn[160 + 4 * i8 + q]; gk[16 + q] = khn[128 + 4 * i8 + q]; gk[20 + q] = khn[160 + 4 * i8 + q]; }
    for (int t = gw; t < T; t += NGW) {
        const int b = t >> 14, s = t & (SEQ - 1);
        const u32x4* qs = (const u32x4*)(QRAW + (size_t)t * 1536); const u32x4* ks = (const u32x4*)(KVRAW + (size_t)t * 2048); const u32x4* ls = (const u32x4*)(LATb + (size_t)t * LATP);
        const u32x4 q0 = qs[lane], q1 = qs[lane + 64], q2 = qs[lane + 128], k0 = ks[lane], k1 = ks[lane + 64], k2 = ks[lane + 128], k3 = ks[lane + 192];
        const u32x4 l0 = ls[lane]; u32x4 l1 = {0u, 0u, 0u, 0u}; if (lane < 24) l1 = ls[lane + 64];
        LAS u32x4* d = (LAS u32x4*)sq;
        d[lane] = q0; d[lane + 64] = q1; d[lane + 128] = q2; d[192 + lane] = k0; d[192 + lane + 64] = k1; d[192 + lane + 128] = k2; d[192 + lane + 192] = k3;
        d[448 + lane] = l0; if (lane < 24) d[448 + lane + 64] = l1;
        float s0 = 0.f;
#define SS4(V_) (bflo(V_.x) * bflo(V_.x) + bfhi(V_.x) * bfhi(V_.x) + bflo(V_.y) * bflo(V_.y) + bfhi(V_.y) * bfhi(V_.y) + bflo(V_.z) * bflo(V_.z) + bfhi(V_.z) * bfhi(V_.z) + bflo(V_.w) * bflo(V_.w) + bfhi(V_.w) * bfhi(V_.w))
        s0 = SS4(l0); const float s1 = SS4(l1);
        const float ssq_q = wave_sum(lane < 48 ? s0 : 0.f, lane), ssq_kv = wave_sum((lane >= 48 ? s0 : 0.f) + (lane < 16 ? s1 : 0.f), lane);
        const float r_q = 1.0f / sqrtf(ssq_q * (1.f / QLR) + EPS), r_kv = 1.0f / sqrtf(ssq_kv * (1.f / KVLR) + EPS);
        if (lane < 32) { const float invf = powf(10000.f, -(float)lane * (1.f / 32.f)); const float ang = (float)pos[t] * invf;
            const double rev = (double)ang * 0.15915494309189535; const float fr = (float)(rev - floor(rev));
            cs[lane] = __builtin_amdgcn_cosf(fr); cs[32 + lane] = __builtin_amdgcn_sinf(fr); }
        LDS_WAIT(); asm volatile("" ::: "memory");
        float cj[4], sj[4];
#pragma unroll
        for (int q = 0; q < 4; ++q) { cj[q] = cs[4 * i8 + q]; sj[q] = cs[32 + 4 * i8 + q]; }
        {   const LAS bf16_t* qh = (const LAS bf16_t*)sq + h * DQK;
            const u32x4 a0 = *(const LAS u32x4*)(qh + 16 * i8), a1 = *(const LAS u32x4*)(qh + 16 * i8 + 8);
            const u32x2 r1 = *(const LAS u32x2*)(qh + 128 + 4 * i8), r2 = *(const LAS u32x2*)(qh + 160 + 4 * i8);
            float v[24];
            v[0] = bflo(a0.x); v[1] = bfhi(a0.x); v[2] = bflo(a0.y); v[3] = bfhi(a0.y); v[4] = bflo(a0.z); v[5] = bfhi(a0.z); v[6] = bflo(a0.w); v[7] = bfhi(a0.w);
            v[8] = bflo(a1.x); v[9] = bfhi(a1.x); v[10] = bflo(a1.y); v[11] = bfhi(a1.y); v[12] = bflo(a1.z); v[13] = bfhi(a1.z); v[14] = bflo(a1.w); v[15] = bfhi(a1.w);
            v[16] = bflo(r1.x); v[17] = bfhi(r1.x); v[18] = bflo(r1.y); v[19] = bfhi(r1.y); v[20] = bflo(r2.x); v[21] = bfhi(r2.x); v[22] = bflo(r2.y); v[23] = bfhi(r2.y);
            float ss = 0.f;
#pragma unroll
            for (int q = 0; q < 24; ++q) ss += v[q] * v[q];
            ss += lane_xor_f(ss, 1, lane); ss += lane_xor_f(ss, 2, lane); ss += lane_xor_f(ss, 4, lane);
            const float sc = r_q / sqrtf(r_q * r_q * ss * (1.f / DQK) + EPS);
#pragma unroll
            for (int q = 0; q < 24; ++q) v[q] *= sc * gq[q];
            bf16_t* qo = Qo + ((size_t)(b * NH + h) * SEQ + s) * DQK;
            u32x4 w0, w1; w0.x = pk2(v[0], v[1]); w0.y = pk2(v[2], v[3]); w0.z = pk2(v[4], v[5]); w0.w = pk2(v[6], v[7]); w1.x = pk2(v[8], v[9]); w1.y = pk2(v[10], v[11]); w1.z = pk2(v[12], v[13]); w1.w = pk2(v[14], v[15]);
            *(u32x4*)(qo + 16 * i8) = w0; *(u32x4*)(qo + 16 * i8 + 8) = w1;
            float o1[4], o2[4];
#pragma unroll
            for (int q = 0; q < 4; ++q) { o1[q] = v[16 + q] * cj[q] - v[20 + q] * sj[q]; o2[q] = v[20 + q] * cj[q] + v[16 + q] * sj[q]; }
            u32x2 e1, e2; e1.x = pk2(o1[0], o1[1]); e1.y = pk2(o1[2], o1[3]); e2.x = pk2(o2[0], o2[1]); e2.y = pk2(o2[2], o2[3]);
            *(u32x2*)(qo + 128 + 4 * i8) = e1; *(u32x2*)(qo + 160 + 4 * i8) = e2; }
        {   const LAS bf16_t* kh = (const LAS bf16_t*)(sq + 3072) + h * 256; const LAS bf16_t* lr = (const LAS bf16_t*)(sq + 7168) + 640;
            const u32x4 a0 = *(const LAS u32x4*)(kh + 16 * i8), a1 = *(const LAS u32x4*)(kh + 16 * i8 + 8);
            const u32x4 b0 = *(const LAS u32x4*)(kh + 128 + 16 * i8), b1 = *(const LAS u32x4*)(kh + 128 + 16 * i8 + 8);
            const u32x2 r1 = *(const LAS u32x2*)(lr + 4 * i8), r2 = *(const LAS u32x2*)(lr + 32 + 4 * i8);
            float v[24];
            v[0] = bflo(a0.x); v[1] = bfhi(a0.x); v[2] = bflo(a0.y); v[3] = bfhi(a0.y); v[4] = bflo(a0.z); v[5] = bfhi(a0.z); v[6] = bflo(a0.w); v[7] = bfhi(a0.w);
            v[8] = bflo(a1.x); v[9] = bfhi(a1.x); v[10] = bflo(a1.y); v[11] = bfhi(a1.y); v[12] = bflo(a1.z); v[13] = bfhi(a1.z); v[14] = bflo(a1.w); v[15] = bfhi(a1.w);
#pragma unroll
            for (int q = 0; q < 16; ++q) v[q] *= r_kv;
            v[16] = bflo(r1.x); v[17] = bfhi(r1.x); v[18] = bflo(r1.y); v[19] = bfhi(r1.y); v[20] = bflo(r2.x); v[21] = bfhi(r2.x); v[22] = bflo(r2.y); v[23] = bfhi(r2.y);
            float ss = 0.f;
#pragma unroll
            for (int q = 0; q < 24; ++q) ss += v[q] * v[q];
            ss += lane_xor_f(ss, 1, lane); ss += lane_xor_f(ss, 2, lane); ss += lane_xor_f(ss, 4, lane);
            const float sc = 1.0f / sqrtf(ss * (1.f / DQK) + EPS);
#pragma unroll
            for (int q = 0; q < 24; ++q) v[q] *= sc * gk[q];
            bf16_t* ko = Ko + ((size_t)(b * NH + h) * SEQ + s) * DQK;
            u32x4 w0, w1; w0.x = pk2(v[0], v[1]); w0.y = pk2(v[2], v[3]); w0.z = pk2(v[4], v[5]); w0.w = pk2(v[6], v[7]); w1.x = pk2(v[8], v[9]); w1.y = pk2(v[10], v[11]); w1.z = pk2(v[12], v[13]); w1.w = pk2(v[14], v[15]);
            *(u32x4*)(ko + 16 * i8) = w0; *(u32x4*)(ko + 16 * i8 + 8) = w1;
            float o1[4], o2[4];
#pragma unroll
            for (int q = 0; q < 4; ++q) { o1[q] = v[16 + q] * cj[q] - v[20 + q] * sj[q]; o2[q] = v[20 + q] * cj[q] + v[16 + q] * sj[q]; }
            u32x2 e1, e2; e1.x = pk2(o1[0], o1[1]); e1.y = pk2(o1[2], o1[3]); e2.x = pk2(o2[0], o2[1]); e2.y = pk2(o2[2], o2[3]);
            *(u32x2*)(ko + 128 + 4 * i8) = e1; *(u32x2*)(ko + 160 + 4 * i8) = e2;
            bf16_t* vo = Vo + ((size_t)(b * NH + h) * SEQ + s) * DV;
            u32x4 x0, x1;
            x0.x = pk2(bflo(b0.x) * r_kv, bfhi(b0.x) * r_kv); x0.y = pk2(bflo(b0.y) * r_kv, bfhi(b0.y) * r_kv); x0.z = pk2(bflo(b0.z) * r_kv, bfhi(b0.z) * r_kv); x0.w = pk2(bflo(b0.w) * r_kv, bfhi(b0.w) * r_kv);
            x1.x = pk2(bflo(b1.x) * r_kv, bfhi(b1.x) * r_kv); x1.y = pk2(bflo(b1.y) * r_kv, bfhi(b1.y) * r_kv); x1.z = pk2(bflo(b1.z) * r_kv, bfhi(b1.z) * r_kv); x1.w = pk2(bflo(b1.w) * r_kv, bfhi(b1.w) * r_kv);
            *(u32x4*)(vo + 16 * i8) = x0; *(u32x4*)(vo + 16 * i8 + 8) = x1; }
        LDS_WAIT(); asm volatile("" ::: "memory");
    }
#undef SS4
}


__device__ __forceinline__ unsigned pk4_fp8(float a, float b, float c, float d) { int w = 0; w = __builtin_amdgcn_cvt_pk_fp8_f32(a, b, w, false); w = __builtin_amdgcn_cvt_pk_fp8_f32(c, d, w, true); return (unsigned)w; }
__device__ __forceinline__ void ld16bf(const bf16_t* p, float* v) { const u32x4 a = *(const u32x4*)p, b = *(const u32x4*)(p + 8);
    v[0] = bflo(a.x); v[1] = bfhi(a.x); v[2] = bflo(a.y); v[3] = bfhi(a.y); v[4] = bflo(a.z); v[5] = bfhi(a.z); v[6] = bflo(a.w); v[7] = bfhi(a.w);
    v[8] = bflo(b.x); v[9] = bfhi(b.x); v[10] = bflo(b.y); v[11] = bfhi(b.y); v[12] = bflo(b.z); v[13] = bfhi(b.z); v[14] = bflo(b.w); v[15] = bfhi(b.w); }
__device__ __forceinline__ void ld4bf(const bf16_t* p, float* v) { const u32x2 a = *(const u32x2*)p; v[0] = bflo(a.x); v[1] = bfhi(a.x); v[2] = bflo(a.y); v[3] = bfhi(a.y); }
__device__ __forceinline__ void qkprep8_phase(const bf16_t* LATb, const bf16_t* QRAW, const bf16_t* KVRAW, const int* pos, const float* qhn, const float* khn,
                                              unsigned char* Q8, unsigned char* K8, unsigned char* VT8, LAS unsigned char* lds, int vcu, int G, int wave, int lane, int tid) {
    const int h = lane >> 3, i8 = lane & 7;
    float gq[24], gk[24], invf[4];
#pragma unroll
    for (int q = 0; q < 16; ++q) { gq[q] = qhn[16 * i8 + q]; gk[q] = khn[16 * i8 + q]; }
#pragma unroll
    for (int q = 0; q < 4; ++q) { gq[16 + q] = qhn[128 + 4 * i8 + q]; gq[20 + q] = qhn[160 + 4 * i8 + q]; gk[16 + q] = khn[128 + 4 * i8 + q]; gk[20 + q] = khn[160 + 4 * i8 + q];
        invf[q] = powf(10000.f, -(float)(4 * i8 + q) * (1.f / 32.f)); }
    for (int tile = vcu; tile < T / 64; tile += G) {
        for (int tt = 0; tt < 8; ++tt) {
            const int kk = wave * 8 + tt, t = tile * 64 + kk, b = t >> 14, s = t & (SEQ - 1);
            const u32x4* ls = (const u32x4*)(LATb + (size_t)t * LATP);
            const u32x4 l0 = ls[lane]; u32x4 l1 = {0u, 0u, 0u, 0u}; if (lane < 24) l1 = ls[lane + 64];
#define SS4(V_) (bflo(V_.x) * bflo(V_.x) + bfhi(V_.x) * bfhi(V_.x) + bflo(V_.y) * bflo(V_.y) + bfhi(V_.y) * bfhi(V_.y) + bflo(V_.z) * bflo(V_.z) + bfhi(V_.z) * bfhi(V_.z) + bflo(V_.w) * bflo(V_.w) + bfhi(V_.w) * bfhi(V_.w))
            const float s0 = SS4(l0), s1 = SS4(l1);
#undef SS4
            const float ssq_q = wave_sum(lane < 48 ? s0 : 0.f, lane), ssq_kv = wave_sum((lane >= 48 ? s0 : 0.f) + (lane < 16 ? s1 : 0.f), lane);
            const float r_q = 1.0f / sqrtf(ssq_q * (1.f / QLR) + EPS), r_kv = 1.0f / sqrtf(ssq_kv * (1.f / KVLR) + EPS);
            float cj[4], sj[4]; const float fpos = (float)pos[t];
#pragma unroll
            for (int q = 0; q < 4; ++q) { const float ang = fpos * invf[q]; const double rev = (double)ang * 0.15915494309189535; const float fr = (float)(rev - floor(rev));
                cj[q] = __builtin_amdgcn_cosf(fr); sj[q] = __builtin_amdgcn_sinf(fr); }
            const size_t orow = ((size_t)(b * NH + h) * SEQ + s) * DQK;
            {
                const bf16_t* qh = QRAW + (size_t)t * 1536 + h * DQK; float v[24];
                ld16bf(qh + 16 * i8, v); ld4bf(qh + 128 + 4 * i8, v + 16); ld4bf(qh + 160 + 4 * i8, v + 20);
                float ss = 0.f;
#pragma unroll
                for (int q = 0; q < 24; ++q) ss += v[q] * v[q];
                ss += lane_xor_f(ss, 1, lane); ss += lane_xor_f(ss, 2, lane); ss += lane_xor_f(ss, 4, lane);
                const float sc = r_q / sqrtf(r_q * r_q * ss * (1.f / DQK) + EPS) * (ATT_PP ? 8.f * 0.07216878364870322f * 1.4426950408889634f : 1.f);
#pragma unroll
                for (int q = 0; q < 24; ++q) v[q] *= sc * gq[q];
                u32x4 w; w.x = pk4_fp8(v[0], v[1], v[2], v[3]); w.y = pk4_fp8(v[4], v[5], v[6], v[7]); w.z = pk4_fp8(v[8], v[9], v[10], v[11]); w.w = pk4_fp8(v[12], v[13], v[14], v[15]);
                *(u32x4*)(Q8 + orow + 16 * i8) = w;
                float o1[4], o2[4];
#pragma unroll
                for (int q = 0; q < 4; ++q) { o1[q] = v[16 + q] * cj[q] - v[20 + q] * sj[q]; o2[q] = v[20 + q] * cj[q] + v[16 + q] * sj[q]; }
                *(unsigned*)(Q8 + orow + 128 + 4 * i8) = pk4_fp8(o1[0], o1[1], o1[2], o1[3]); *(unsigned*)(Q8 + orow + 160 + 4 * i8) = pk4_fp8(o2[0], o2[1], o2[2], o2[3]); }
            {
                const bf16_t* kh = KVRAW + (size_t)t * 2048 + h * 256; const bf16_t* lr = LATb + (size_t)t * LATP + 640; float v[24], vv[16];
                ld16bf(kh + 16 * i8, v); ld4bf(lr + 4 * i8, v + 16); ld4bf(lr + 32 + 4 * i8, v + 20); ld16bf(kh + 128 + 16 * i8, vv);
#pragma unroll
                for (int q = 0; q < 16; ++q) v[q] *= r_kv;
                float ss = 0.f;
#pragma unroll
                for (int q = 0; q < 24; ++q) ss += v[q] * v[q];
                ss += lane_xor_f(ss, 1, lane); ss += lane_xor_f(ss, 2, lane); ss += lane_xor_f(ss, 4, lane);
                const float sc = 1.0f / sqrtf(ss * (1.f / DQK) + EPS);
#pragma unroll
                for (int q = 0; q < 24; ++q) v[q] *= sc * gk[q];
                u32x4 w; w.x = pk4_fp8(v[0], v[1], v[2], v[3]); w.y = pk4_fp8(v[4], v[5], v[6], v[7]); w.z = pk4_fp8(v[8], v[9], v[10], v[11]); w.w = pk4_fp8(v[12], v[13], v[14], v[15]);
                *(u32x4*)(K8 + orow + 16 * i8) = w;
                float o1[4], o2[4];
#pragma unroll
                for (int q = 0; q < 4; ++q) { o1[q] = v[16 + q] * cj[q] - v[20 + q] * sj[q]; o2[q] = v[20 + q] * cj[q] + v[16 + q] * sj[q]; }
                *(unsigned*)(K8 + orow + 128 + 4 * i8) = pk4_fp8(o1[0], o1[1], o1[2], o1[3]); *(unsigned*)(K8 + orow + 160 + 4 * i8) = pk4_fp8(o2[0], o2[1], o2[2], o2[3]);
                const int low5 = kk & 31, hh = (low5 >> 2) & 1, rr = (low5 & 3) + 4 * (low5 >> 3), posb = hh * 32 + rr + 16 * (kk >> 5);
                LAS unsigned char* vt = lds + h * 8192 + (16 * i8) * 64 + posb;
#pragma unroll
                for (int q = 0; q < 4; ++q) { const unsigned w4 = pk4_fp8(vv[4 * q] * r_kv, vv[4 * q + 1] * r_kv, vv[4 * q + 2] * r_kv, vv[4 * q + 3] * r_kv);
                    vt[(4 * q) * 64] = (unsigned char)w4; vt[(4 * q + 1) * 64] = (unsigned char)(w4 >> 8); vt[(4 * q + 2) * 64] = (unsigned char)(w4 >> 16); vt[(4 * q + 3) * 64] = (unsigned char)(w4 >> 24); } }
        }
        __syncthreads();
        {   const int t0 = tile * 64, b = t0 >> 14, st = (t0 & (SEQ - 1)) >> 6;
#pragma unroll
            for (int i = 0; i < 8; ++i) { const int ch = tid + 512 * i, hh = ch >> 9, off = (ch & 511) * 16;
                *(u32x4*)(VT8 + ((size_t)(b * NH + hh) * (SEQ / 64) + st) * 8192 + off) = *(const LAS u32x4*)(lds + hh * 8192 + off); } }
        __syncthreads();
    }
}

__device__ __forceinline__ void route_phase(const float* LG, const float* bg, const float* be, gu32* cnt, int* eid, int* rank, float* gate, int gtid, int NGT) {
    for (int t = gtid; t < T; t += NGT) {
        const float* lg = LG + (size_t)t * 128;
        float gl[8];
        { const f32x4 a = *(const f32x4*)lg, b = *(const f32x4*)(lg + 4); gl[0] = a.x; gl[1] = a.y; gl[2] = a.z; gl[3] = a.w; gl[4] = b.x; gl[5] = b.y; gl[6] = b.z; gl[7] = b.w; }
        float gm = gl[0]; int gs = 0; float bm = gl[0] + bg[0];
#pragma unroll
        for (int q = 1; q < 8; ++q) { gm = fmaxf(gm, gl[q]); const float v = gl[q] + bg[q]; if (v > bm) { bm = v; gs = q; } }
        float gsum = 0.f, gsel = 0.f;
#pragma unroll
        for (int q = 0; q < 8; ++q) { const float e = __expf(gl[q] - gm); gsum += e; gsel = (q == gs) ? e : gsel; }
        const float g_gate = gsel / gsum;
        float el[8];
        { const f32x4 a = *(const f32x4*)(lg + 8 + gs * 8), b = *(const f32x4*)(lg + 12 + gs * 8); el[0] = a.x; el[1] = a.y; el[2] = a.z; el[3] = a.w; el[4] = b.x; el[5] = b.y; el[6] = b.z; el[7] = b.w; }
        int i0 = 0; float v0 = el[0] + be[gs * 8];
#pragma unroll
        for (int q = 1; q < 8; ++q) { const float v = el[q] + be[gs * 8 + q]; if (v > v0) { v0 = v; i0 = q; } }
        int i1 = -1; float v1 = -3.0e38f;
#pragma unroll
        for (int q = 0; q < 8; ++q) { const float v = el[q] + be[gs * 8 + q]; if (q != i0 && v > v1) { v1 = v; i1 = q; } }
        float l0 = 0.f, l1 = 0.f;
#pragma unroll
        for (int q = 0; q < 8; ++q) { l0 = (q == i0) ? el[q] : l0; l1 = (q == i1) ? el[q] : l1; }
        const float mm = fmaxf(l0, l1), p0 = __expf(l0 - mm), p1 = __expf(l1 - mm), inv = 1.f / (p0 + p1);
        const int e0 = gs * 8 + i0, e1 = gs * 8 + i1;
        const unsigned r0 = __hip_atomic_fetch_add(cnt + e0, 1u, RLX_AGENT), r1 = __hip_atomic_fetch_add(cnt + e1, 1u, RLX_AGENT);
        eid[2 * t] = e0; eid[2 * t + 1] = e1; rank[2 * t] = (int)r0; rank[2 * t + 1] = (int)r1; gate[2 * t] = g_gate * p0 * inv; gate[2 * t + 1] = g_gate * p1 * inv;
    }
}

__device__ __forceinline__ int build_tables(gu32* cnt, LAS int* tbl, LAS int* pstart, int tid) {
    if (tid < 64) {
        const int c = (int)__hip_atomic_load(cnt + tid, RLX_AGENT); const int pad = (c + 255) & ~255;
        int incl = pad;
#pragma unroll
        for (int o = 1; o < 64; o <<= 1) { const int v = __builtin_amdgcn_ds_bpermute((tid - o) << 2, incl); if (tid >= o) incl += v; }
        const int start = incl - pad; pstart[tid] = start; if (tid == 63) pstart[64] = incl;
        for (int q = start >> 8; q < (incl >> 8); ++q) tbl[q] = tid;
    }
    __syncthreads();
    return pstart[64] >> 8;
}

__device__ __forceinline__ void scatter_phase(const bf16_t* H, const int* eid, const int* rank, const float* gate, gu32* cnt, bf16_t* XS, int* sdest, float* sgate,
                                              const LAS int* pstart, int gw, int NGW, int lane, int gtid, int NGT) {
    for (int a = gw; a < NASSIGN; a += NGW) {
        const int e = eid[a], slot = pstart[e] + rank[a], t = a >> 1;
        const u32x4* src = (const u32x4*)(H + (size_t)t * DM); u32x4* dst = (u32x4*)(XS + (size_t)slot * DM);
        dst[lane] = src[lane]; dst[lane + 64] = src[lane + 64];
        if (lane == 0) { sdest[slot] = a; sgate[slot] = gate[a]; }
    }
    for (int i = gtid; i < NE * 256; i += NGT) { const int e = i >> 8, q = i & 255; const int c = (int)__hip_atomic_load(cnt + e, RLX_AGENT); const int pad = (c + 255) & ~255;
        if (c + q < pad) { sdest[pstart[e] + c + q] = -1; sgate[pstart[e] + c + q] = 0.f; } }
}

constexpr int PTAB_OFF = MISC_OFF + 128;
__device__ __forceinline__ unsigned char* ldptr(int i) {
    extern __shared__ __attribute__((aligned(16))) unsigned char lds_raw[];
    volatile LAS unsigned* pt = (volatile LAS unsigned*)((LAS unsigned char*)lds_raw + PTAB_OFF) + 2 * sgpr_now(i);
    const unsigned lo = __builtin_amdgcn_readfirstlane(pt[0]), hi = __builtin_amdgcn_readfirstlane(pt[1]);
    return (unsigned char*)(GAS unsigned char*)(((unsigned long long)hi << 32) | lo);
}
#define P_IN(i) ((const float*)ldptr(i))
#define P_OUT() ((float*)ldptr(23))
#define P_WS() (ldptr(24))
__device__ __forceinline__ void grid_barrier(int tid) {
    extern __shared__ __attribute__((aligned(16))) unsigned char lds_raw[];
    XcdBarrier b; b.bar = (unsigned*)(P_WS() + WS_CTL) + CW_BAR; b.x = xb_xcc_id(); b.st = (volatile LAS unsigned*)((LAS unsigned char*)lds_raw + MISC_OFF) + 8;
    xcd_barrier(b, tid == 0);
}

__global__ void __launch_bounds__(NWAVES * 64, 2) fwd(Args args) {
    extern __shared__ __attribute__((aligned(16))) unsigned char lds_raw[];
    LAS unsigned char* lds = (LAS unsigned char*)lds_raw;
    for (int u = threadIdx.x; u < (LDS_BYTES - LDSCTL_OFF) / 4; u += NWAVES * 64) ((LAS unsigned*)(lds + LDSCTL_OFF))[u] = 0u;
    __syncthreads();
    if (threadIdx.x == 0) { LAS unsigned long long* pt = (LAS unsigned long long*)(lds + PTAB_OFF);
#pragma unroll
        for (int i = 0; i < 23; ++i) pt[i] = (unsigned long long)args.in[i];
        pt[23] = (unsigned long long)args.out; pt[24] = (unsigned long long)args.ws; }
    __syncthreads();
    const int lo = args.ph_lo, hi = args.ph_hi;
    if (hi - lo > 1) (void)xcd_barrier_post((unsigned*)(P_WS() + WS_CTL) + CW_BAR, (volatile LAS unsigned*)(lds + MISC_OFF) + 8, threadIdx.x == 0);
    const int wave_s = __builtin_amdgcn_readfirstlane((int)threadIdx.x >> 6);
#define IN(k) (lo <= (k) && (k) < hi)
#define SEAM(k) do { if (hi > (k) + 1) grid_barrier(TID); } while (0)
#define TID (tid_now(wave_s))
#define LANE (tid_now(wave_s) & 63)
#define WAVE (sgpr_now(wave_s))
#define GRID (sgpr_now((int)gridDim.x))
#define BX (sgpr_now((int)blockIdx.x))
#define VCU ((GRID % 8 == 0) ? (BX % 8) * (GRID / 8) + BX / 8 : BX)
#define GW (VCU * NWAVES + WAVE)
#define NGW (GRID * NWAVES)
#define GTID (BX * (NWAVES * 64) + TID)
#define NGT (GRID * NWAVES * 64)
#define TBL ((LAS int*)(lds + TBL_OFF))
#define PSTART (TBL + 384)

    if (IN(0)) { for (int rep = 0; rep < REP_PRO; ++rep) prologue_phase(lds, GW, NGW, WAVE, LANE, GTID, NGT); SEAM(0); }

    for (int L = 0; L < 4; ++L) {
        const int pb = 1 + 12 * L;
        if ((L & 1) == 0) {
            if (IN(pb + 0)) { unsigned char* ws = P_WS(); const float* xsrc = (L == 0) ? P_IN(I_X) : P_OUT();
                norm_phase(xsrc, (L > 0 && MK_ENABLE_MOE) ? (const bf16_t*)(ws + WS_Y) : nullptr, (L == 0) ? nullptr : P_OUT(), (bf16_t*)(ws + WS_H), GW, NGW, LANE); SEAM(pb + 0); }
            if (IN(pb + 1)) { unsigned char* ws = P_WS(); const int j = L >> 1;
                pg8::Gemm g{DM, DM}; pg8::StaticOrder S; S.init(ws + WS_H, DM, (bf16_t*)(ws + WS_WIN) + (size_t)j * 3072 * 1024, DM, T, 3072, GRID, BX);
                pg8::EpiConvIn E{(bf16_t*)(ws + WS_GB), (bf16_t*)(ws + WS_Z)}; pg8::gemm_phase(lds, g, S, E, TID); SEAM(pb + 1); }
            if (IN(pb + 2)) { unsigned char* ws = P_WS(); const int j = L >> 1;
                conv_phase((const bf16_t*)(ws + WS_GB), (const bf16_t*)(ws + WS_Z), P_IN(I_CK) + j * 3 * DM, (bf16_t*)(ws + WS_YC), GTID, NGT); SEAM(pb + 2); }
            if (IN(pb + 3)) { unsigned char* ws = P_WS(); const int j = L >> 1; const float* xsrc = (L == 0) ? P_IN(I_X) : P_OUT();
                pg8::Gemm g{DM, DM}; pg8::StaticOrder S; S.init(ws + WS_YC, DM, (bf16_t*)(ws + WS_WOUTC) + (size_t)j * 1024 * 1024, DM, T, DM, GRID, BX);
                pg8::EpiResid E{xsrc, P_OUT()}; pg8::gemm_phase(lds, g, S, E, TID); SEAM(pb + 5); }
        } else {
#if MK_ENABLE_MLA
            if (IN(pb + 0)) { unsigned char* ws = P_WS();
                norm_phase(P_OUT(), MK_ENABLE_MOE ? (const bf16_t*)(ws + WS_Y) : nullptr, P_OUT(), (bf16_t*)(ws + WS_H), GW, NGW, LANE); SEAM(pb + 0); }
            if (IN(pb + 1)) { unsigned char* ws = P_WS(); const int j = L >> 1;
                pg8::Gemm g{DM, DM}; pg8::StaticOrder S; S.init(ws + WS_H, DM, (bf16_t*)(ws + WS_WDOWN) + (size_t)j * LATP * 1024, DM, T, LATP, GRID, BX);
                pg8::EpiBf16 E{(bf16_t*)(ws + WS_LAT), LATP}; pg8::gemm_phase(lds, g, S, E, TID); SEAM(pb + 1); }
            if (IN(pb + 2)) {
                { unsigned char* ws = P_WS(); const int j = L >> 1;
                  pg8::Gemm g{LATP, QLR}; pg8::StaticOrder S; S.init(ws + WS_LAT, LATP, ws + WS_WQ + (size_t)j * 1536 * 1024, QLR, T, 1536, GRID, BX);
                  pg8::EpiBf16 E{(bf16_t*)(ws + WS_QRAW), 1536}; pg8::gemm_phase(lds, g, S, E, TID); }
                { unsigned char* ws = P_WS(); const int j = L >> 1;
                  pg8::Gemm g{LATP, KVLR}; pg8::StaticOrder S; S.init((bf16_t*)(ws + WS_LAT) + QLR, LATP, (bf16_t*)(ws + WS_WKV) + (size_t)j * 2048 * 256, KVLR, T, 2048, GRID, BX);
                  pg8::EpiBf16 E{(bf16_t*)(ws + WS_KVRAW), 2048}; pg8::gemm_phase(lds, g, S, E, TID); }
                SEAM(pb + 2); }
#if ATT_FP8
            if (IN(pb + 3)) { unsigned char* ws = P_WS(); const int j = L >> 1;
                qkprep8_phase((const bf16_t*)(ws + WS_LAT), (const bf16_t*)(ws + WS_QRAW), (const bf16_t*)(ws + WS_KVRAW), (const int*)P_IN(I_POS),
                              P_IN(I_MQHN) + j * DQK, P_IN(I_MKHN) + j * DQK, ws + WS_Q, ws + WS_K, ws + WS_V, lds, VCU, GRID, WAVE, LANE, TID); SEAM(pb + 3); }
#else
            if (IN(pb + 3)) { unsigned char* ws = P_WS(); const int j = L >> 1;
                qkprep_phase((const bf16_t*)(ws + WS_LAT), (const bf16_t*)(ws + WS_QRAW), (const bf16_t*)(ws + WS_KVRAW), (const int*)P_IN(I_POS),
                             P_IN(I_MQHN) + j * DQK, P_IN(I_MKHN) + j * DQK, (bf16_t*)(ws + WS_Q), (bf16_t*)(ws + WS_K), (bf16_t*)(ws + WS_V), lds, GW, NGW, WAVE, LANE); SEAM(pb + 3); }
#endif
            if (IN(pb + 4)) {
              for (int rep = 0; rep < REP_ATT; ++rep)
                for (int i = 0;; ++i) {
                    int bh, qb;
                    if (GRID == 256) { if (i >= 4) break; const int idx = i * 32 + (VCU & 31); bh = 2 * (VCU >> 5) + (idx >> 6); qb = idx & 63; }
                    else { const int k = i * GRID + BX; if (k >= NB * NH * 64) break; bh = k >> 6; qb = k & 63; }
                    const int b = bh >> 3, h = bh & 7; unsigned char* ws = P_WS();
#if ATT_FP8
#if ATT_PP
                    att8::attn_unit_pp(ws + WS_Q
#else
                    att8::attn_unit(ws + WS_Q
#endif
                                    + ((size_t)bh * SEQ + qb * 256) * DQK, ws + WS_K + (size_t)bh * SEQ * DQK, ws + WS_V + (size_t)bh * SEQ * DV,
                                    (bf16_t*)(ws + WS_O) + ((size_t)(b * SEQ + qb * 256)) * DM + h * DV, (char*)lds_raw, TID);
#else
                    att::attn_unit((const bf16_t*)(ws + WS_Q) + ((size_t)bh * SEQ + qb * 256) * DQK, (const bf16_t*)(ws + WS_K) + (size_t)bh * SEQ * DQK, (const bf16_t*)(ws + WS_V) + (size_t)bh * SEQ * DV,
                                   (bf16_t*)(ws + WS_O) + ((size_t)(b * SEQ + qb * 256)) * DM + h * DV, (char*)lds_raw, TID);
#endif
                }
                SEAM(pb + 4); }
            if (IN(pb + 5)) { unsigned char* ws = P_WS(); const int j = L >> 1;
                pg8::Gemm g{DM, DM}; pg8::StaticOrder S; S.init(ws + WS_O, DM, (bf16_t*)(ws + WS_WO) + (size_t)j * 1024 * 1024, DM, T, DM, GRID, BX);
                pg8::EpiResid E{P_OUT(), P_OUT()}; pg8::gemm_phase(lds, g, S, E, TID); SEAM(pb + 5); }
#else
            if (IN(pb + 0)) { unsigned char* ws = P_WS(); norm_phase(P_OUT(), MK_ENABLE_MOE ? (const bf16_t*)(ws + WS_Y) : nullptr, P_OUT(), nullptr, GW, NGW, LANE); SEAM(pb + 5); }
#endif
        }
#if MK_ENABLE_MOE
#define CNT ((gu32*)(ws + WS_CTL) + CW_CNT + L * 64)
#define EID ((int*)(ws + WS_RT + RT_EID))
#define RANK ((int*)(ws + WS_RT + RT_RANK))
#define GATE ((float*)(ws + WS_RT + RT_GATE))
#define SDEST ((int*)(ws + WS_RT + RT_SDEST))
#define SGATE ((float*)(ws + WS_RT + RT_SGATE))
        if (IN(pb + 6)) { unsigned char* ws = P_WS(); norm_phase(P_OUT(), nullptr, nullptr, (bf16_t*)(ws + WS_H), GW, NGW, LANE); SEAM(pb + 6); }
        if (IN(pb + 7)) { unsigned char* ws = P_WS();
            pg8::Gemm g{DM, DM}; pg8::StaticOrder S; S.init(ws + WS_H, DM, (bf16_t*)(ws + WS_WRT) + (size_t)L * 256 * 1024, DM, T, 256, GRID, BX);
            pg8::EpiLogits E{(float*)(ws + WS_LG)}; pg8::gemm_phase(lds, g, S, E, TID); SEAM(pb + 7); }
        if (IN(pb + 8)) { unsigned char* ws = P_WS();
            route_phase((const float*)(ws + WS_LG), P_IN(I_RBG) + L * 8, P_IN(I_RBE) + L * 64, CNT, EID, RANK, GATE, GTID, NGT); SEAM(pb + 8); }
        if (IN(pb + 9)) { unsigned char* ws = P_WS(); build_tables(CNT, TBL, PSTART, TID);
            scatter_phase((const bf16_t*)(ws + WS_H), EID, RANK, GATE, CNT, (bf16_t*)(ws + WS_XS), SDEST, SGATE, PSTART, GW, NGW, LANE, GTID, NGT); SEAM(pb + 9); }
        if (IN(pb + 10)) { unsigned char* ws = P_WS(); const int ntiles = build_tables(CNT, TBL, PSTART, TID);
            pg8::Gemm g{DM, DM}; pg8::GroupedOrder S{ntiles * 3, 3, GRID, VCU, (const char*)(ws + WS_XS), (const char*)(ws + WS_WE1) + (size_t)L * NE * 768 * 1024 * 2, (size_t)256 * DM * 2, (size_t)768 * 1024 * 2, (size_t)256 * 1024 * 2, TBL};
            pg8::EpiSwiGLU E{(bf16_t*)(ws + WS_HID)}; pg8::gemm_phase(lds, g, S, E, TID); SEAM(pb + 10); }
        if (IN(pb + 11)) { unsigned char* ws = P_WS(); const int ntiles = build_tables(CNT, TBL, PSTART, TID);
            pg8::Gemm g{DFF, DFF}; pg8::GroupedOrder S{ntiles * 4, 4, GRID, VCU, (const char*)(ws + WS_HID), (const char*)(ws + WS_WE2) + (size_t)L * NE * 1024 * DFF * 2, (size_t)256 * DFF * 2, (size_t)1024 * DFF * 2, (size_t)256 * DFF * 2, TBL};
            pg8::EpiScatterY E{(bf16_t*)(ws + WS_Y), SDEST, SGATE}; pg8::gemm_phase(lds, g, S, E, TID); SEAM(pb + 11); }
#endif
    }
    if (IN(49)) {
#if MK_ENABLE_MOE
        unsigned char* ws = P_WS(); norm_phase(P_OUT(), (const bf16_t*)(ws + WS_Y), P_OUT(), nullptr, GW, NGW, LANE);
#endif
    }
#undef IN
#undef SEAM
}

extern "C" void kernel_launch(void* const* d_in, const int* in_sizes, int n_in, void* d_out, int out_size, void* d_ws, size_t ws_size, hipStream_t stream) {
    static int grid = 0;
    if (grid == 0) {
        if (n_in != 23 || out_size != T * DM || ws_size < WS_END) { fprintf(stderr, "kernel_launch: unexpected shapes: n_in %d out %d ws %zu (need %zu)\n", n_in, out_size, ws_size, (size_t)WS_END); grid = -1; return; }
        int dev = 0, cus = 0, per_cu = 0;
        if (hipGetDevice(&dev) != hipSuccess || hipDeviceGetAttribute(&cus, hipDeviceAttributeMultiprocessorCount, dev) != hipSuccess) { grid = -1; return; }
        if (hipFuncSetAttribute((const void*)fwd, hipFuncAttributeMaxDynamicSharedMemorySize, LDS_BYTES) != hipSuccess) { fprintf(stderr, "kernel_launch: hipFuncSetAttribute failed\n"); grid = -1; return; }
        if (hipOccupancyMaxActiveBlocksPerMultiprocessor(&per_cu, (const void*)fwd, NWAVES * 64, LDS_BYTES) != hipSuccess || per_cu < 1) fprintf(stderr, "kernel_launch: occupancy query says %d\n", per_cu);
        (void)hipGetLastError();
        grid = cus;
    }
    if (grid < 0) return;
    if (hipMemsetAsync((char*)d_ws + WS_CTL, 0, CTL_ZERO_BYTES, stream) != hipSuccess) return;
    Args a{};
    for (int i = 0; i < 23; ++i) a.in[i] = d_in[i];
    a.out = (float*)d_out; a.ws = (unsigned char*)d_ws;
#if MK_ONE_LAUNCH
    a.ph_lo = 0; a.ph_hi = 50;
    hipLaunchKernelGGL(fwd, dim3(grid), dim3(NWAVES * 64), LDS_BYTES, stream, a);
#else
    for (int p = 0; p < 50; ++p) {
        if (p >= 1 && p < 49) { const int L = (p - 1) / 12, k = (p - 1) % 12;
            if (k < 6) { if ((L & 1) == 0) { if (k > 3) continue; } else { if (!MK_ENABLE_MLA && k > 0) continue; } }
            else if (!MK_ENABLE_MOE) continue; }
        if (p == 49 && !MK_ENABLE_MOE) continue;
        a.ph_lo = p; a.ph_hi = p + 1;
        hipLaunchKernelGGL(fwd, dim3(grid), dim3(NWAVES * 64), LDS_BYTES, stream, a);
    }
#endif
    const hipError_t le = hipPeekAtLastError();
    if (le != hipSuccess) fprintf(stderr, "kernel_launch: launch failed: %s\n", hipGetErrorName(le));
}
```

```cpp
#include <hip/hip_runtime.h>
#include <cstdio>
#include <cstdint>

#ifndef MK_ONE_LAUNCH
#define MK_ONE_LAUNCH 1
#endif
#ifndef REP_ATT
#define REP_ATT 1
#endif
#ifndef REP_GEMM
#define REP_GEMM 1
#endif
#ifndef REP_THIN
#define REP_THIN 1
#endif
#ifndef REP_PRO
#define REP_PRO 1
#endif
#ifndef ATT_FP8
#define ATT_FP8 1
#endif
#ifndef ATT_PP
#define ATT_PP 1
#endif
#ifndef MK_ENABLE_MLA
#define MK_ENABLE_MLA 1
#endif
#ifndef MK_ENABLE_MOE
#define MK_ENABLE_MOE 1
#endif

#define GAS __attribute__((address_space(1)))
#define LAS __attribute__((address_space(3)))
typedef unsigned short bf16_t;
typedef short bf16x8 __attribute__((ext_vector_type(8)));
typedef short s16x4 __attribute__((ext_vector_type(4)));
typedef float f32x2 __attribute__((ext_vector_type(2)));
typedef float f32x4 __attribute__((ext_vector_type(4)));
typedef float f32x16 __attribute__((ext_vector_type(16)));
typedef unsigned u32x2 __attribute__((ext_vector_type(2)));
typedef unsigned u32x4 __attribute__((ext_vector_type(4)));
typedef GAS unsigned gu32;

constexpr int DM = 1024, NB = 2, SEQ = 16384, T = NB * SEQ;
constexpr int NH = 8, QLR = 384, KVLR = 256, DNOPE = 128, DROPE = 64, DQK = 192, DV = 128, LAT = 704, LATP = 768;
constexpr int NE = 64, DFF = 384;
constexpr int NASSIGN = 2 * T;
constexpr int NSLOT = NASSIGN + NE * 256;
constexpr int MAXTILES = NSLOT / 256;
constexpr float EPS = 1e-6f;
constexpr int NWAVES = 8;

constexpr size_t MiB = 1u << 20;
constexpr size_t WS_CTL = 0, CTL_ZERO_BYTES = 1 * MiB;
constexpr size_t WS_WIN = 2 * MiB;
constexpr size_t WS_WOUTC = 14 * MiB;
constexpr size_t WS_WDOWN = 18 * MiB;
constexpr size_t WS_WQ = 21 * MiB;
constexpr size_t WS_WKV = 24 * MiB;
constexpr size_t WS_WO = 26 * MiB;
constexpr size_t WS_WRT = 30 * MiB;
constexpr size_t WS_WE1 = 32 * MiB;
constexpr size_t WS_WE2 = 416 * MiB;
constexpr size_t WS_XB = 608 * MiB;
constexpr size_t WS_RINV = 1202 * MiB;
constexpr size_t WS_PSQ = 1200 * MiB;
constexpr size_t WS_S = 672 * MiB;
constexpr size_t WS_GB = WS_S, WS_Z = WS_S + 64 * MiB, WS_YC = WS_S + 128 * MiB;
constexpr size_t WS_LAT = WS_S, WS_QRAW = WS_S + 48 * MiB, WS_KVRAW = WS_S + 144 * MiB;
constexpr size_t WS_Q = WS_S + 272 * MiB, WS_K = WS_S + 368 * MiB, WS_V = WS_S + 464 * MiB, WS_O = WS_QRAW;
constexpr size_t WS_XS = WS_S, WS_HID = WS_S + 160 * MiB, WS_Y = WS_S + 224 * MiB, WS_LG = WS_S + 352 * MiB;
constexpr size_t WS_RT = WS_S + 368 * MiB;
constexpr size_t WS_END = WS_S + 531 * MiB;
constexpr size_t RT_EID = 0, RT_RANK = 256 * 1024, RT_GATE = 512 * 1024, RT_SDEST = 768 * 1024, RT_SGATE = 768 * 1024 + 327680, RT_STOK = 768 * 1024 + 2 * 327680, RT_SSCALE = 768 * 1024 + 3 * 327680;
static_assert(RT_SSCALE + 327680 <= 4 * MiB, "routing arrays");
constexpr int CW_TMO = 0, CW_CODE = 1, CW_BAR = 4096, CW_CNT = 8192  , CW_CHK = 12288;

constexpr int RING_BYTES = 131072;
constexpr int LDSCTL_OFF = RING_BYTES, MISC_OFF = LDSCTL_OFF + 320;
constexpr int TBL_OFF = LDSCTL_OFF + 1024;
constexpr int LDS_BYTES = 147456;

#define RLX_AGENT __ATOMIC_RELAXED, __HIP_MEMORY_SCOPE_AGENT
#define LDS_WAIT() asm volatile("s_waitcnt lgkmcnt(0)" ::: "memory")
#define VM_WAIT() asm volatile("s_waitcnt vmcnt(0)" ::: "memory")
__device__ __forceinline__ unsigned f2bf(float f) { unsigned u = __builtin_bit_cast(unsigned, f); return (u + 0x7fffu + ((u >> 16) & 1u)) >> 16; }
__device__ __forceinline__ unsigned pk2(float lo, float hi) { return f2bf(lo) | (f2bf(hi) << 16); }
__device__ __forceinline__ float bflo(unsigned w) { return __builtin_bit_cast(float, w << 16); }
__device__ __forceinline__ float bfhi(unsigned w) { return __builtin_bit_cast(float, w & 0xffff0000u); }
__device__ __forceinline__ float bf2f(bf16_t h) { return __builtin_bit_cast(float, (unsigned)h << 16); }
__device__ __forceinline__ unsigned cvt_pk_bf16(float lo, float hi) { unsigned r; asm volatile("v_cvt_pk_bf16_f32 %0, %1, %2" : "=v"(r) : "v"(lo), "v"(hi)); return r; }
__device__ __forceinline__ int tid_now(int wave_s) { int l; asm volatile("v_mbcnt_lo_u32_b32 %0, -1, 0\n\tv_mbcnt_hi_u32_b32 %0, -1, %0" : "=v"(l)); return wave_s * 64 + l; }
__device__ __forceinline__ int sgpr_now(int v) { asm volatile("" : "+s"(v)); return v; }
__device__ __forceinline__ float lane_xor_f(float v, int m, int lane) { return __builtin_bit_cast(float, __builtin_amdgcn_ds_bpermute((lane ^ m) << 2, __builtin_bit_cast(int, v))); }
__device__ __forceinline__ float wave_sum(float v, int lane) {
#pragma unroll
    for (int o = 1; o < 64; o <<= 1) v += lane_xor_f(v, o, lane);
    return v;
}

#define XB_TMO      128
#define XB_XCNT(j)  (256  + 64 * (j))
#define XB_XSUB(j)  (1280 + 64 * (j))
#define XB_XGEN(j)  (2304 + 64 * (j))
#define XB_TOP      3328
#define XB_TOPGEN   3392
#define XCD_BAR_WORDS 3456
#define XB_SPIN_CAP (1u << 18)
__device__ __forceinline__ unsigned xb_ld(unsigned* p)              { return __hip_atomic_load(p, __ATOMIC_RELAXED, __HIP_MEMORY_SCOPE_AGENT); }
__device__ __forceinline__ unsigned xb_add(unsigned* p, unsigned v) { return __hip_atomic_fetch_add(p, v, __ATOMIC_RELAXED, __HIP_MEMORY_SCOPE_AGENT); }
__device__ __forceinline__ unsigned xb_xcc_id() { return (unsigned)__builtin_amdgcn_s_getreg((3 << 11) | 20) & 0xFu; }
#define XB_SPIN(cond, bar) do { unsigned _sp = 0; while (cond) { __builtin_amdgcn_s_sleep(1); \
    if ((++_sp & 255u) == 0u) { if (xb_ld(&(bar)[XB_TMO])) break; if (_sp > XB_SPIN_CAP) { atomicAdd(&(bar)[XB_TMO], 1u); break; } } } } while (0)
struct XcdBarrier { unsigned* bar; unsigned x; volatile LAS unsigned* st; };
__device__ __forceinline__ XcdBarrier xcd_barrier_post(unsigned* bar, volatile LAS unsigned* st, bool leader) {
    XcdBarrier b; b.bar = bar; b.x = xb_xcc_id(); b.st = st;
    if (leader) (void)xb_add(&bar[XB_XCNT(b.x)], 1u);
    return b;
}
__device__ __forceinline__ void xcd_barrier_complete(unsigned* bar, unsigned x, unsigned& nloc, unsigned& nx) {
    const unsigned G = gridDim.x * gridDim.y * gridDim.z;
    unsigned sum, cnt, mine, sp = 0u;
    for (;;) {
        sum = 0u; cnt = 0u; mine = 0u;
#pragma unroll
        for (unsigned j = 0; j < 16; ++j) { const unsigned c = xb_ld(&bar[XB_XCNT(j)]); sum += c; cnt += (c > 0u) ? 1u : 0u; mine = (j == x) ? c : mine; }
        if (sum == G) break;
        __builtin_amdgcn_s_sleep(1);
        if ((++sp & 255u) == 0u) { if (xb_ld(&bar[XB_TMO])) break; if (sp > XB_SPIN_CAP) { atomicAdd(&bar[XB_TMO], 1u); break; } }
    }
    nloc = mine > 0u ? mine : 1u; nx = cnt > 0u ? cnt : 1u;
}
__device__ __forceinline__ void xcd_barrier(const XcdBarrier& b, bool leader) {
    asm volatile("s_waitcnt vmcnt(0)" ::: "memory");
    __syncthreads();
    if (leader) {
        unsigned* bar = b.bar;
        __builtin_amdgcn_s_waitcnt(0);
        unsigned nloc = b.st[0], nx = b.st[1];
        if (nloc == 0u) { xcd_barrier_complete(bar, b.x, nloc, nx); b.st[0] = nloc; b.st[1] = nx; }
        const unsigned old = xb_add(&bar[XB_XSUB(b.x)], 1u);
        const unsigned gen = old / nloc;
        if (old + 1u == (gen + 1u) * nloc) {
            __builtin_amdgcn_fence(__ATOMIC_RELEASE, "agent");
            asm volatile("s_waitcnt vmcnt(0)" ::: "memory");
            const unsigned og = xb_add(&bar[XB_TOP], 1u);
            const unsigned tg = og / nx;
            if (og + 1u == (tg + 1u) * nx) xb_add(&bar[XB_TOPGEN], 1u);
            else XB_SPIN(xb_ld(&bar[XB_TOPGEN]) == tg, bar);
            __builtin_amdgcn_fence(__ATOMIC_ACQUIRE, "agent");
            xb_add(&bar[XB_XGEN(b.x)], 1u);
            asm volatile("s_waitcnt vmcnt(0)" ::: "memory");
        } else {
            XB_SPIN(xb_ld(&bar[XB_XGEN(b.x)]) == gen, bar);
            __builtin_amdgcn_fence(__ATOMIC_ACQUIRE, "agent");
            asm volatile("s_waitcnt vmcnt(0)" ::: "memory");
        }
    }
    __syncthreads();
}

namespace pg8 {
constexpr int BM = 256, BK = 64, HALF = 128, HTB = HALF * BK * 2, NXCD = 8, WGM = 8;
__host__ __device__ __forceinline__ int lds_byte(int r, int c) { const int st = (r >> 4) * 2 + (c >> 5), rr = r & 15, cc = c & 31, ob = rr * 64 + cc * 2; return st * 1024 + (ob ^ (((ob >> 9) & 1) << 5)); }
__host__ __device__ __forceinline__ void stage_rc(int b, int& R, int& C) { const int st = b / 1024, sb = b % 1024, swz = sb ^ (((sb >> 9) & 1) << 5); R = (st >> 1) * 16 + swz / 64; C = (st & 1) * 32 + (swz % 64) / 2; }
__host__ __device__ __forceinline__ int perm32(int rho) { const int n = rho >> 4, i = rho & 15; return 8 * (i >> 2) + 4 * n + (i & 3); }

struct Unit { const char* A; const char* B; int pm, pn; };
struct Gemm { int lda, K; const int* rowidx; };

struct StaticOrder {
    int nM, nN, nwg, G, c; const char* A; const char* B; size_t astep, bstep;
    __device__ void init(const void* A_, int lda, const void* B_, int K, int M, int N, int G_, int c_) { nM = M / BM; nN = N / BM; nwg = nM * nN; G = G_; c = c_; A = (const char*)A_; B = (const char*)B_; astep = (size_t)BM * lda * 2; bstep = (size_t)BM * K * 2; }
    __device__ __forceinline__ bool next(int i, Unit& u) const {
        const long L = (long)i * G + c; if (L >= nwg) return false;
        int wgid = (int)L; { const int q = nwg / NXCD, r = nwg % NXCD, xcd = wgid % NXCD, off = wgid / NXCD; wgid = (xcd < r ? xcd * (q + 1) : r * (q + 1) + (xcd - r) * q) + off; }
        const int nig = WGM * nN, gid = wgid / nig, fm = gid * WGM, gsz = (nM - fm) < WGM ? (nM - fm) : WGM;
        u.pm = fm + ((wgid % nig) % gsz); u.pn = (wgid % nig) / gsz; u.A = A + (size_t)u.pm * astep; u.B = B + (size_t)u.pn * bstep; return true;
    }
};
struct GroupedOrder {
    int n_units, nN, G, c; const char* A; const char* B; size_t astep, bexp, bstep; const LAS int* tbl;
    __device__ __forceinline__ bool next(int i, Unit& u) const {
        const int L = i * G + c; if (L >= n_units) return false;
        const int tile = L / nN, pn = L - tile * nN; const int e = __builtin_amdgcn_readfirstlane(tbl[tile]);
        u.pm = tile; u.pn = pn; u.A = A + (size_t)tile * astep; u.B = B + (size_t)e * bexp + (size_t)pn * bstep; return true;
    }
};

typedef f32x4 Acc[2][2][4][2];

struct EpiBf16 {
    static constexpr bool PERM = true;
    bf16_t* O; int ldc; const float* rs;
    __device__ __forceinline__ void operator()(const Acc& acc, const Unit& u, int wr, int wc, int fr, int fq) const {
        const int row0 = u.pm * BM + wr * 64 + fr, col0 = u.pn * BM + wc * 32 + 8 * fq;
#pragma unroll
        for (int ai = 0; ai < 2; ++ai)
#pragma unroll
            for (int m = 0; m < 4; ++m) { const int row = row0 + ai * HALF + m * 16; bf16_t* rowp = O + (size_t)row * ldc + col0; const float r = rs ? rs[row] : 1.f;
#pragma unroll
                for (int bj = 0; bj < 2; ++bj) { const f32x4 v0 = acc[ai][bj][m][0] * r, v1 = acc[ai][bj][m][1] * r;
                    u32x4 w; w.x = cvt_pk_bf16(v0[0], v0[1]); w.y = cvt_pk_bf16(v0[2], v0[3]); w.z = cvt_pk_bf16(v1[0], v1[1]); w.w = cvt_pk_bf16(v1[2], v1[3]);
                    *(u32x4*)(rowp + bj * HALF) = w; } }
    }
};
struct EpiConvIn {
    static constexpr bool PERM = true;
    bf16_t* GBp; bf16_t* Zp; const float* rs;
    __device__ __forceinline__ void operator()(const Acc& acc, const Unit& u, int wr, int wc, int fr, int fq) const {
        const int row0 = u.pm * BM + wr * 64 + fr;
        if (u.pn < 4) {
            const int col0 = u.pn * BM + wc * 32 + 8 * fq;
#pragma unroll
            for (int ai = 0; ai < 2; ++ai)
#pragma unroll
                for (int m = 0; m < 4; ++m) { const int row = row0 + ai * HALF + m * 16; bf16_t* rowp = GBp + (size_t)row * DM + col0; const float r = rs[row];
#pragma unroll
                    for (int bj = 0; bj < 2; ++bj) { const f32x4 v0 = acc[ai][bj][m][0] * r, v1 = acc[ai][bj][m][1] * r;
                        u32x4 w; w.x = cvt_pk_bf16(v0[0], v0[1]); w.y = cvt_pk_bf16(v0[2], v0[3]); w.z = cvt_pk_bf16(v1[0], v1[1]); w.w = cvt_pk_bf16(v1[2], v1[3]);
                        *(u32x4*)(rowp + bj * HALF) = w; } }
        } else {
            const int col0 = (u.pn - 4) * HALF + wc * 32 + 8 * fq;
#pragma unroll
            for (int ai = 0; ai < 2; ++ai)
#pragma unroll
                for (int m = 0; m < 4; ++m) { const int row = row0 + ai * HALF + m * 16; bf16_t* rowp = Zp + (size_t)row * DM + col0; const float r = rs[row], r2 = r * r;
                    const f32x4 v0 = acc[ai][0][m][0] * acc[ai][1][m][0] * r2, v1 = acc[ai][0][m][1] * acc[ai][1][m][1] * r2;
                    u32x4 w; w.x = cvt_pk_bf16(v0[0], v0[1]); w.y = cvt_pk_bf16(v0[2], v0[3]); w.z = cvt_pk_bf16(v1[0], v1[1]); w.w = cvt_pk_bf16(v1[2], v1[3]);
                    *(u32x4*)rowp = w; }
        }
    }
};
__device__ __forceinline__ float silu_mul(float g, float u) { return g * __builtin_amdgcn_rcpf(1.f + __expf(-g)) * u; }
struct EpiSwiGLU {
    static constexpr bool PERM = true;
    bf16_t* Hd; const float* ss;
    __device__ __forceinline__ void operator()(const Acc& acc, const Unit& u, int wr, int wc, int fr, int fq) const {
        const int row0 = u.pm * BM + wr * 64 + fr, col0 = u.pn * HALF + wc * 32 + 8 * fq;
#pragma unroll
        for (int ai = 0; ai < 2; ++ai)
#pragma unroll
            for (int m = 0; m < 4; ++m) { const int row = row0 + ai * HALF + m * 16; bf16_t* rowp = Hd + (size_t)row * DFF + col0; const float r = ss[row];
                f32x4 v0, v1;
#pragma unroll
                for (int q = 0; q < 4; ++q) { v0[q] = silu_mul(acc[ai][0][m][0][q] * r, acc[ai][1][m][0][q] * r); v1[q] = silu_mul(acc[ai][0][m][1][q] * r, acc[ai][1][m][1][q] * r); }
                u32x4 w; w.x = cvt_pk_bf16(v0[0], v0[1]); w.y = cvt_pk_bf16(v0[2], v0[3]); w.z = cvt_pk_bf16(v1[0], v1[1]); w.w = cvt_pk_bf16(v1[2], v1[3]);
                *(u32x4*)rowp = w; }
    }
};
struct EpiResid {
    static constexpr bool PERM = true;
    bf16_t* XB; float* PSQ; int lane;
    __device__ __forceinline__ void operator()(const Acc& acc, const Unit& u, int wr, int wc, int fr, int fq) const {
        const int row0 = u.pm * BM + wr * 64 + fr, col0 = u.pn * BM + wc * 32 + 8 * fq;
#pragma unroll
        for (int ai = 0; ai < 2; ++ai)
#pragma unroll
            for (int m = 0; m < 4; ++m) { const int row = row0 + ai * HALF + m * 16; bf16_t* rowp = XB + (size_t)row * DM + col0; float ss = 0.f;
#pragma unroll
                for (int bj = 0; bj < 2; ++bj) { const u32x4 xv = *(const u32x4*)(rowp + bj * HALF);
                    const f32x4 v0 = acc[ai][bj][m][0] + (f32x4){bflo(xv.x), bfhi(xv.x), bflo(xv.y), bfhi(xv.y)}, v1 = acc[ai][bj][m][1] + (f32x4){bflo(xv.z), bfhi(xv.z), bflo(xv.w), bfhi(xv.w)};
                    ss += (v0[0] * v0[0] + v0[1] * v0[1]) + (v0[2] * v0[2] + v0[3] * v0[3]) + (v1[0] * v1[0] + v1[1] * v1[1]) + (v1[2] * v1[2] + v1[3] * v1[3]);
                    u32x4 w; w.x = cvt_pk_bf16(v0[0], v0[1]); w.y = cvt_pk_bf16(v0[2], v0[3]); w.z = cvt_pk_bf16(v1[0], v1[1]); w.w = cvt_pk_bf16(v1[2], v1[3]);
                    *(u32x4*)(rowp + bj * HALF) = w; }
                ss += lane_xor_f(ss, 16, lane); ss += lane_xor_f(ss, 32, lane);
                if (fq == 0) PSQ[(size_t)row * 16 + u.pn * 4 + wc] = ss; }
    }
};
struct EpiLogits {
    static constexpr bool PERM = false;
    float* LG; const float* rs;
    __device__ __forceinline__ void operator()(const Acc& acc, const Unit& u, int wr, int wc, int fr, int fq) const {
        const int row0 = u.pm * BM + wr * 64 + fr, col0 = wc * 32 + 4 * fq;
#pragma unroll
        for (int ai = 0; ai < 2; ++ai)
#pragma unroll
            for (int m = 0; m < 4; ++m) { const int row = row0 + ai * HALF + m * 16; const size_t off = (size_t)row * 128 + col0; const float r = rs[row];
#pragma unroll
                for (int n = 0; n < 2; ++n) *(f32x4*)(LG + off + n * 16) = acc[ai][0][m][n] * r; }
    }
};
struct EpiScatterY {
    static constexpr bool PERM = true;
    bf16_t* Y; const int* sdest; const float* sgate;
    __device__ __forceinline__ void operator()(const Acc& acc, const Unit& u, int wr, int wc, int fr, int fq) const {
        const int row0 = u.pm * BM + wr * 64 + fr, col0 = u.pn * BM + wc * 32 + 8 * fq;
#pragma unroll
        for (int ai = 0; ai < 2; ++ai)
#pragma unroll
            for (int m = 0; m < 4; ++m) { const int slot = row0 + ai * HALF + m * 16; const int d = sdest[slot]; const float g = sgate[slot];
                if (d >= 0) { bf16_t* rowp = Y + (size_t)d * DM + col0;
#pragma unroll
                    for (int bj = 0; bj < 2; ++bj) { const f32x4 v0 = acc[ai][bj][m][0] * g, v1 = acc[ai][bj][m][1] * g;
                        u32x4 w; w.x = cvt_pk_bf16(v0[0], v0[1]); w.y = cvt_pk_bf16(v0[2], v0[3]); w.z = cvt_pk_bf16(v1[0], v1[1]); w.w = cvt_pk_bf16(v1[2], v1[3]);
                        *(u32x4*)(rowp + bj * HALF) = w; } }
                asm volatile("" ::: "memory"); }
    }
};

template <bool GATHER = false, class Epi, class Sched>
__device__ __forceinline__ void gemm_phase(LAS unsigned char* lds, const Gemm g, const Sched& S, const Epi& E, int tid) {
    const int wid = __builtin_amdgcn_readfirstlane(tid >> 6), lane = tid & 63, wr = wid >> 2, wc = wid & 3, fr = lane & 15, fq = lane >> 4;
    const int K = g.K, lda = g.lda, nt = K / BK;
    unsigned voffA[2], voffB[2];
#pragma unroll
    for (int i = 0; i < 2; ++i) { int R, C; stage_rc(tid * 16 + i * 8192, R, C); const int Rb = Epi::PERM ? ((R & ~31) + perm32(R & 31)) : R;
        voffA[i] = (unsigned)(R * lda + C) * 2u; voffB[i] = (unsigned)(Rb * K + C) * 2u; }
    const size_t kstep = (size_t)(BK * 2);
    const size_t hstepA = (size_t)HALF * lda * 2, hstepB = (size_t)HALF * K * 2;
    unsigned goC[2][2] = {{0u, 0u}, {0u, 0u}}, goN[2][2] = {{0u, 0u}, {0u, 0u}}; int gR[2] = {0, 0}; unsigned gC[2] = {0u, 0u};
    if constexpr (GATHER) {
#pragma unroll
        for (int i = 0; i < 2; ++i) { int R, C; stage_rc(tid * 16 + i * 8192, R, C); gR[i] = R; gC[i] = (unsigned)C * 2u; } }
#define PG8_GO(dst, pm_) do { _Pragma("unroll") for (int h_ = 0; h_ < 2; ++h_) _Pragma("unroll") for (int i_ = 0; i_ < 2; ++i_) \
        dst[h_][i_] = (unsigned)g.rowidx[(pm_) * BM + h_ * HALF + gR[i_]] * (unsigned)(lda * 2) + gC[i_]; } while (0)
    const unsigned ldsw = (unsigned)wid * 1024u;
    const int aoff = lds_byte(wr * 64 + fr, fq * 8), boff = lds_byte(wc * 32 + fr, fq * 8);
#define PG8_SA(b, h) (((b) * 2 + (h)) * HTB)
#define PG8_SB(b, h) ((4 + (b) * 2 + (h)) * HTB)
#define PG8_STAGE(bufoff, gbase, voff) do { _Pragma("unroll") for (int _i = 0; _i < 2; ++_i) \
        __builtin_amdgcn_global_load_lds((const unsigned*)((const char*)(gbase) + (voff)[_i]), (LAS unsigned*)(lds + (bufoff) + ldsw + _i * 8192), 16, 0, 0); } while (0)
#define PG8_LDA(dst, b, h) do { _Pragma("unroll") for (int m = 0; m < 4; ++m) _Pragma("unroll") for (int k = 0; k < 2; ++k) dst[m][k] = *(const LAS bf16x8*)(lds + PG8_SA(b, h) + aoff + m * 2048 + k * 1024); } while (0)
#define PG8_LDB(dst, b, h) do { _Pragma("unroll") for (int n = 0; n < 2; ++n) _Pragma("unroll") for (int k = 0; k < 2; ++k) dst[n][k] = *(const LAS bf16x8*)(lds + PG8_SB(b, h) + boff + n * 2048 + k * 1024); } while (0)
#define PG8_MMA(ai, bj, At, Bt) do { __builtin_amdgcn_s_setprio(1); _Pragma("unroll") for (int m = 0; m < 4; ++m) _Pragma("unroll") for (int n = 0; n < 2; ++n) _Pragma("unroll") for (int k = 0; k < 2; ++k) \
        acc[ai][bj][m][n] = __builtin_amdgcn_mfma_f32_16x16x32_bf16(Bt[n][k], At[m][k], acc[ai][bj][m][n], 0, 0, 0); __builtin_amdgcn_s_setprio(0); } while (0)
#define PG8_WAIT_V(n) asm volatile("s_waitcnt vmcnt(" #n ")" ::: "memory")
#define PG8_WAIT_L(n) asm volatile("s_waitcnt lgkmcnt(" #n ")" ::: "memory")
#define PG8_BAR __builtin_amdgcn_s_barrier()
#define PG8_SCHED __builtin_amdgcn_sched_barrier(0)
    Unit cur, nxt; int ui = 0;
    if (!S.next(0, cur)) return;
    Acc acc;
#pragma unroll
    for (int a = 0; a < 2; ++a)
#pragma unroll
        for (int b = 0; b < 2; ++b)
#pragma unroll
            for (int m = 0; m < 4; ++m)
#pragma unroll
                for (int n = 0; n < 2; ++n) acc[a][b][m][n] = (f32x4){0.f, 0.f, 0.f, 0.f};
    bf16x8 At[4][2], B0[2][2], B1[2][2];
    const char* cA = cur.A; const char* cB = cur.B;
    if constexpr (GATHER) PG8_GO(goC, cur.pm);
    PG8_STAGE(PG8_SB(0, 0), cB, voffB); PG8_STAGE(PG8_SB(0, 1), cB + hstepB, voffB);
    if constexpr (GATHER) { PG8_STAGE(PG8_SA(0, 0), cA, goC[0]); PG8_STAGE(PG8_SA(0, 1), cA, goC[1]); } else { PG8_STAGE(PG8_SA(0, 0), cA, voffA); PG8_STAGE(PG8_SA(0, 1), cA + hstepA, voffA); }
    if (wr == 1) PG8_BAR;
    PG8_WAIT_V(2); PG8_BAR;
    PG8_STAGE(PG8_SB(1, 0), cB + kstep, voffB); if constexpr (GATHER) PG8_STAGE(PG8_SA(1, 0), cA + kstep, goC[0]); else PG8_STAGE(PG8_SA(1, 0), cA + kstep, voffA); PG8_STAGE(PG8_SB(1, 1), cB + hstepB + kstep, voffB);
    PG8_WAIT_V(6); PG8_BAR;
    for (;;) {
        const bool has_next = S.next(ui + 1, nxt);
        const char* nA = has_next ? nxt.A : cA; const char* nB = has_next ? nxt.B : cB;
        if constexpr (GATHER) { if (has_next) PG8_GO(goN, nxt.pm); else { goN[0][0] = goC[0][0]; goN[0][1] = goC[0][1]; goN[1][0] = goC[1][0]; goN[1][1] = goC[1][1]; } }
        for (int t = 0; t < nt; t += 2) {
            const bool last = (t == nt - 2);
            const char* a1 = cA + (size_t)(t + 1) * kstep;
            const char* a2 = last ? nA : cA + (size_t)(t + 2) * kstep; const char* b2 = last ? nB : cB + (size_t)(t + 2) * kstep;
            const char* a3 = a2 + kstep; const char* b3 = b2 + kstep;
            unsigned g2h0[2], g2h1[2];
            if constexpr (GATHER) { g2h0[0] = last ? goN[0][0] : goC[0][0]; g2h0[1] = last ? goN[0][1] : goC[0][1]; g2h1[0] = last ? goN[1][0] : goC[1][0]; g2h1[1] = last ? goN[1][1] : goC[1][1]; }
            PG8_LDB(B0, 0, 0); PG8_LDB(B1, 0, 1); PG8_SCHED; PG8_LDA(At, 0, 0); if constexpr (GATHER) PG8_STAGE(PG8_SA(1, 1), a1, goC[1]); else PG8_STAGE(PG8_SA(1, 1), a1 + hstepA, voffA);
            PG8_WAIT_V(8); PG8_WAIT_L(0); PG8_BAR; PG8_MMA(0, 0, At, B0); PG8_MMA(0, 1, At, B1); PG8_BAR; PG8_SCHED;
            PG8_LDA(At, 0, 1); PG8_STAGE(PG8_SB(0, 0), b2, voffB); PG8_STAGE(PG8_SB(0, 1), b2 + hstepB, voffB); if constexpr (GATHER) PG8_STAGE(PG8_SA(0, 0), a2, g2h0); else PG8_STAGE(PG8_SA(0, 0), a2, voffA);
            PG8_WAIT_V(8); PG8_WAIT_L(0); PG8_BAR; PG8_MMA(1, 0, At, B0); PG8_MMA(1, 1, At, B1); PG8_BAR; PG8_SCHED;
            PG8_LDB(B0, 1, 0); PG8_LDB(B1, 1, 1); PG8_SCHED; PG8_LDA(At, 1, 0); if constexpr (GATHER) PG8_STAGE(PG8_SA(0, 1), a2, g2h1); else PG8_STAGE(PG8_SA(0, 1), a2 + hstepA, voffA);
            PG8_WAIT_V(8); PG8_WAIT_L(0); PG8_BAR; PG8_MMA(0, 0, At, B0); PG8_MMA(0, 1, At, B1); PG8_BAR; PG8_SCHED;
            PG8_LDA(At, 1, 1); PG8_STAGE(PG8_SB(1, 0), b3, voffB); PG8_STAGE(PG8_SB(1, 1), b3 + hstepB, voffB); if constexpr (GATHER) PG8_STAGE(PG8_SA(1, 0), a3, g2h0); else PG8_STAGE(PG8_SA(1, 0), a3, voffA);
            PG8_WAIT_V(8); PG8_WAIT_L(0); PG8_BAR; PG8_MMA(1, 0, At, B0); PG8_MMA(1, 1, At, B1); PG8_BAR; PG8_SCHED;
        }
        if (wr == 0) PG8_BAR;
        E(acc, cur, wr, wc, fr, fq);
        if (!has_next) break;
#pragma unroll
        for (int a = 0; a < 2; ++a)
#pragma unroll
            for (int b = 0; b < 2; ++b)
#pragma unroll
                for (int m = 0; m < 4; ++m)
#pragma unroll
                    for (int n = 0; n < 2; ++n) acc[a][b][m][n] = (f32x4){0.f, 0.f, 0.f, 0.f};
        cur = nxt; cA = nA; cB = nB; ++ui;
        if constexpr (GATHER) { goC[0][0] = goN[0][0]; goC[0][1] = goN[0][1]; goC[1][0] = goN[1][0]; goC[1][1] = goN[1][1]; }
        if (wr == 1) PG8_BAR;
    }
    PG8_WAIT_V(0);
    PG8_BAR;
#undef PG8_GO
#undef PG8_SA
#undef PG8_SB
#undef PG8_STAGE
#undef PG8_LDA
#undef PG8_LDB
#undef PG8_MMA
#undef PG8_WAIT_V
#undef PG8_WAIT_L
#undef PG8_BAR
#undef PG8_SCHED
}
}

namespace att {
constexpr int NW = 8, QBLK = 32, KVBLK = 64;
constexpr float SCALE = 0.07216878364870322f;
constexpr float THR = 8.f;
#ifndef ATT_SDEPTH
#define ATT_SDEPTH 2
#endif
constexpr int SDEPTH = ATT_SDEPTH;
constexpr int KROW = 400;
constexpr int SHM_V = KVBLK * DV * 2, SHM_K = KVBLK * KROW;
#ifndef ATT_NQR
#define ATT_NQR 8
#endif
constexpr int NQR = ATT_NQR;
constexpr int QLROW = (12 - NQR) * 32 + 16;
constexpr int OFF_V = 0, OFF_K = 2 * SHM_V, OFF_WS = OFF_K + 2 * SHM_K, OFF_QL = OFF_WS + NW * 64 * 4, ATT_LDS = OFF_QL + NW * 32 * QLROW;
static_assert(ATT_LDS <= RING_BYTES, "attention LDS");
#define SBAR() __builtin_amdgcn_sched_barrier(0)
__device__ __forceinline__ int crow(int r, int hi) { return (r & 3) + 8 * (r >> 2) + 4 * hi; }
__device__ __forceinline__ void partialSM(f32x16& p0, f32x16& p1, float& m_reg, float& mn, float& alpha) {
    constexpr float C = SCALE * 1.4426950408889634f;
    float pmax = p0[0];
#pragma unroll
    for (int r = 1; r < 16; ++r) pmax = fmaxf(pmax, p0[r]);
#pragma unroll
    for (int r = 0; r < 16; ++r) pmax = fmaxf(pmax, p1[r]);
    { auto rr = __builtin_amdgcn_permlane32_swap(__float_as_uint(pmax), __float_as_uint(pmax), false, false);
      pmax = fmaxf(__uint_as_float(rr[0]), __uint_as_float(rr[1])); }
    if (__builtin_expect(__all(pmax - m_reg <= THR / SCALE), 1)) { mn = m_reg; alpha = 1.f; }
    else { mn = fmaxf(m_reg, pmax); alpha = __builtin_amdgcn_exp2f((m_reg - mn) * C); m_reg = mn; }
    const float mnC = -mn * C;
#pragma unroll
    for (int r = 0; r < 16; ++r) p0[r] = fmaf(p0[r], C, mnC);
#pragma unroll
    for (int r = 0; r < 16; ++r) p1[r] = fmaf(p1[r], C, mnC);
#pragma unroll
    for (int r = 0; r < 16; ++r) p0[r] = __builtin_amdgcn_exp2f(p0[r]);
}
__device__ __forceinline__ void finishSM(f32x16& p0, f32x16& p1, float alpha, float& l_reg, bf16x8& pa0, bf16x8& pa1, bf16x8& pa2, bf16x8& pa3) {
#pragma unroll
    for (int r = 0; r < 16; ++r) p1[r] = __builtin_amdgcn_exp2f(p1[r]);
    float ps = 0;
#pragma unroll
    for (int r = 0; r < 16; ++r) ps += p0[r];
#pragma unroll
    for (int r = 0; r < 16; ++r) ps += p1[r];
    { auto rr = __builtin_amdgcn_permlane32_swap(__float_as_uint(ps), __float_as_uint(ps), false, false);
      ps = __uint_as_float(rr[0]) + __uint_as_float(rr[1]); }
    l_reg = l_reg * alpha + ps;
#define PK4(P, BASE, OUT) do { unsigned a0 = cvt_pk_bf16(P[BASE + 0], P[BASE + 1]), a1 = cvt_pk_bf16(P[BASE + 2], P[BASE + 3]);   \
    unsigned b0 = cvt_pk_bf16(P[BASE + 4], P[BASE + 5]), b1 = cvt_pk_bf16(P[BASE + 6], P[BASE + 7]);                              \
    auto r0 = __builtin_amdgcn_permlane32_swap(a0, b0, false, false); auto r1 = __builtin_amdgcn_permlane32_swap(a1, b1, false, false); \
    u32x4 w = {r0[0], r1[0], r0[1], r1[1]}; OUT = *reinterpret_cast<bf16x8*>(&w); } while (0)
    PK4(p0, 0, pa0); PK4(p0, 8, pa1); PK4(p1, 0, pa2); PK4(p1, 8, pa3);
#undef PK4
}
__device__ __forceinline__ void qkt(f32x16& p0, f32x16& p1, const char* Ks, const bf16x8* qr, const char* ql, int r32, int hi) {
    p0 = f32x16{}; p1 = f32x16{};
#pragma unroll
    for (int d0 = 0; d0 < 12; ++d0) { const int cb = d0 * 32 + hi * 16;
        const bf16x8 b0 = *reinterpret_cast<const bf16x8*>(Ks + r32 * KROW + cb);
        const bf16x8 b1 = *reinterpret_cast<const bf16x8*>(Ks + (32 + r32) * KROW + cb);
        const bf16x8 qf = (d0 < NQR) ? qr[d0] : *reinterpret_cast<const bf16x8*>(ql + (d0 - NQR) * 32);
        p0 = __builtin_amdgcn_mfma_f32_32x32x16_bf16(b0, qf, p0, 0, 0, 0);
        p1 = __builtin_amdgcn_mfma_f32_32x32x16_bf16(b1, qf, p1, 0, 0, 0); }
}
__device__ __forceinline__ int v_st(int k, int c) { const int kk = (k & ~0xC) | ((k & 4) << 1) | ((k & 8) >> 1); return ((kk >> 3) * 4 + (c >> 5)) * 512 + ((kk & 7) * 32 + (c & 31)) * 2; }
__device__ __forceinline__ int v_rd_base(int lane) { return ((lane & 3) << 3) | (((lane >> 2) & 3) << 6) | (((lane >> 4) & 1) << 5) | (((lane >> 5) & 1) << 8); }
constexpr int v_rd_off(int d0, int ks, int half) { return d0 * 512 + ks * 4096 + half * 2048; }
template <int OFF> __device__ __forceinline__ s16x4 tr_read(int vb) {
    s16x4 r; asm volatile("ds_read_b64_tr_b16 %0, %1 offset:%2" : "=&v"(r) : "v"(vb), "i"(OFF) : "memory"); return r;
}
template <int D0> __device__ __forceinline__ void pv_one(f32x16& od, int vb, bf16x8 pa0, bf16x8 pa1, bf16x8 pa2, bf16x8 pa3) {
    const s16x4 l0 = tr_read<v_rd_off(D0, 0, 0)>(vb), h0 = tr_read<v_rd_off(D0, 0, 1)>(vb), l1 = tr_read<v_rd_off(D0, 1, 0)>(vb), h1 = tr_read<v_rd_off(D0, 1, 1)>(vb);
    const s16x4 l2 = tr_read<v_rd_off(D0, 2, 0)>(vb), h2 = tr_read<v_rd_off(D0, 2, 1)>(vb), l3 = tr_read<v_rd_off(D0, 3, 0)>(vb), h3 = tr_read<v_rd_off(D0, 3, 1)>(vb);
    asm volatile("s_waitcnt lgkmcnt(0)" ::: "memory"); SBAR();
#define PK(L, H) (bf16x8){L[0], L[1], L[2], L[3], H[0], H[1], H[2], H[3]}
    od = __builtin_amdgcn_mfma_f32_32x32x16_bf16(pa0, PK(l0, h0), od, 0, 0, 0);
    od = __builtin_amdgcn_mfma_f32_32x32x16_bf16(pa1, PK(l1, h1), od, 0, 0, 0);
    od = __builtin_amdgcn_mfma_f32_32x32x16_bf16(pa2, PK(l2, h2), od, 0, 0, 0);
    od = __builtin_amdgcn_mfma_f32_32x32x16_bf16(pa3, PK(l3, h3), od, 0, 0, 0);
#undef PK
}
__device__ __forceinline__ void pv_d0(f32x16* o, int vb, bf16x8 pa0, bf16x8 pa1, bf16x8 pa2, bf16x8 pa3) {
    pv_one<0>(o[0], vb, pa0, pa1, pa2, pa3); pv_one<1>(o[1], vb, pa0, pa1, pa2, pa3); pv_one<2>(o[2], vb, pa0, pa1, pa2, pa3); pv_one<3>(o[3], vb, pa0, pa1, pa2, pa3);
}
__device__ __forceinline__ void attn_unit(const bf16_t* __restrict__ Qb, const bf16_t* __restrict__ Kh, const bf16_t* __restrict__ Vh, bf16_t* __restrict__ Ob, char* lds, int tid) {
    const int wid = tid >> 6, lane = tid & 63, r32 = lane & 31, hi = lane >> 5;
    char* V_lds = lds + OFF_V; char* K_lds = lds + OFF_K;
    float* ws = (float*)(lds + OFF_WS) + wid * 64; float* li_l = ws; float* al_l = ws + 32;
    float m_reg = -1e30f, l_reg = 0; f32x16 o[4] = {}; bf16x8 qr[NQR];
    const bf16_t* Qw = Qb + (long)(wid * QBLK + r32) * DQK + hi * 8;
#pragma unroll
    for (int d0 = 0; d0 < NQR; ++d0) qr[d0] = *reinterpret_cast<const bf16x8*>(Qw + d0 * 16);
    char* ql = lds + OFF_QL + wid * (32 * QLROW) + r32 * QLROW + hi * 16;
#pragma unroll
    for (int d0 = NQR; d0 < 12; ++d0) *reinterpret_cast<bf16x8*>(ql + (d0 - NQR) * 32) = *reinterpret_cast<const bf16x8*>(Qw + d0 * 16);
    const int sr = tid >> 4, sc = (tid & 15) * 8, vst0 = v_st(sr, sc), vst1 = v_st(32 + sr, sc);
    int kst[3];
#pragma unroll
    for (int i = 0; i < 3; ++i) { const int q = tid + 512 * i; kst[i] = (q / 24) * KROW + (q % 24) * 16; }
    const int vb0 = (int)(uintptr_t)V_lds + v_rd_base(lane);
    struct { bf16x8 vs0, vs1, ks0, ks1, ks2; } sr_[SDEPTH];
#define SLOAD(i, k0) do { sr_[i].vs0 = *reinterpret_cast<const bf16x8*>(&Vh[(long)((k0) + sr) * DV + sc]); sr_[i].vs1 = *reinterpret_cast<const bf16x8*>(&Vh[(long)((k0) + 32 + sr) * DV + sc]); \
    const bf16_t* kp_ = Kh + (long)(k0) * DQK + tid * 8; sr_[i].ks0 = *reinterpret_cast<const bf16x8*>(kp_); sr_[i].ks1 = *reinterpret_cast<const bf16x8*>(kp_ + 4096); sr_[i].ks2 = *reinterpret_cast<const bf16x8*>(kp_ + 8192); } while (0)
#define SWRITE(b, i) do { *(bf16x8*)(V_lds + (b) * SHM_V + vst0) = sr_[i].vs0; *(bf16x8*)(V_lds + (b) * SHM_V + vst1) = sr_[i].vs1; \
    *(bf16x8*)(K_lds + (b) * SHM_K + kst[0]) = sr_[i].ks0; *(bf16x8*)(K_lds + (b) * SHM_K + kst[1]) = sr_[i].ks1; *(bf16x8*)(K_lds + (b) * SHM_K + kst[2]) = sr_[i].ks2; } while (0)
#define SWAIT() do { if constexpr (SDEPTH == 2) asm volatile("s_waitcnt vmcnt(5)" ::: "memory"); else asm volatile("s_waitcnt vmcnt(0)" ::: "memory"); } while (0)
#define RESC(a) do { if (__any((a) < 1.f)) { if (hi == 0) al_l[r32] = (a); asm volatile("s_waitcnt lgkmcnt(0)" ::: "memory"); \
    _Pragma("unroll") for (int d = 0; d < 4; ++d) _Pragma("unroll") for (int r = 0; r < 16; ++r) o[d][r] *= al_l[crow(r, hi)]; } } while (0)
    f32x16 pA0, pA1, pB0, pB1; float mnA, mnB, alA, alB; bf16x8 pa0, pa1, pa2, pa3; constexpr int NT = SEQ / KVBLK;
    constexpr int SE = 0, SO = SDEPTH - 1;
    SLOAD(SE, 0); asm volatile("s_waitcnt vmcnt(0)" ::: "memory"); SWRITE(0, SE); __syncthreads();
    qkt(pA0, pA1, K_lds, qr, ql, r32, hi); partialSM(pA0, pA1, m_reg, mnA, alA);
    SLOAD(SO, KVBLK); if constexpr (SDEPTH == 2) SLOAD(SE, 2 * KVBLK);
    SWAIT(); SWRITE(1, SO); __syncthreads();
    for (int j = 1; j + 1 < NT; j += 2) {
        SBAR(); qkt(pB0, pB1, K_lds + SHM_K, qr, ql, r32, hi);
        finishSM(pA0, pA1, alA, l_reg, pa0, pa1, pa2, pa3); SBAR();
        SLOAD(SO, (j + SDEPTH) * KVBLK); SBAR();
        pv_d0(o, vb0, pa0, pa1, pa2, pa3); partialSM(pB0, pB1, m_reg, mnB, alB);
        __syncthreads(); SWAIT(); SWRITE(0, SE);
        RESC(alB); __syncthreads();
        SBAR(); qkt(pA0, pA1, K_lds, qr, ql, r32, hi);
        finishSM(pB0, pB1, alB, l_reg, pa0, pa1, pa2, pa3); SBAR();
        if (SDEPTH == 1 || j + 3 < NT) SLOAD(SE, (j + 1 + SDEPTH) * KVBLK); SBAR();
        pv_d0(o, vb0 + SHM_V, pa0, pa1, pa2, pa3); partialSM(pA0, pA1, m_reg, mnA, alA);
        __syncthreads(); SWAIT(); SWRITE(1, SO);
        RESC(alA); __syncthreads();
    }
    SBAR(); qkt(pB0, pB1, K_lds + SHM_K, qr, ql, r32, hi);
    finishSM(pA0, pA1, alA, l_reg, pa0, pa1, pa2, pa3); SBAR();
    pv_d0(o, vb0, pa0, pa1, pa2, pa3); partialSM(pB0, pB1, m_reg, mnB, alB);
    __syncthreads(); RESC(alB);
    finishSM(pB0, pB1, alB, l_reg, pa0, pa1, pa2, pa3); SBAR();
    pv_d0(o, vb0 + SHM_V, pa0, pa1, pa2, pa3);
    if (hi == 0) li_l[r32] = l_reg; asm volatile("s_waitcnt lgkmcnt(0)" ::: "memory");
    float rli[16];
#pragma unroll
    for (int r = 0; r < 16; ++r) rli[r] = __builtin_amdgcn_rcpf(li_l[crow(r, hi)]);
    __syncthreads();
    bf16_t* ost = (bf16_t*)(lds + wid * 8192);
#pragma unroll
    for (int r = 0; r < 16; ++r) { const int orow = crow(r, hi);
#pragma unroll
        for (int d0 = 0; d0 < 4; ++d0) ost[orow * 128 + d0 * 32 + r32] = (bf16_t)f2bf(o[d0][r] * rli[r]); }
    asm volatile("s_waitcnt lgkmcnt(0)" ::: "memory");
    bf16_t* Ow = Ob + (long)(wid * QBLK) * DM;
#pragma unroll
    for (int i = 0; i < 8; ++i) { const int ch = lane + 64 * i, row = ch >> 4, c = ch & 15;
        const u32x4 v = *(const u32x4*)((const char*)ost + row * 256 + c * 16); *(u32x4*)(Ow + (long)row * DM + c * 8) = v; }
    __syncthreads();
#undef SLOAD
#undef SWRITE
#undef SWAIT
#undef RESC
#undef SBAR
}
}


namespace att8 {
typedef int i32x8 __attribute__((ext_vector_type(8)));
constexpr int NW = 8, QBLK = 32, KVBLK = 64;
constexpr float SCALE = 0.07216878364870322f;
constexpr float THR = 3.f;
constexpr float POFF = 4.f;
constexpr int KROW = 208, VROW = 80;
constexpr int SHM_K = KVBLK * KROW, SHM_V = DV * VROW;
constexpr int OFF_V = 0, OFF_K = 2 * SHM_V, OFF_WS = OFF_K + 2 * SHM_K, ATT_LDS = OFF_WS + NW * 64 * 4;
static_assert(ATT_LDS <= 65536, "O staging reuses [0, 64 KiB)");
#define SBAR() __builtin_amdgcn_sched_barrier(0)
__device__ __forceinline__ int crow(int r, int hi) { return (r & 3) + 8 * (r >> 2) + 4 * hi; }
__device__ __forceinline__ f32x16 mfma8(i32x8 a, i32x8 b, f32x16 c) { return __builtin_amdgcn_mfma_scale_f32_32x32x64_f8f6f4(a, b, c, 0, 0, 0, 0x7F7F7F7F, 0, 0x7F7F7F7F); }
__device__ __forceinline__ i32x8 ld32(const char* p) { const u32x4 a = *reinterpret_cast<const u32x4*>(p), b = *reinterpret_cast<const u32x4*>(p + 16); return (i32x8){(int)a.x, (int)a.y, (int)a.z, (int)a.w, (int)b.x, (int)b.y, (int)b.z, (int)b.w}; }
__device__ __forceinline__ void partialSM(f32x16& p0, f32x16& p1, float& m_reg, float& mn, float& alpha) {
    constexpr float C = SCALE * 1.4426950408889634f;
    float pmax = p0[0];
#pragma unroll
    for (int r = 1; r < 16; ++r) pmax = fmaxf(pmax, p0[r]);
#pragma unroll
    for (int r = 0; r < 16; ++r) pmax = fmaxf(pmax, p1[r]);
    { auto rr = __builtin_amdgcn_permlane32_swap(__float_as_uint(pmax), __float_as_uint(pmax), false, false);
      pmax = fmaxf(__uint_as_float(rr[0]), __uint_as_float(rr[1])); }
    if (__builtin_expect(__all(pmax - m_reg <= THR / SCALE), 1)) { mn = m_reg; alpha = 1.f; }
    else { mn = fmaxf(m_reg, pmax); alpha = __builtin_amdgcn_exp2f((m_reg - mn) * C); m_reg = mn; }
    const float mnC = POFF - mn * C;
#pragma unroll
    for (int r = 0; r < 16; ++r) p0[r] = fmaf(p0[r], C, mnC);
#pragma unroll
    for (int r = 0; r < 16; ++r) p1[r] = fmaf(p1[r], C, mnC);
#pragma unroll
    for (int r = 0; r < 16; ++r) p0[r] = __builtin_amdgcn_exp2f(p0[r]);
}
__device__ __forceinline__ void finishSM(f32x16& p0, f32x16& p1, float alpha, float& l_reg, i32x8& pa) {
#pragma unroll
    for (int r = 0; r < 16; ++r) p1[r] = __builtin_amdgcn_exp2f(p1[r]);
    float ps = 0;
#pragma unroll
    for (int r = 0; r < 16; ++r) ps += p0[r];
#pragma unroll
    for (int r = 0; r < 16; ++r) ps += p1[r];
    { auto rr = __builtin_amdgcn_permlane32_swap(__float_as_uint(ps), __float_as_uint(ps), false, false);
      ps = __uint_as_float(rr[0]) + __uint_as_float(rr[1]); }
    l_reg = l_reg * alpha + ps;
#pragma unroll
    for (int g = 0; g < 4; ++g) { int w = 0; w = __builtin_amdgcn_cvt_pk_fp8_f32(p0[4 * g], p0[4 * g + 1], w, false); w = __builtin_amdgcn_cvt_pk_fp8_f32(p0[4 * g + 2], p0[4 * g + 3], w, true); pa[g] = w; }
#pragma unroll
    for (int g = 0; g < 4; ++g) { int w = 0; w = __builtin_amdgcn_cvt_pk_fp8_f32(p1[4 * g], p1[4 * g + 1], w, false); w = __builtin_amdgcn_cvt_pk_fp8_f32(p1[4 * g + 2], p1[4 * g + 3], w, true); pa[4 + g] = w; }
}
__device__ __forceinline__ void qkt(f32x16& p0, f32x16& p1, const char* Ks, const i32x8* qr, int r32, int hi) {
    p0 = f32x16{}; p1 = f32x16{};
#pragma unroll
    for (int ks = 0; ks < 3; ++ks) { const int cb = ks * 64 + hi * 32;
        const i32x8 a0 = ld32(Ks + r32 * KROW + cb), a1 = ld32(Ks + (32 + r32) * KROW + cb);
        p0 = mfma8(a0, qr[ks], p0); p1 = mfma8(a1, qr[ks], p1); }
}
__device__ __forceinline__ void pv(f32x16* o, const char* Vs, i32x8 pa, int r32, int hi) {
#pragma unroll
    for (int d0 = 0; d0 < 4; ++d0) { const i32x8 b = ld32(Vs + (32 * d0 + r32) * VROW + hi * 32); o[d0] = mfma8(pa, b, o[d0]); }
}
__device__ __forceinline__ void attn_unit(const unsigned char* __restrict__ Qb, const unsigned char* __restrict__ Kh, const unsigned char* __restrict__ Vt, bf16_t* __restrict__ Ob, char* lds, int tid) {
    const int wid = tid >> 6, lane = tid & 63, r32 = lane & 31, hi = lane >> 5;
    char* V_lds = lds + OFF_V; char* K_lds = lds + OFF_K;
    float* ws = (float*)(lds + OFF_WS) + wid * 64; float* li_l = ws; float* al_l = ws + 32;
    float m_reg = -1e30f, l_reg = 0; f32x16 o[4] = {}; i32x8 qr[3];
    const unsigned char* Qw = Qb + (long)(wid * QBLK + r32) * DQK + hi * 32;
#pragma unroll
    for (int ks = 0; ks < 3; ++ks) qr[ks] = ld32((const char*)Qw + ks * 64);
    const int kst0 = (tid / 12) * KROW + (tid % 12) * 16, kst1 = ((tid + 512) / 12) * KROW + ((tid + 512) % 12) * 16, vst = (tid >> 2) * VROW + (tid & 3) * 16;
    const bool k2 = tid < 256;
    struct { u32x4 v, k0, k1; } sr_[2];
#define SLOAD(i, t) do { sr_[i].v = *reinterpret_cast<const u32x4*>(Vt + (long)(t) * 8192 + tid * 16); const unsigned char* kp_ = Kh + (long)(t) * 12288 + tid * 16; \
    sr_[i].k0 = *reinterpret_cast<const u32x4*>(kp_); if (k2) sr_[i].k1 = *reinterpret_cast<const u32x4*>(kp_ + 8192); } while (0)
#define SWRITE(b, i) do { *(u32x4*)(V_lds + (b) * SHM_V + vst) = sr_[i].v; *(u32x4*)(K_lds + (b) * SHM_K + kst0) = sr_[i].k0; if (k2) *(u32x4*)(K_lds + (b) * SHM_K + kst1) = sr_[i].k1; } while (0)
#define RESC(a) do { if (__any((a) < 1.f)) { if (hi == 0) al_l[r32] = (a); asm volatile("s_waitcnt lgkmcnt(0)" ::: "memory"); \
    _Pragma("unroll") for (int d = 0; d < 4; ++d) _Pragma("unroll") for (int r = 0; r < 16; ++r) o[d][r] *= al_l[crow(r, hi)]; } } while (0)
    f32x16 pA0, pA1, pB0, pB1; float mnA, mnB, alA, alB; i32x8 pa; constexpr int NT = SEQ / KVBLK;
    SLOAD(0, 0); asm volatile("s_waitcnt vmcnt(0)" ::: "memory"); SWRITE(0, 0); __syncthreads();
    qkt(pA0, pA1, K_lds, qr, r32, hi); partialSM(pA0, pA1, m_reg, mnA, alA);
    SLOAD(1, 1); SLOAD(0, 2);
    SWRITE(1, 1); __syncthreads();
    for (int j = 1; j + 1 < NT; j += 2) {
        SBAR(); qkt(pB0, pB1, K_lds + SHM_K, qr, r32, hi);
        finishSM(pA0, pA1, alA, l_reg, pa); SBAR();
        SLOAD(1, j + 2); SBAR();
        pv(o, V_lds, pa, r32, hi); partialSM(pB0, pB1, m_reg, mnB, alB);
        __syncthreads(); SWRITE(0, 0);
        RESC(alB); __syncthreads();
        SBAR(); qkt(pA0, pA1, K_lds, qr, r32, hi);
        finishSM(pB0, pB1, alB, l_reg, pa); SBAR();
        if (j + 3 < NT) SLOAD(0, j + 3); SBAR();
        pv(o, V_lds + SHM_V, pa, r32, hi); partialSM(pA0, pA1, m_reg, mnA, alA);
        __syncthreads(); SWRITE(1, 1);
        RESC(alA); __syncthreads();
    }
    SBAR(); qkt(pB0, pB1, K_lds + SHM_K, qr, r32, hi);
    finishSM(pA0, pA1, alA, l_reg, pa); SBAR();
    pv(o, V_lds, pa, r32, hi); partialSM(pB0, pB1, m_reg, mnB, alB);
    __syncthreads(); RESC(alB);
    finishSM(pB0, pB1, alB, l_reg, pa); SBAR();
    pv(o, V_lds + SHM_V, pa, r32, hi);
    if (hi == 0) li_l[r32] = l_reg; asm volatile("s_waitcnt lgkmcnt(0)" ::: "memory");
    float rli[16];
#pragma unroll
    for (int r = 0; r < 16; ++r) rli[r] = __builtin_amdgcn_rcpf(li_l[crow(r, hi)]);
    __syncthreads();
    bf16_t* ost = (bf16_t*)(lds + wid * 8192);
#pragma unroll
    for (int r = 0; r < 16; ++r) { const int orow = crow(r, hi);
#pragma unroll
        for (int d0 = 0; d0 < 4; ++d0) ost[orow * 128 + d0 * 32 + r32] = (bf16_t)f2bf(o[d0][r] * rli[r]); }
    asm volatile("s_waitcnt lgkmcnt(0)" ::: "memory");
    bf16_t* Ow = Ob + (long)(wid * QBLK) * DM;
#pragma unroll
    for (int i = 0; i < 8; ++i) { const int ch = lane + 64 * i, row = ch >> 4, c = ch & 15;
        const u32x4 v = *(const u32x4*)((const char*)ost + row * 256 + c * 16); *(u32x4*)(Ow + (long)row * DM + c * 8) = v; }
    __syncthreads();
#undef SLOAD
#undef SWRITE
#undef RESC
}

__device__ __forceinline__ float max3f(float a, float b, float c) { float r; asm("v_max3_f32 %0, %1, %2, %3" : "=v"(r) : "v"(a), "v"(b), "v"(c)); return r; }
__device__ __forceinline__ float max2f(float a, float b) { float r; asm("v_max_f32_e32 %0, %1, %2" : "=v"(r) : "v"(a), "v"(b)); return r; }
constexpr float THR2 = THR * 1.4426950408889634f;
__device__ __forceinline__ void softmax_seg(f32x16& p0, f32x16& p1, f32x16& negm, float& l_reg, f32x16* o, i32x8& pa, float* al_l, int r32, int hi) {
    float pmax = max3f(p0[0], p0[1], p0[2]);
#pragma unroll
    for (int r = 3; r < 15; r += 2) pmax = max3f(pmax, p0[r], p0[r + 1]);
    pmax = max3f(pmax, p0[15], p1[0]);
#pragma unroll
    for (int r = 1; r < 15; r += 2) pmax = max3f(pmax, p1[r], p1[r + 1]);
    pmax = max2f(pmax, p1[15]);
    { auto rr = __builtin_amdgcn_permlane32_swap(__float_as_uint(pmax), __float_as_uint(pmax), false, false);
      pmax = max2f(__uint_as_float(rr[0]), __uint_as_float(rr[1])); }
    float alpha = 1.f;
    if (!__builtin_expect(__all(pmax <= POFF + THR2), 1)) {
        const float d = fmaxf(pmax - POFF, 0.f);
        alpha = __builtin_amdgcn_exp2f(-d);
#pragma unroll
        for (int r = 0; r < 16; ++r) { p0[r] -= d; p1[r] -= d; negm[r] -= d; }
        if (hi == 0) al_l[r32] = alpha; asm volatile("s_waitcnt lgkmcnt(0)" ::: "memory");
#pragma unroll
        for (int dd = 0; dd < 4; ++dd)
#pragma unroll
            for (int r = 0; r < 16; ++r) o[dd][r] *= al_l[crow(r, hi)];
    }
    float ps = 0;
#pragma unroll
    for (int r = 0; r < 16; ++r) { p0[r] = __builtin_amdgcn_exp2f(p0[r]); ps += p0[r]; }
#pragma unroll
    for (int r = 0; r < 16; ++r) { p1[r] = __builtin_amdgcn_exp2f(p1[r]); ps += p1[r]; }
    { auto rr = __builtin_amdgcn_permlane32_swap(__float_as_uint(ps), __float_as_uint(ps), false, false);
      ps = __uint_as_float(rr[0]) + __uint_as_float(rr[1]); }
    l_reg = l_reg * alpha + ps;
#pragma unroll
    for (int g = 0; g < 4; ++g) { int w = 0; w = __builtin_amdgcn_cvt_pk_fp8_f32(p0[4 * g], p0[4 * g + 1], w, false); w = __builtin_amdgcn_cvt_pk_fp8_f32(p0[4 * g + 2], p0[4 * g + 3], w, true); pa[g] = w; }
#pragma unroll
    for (int g = 0; g < 4; ++g) { int w = 0; w = __builtin_amdgcn_cvt_pk_fp8_f32(p1[4 * g], p1[4 * g + 1], w, false); w = __builtin_amdgcn_cvt_pk_fp8_f32(p1[4 * g + 2], p1[4 * g + 3], w, true); pa[4 + g] = w; }
}
__device__ __forceinline__ f32x16 mfma8q(i32x8 a, i32x8 b, f32x16 c) { return __builtin_amdgcn_mfma_scale_f32_32x32x64_f8f6f4(a, b, c, 0, 0, 0, 0x7F7F7F7F, 0, 0x7C7C7C7C); }
template <bool DO_QK, bool DO_PV>
__device__ __forceinline__ void mfma_seg(f32x16& p0, f32x16& p1, const f32x16& negm, f32x16* o, const char* Ks, const char* Vs, const i32x8* qr, i32x8 pa, int r32, int hi) {
    i32x8 ka[3][2], vb[4];
    if (DO_QK) {
#pragma unroll
        for (int ks = 0; ks < 3; ++ks) { const int cb = ks * 64 + hi * 32; ka[ks][0] = ld32(Ks + r32 * KROW + cb); ka[ks][1] = ld32(Ks + (32 + r32) * KROW + cb); } }
    if (DO_PV) {
#pragma unroll
        for (int d0 = 0; d0 < 4; ++d0) vb[d0] = ld32(Vs + (32 * d0 + r32) * VROW + hi * 32); }
    SBAR();
    if (DO_QK) {
        p0 = mfma8q(ka[0][0], qr[0], negm); p1 = mfma8q(ka[0][1], qr[0], negm);
        p0 = mfma8q(ka[1][0], qr[1], p0); p1 = mfma8q(ka[1][1], qr[1], p1);
        p0 = mfma8q(ka[2][0], qr[2], p0); p1 = mfma8q(ka[2][1], qr[2], p1); }
    if (DO_PV) {
#pragma unroll
        for (int d0 = 0; d0 < 4; ++d0) o[d0] = mfma8(pa, vb[d0], o[d0]); }
}
__device__ __forceinline__ void attn_unit_pp(const unsigned char* __restrict__ Qb, const unsigned char* __restrict__ Kh, const unsigned char* __restrict__ Vt, bf16_t* __restrict__ Ob, char* lds, int tid) {
    const int wid = __builtin_amdgcn_readfirstlane(tid >> 6), lane = tid & 63, r32 = lane & 31, hi = lane >> 5;
    const bool halfB = wid >= 4;
    char* V_lds = lds + OFF_V; char* K_lds = lds + OFF_K;
    float* ws = (float*)(lds + OFF_WS) + wid * 64; float* li_l = ws; float* al_l = ws + 32;
    float l_reg = 0; f32x16 o[4] = {}; i32x8 qr[3]; f32x16 negm;
#pragma unroll
    for (int r = 0; r < 16; ++r) negm[r] = 60.f;
    const unsigned char* Qw = Qb + (long)(wid * QBLK + r32) * DQK + hi * 32;
#pragma unroll
    for (int ks = 0; ks < 3; ++ks) qr[ks] = ld32((const char*)Qw + ks * 64);
    const int kst0 = (tid / 12) * KROW + (tid % 12) * 16, kst1 = ((tid + 512) / 12) * KROW + ((tid + 512) % 12) * 16, vst = (tid >> 2) * VROW + (tid & 3) * 16;
    const bool k2 = wid < 4;
    constexpr int NT = SEQ / KVBLK;
    u32x4 sv, sk0, sk1 = {0u, 0u, 0u, 0u};
#define LOADK(t) do { const unsigned char* kp_ = Kh + (long)((t) < NT ? (t) : NT - 1) * 12288 + tid * 16; sk0 = *reinterpret_cast<const u32x4*>(kp_); if (k2) sk1 = *reinterpret_cast<const u32x4*>(kp_ + 8192); } while (0)
#define LOADV(t) do { sv = *reinterpret_cast<const u32x4*>(Vt + (long)((t) < NT ? (t) : NT - 1) * 8192 + tid * 16); } while (0)
#define WRITEK(b) do { *(u32x4*)(K_lds + (b) * SHM_K + kst0) = sk0; if (k2) *(u32x4*)(K_lds + (b) * SHM_K + kst1) = sk1; } while (0)
#define WRITEV(b) do { *(u32x4*)(V_lds + (b) * SHM_V + vst) = sv; } while (0)
#define BAR() do { SBAR(); __syncthreads(); SBAR(); } while (0)
    f32x16 p0, p1; i32x8 pa = {};
    LOADK(0); WRITEK(0); __syncthreads();
    LOADK(1); LOADV(0);
    if (halfB) BAR();
    WRITEK(1); WRITEV(0); LOADK(2); LOADV(1);
    mfma_seg<true, false>(p0, p1, negm, o, K_lds, V_lds, qr, pa, r32, hi);
    BAR();
    softmax_seg(p0, p1, negm, l_reg, o, pa, al_l, r32, hi);
    BAR();
    for (int t = 0; t < NT - 1; ++t) {
        const int b1 = (t + 1) & 1, b0 = t & 1;
        WRITEK(b0); WRITEV(b1); LOADK(t + 3); LOADV(t + 2);
        mfma_seg<true, true>(p0, p1, negm, o, K_lds + b1 * SHM_K, V_lds + b0 * SHM_V, qr, pa, r32, hi);
        BAR();
        softmax_seg(p0, p1, negm, l_reg, o, pa, al_l, r32, hi);
        BAR();
    }
    mfma_seg<false, true>(p0, p1, negm, o, K_lds, V_lds + ((NT - 1) & 1) * SHM_V, qr, pa, r32, hi);
    if (!halfB) BAR();
    if (hi == 0) li_l[r32] = l_reg; asm volatile("s_waitcnt lgkmcnt(0)" ::: "memory");
    float rli[16];
#pragma unroll
    for (int r = 0; r < 16; ++r) rli[r] = __builtin_amdgcn_rcpf(li_l[crow(r, hi)]);
    __syncthreads();
    bf16_t* ost = (bf16_t*)(lds + wid * 8192);
#pragma unroll
    for (int r = 0; r < 16; ++r) { const int orow = crow(r, hi);
#pragma unroll
        for (int d0 = 0; d0 < 4; ++d0) ost[orow * 128 + d0 * 32 + r32] = (bf16_t)f2bf(o[d0][r] * rli[r]); }
    asm volatile("s_waitcnt lgkmcnt(0)" ::: "memory");
    bf16_t* Ow = Ob + (long)(wid * QBLK) * DM;
#pragma unroll
    for (int i = 0; i < 8; ++i) { const int ch = lane + 64 * i, row = ch >> 4, c = ch & 15;
        const u32x4 v = *(const u32x4*)((const char*)ost + row * 256 + c * 16); *(u32x4*)(Ow + (long)row * DM + c * 8) = v; }
    __syncthreads();
#undef LOADK
#undef LOADV
#undef WRITEK
#undef WRITEV
#undef BAR
}
#undef SBAR
}

struct Args { const void* in[23]; float* out; unsigned char* ws; int ph_lo, ph_hi; };
enum { I_X = 0, I_POS, I_CNW, I_CWIN, I_CK, I_CWOUT, I_MNW, I_MWDOWN, I_MQLN, I_MKVLN, I_MWQ, I_MWKV, I_MQHN, I_MKHN, I_MWO, I_FNW, I_RWG, I_RBG, I_RWE, I_RBE, I_EWG, I_EWU, I_EWD };

struct CvtItem { const float* W; bf16_t* WT; const float* ksc; int K, N, k0, n0, drow0; };
__device__ __forceinline__ unsigned char* ldptr(int i);
constexpr int CVT_PER_J = 768 + 256 + 176 + 144 + 128 + 256;
constexpr int CVT_MIX = 2 * CVT_PER_J, CVT_EXP = MK_ENABLE_MOE ? 4 * NE * 288 : 0, CVT_ITEMS = CVT_MIX + CVT_EXP;
__device__ __forceinline__ void cvt_decode(int it, CvtItem& c, unsigned char* ws) {
    if (it < CVT_MIX) {
        const int j = it / CVT_PER_J; int r = it - j * CVT_PER_J; int kb, nb;
        if (r < 768) { c.K = 1024; c.N = 3072; c.W = (const float*)ldptr(I_CWIN) + (size_t)j * 1024 * 3072; c.WT = (bf16_t*)(ws + WS_WIN) + (size_t)j * 3072 * 1024; c.ksc = (const float*)ldptr(I_CNW) + j * 1024;
            kb = r / 48; nb = r % 48; const int n0 = nb * 64;
            if (n0 < 1024) c.drow0 = n0; else if (n0 < 2048) { const int q = n0 - 1024; c.drow0 = 1024 + (q >> 7) * 256 + (q & 127); } else { const int q = n0 - 2048; c.drow0 = 1024 + (q >> 7) * 256 + 128 + (q & 127); } }
        else if ((r -= 768) < 256) { c.K = 1024; c.N = 1024; c.W = (const float*)ldptr(I_CWOUT) + (size_t)j * 1024 * 1024; c.WT = (bf16_t*)(ws + WS_WOUTC) + (size_t)j * 1024 * 1024; c.ksc = nullptr; kb = r / 16; nb = r % 16; c.drow0 = nb * 64; }
        else if ((r -= 256) < 176) { c.K = 1024; c.N = LAT; c.W = (const float*)ldptr(I_MWDOWN) + (size_t)j * 1024 * LAT; c.WT = (bf16_t*)(ws + WS_WDOWN) + (size_t)j * LATP * 1024; c.ksc = (const float*)ldptr(I_MNW) + j * 1024; kb = r / 11; nb = r % 11; c.drow0 = nb * 64; }
        else if ((r -= 176) < 144) { c.K = QLR; c.N = NH * DQK; c.W = (const float*)ldptr(I_MWQ) + (size_t)j * QLR * NH * DQK; c.WT = (bf16_t*)(ws + WS_WQ + (size_t)j * 1536 * 1024); c.ksc = (const float*)ldptr(I_MQLN) + j * QLR; kb = r / 24; nb = r % 24; c.drow0 = nb * 64; }
        else if ((r -= 144) < 128) { c.K = KVLR; c.N = NH * 256; c.W = (const float*)ldptr(I_MWKV) + (size_t)j * KVLR * NH * 256; c.WT = (bf16_t*)(ws + WS_WKV) + (size_t)j * 2048 * 256; c.ksc = (const float*)ldptr(I_MKVLN) + j * KVLR; kb = r / 32; nb = r % 32; c.drow0 = nb * 64; }
        else { r -= 128; c.K = 1024; c.N = 1024; c.W = (const float*)ldptr(I_MWO) + (size_t)j * 1024 * 1024; c.WT = (bf16_t*)(ws + WS_WO) + (size_t)j * 1024 * 1024; c.ksc = nullptr; kb = r / 16; nb = r % 16; c.drow0 = nb * 64; }
        c.k0 = kb * 64; c.n0 = nb * 64;
    } else {
        const int r = it - CVT_MIX; const int le = r / 288, q = r - le * 288, L = le >> 6; const int kind = q / 96, idx = q - kind * 96; int kb, nb;
        if (kind < 2) { c.K = 1024; c.N = DFF; c.W = (const float*)ldptr(kind == 0 ? I_EWG : I_EWU) + (size_t)le * 1024 * DFF; c.WT = (bf16_t*)(ws + WS_WE1) + (size_t)le * 768 * 1024; c.ksc = (const float*)ldptr(I_FNW) + L * 1024;
            kb = idx / 6; nb = idx % 6; const int n0 = nb * 64; c.drow0 = (n0 >> 7) * 256 + kind * 128 + (n0 & 127); }
        else { c.K = DFF; c.N = 1024; c.W = (const float*)ldptr(I_EWD) + (size_t)le * DFF * 1024; c.WT = (bf16_t*)(ws + WS_WE2) + (size_t)le * 1024 * DFF; c.ksc = nullptr; kb = idx / 16; nb = idx % 16; c.drow0 = nb * 64; }
        c.k0 = kb * 64; c.n0 = nb * 64;
    }
}
__device__ __forceinline__ void cvt_load(const CvtItem& c, f32x4 (&v)[16], int lane) {
    const float* p = c.W + (size_t)(c.k0 + (lane >> 4)) * c.N + c.n0 + 4 * (lane & 15);
#pragma unroll
    for (int i = 0; i < 16; ++i) v[i] = *(const f32x4*)(p + (size_t)(4 * i) * c.N);
}
__device__ __forceinline__ void cvt_lds_write(LAS float* tile, const f32x4 (&v)[16], int lane) {
#pragma unroll
    for (int i = 0; i < 16; ++i) { const int r = 4 * i + (lane >> 4), n = 4 * (lane & 15), x = r & 31; LAS float* row = tile + r * 64;
        row[(n + 0) ^ x] = v[i].x; row[(n + 1) ^ x] = v[i].y; row[(n + 2) ^ x] = v[i].z; row[(n + 3) ^ x] = v[i].w; }
}
__device__ __forceinline__ void cvt_out(const CvtItem& c, const LAS float* tile, int lane) {
    const int cc = lane & 7, np = lane >> 3;
    f32x4 s0 = {1.f, 1.f, 1.f, 1.f}, s1 = {1.f, 1.f, 1.f, 1.f};
    if (c.ksc) { s0 = *(const f32x4*)(c.ksc + c.k0 + 8 * cc); s1 = *(const f32x4*)(c.ksc + c.k0 + 8 * cc + 4); }
#pragma unroll
    for (int jj = 0; jj < 8; ++jj) { const int n = np + 8 * jj; float t[8];
#pragma unroll
        for (int q = 0; q < 8; ++q) { const int k = 8 * cc + q; t[q] = tile[k * 64 + (n ^ (k & 31))]; }
        u32x4 o; o.x = pk2(t[0] * s0.x, t[1] * s0.y); o.y = pk2(t[2] * s0.z, t[3] * s0.w); o.z = pk2(t[4] * s1.x, t[5] * s1.y); o.w = pk2(t[6] * s1.z, t[7] * s1.w);
        *(GAS u32x4*)(c.WT + (size_t)(c.drow0 + n) * c.K + c.k0 + 8 * cc) = o; }
}

__device__ __forceinline__ void prologue_phase(LAS unsigned char* lds, int gw, int NGW, int wave, int lane, int gtid, int NGT) {
    unsigned char* ws = ldptr(24);
    LAS float* tile = (LAS float*)(lds + wave * 16384);
    {   CvtItem cur, nxt; f32x4 v[16]; int it = gw;
        if (it < CVT_ITEMS) { cvt_decode(it, cur, ws); cvt_load(cur, v, lane); }
        while (it < CVT_ITEMS) {
            cvt_lds_write(tile, v, lane);
            const int itn = it + NGW;
            if (itn < CVT_ITEMS) { cvt_decode(itn, nxt, ws); cvt_load(nxt, v, lane); }
            LDS_WAIT(); asm volatile("" ::: "memory");
            cvt_out(cur, tile, lane);
            LDS_WAIT(); asm volatile("" ::: "memory");
            cur = nxt; it = itn;
        }
    }
#if MK_ENABLE_MOE
    const float* fnw = (const float*)ldptr(I_FNW); const float* rwg = (const float*)ldptr(I_RWG); const float* rwe = (const float*)ldptr(I_RWE);
    for (int i = gtid; i < 4 * 256 * 128; i += NGT) {
        const int L = i >> 15, n = (i >> 7) & 255, k8 = (i & 127) * 8;
        u32x4 o = {0u, 0u, 0u, 0u};
        if (n < 72) { float v[8];
#pragma unroll
            for (int q = 0; q < 8; ++q) { const int k = k8 + q; const float g = fnw[L * 1024 + k];
                v[q] = g * (n < 8 ? rwg[((size_t)L * 1024 + k) * 8 + n] : rwe[((size_t)L * 1024 + k) * 64 + (n - 8)]); }
            o.x = pk2(v[0], v[1]); o.y = pk2(v[2], v[3]); o.z = pk2(v[4], v[5]); o.w = pk2(v[6], v[7]); }
        *(u32x4*)((bf16_t*)(ws + WS_WRT) + ((size_t)L * 256 + n) * 1024 + k8) = o;
    }
#endif
    for (int i = gtid; i < 2 * 64 * 128; i += NGT) { const int j = i >> 13, n = LAT + ((i >> 7) & 63), k8 = (i & 127) * 8;
        *(u32x4*)((bf16_t*)(ws + WS_WDOWN) + ((size_t)j * LATP + n) * 1024 + k8) = (u32x4){0u, 0u, 0u, 0u}; }
}

template <bool XF32_IN, bool F32_OUT>
__device__ __forceinline__ void resid_phase(const void* xin, const bf16_t* Y, void* xout, float* rinv, int gw, int NGW, int lane) {
    for (int m = gw; m < T; m += NGW) {
        f32x4 v[4];
        if constexpr (XF32_IN) { const f32x4* xr = (const f32x4*)((const float*)xin + (size_t)m * DM) + lane;
#pragma unroll
            for (int j = 0; j < 4; ++j) v[j] = xr[64 * j]; }
        else { const u32x2* xr = (const u32x2*)((const bf16_t*)xin + (size_t)m * DM) + lane;
#pragma unroll
            for (int j = 0; j < 4; ++j) { const u32x2 p = xr[64 * j]; v[j] = (f32x4){bflo(p.x), bfhi(p.x), bflo(p.y), bfhi(p.y)}; } }
        if (Y) { const u32x2* y0 = (const u32x2*)(Y + (size_t)(2 * m) * DM) + lane; const u32x2* y1 = y0 + 256;
#pragma unroll
            for (int j = 0; j < 4; ++j) { const u32x2 p = y0[64 * j], q = y1[64 * j];
                v[j].x += bflo(p.x) + bflo(q.x); v[j].y += bfhi(p.x) + bfhi(q.x); v[j].z += bflo(p.y) + bflo(q.y); v[j].w += bfhi(p.y) + bfhi(q.y); } }
        if constexpr (F32_OUT) { f32x4* xo = (f32x4*)((float*)xout + (size_t)m * DM) + lane;
#pragma unroll
            for (int j = 0; j < 4; ++j) xo[64 * j] = v[j]; }
        else { u32x2* xo = (u32x2*)((bf16_t*)xout + (size_t)m * DM) + lane;
#pragma unroll
            for (int j = 0; j < 4; ++j) { u32x2 w; w.x = pk2(v[j].x, v[j].y); w.y = pk2(v[j].z, v[j].w); xo[64 * j] = w; } }
        if (rinv) { float s = 0.f;
#pragma unroll
            for (int j = 0; j < 4; ++j) s += (v[j].x * v[j].x + v[j].y * v[j].y) + (v[j].z * v[j].z + v[j].w * v[j].w);
            const float r = 1.0f / sqrtf(wave_sum(s, lane) * (1.f / DM) + EPS);
            if (lane == 0) rinv[m] = r; }
    }
}

__device__ __forceinline__ void conv_phase(const bf16_t* GBp, const bf16_t* Zp, const float* ck, bf16_t* YCp, int gtid, int NGT) {
    for (int i = gtid; i < T * 128; i += NGT) {
        const int t = i >> 7, c8 = (i & 127) * 8, s = t & (SEQ - 1);
        const u32x4 zc = *(const u32x4*)(Zp + (size_t)t * DM + c8), g = *(const u32x4*)(GBp + (size_t)t * DM + c8);
        u32x4 zm = {0u, 0u, 0u, 0u}, zp = {0u, 0u, 0u, 0u};
        if (s > 0) zm = *(const u32x4*)(Zp + (size_t)(t - 1) * DM + c8);
        if (s < SEQ - 1) zp = *(const u32x4*)(Zp + (size_t)(t + 1) * DM + c8);
        const f32x4 k0a = *(const f32x4*)(ck + c8), k0b = *(const f32x4*)(ck + c8 + 4), k1a = *(const f32x4*)(ck + DM + c8), k1b = *(const f32x4*)(ck + DM + c8 + 4), k2a = *(const f32x4*)(ck + 2 * DM + c8), k2b = *(const f32x4*)(ck + 2 * DM + c8 + 4);
        float y[8];
#define CV(q, W, KA, LOHI) y[q] = LOHI(g.W) * (LOHI(zm.W) * k0##KA + LOHI(zc.W) * k1##KA + LOHI(zp.W) * k2##KA)
        CV(0, x, a[0], bflo); CV(1, x, a[1], bfhi); CV(2, y, a[2], bflo); CV(3, y, a[3], bfhi); CV(4, z, b[0], bflo); CV(5, z, b[1], bfhi); CV(6, w, b[2], bflo); CV(7, w, b[3], bfhi);
#undef CV
        u32x4 o; o.x = pk2(y[0], y[1]); o.y = pk2(y[2], y[3]); o.z = pk2(y[4], y[5]); o.w = pk2(y[6], y[7]);
        *(u32x4*)(YCp + (size_t)t * DM + c8) = o;
    }
}

__device__ __forceinline__ void qkprep_phase(const bf16_t* LATb, const bf16_t* QRAW, const bf16_t* KVRAW, const int* pos, const float* qhn, const float* khn,
                                             bf16_t* Qo, bf16_t* Ko, bf16_t* Vo, LAS unsigned char* lds, int gw, int NGW, int wave, int lane) {
    LAS unsigned char* sq = lds + wave * 10240;
    LAS float* cs = (LAS float*)(sq + 8704);
    const int h = lane >> 3, i8 = lane & 7;
    float gq[24], gk[24];
#pragma unroll
    for (int q = 0; q < 16; ++q) { gq[q] = qhn[16 * i8 + q]; gk[q] = khn[16 * i8 + q]; }
#pragma unroll
    for (int q = 0; q < 4; ++q) { gq[16 + q] = qhn[128 + 4 * i8 + q]; gq[20 + q] = qhn[160 + 4 * i8 + q]; gk[16 + q] = khn[128 + 4 * i8 + q]; gk[20 + q] = khn[160 + 4 * i8 + q]; }
    for (int t = gw; t < T; t += NGW) {
        const int b = t >> 14, s = t & (SEQ - 1);
        const u32x4* qs = (const u32x4*)(QRAW + (size_t)t * 1536); const u32x4* ks = (const u32x4*)(KVRAW + (size_t)t * 2048); const u32x4* ls = (const u32x4*)(LATb + (size_t)t * LATP);
        const u32x4 q0 = qs[lane], q1 = qs[lane + 64], q2 = qs[lane + 128], k0 = ks[lane], k1 = ks[lane + 64], k2 = ks[lane + 128], k3 = ks[lane + 192];
        const u32x4 l0 = ls[lane]; u32x4 l1 = {0u, 0u, 0u, 0u}; if (lane < 24) l1 = ls[lane + 64];
        LAS u32x4* d = (LAS u32x4*)sq;
        d[lane] = q0; d[lane + 64] = q1; d[lane + 128] = q2; d[192 + lane] = k0; d[192 + lane + 64] = k1; d[192 + lane + 128] = k2; d[192 + lane + 192] = k3;
        d[448 + lane] = l0; if (lane < 24) d[448 + lane + 64] = l1;
        float s0 = 0.f;
#define SS4(V_) (bflo(V_.x) * bflo(V_.x) + bfhi(V_.x) * bfhi(V_.x) + bflo(V_.y) * bflo(V_.y) + bfhi(V_.y) * bfhi(V_.y) + bflo(V_.z) * bflo(V_.z) + bfhi(V_.z) * bfhi(V_.z) + bflo(V_.w) * bflo(V_.w) + bfhi(V_.w) * bfhi(V_.w))
        s0 = SS4(l0); const float s1 = SS4(l1);
        const float ssq_q = wave_sum(lane < 48 ? s0 : 0.f, lane), ssq_kv = wave_sum((lane >= 48 ? s0 : 0.f) + (lane < 16 ? s1 : 0.f), lane);
        const float r_q = 1.0f / sqrtf(ssq_q * (1.f / QLR) + EPS), r_kv = 1.0f / sqrtf(ssq_kv * (1.f / KVLR) + EPS);
        if (lane < 32) { const float invf = powf(10000.f, -(float)lane * (1.f / 32.f)); const float ang = (float)pos[t] * invf;
            const double rev = (double)ang * 0.15915494309189535; const float fr = (float)(rev - floor(rev));
            cs[lane] = __builtin_amdgcn_cosf(fr); cs[32 + lane] = __builtin_amdgcn_sinf(fr); }
        LDS_WAIT(); asm volatile("" ::: "memory");
        float cj[4], sj[4];
#pragma unroll
        for (int q = 0; q < 4; ++q) { cj[q] = cs[4 * i8 + q]; sj[q] = cs[32 + 4 * i8 + q]; }
        {   const LAS bf16_t* qh = (const LAS bf16_t*)sq + h * DQK;
            const u32x4 a0 = *(const LAS u32x4*)(qh + 16 * i8), a1 = *(const LAS u32x4*)(qh + 16 * i8 + 8);
            const u32x2 r1 = *(const LAS u32x2*)(qh + 128 + 4 * i8), r2 = *(const LAS u32x2*)(qh + 160 + 4 * i8);
            float v[24];
            v[0] = bflo(a0.x); v[1] = bfhi(a0.x); v[2] = bflo(a0.y); v[3] = bfhi(a0.y); v[4] = bflo(a0.z); v[5] = bfhi(a0.z); v[6] = bflo(a0.w); v[7] = bfhi(a0.w);
            v[8] = bflo(a1.x); v[9] = bfhi(a1.x); v[10] = bflo(a1.y); v[11] = bfhi(a1.y); v[12] = bflo(a1.z); v[13] = bfhi(a1.z); v[14] = bflo(a1.w); v[15] = bfhi(a1.w);
            v[16] = bflo(r1.x); v[17] = bfhi(r1.x); v[18] = bflo(r1.y); v[19] = bfhi(r1.y); v[20] = bflo(r2.x); v[21] = bfhi(r2.x); v[22] = bflo(r2.y); v[23] = bfhi(r2.y);
            float ss = 0.f;
#pragma unroll
            for (int q = 0; q < 24; ++q) ss += v[q] * v[q];
            ss += lane_xor_f(ss, 1, lane); ss += lane_xor_f(ss, 2, lane); ss += lane_xor_f(ss, 4, lane);
            const float sc = r_q / sqrtf(r_q * r_q * ss * (1.f / DQK) + EPS);
#pragma unroll
            for (int q = 0; q < 24; ++q) v[q] *= sc * gq[q];
            bf16_t* qo = Qo + ((size_t)(b * NH + h) * SEQ + s) * DQK;
            u32x4 w0, w1; w0.x = pk2(v[0], v[1]); w0.y = pk2(v[2], v[3]); w0.z = pk2(v[4], v[5]); w0.w = pk2(v[6], v[7]); w1.x = pk2(v[8], v[9]); w1.y = pk2(v[10], v[11]); w1.z = pk2(v[12], v[13]); w1.w = pk2(v[14], v[15]);
            *(u32x4*)(qo + 16 * i8) = w0; *(u32x4*)(qo + 16 * i8 + 8) = w1;
            float o1[4], o2[4];
#pragma unroll
            for (int q = 0; q < 4; ++q) { o1[q] = v[16 + q] * cj[q] - v[20 + q] * sj[q]; o2[q] = v[20 + q] * cj[q] + v[16 + q] * sj[q]; }
            u32x2 e1, e2; e1.x = pk2(o1[0], o1[1]); e1.y = pk2(o1[2], o1[3]); e2.x = pk2(o2[0], o2[1]); e2.y = pk2(o2[2], o2[3]);
            *(u32x2*)(qo + 128 + 4 * i8) = e1; *(u32x2*)(qo + 160 + 4 * i8) = e2; }
        {   const LAS bf16_t* kh = (const LAS bf16_t*)(sq + 3072) + h * 256; const LAS bf16_t* lr = (const LAS bf16_t*)(sq + 7168) + 640;
            const u32x4 a0 = *(const LAS u32x4*)(kh + 16 * i8), a1 = *(const LAS u32x4*)(kh + 16 * i8 + 8);
            const u32x4 b0 = *(const LAS u32x4*)(kh + 128 + 16 * i8), b1 = *(const LAS u32x4*)(kh + 128 + 16 * i8 + 8);
            const u32x2 r1 = *(const LAS u32x2*)(lr + 4 * i8), r2 = *(const LAS u32x2*)(lr + 32 + 4 * i8);
            float v[24];
            v[0] = bflo(a0.x); v[1] = bfhi(a0.x); v[2] = bflo(a0.y); v[3] = bfhi(a0.y); v[4] = bflo(a0.z); v[5] = bfhi(a0.z); v[6] = bflo(a0.w); v[7] = bfhi(a0.w);
            v[8] = bflo(a1.x); v[9] = bfhi(a1.x); v[10] = bflo(a1.y); v[11] = bfhi(a1.y); v[12] = bflo(a1.z); v[13] = bfhi(a1.z); v[14] = bflo(a1.w); v[15] = bfhi(a1.w);
#pragma unroll
            for (int q = 0; q < 16; ++q) v[q] *= r_kv;
            v[16] = bflo(r1.x); v[17] = bfhi(r1.x); v[18] = bflo(r1.y); v[19] = bfhi(r1.y); v[20] = bflo(r2.x); v[21] = bfhi(r2.x); v[22] = bflo(r2.y); v[23] = bfhi(r2.y);
            float ss = 0.f;
#pragma unroll
            for (int q = 0; q < 24; ++q) ss += v[q] * v[q];
            ss += lane_xor_f(ss, 1, lane); ss += lane_xor_f(ss, 2, lane); ss += lane_xor_f(ss, 4, lane);
            const float sc = 1.0f / sqrtf(ss * (1.f / DQK) + EPS);
#pragma unroll
            for (int q = 0; q < 24; ++q) v[q] *= sc * gk[q];
            bf16_t* ko = Ko + ((size_t)(b * NH + h) * SEQ + s) * DQK;
            u32x4 w0, w1; w0.x = pk2(v[0], v[1]); w0.y = pk2(v[2], v[3]); w0.z = pk2(v[4], v[5]); w0.w = pk2(v[6], v[7]); w1.x = pk2(v[8], v[9]); w1.y = pk2(v[10], v[11]); w1.z = pk2(v[12], v[13]); w1.w = pk2(v[14], v[15]);
            *(u32x4*)(ko + 16 * i8) = w0; *(u32x4*)(ko + 16 * i8 + 8) = w1;
            float o1[4], o2[4];
#pragma unroll
            for (int q = 0; q < 4; ++q) { o1[q] = v[16 + q] * cj[q] - v[20 + q] * sj[q]; o2[q] = v[20 + q] * cj[q] + v[16 + q] * sj[q]; }
            u32x2 e1, e2; e1.x = pk2(o1[0], o1[1]); e1.y = pk2(o1[2], o1[3]); e2.x = pk2(o2[0], o2[1]); e2.y = pk2(o2[2], o2[3]);
            *(u32x2*)(ko + 128 + 4 * i8) = e1; *(u32x2*)(ko + 160 + 4 * i8) = e2;
            bf16_t* vo = Vo + ((size_t)(b * NH + h) * SEQ + s) * DV;
            u32x4 x0, x1;
            x0.x = pk2(bflo(b0.x) * r_kv, bfhi(b0.x) * r_kv); x0.y = pk2(bflo(b0.y) * r_kv, bfhi(b0.y) * r_kv); x0.z = pk2(bflo(b0.z) * r_kv, bfhi(b0.z) * r_kv); x0.w = pk2(bflo(b0.w) * r_kv, bfhi(b0.w) * r_kv);
            x1.x = pk2(bflo(b1.x) * r_kv, bfhi(b1.x) * r_kv); x1.y = pk2(bflo(b1.y) * r_kv, bfhi(b1.y) * r_kv); x1.z = pk2(bflo(b1.z) * r_kv, bfhi(b1.z) * r_kv); x1.w = pk2(bflo(b1.w) * r_kv, bfhi(b1.w) * r_kv);
            *(u32x4*)(vo + 16 * i8) = x0; *(u32x4*)(vo + 16 * i8 + 8) = x1; }
        LDS_WAIT(); asm volatile("" ::: "memory");
    }
#undef SS4
}


__device__ __forceinline__ unsigned pk4_fp8(float a, float b, float c, float d) { int w = 0; w = __builtin_amdgcn_cvt_pk_fp8_f32(a, b, w, false); w = __builtin_amdgcn_cvt_pk_fp8_f32(c, d, w, true); return (unsigned)w; }
__device__ __forceinline__ void ld16bf(const bf16_t* p, float* v) { const u32x4 a = *(const u32x4*)p, b = *(const u32x4*)(p + 8);
    v[0] = bflo(a.x); v[1] = bfhi(a.x); v[2] = bflo(a.y); v[3] = bfhi(a.y); v[4] = bflo(a.z); v[5] = bfhi(a.z); v[6] = bflo(a.w); v[7] = bfhi(a.w);
    v[8] = bflo(b.x); v[9] = bfhi(b.x); v[10] = bflo(b.y); v[11] = bfhi(b.y); v[12] = bflo(b.z); v[13] = bfhi(b.z); v[14] = bflo(b.w); v[15] = bfhi(b.w); }
__device__ __forceinline__ void ld4bf(const bf16_t* p, float* v) { const u32x2 a = *(const u32x2*)p; v[0] = bflo(a.x); v[1] = bfhi(a.x); v[2] = bflo(a.y); v[3] = bfhi(a.y); }
__device__ __forceinline__ void qkprep8_phase(const bf16_t* LATb, const bf16_t* QRAW, const bf16_t* KVRAW, const int* pos, const float* qhn, const float* khn,
                                              unsigned char* Q8, unsigned char* K8, unsigned char* VT8, LAS unsigned char* lds, int vcu, int G, int wave, int lane, int tid) {
    const int h = lane >> 3, i8 = lane & 7;
    float gq[24], gk[24], invf[4];
#pragma unroll
    for (int q = 0; q < 16; ++q) { gq[q] = qhn[16 * i8 + q]; gk[q] = khn[16 * i8 + q]; }
#pragma unroll
    for (int q = 0; q < 4; ++q) { gq[16 + q] = qhn[128 + 4 * i8 + q]; gq[20 + q] = qhn[160 + 4 * i8 + q]; gk[16 + q] = khn[128 + 4 * i8 + q]; gk[20 + q] = khn[160 + 4 * i8 + q];
        invf[q] = powf(10000.f, -(float)(4 * i8 + q) * (1.f / 32.f)); }
    for (int tile = vcu; tile < T / 64; tile += G) {
        for (int tt = 0; tt < 8; ++tt) {
            const int kk = wave * 8 + tt, t = tile * 64 + kk, b = t >> 14, s = t & (SEQ - 1);
            const u32x4* ls = (const u32x4*)(LATb + (size_t)t * LATP);
            const u32x4 l0 = ls[lane]; u32x4 l1 = {0u, 0u, 0u, 0u}; if (lane < 24) l1 = ls[lane + 64];
#define SS4(V_) (bflo(V_.x) * bflo(V_.x) + bfhi(V_.x) * bfhi(V_.x) + bflo(V_.y) * bflo(V_.y) + bfhi(V_.y) * bfhi(V_.y) + bflo(V_.z) * bflo(V_.z) + bfhi(V_.z) * bfhi(V_.z) + bflo(V_.w) * bflo(V_.w) + bfhi(V_.w) * bfhi(V_.w))
            const float s0 = SS4(l0), s1 = SS4(l1);
#undef SS4
            const float ssq_q = wave_sum(lane < 48 ? s0 : 0.f, lane), ssq_kv = wave_sum((lane >= 48 ? s0 : 0.f) + (lane < 16 ? s1 : 0.f), lane);
            const float r_q = 1.0f / sqrtf(ssq_q * (1.f / QLR) + EPS), r_kv = 1.0f / sqrtf(ssq_kv * (1.f / KVLR) + EPS);
            float cj[4], sj[4]; const float fpos = (float)pos[t];
#pragma unroll
            for (int q = 0; q < 4; ++q) { const float ang = fpos * invf[q]; const double rev = (double)ang * 0.15915494309189535; const float fr = (float)(rev - floor(rev));
                cj[q] = __builtin_amdgcn_cosf(fr); sj[q] = __builtin_amdgcn_sinf(fr); }
            const size_t orow = ((size_t)(b * NH + h) * SEQ + s) * DQK;
            {
                const bf16_t* qh = QRAW + (size_t)t * 1536 + h * DQK; float v[24];
                ld16bf(qh + 16 * i8, v); ld4bf(qh + 128 + 4 * i8, v + 16); ld4bf(qh + 160 + 4 * i8, v + 20);
                float ss = 0.f;
#pragma unroll
                for (int q = 0; q < 24; ++q) ss += v[q] * v[q];
                ss += lane_xor_f(ss, 1, lane); ss += lane_xor_f(ss, 2, lane); ss += lane_xor_f(ss, 4, lane);
                const float sc = r_q / sqrtf(r_q * r_q * ss * (1.f / DQK) + EPS) * (ATT_PP ? 8.f * 0.07216878364870322f * 1.4426950408889634f : 1.f);
#pragma unroll
                for (int q = 0; q < 24; ++q) v[q] *= sc * gq[q];
                u32x4 w; w.x = pk4_fp8(v[0], v[1], v[2], v[3]); w.y = pk4_fp8(v[4], v[5], v[6], v[7]); w.z = pk4_fp8(v[8], v[9], v[10], v[11]); w.w = pk4_fp8(v[12], v[13], v[14], v[15]);
                *(u32x4*)(Q8 + orow + 16 * i8) = w;
                float o1[4], o2[4];
#pragma unroll
                for (int q = 0; q < 4; ++q) { o1[q] = v[16 + q] * cj[q] - v[20 + q] * sj[q]; o2[q] = v[20 + q] * cj[q] + v[16 + q] * sj[q]; }
                *(unsigned*)(Q8 + orow + 128 + 4 * i8) = pk4_fp8(o1[0], o1[1], o1[2], o1[3]); *(unsigned*)(Q8 + orow + 160 + 4 * i8) = pk4_fp8(o2[0], o2[1], o2[2], o2[3]); }
            {
                const bf16_t* kh = KVRAW + (size_t)t * 2048 + h * 256; const bf16_t* lr = LATb + (size_t)t * LATP + 640; float v[24], vv[16];
                ld16bf(kh + 16 * i8, v); ld4bf(lr + 4 * i8, v + 16); ld4bf(lr + 32 + 4 * i8, v + 20); ld16bf(kh + 128 + 16 * i8, vv);
#pragma unroll
                for (int q = 0; q < 16; ++q) v[q] *= r_kv;
                float ss = 0.f;
#pragma unroll
                for (int q = 0; q < 24; ++q) ss += v[q] * v[q];
                ss += lane_xor_f(ss, 1, lane); ss += lane_xor_f(ss, 2, lane); ss += lane_xor_f(ss, 4, lane);
                const float sc = 1.0f / sqrtf(ss * (1.f / DQK) + EPS);
#pragma unroll
                for (int q = 0; q < 24; ++q) v[q] *= sc * gk[q];
                u32x4 w; w.x = pk4_fp8(v[0], v[1], v[2], v[3]); w.y = pk4_fp8(v[4], v[5], v[6], v[7]); w.z = pk4_fp8(v[8], v[9], v[10], v[11]); w.w = pk4_fp8(v[12], v[13], v[14], v[15]);
                *(u32x4*)(K8 + orow + 16 * i8) = w;
                float o1[4], o2[4];
#pragma unroll
                for (int q = 0; q < 4; ++q) { o1[q] = v[16 + q] * cj[q] - v[20 + q] * sj[q]; o2[q] = v[20 + q] * cj[q] + v[16 + q] * sj[q]; }
                *(unsigned*)(K8 + orow + 128 + 4 * i8) = pk4_fp8(o1[0], o1[1], o1[2], o1[3]); *(unsigned*)(K8 + orow + 160 + 4 * i8) = pk4_fp8(o2[0], o2[1], o2[2], o2[3]);
                const int low5 = kk & 31, hh = (low5 >> 2) & 1, rr = (low5 & 3) + 4 * (low5 >> 3), posb = hh * 32 + rr + 16 * (kk >> 5);
                LAS unsigned char* vt = lds + h * 8192 + (16 * i8) * 64 + posb;
#pragma unroll
                for (int q = 0; q < 4; ++q) { const unsigned w4 = pk4_fp8(vv[4 * q] * r_kv, vv[4 * q + 1] * r_kv, vv[4 * q + 2] * r_kv, vv[4 * q + 3] * r_kv);
                    vt[(4 * q) * 64] = (unsigned char)w4; vt[(4 * q + 1) * 64] = (unsigned char)(w4 >> 8); vt[(4 * q + 2) * 64] = (unsigned char)(w4 >> 16); vt[(4 * q + 3) * 64] = (unsigned char)(w4 >> 24); } }
        }
        __syncthreads();
        {   const int t0 = tile * 64, b = t0 >> 14, st = (t0 & (SEQ - 1)) >> 6;
#pragma unroll
            for (int i = 0; i < 8; ++i) { const int ch = tid + 512 * i, hh = ch >> 9, off = (ch & 511) * 16;
                *(u32x4*)(VT8 + ((size_t)(b * NH + hh) * (SEQ / 64) + st) * 8192 + off) = *(const LAS u32x4*)(lds + hh * 8192 + off); } }
        __syncthreads();
    }
}

__device__ __forceinline__ void route_phase(const float* LG, const float* bg, const float* be, gu32* cnt, int* eid, int* rank, float* gate, int gtid, int NGT) {
    for (int t = gtid; t < T; t += NGT) {
        const float* lg = LG + (size_t)t * 128;
        float gl[8];
        { const f32x4 a = *(const f32x4*)lg, b = *(const f32x4*)(lg + 4); gl[0] = a.x; gl[1] = a.y; gl[2] = a.z; gl[3] = a.w; gl[4] = b.x; gl[5] = b.y; gl[6] = b.z; gl[7] = b.w; }
        float gm = gl[0]; int gs = 0; float bm = gl[0] + bg[0];
#pragma unroll
        for (int q = 1; q < 8; ++q) { gm = fmaxf(gm, gl[q]); const float v = gl[q] + bg[q]; if (v > bm) { bm = v; gs = q; } }
        float gsum = 0.f, gsel = 0.f;
#pragma unroll
        for (int q = 0; q < 8; ++q) { const float e = __expf(gl[q] - gm); gsum += e; gsel = (q == gs) ? e : gsel; }
        const float g_gate = gsel / gsum;
        float el[8];
        { const f32x4 a = *(const f32x4*)(lg + 8 + gs * 8), b = *(const f32x4*)(lg + 12 + gs * 8); el[0] = a.x; el[1] = a.y; el[2] = a.z; el[3] = a.w; el[4] = b.x; el[5] = b.y; el[6] = b.z; el[7] = b.w; }
        int i0 = 0; float v0 = el[0] + be[gs * 8];
#pragma unroll
        for (int q = 1; q < 8; ++q) { const float v = el[q] + be[gs * 8 + q]; if (v > v0) { v0 = v; i0 = q; } }
        int i1 = -1; float v1 = -3.0e38f;
#pragma unroll
        for (int q = 0; q < 8; ++q) { const float v = el[q] + be[gs * 8 + q]; if (q != i0 && v > v1) { v1 = v; i1 = q; } }
        float l0 = 0.f, l1 = 0.f;
#pragma unroll
        for (int q = 0; q < 8; ++q) { l0 = (q == i0) ? el[q] : l0; l1 = (q == i1) ? el[q] : l1; }
        const float mm = fmaxf(l0, l1), p0 = __expf(l0 - mm), p1 = __expf(l1 - mm), inv = 1.f / (p0 + p1);
        const int e0 = gs * 8 + i0, e1 = gs * 8 + i1;
        const unsigned r0 = __hip_atomic_fetch_add(cnt + e0, 1u, RLX_AGENT), r1 = __hip_atomic_fetch_add(cnt + e1, 1u, RLX_AGENT);
        eid[2 * t] = e0; eid[2 * t + 1] = e1; rank[2 * t] = (int)r0; rank[2 * t + 1] = (int)r1; gate[2 * t] = g_gate * p0 * inv; gate[2 * t + 1] = g_gate * p1 * inv;
    }
}

__device__ __forceinline__ int build_tables(gu32* cnt, LAS int* tbl, LAS int* pstart, int tid) {
    if (tid < 64) {
        const int c = (int)__hip_atomic_load(cnt + tid, RLX_AGENT); const int pad = (c + 255) & ~255;
        int incl = pad;
#pragma unroll
        for (int o = 1; o < 64; o <<= 1) { const int v = __builtin_amdgcn_ds_bpermute((tid - o) << 2, incl); if (tid >= o) incl += v; }
        const int start = incl - pad; pstart[tid] = start; if (tid == 63) pstart[64] = incl;
        for (int q = start >> 8; q < (incl >> 8); ++q) tbl[q] = tid;
    }
    __syncthreads();
    return pstart[64] >> 8;
}

__device__ __forceinline__ void scatter_phase(const int* eid, const int* rank, const float* gate, const float* rinv, gu32* cnt, int* stok, int* sdest, float* sgate, float* sscale, const LAS int* pstart, int gtid, int NGT) {
    for (int a = gtid; a < NASSIGN; a += NGT) { const int slot = pstart[eid[a]] + rank[a]; stok[slot] = a >> 1; sdest[slot] = a; sgate[slot] = gate[a]; sscale[slot] = rinv[a >> 1]; }
    for (int i = gtid; i < NE * 256; i += NGT) { const int e = i >> 8, q = i & 255; const int c = (int)__hip_atomic_load(cnt + e, RLX_AGENT); const int pad = (c + 255) & ~255;
        if (c + q < pad) { const int slot = pstart[e] + c + q; stok[slot] = 0; sdest[slot] = -1; sgate[slot] = 0.f; sscale[slot] = 0.f; } }
}

constexpr int PTAB_OFF = MISC_OFF + 128;
__device__ __forceinline__ unsigned char* ldptr(int i) {
    extern __shared__ __attribute__((aligned(16))) unsigned char lds_raw[];
    volatile LAS unsigned* pt = (volatile LAS unsigned*)((LAS unsigned char*)lds_raw + PTAB_OFF) + 2 * sgpr_now(i);
    const unsigned lo = __builtin_amdgcn_readfirstlane(pt[0]), hi = __builtin_amdgcn_readfirstlane(pt[1]);
    return (unsigned char*)(GAS unsigned char*)(((unsigned long long)hi << 32) | lo);
}
#define P_IN(i) ((const float*)ldptr(i))
#define P_OUT() ((float*)ldptr(23))
#define P_WS() (ldptr(24))
__device__ __forceinline__ void grid_barrier(int tid) {
    extern __shared__ __attribute__((aligned(16))) unsigned char lds_raw[];
    XcdBarrier b; b.bar = (unsigned*)(P_WS() + WS_CTL) + CW_BAR; b.x = xb_xcc_id(); b.st = (volatile LAS unsigned*)((LAS unsigned char*)lds_raw + MISC_OFF) + 8;
    xcd_barrier(b, tid == 0);
}

__global__ void __launch_bounds__(NWAVES * 64, 2) fwd(Args args) {
    extern __shared__ __attribute__((aligned(16))) unsigned char lds_raw[];
    LAS unsigned char* lds = (LAS unsigned char*)lds_raw;
    for (int u = threadIdx.x; u < (LDS_BYTES - LDSCTL_OFF) / 4; u += NWAVES * 64) ((LAS unsigned*)(lds + LDSCTL_OFF))[u] = 0u;
    __syncthreads();
    if (threadIdx.x == 0) { LAS unsigned long long* pt = (LAS unsigned long long*)(lds + PTAB_OFF);
#pragma unroll
        for (int i = 0; i < 23; ++i) pt[i] = (unsigned long long)args.in[i];
        pt[23] = (unsigned long long)args.out; pt[24] = (unsigned long long)args.ws; }
    __syncthreads();
    const int lo = args.ph_lo, hi = args.ph_hi;
    if (hi - lo > 1) (void)xcd_barrier_post((unsigned*)(P_WS() + WS_CTL) + CW_BAR, (volatile LAS unsigned*)(lds + MISC_OFF) + 8, threadIdx.x == 0);
    const int wave_s = __builtin_amdgcn_readfirstlane((int)threadIdx.x >> 6);
#define IN(k) (lo <= (k) && (k) < hi)
#define SEAM(k) do { if (hi > (k) + 1) grid_barrier(TID); } while (0)
#define TID (tid_now(wave_s))
#define LANE (tid_now(wave_s) & 63)
#define WAVE (sgpr_now(wave_s))
#define GRID (sgpr_now((int)gridDim.x))
#define BX (sgpr_now((int)blockIdx.x))
#define VCU ((GRID % 8 == 0) ? (BX % 8) * (GRID / 8) + BX / 8 : BX)
#define GW (VCU * NWAVES + WAVE)
#define NGW (GRID * NWAVES)
#define GTID (BX * (NWAVES * 64) + TID)
#define NGT (GRID * NWAVES * 64)
#define TBL ((LAS int*)(lds + TBL_OFF))
#define PSTART (TBL + 384)

    if (IN(0)) { for (int rep = 0; rep < REP_PRO; ++rep) prologue_phase(lds, GW, NGW, WAVE, LANE, GTID, NGT); SEAM(0); }

    for (int L = 0; L < 4; ++L) {
        const int pb = 1 + 12 * L;
#define XBP ((bf16_t*)(ws + WS_XB))
#define RINVP ((float*)(ws + WS_RINV))
#define PSQP ((float*)(ws + WS_PSQ))
#define YP ((const bf16_t*)(ws + WS_Y))
        if (IN(pb + 0)) { unsigned char* ws = P_WS();
            if (L == 0) resid_phase<true, false>(P_IN(I_X), nullptr, XBP, RINVP, GW, NGW, LANE);
            else resid_phase<false, false>(XBP, MK_ENABLE_MOE ? YP : nullptr, XBP, RINVP, GW, NGW, LANE);
            SEAM(pb + 0); }
        if ((L & 1) == 0) {
            if (IN(pb + 1)) { unsigned char* ws = P_WS(); const int j = L >> 1;
                pg8::Gemm g{DM, DM, nullptr}; pg8::StaticOrder S; S.init(ws + WS_XB, DM, (bf16_t*)(ws + WS_WIN) + (size_t)j * 3072 * 1024, DM, T, 3072, GRID, BX);
                pg8::EpiConvIn E{(bf16_t*)(ws + WS_GB), (bf16_t*)(ws + WS_Z), RINVP}; for (int rep_ = 0; rep_ < REP_GEMM; ++rep_) pg8::gemm_phase(lds, g, S, E, TID); SEAM(pb + 1); }
            if (IN(pb + 2)) { unsigned char* ws = P_WS(); const int j = L >> 1;
                for (int rep_ = 0; rep_ < REP_THIN; ++rep_) conv_phase((const bf16_t*)(ws + WS_GB), (const bf16_t*)(ws + WS_Z), P_IN(I_CK) + j * 3 * DM, (bf16_t*)(ws + WS_YC), GTID, NGT); SEAM(pb + 2); }
            if (IN(pb + 3)) { unsigned char* ws = P_WS(); const int j = L >> 1;
                pg8::Gemm g{DM, DM, nullptr}; pg8::StaticOrder S; S.init(ws + WS_YC, DM, (bf16_t*)(ws + WS_WOUTC) + (size_t)j * 1024 * 1024, DM, T, DM, GRID, BX);
                pg8::EpiResid E{XBP, PSQP, LANE}; pg8::gemm_phase(lds, g, S, E, TID); SEAM(pb + 5); }
        } else {
            if (IN(pb + 1)) { unsigned char* ws = P_WS(); const int j = L >> 1;
                pg8::Gemm g{DM, DM, nullptr}; pg8::StaticOrder S; S.init(ws + WS_XB, DM, (bf16_t*)(ws + WS_WDOWN) + (size_t)j * LATP * 1024, DM, T, LATP, GRID, BX);
                pg8::EpiBf16 E{(bf16_t*)(ws + WS_LAT), LATP, RINVP}; for (int rep_ = 0; rep_ < REP_GEMM; ++rep_) pg8::gemm_phase(lds, g, S, E, TID); SEAM(pb + 1); }
            if (IN(pb + 2)) {
                { unsigned char* ws = P_WS(); const int j = L >> 1;
                  pg8::Gemm g{LATP, QLR, nullptr}; pg8::StaticOrder S; S.init(ws + WS_LAT, LATP, ws + WS_WQ + (size_t)j * 1536 * 1024, QLR, T, 1536, GRID, BX);
                  pg8::EpiBf16 E{(bf16_t*)(ws + WS_QRAW), 1536, nullptr}; for (int rep_ = 0; rep_ < REP_GEMM; ++rep_) pg8::gemm_phase(lds, g, S, E, TID); }
                { unsigned char* ws = P_WS(); const int j = L >> 1;
                  pg8::Gemm g{LATP, KVLR, nullptr}; pg8::StaticOrder S; S.init((bf16_t*)(ws + WS_LAT) + QLR, LATP, (bf16_t*)(ws + WS_WKV) + (size_t)j * 2048 * 256, KVLR, T, 2048, GRID, BX);
                  pg8::EpiBf16 E{(bf16_t*)(ws + WS_KVRAW), 2048, nullptr}; for (int rep_ = 0; rep_ < REP_GEMM; ++rep_) pg8::gemm_phase(lds, g, S, E, TID); }
                SEAM(pb + 2); }
#if ATT_FP8
            if (IN(pb + 3)) { unsigned char* ws = P_WS(); const int j = L >> 1;
                for (int rep_ = 0; rep_ < REP_THIN; ++rep_) qkprep8_phase((const bf16_t*)(ws + WS_LAT), (const bf16_t*)(ws + WS_QRAW), (const bf16_t*)(ws + WS_KVRAW), (const int*)P_IN(I_POS),
                              P_IN(I_MQHN) + j * DQK, P_IN(I_MKHN) + j * DQK, ws + WS_Q, ws + WS_K, ws + WS_V, lds, VCU, GRID, WAVE, LANE, TID); SEAM(pb + 3); }
#else
            if (IN(pb + 3)) { unsigned char* ws = P_WS(); const int j = L >> 1;
                qkprep_phase((const bf16_t*)(ws + WS_LAT), (const bf16_t*)(ws + WS_QRAW), (const bf16_t*)(ws + WS_KVRAW), (const int*)P_IN(I_POS),
                             P_IN(I_MQHN) + j * DQK, P_IN(I_MKHN) + j * DQK, (bf16_t*)(ws + WS_Q), (bf16_t*)(ws + WS_K), (bf16_t*)(ws + WS_V), lds, GW, NGW, WAVE, LANE); SEAM(pb + 3); }
#endif
            if (IN(pb + 4)) {
              for (int rep = 0; rep < REP_ATT; ++rep)
                for (int i = 0;; ++i) {
                    int bh, qb;
                    if (GRID == 256) { if (i >= 4) break; const int idx = i * 32 + (VCU & 31); bh = 2 * (VCU >> 5) + (idx >> 6); qb = idx & 63; }
                    else { const int k = i * GRID + BX; if (k >= NB * NH * 64) break; bh = k >> 6; qb = k & 63; }
                    const int b = bh >> 3, h = bh & 7; unsigned char* ws = P_WS();
#if ATT_FP8 && ATT_PP
                    att8::attn_unit_pp(ws + WS_Q + ((size_t)bh * SEQ + qb * 256) * DQK, ws + WS_K + (size_t)bh * SEQ * DQK, ws + WS_V + (size_t)bh * SEQ * DV,
                                       (bf16_t*)(ws + WS_O) + ((size_t)(b * SEQ + qb * 256)) * DM + h * DV, (char*)lds_raw, TID);
#elif ATT_FP8
                    att8::attn_unit(ws + WS_Q + ((size_t)bh * SEQ + qb * 256) * DQK, ws + WS_K + (size_t)bh * SEQ * DQK, ws + WS_V + (size_t)bh * SEQ * DV,
                                    (bf16_t*)(ws + WS_O) + ((size_t)(b * SEQ + qb * 256)) * DM + h * DV, (char*)lds_raw, TID);
#else
                    att::attn_unit((const bf16_t*)(ws + WS_Q) + ((size_t)bh * SEQ + qb * 256) * DQK, (const bf16_t*)(ws + WS_K) + (size_t)bh * SEQ * DQK, (const bf16_t*)(ws + WS_V) + (size_t)bh * SEQ * DV,
                                   (bf16_t*)(ws + WS_O) + ((size_t)(b * SEQ + qb * 256)) * DM + h * DV, (char*)lds_raw, TID);
#endif
                }
                SEAM(pb + 4); }
            if (IN(pb + 5)) { unsigned char* ws = P_WS(); const int j = L >> 1;
                pg8::Gemm g{DM, DM, nullptr}; pg8::StaticOrder S; S.init(ws + WS_O, DM, (bf16_t*)(ws + WS_WO) + (size_t)j * 1024 * 1024, DM, T, DM, GRID, BX);
                pg8::EpiResid E{XBP, PSQP, LANE}; pg8::gemm_phase(lds, g, S, E, TID); SEAM(pb + 5); }
        }
#if MK_ENABLE_MOE
#define CNT ((gu32*)(ws + WS_CTL) + CW_CNT + L * 64)
#define EID ((int*)(ws + WS_RT + RT_EID))
#define RANK ((int*)(ws + WS_RT + RT_RANK))
#define GATE ((float*)(ws + WS_RT + RT_GATE))
#define SDEST ((int*)(ws + WS_RT + RT_SDEST))
#define SGATE ((float*)(ws + WS_RT + RT_SGATE))
#define STOK ((int*)(ws + WS_RT + RT_STOK))
#define SSCALE ((float*)(ws + WS_RT + RT_SSCALE))
        if (IN(pb + 7)) { unsigned char* ws = P_WS();
            pg8::Gemm g{DM, DM, nullptr}; pg8::StaticOrder S; S.init(ws + WS_XB, DM, (bf16_t*)(ws + WS_WRT) + (size_t)L * 256 * 1024, DM, T, 256, GRID, BX);
            { pg8::Unit u0; const int t_ = TID;
              if (S.next(0, u0) && t_ < 256) { const f32x4* q = (const f32x4*)(PSQP + (size_t)(u0.pm * 256 + t_) * 16); const f32x4 a = q[0], b = q[1], c = q[2], d = q[3];
                  const float ssum = ((a.x + a.y) + (a.z + a.w)) + ((b.x + b.y) + (b.z + b.w)) + ((c.x + c.y) + (c.z + c.w)) + ((d.x + d.y) + (d.z + d.w));
                  RINVP[u0.pm * 256 + t_] = 1.0f / sqrtf(ssum * (1.f / DM) + EPS); }
              VM_WAIT(); __syncthreads(); }
            pg8::EpiLogits E{(float*)(ws + WS_LG), RINVP}; for (int rep_ = 0; rep_ < REP_GEMM; ++rep_) pg8::gemm_phase(lds, g, S, E, TID); SEAM(pb + 7); }
        if (IN(pb + 8)) { unsigned char* ws = P_WS();
            route_phase((const float*)(ws + WS_LG), P_IN(I_RBG) + L * 8, P_IN(I_RBE) + L * 64, CNT, EID, RANK, GATE, GTID, NGT); SEAM(pb + 8); }
        if (IN(pb + 9)) { unsigned char* ws = P_WS(); build_tables(CNT, TBL, PSTART, TID);
            scatter_phase(EID, RANK, GATE, RINVP, CNT, STOK, SDEST, SGATE, SSCALE, PSTART, GTID, NGT); SEAM(pb + 9); }
        if (IN(pb + 10)) { unsigned char* ws = P_WS(); const int ntiles = build_tables(CNT, TBL, PSTART, TID);
            pg8::Gemm g{DM, DM, STOK}; pg8::GroupedOrder S{ntiles * 3, 3, GRID, VCU, (const char*)(ws + WS_XB), (const char*)(ws + WS_WE1) + (size_t)L * NE * 768 * 1024 * 2, (size_t)0, (size_t)768 * 1024 * 2, (size_t)256 * 1024 * 2, TBL};
            pg8::EpiSwiGLU E{(bf16_t*)(ws + WS_HID), SSCALE}; for (int rep_ = 0; rep_ < REP_GEMM; ++rep_) pg8::gemm_phase<true>(lds, g, S, E, TID); SEAM(pb + 10); }
        if (IN(pb + 11)) { unsigned char* ws = P_WS(); const int ntiles = build_tables(CNT, TBL, PSTART, TID);
            pg8::Gemm g{DFF, DFF, nullptr}; pg8::GroupedOrder S{ntiles * 4, 4, GRID, VCU, (const char*)(ws + WS_HID), (const char*)(ws + WS_WE2) + (size_t)L * NE * 1024 * DFF * 2, (size_t)256 * DFF * 2, (size_t)1024 * DFF * 2, (size_t)256 * DFF * 2, TBL};
            pg8::EpiScatterY E{(bf16_t*)(ws + WS_Y), SDEST, SGATE}; for (int rep_ = 0; rep_ < REP_GEMM; ++rep_) pg8::gemm_phase(lds, g, S, E, TID); SEAM(pb + 11); }
#endif
    }
    if (IN(49)) { unsigned char* ws = P_WS(); resid_phase<false, true>(XBP, MK_ENABLE_MOE ? YP : nullptr, P_OUT(), nullptr, GW, NGW, LANE); }
#undef IN
#undef SEAM
}

extern "C" void kernel_launch(void* const* d_in, const int* in_sizes, int n_in, void* d_out, int out_size, void* d_ws, size_t ws_size, hipStream_t stream) {
    static int grid = 0;
    if (grid == 0) {
        if (n_in != 23 || out_size != T * DM || ws_size < WS_END) { fprintf(stderr, "kernel_launch: unexpected shapes: n_in %d out %d ws %zu (need %zu)\n", n_in, out_size, ws_size, (size_t)WS_END); grid = -1; return; }
        int dev = 0, cus = 0, per_cu = 0;
        if (hipGetDevice(&dev) != hipSuccess || hipDeviceGetAttribute(&cus, hipDeviceAttributeMultiprocessorCount, dev) != hipSuccess) { grid = -1; return; }
        if (hipFuncSetAttribute((const void*)fwd, hipFuncAttributeMaxDynamicSharedMemorySize, LDS_BYTES) != hipSuccess) { fprintf(stderr, "kernel_launch: hipFuncSetAttribute failed\n"); grid = -1; return; }
        if (hipOccupancyMaxActiveBlocksPerMultiprocessor(&per_cu, (const void*)fwd, NWAVES * 64, LDS_BYTES) != hipSuccess || per_cu < 1) fprintf(stderr, "kernel_launch: occupancy query says %d\n", per_cu);
        (void)hipGetLastError();
        grid = cus;
    }
    if (grid < 0) return;
    if (hipMemsetAsync((char*)d_ws + WS_CTL, 0, CTL_ZERO_BYTES, stream) != hipSuccess) return;
    Args a{};
    for (int i = 0; i < 23; ++i) a.in[i] = d_in[i];
    a.out = (float*)d_out; a.ws = (unsigned char*)d_ws;
#if MK_ONE_LAUNCH
    a.ph_lo = 0; a.ph_hi = 50;
    hipLaunchKernelGGL(fwd, dim3(grid), dim3(NWAVES * 64), LDS_BYTES, stream, a);
#else
    for (int p = 0; p < 50; ++p) {
        if (p >= 1 && p < 49) { const int L = (p - 1) / 12, k = (p - 1) % 12;
            if (k == 6) continue;
            if (k < 6 && (L & 1) == 0 && k > 3) continue;
            if (k > 6 && !MK_ENABLE_MOE) continue; }
        a.ph_lo = p; a.ph_hi = p + 1;
        hipLaunchKernelGGL(fwd, dim3(grid), dim3(NWAVES * 64), LDS_BYTES, stream, a);
    }
#endif
    const hipError_t le = hipPeekAtLastError();
    if (le != hipSuccess) fprintf(stderr, "kernel_launch: launch failed: %s\n", hipGetErrorName(le));
}
```

```cpp
#include <hip/hip_runtime.h>
#include <cstdio>
#include <cstdint>

#ifndef MK_ONE_LAUNCH
#define MK_ONE_LAUNCH 1
#endif
#ifndef REP_ATT
#define REP_ATT 1
#endif
#ifndef REP_GEMM
#define REP_GEMM 1
#endif
#ifndef REP_THIN
#define REP_THIN 1
#endif
#ifndef REP_PRO
#define REP_PRO 1
#endif
#ifndef ATT_FP8
#define ATT_FP8 1
#endif
#ifndef ATT_PP
#define ATT_PP 1
#endif
#ifndef MK_ENABLE_MLA
#define MK_ENABLE_MLA 1
#endif
#ifndef MK_ENABLE_MOE
#define MK_ENABLE_MOE 1
#endif

#define GAS __attribute__((address_space(1)))
#define LAS __attribute__((address_space(3)))
typedef unsigned short bf16_t;
typedef short bf16x8 __attribute__((ext_vector_type(8)));
typedef short s16x4 __attribute__((ext_vector_type(4)));
typedef float f32x2 __attribute__((ext_vector_type(2)));
typedef float f32x4 __attribute__((ext_vector_type(4)));
typedef float f32x16 __attribute__((ext_vector_type(16)));
typedef unsigned u32x2 __attribute__((ext_vector_type(2)));
typedef unsigned u32x4 __attribute__((ext_vector_type(4)));
typedef GAS unsigned gu32;

constexpr int DM = 1024, NB = 2, SEQ = 16384, T = NB * SEQ;
constexpr int NH = 8, QLR = 384, KVLR = 256, DNOPE = 128, DROPE = 64, DQK = 192, DV = 128, LAT = 704, LATP = 768;
constexpr int NE = 64, DFF = 384;
constexpr int NASSIGN = 2 * T;
constexpr int NSLOT = NASSIGN + NE * 256;
constexpr int MAXTILES = NSLOT / 256;
constexpr float EPS = 1e-6f;
constexpr int NWAVES = 8;

constexpr size_t MiB = 1u << 20;
constexpr size_t WS_CTL = 0, CTL_ZERO_BYTES = 1 * MiB;
constexpr size_t WS_WIN = 2 * MiB;
constexpr size_t WS_WOUTC = 14 * MiB;
constexpr size_t WS_WDOWN = 18 * MiB;
constexpr size_t WS_WQ = 21 * MiB;
constexpr size_t WS_WKV = 24 * MiB;
constexpr size_t WS_WO = 26 * MiB;
constexpr size_t WS_WRT = 30 * MiB;
constexpr size_t WS_WE1 = 32 * MiB;
constexpr size_t WS_WE2 = 416 * MiB;
constexpr size_t WS_XB = 608 * MiB;
constexpr size_t WS_RINV = 1202 * MiB;
constexpr size_t WS_PSQ = 1200 * MiB;
constexpr size_t WS_S = 672 * MiB;
constexpr size_t WS_GB = WS_S, WS_Z = WS_S + 64 * MiB, WS_YC = WS_S + 128 * MiB;
constexpr size_t WS_LAT = WS_S, WS_QRAW = WS_S + 48 * MiB, WS_KVRAW = WS_S + 144 * MiB;
constexpr size_t WS_Q = WS_S + 272 * MiB, WS_K = WS_S + 368 * MiB, WS_V = WS_S + 464 * MiB, WS_O = WS_QRAW;
constexpr size_t WS_XS = WS_S, WS_HID = WS_S + 160 * MiB, WS_Y = WS_S + 224 * MiB, WS_LG = WS_S + 352 * MiB;
constexpr size_t WS_RT = WS_S + 368 * MiB;
constexpr size_t WS_END = WS_S + 531 * MiB;
constexpr size_t RT_EID = 0, RT_RANK = 256 * 1024, RT_GATE = 512 * 1024, RT_SDEST = 768 * 1024, RT_SGATE = 768 * 1024 + 327680, RT_STOK = 768 * 1024 + 2 * 327680, RT_SSCALE = 768 * 1024 + 3 * 327680;
static_assert(RT_SSCALE + 327680 <= 4 * MiB, "routing arrays");
constexpr int CW_TMO = 0, CW_CODE = 1, CW_BAR = 4096, CW_CNT = 8192  , CW_CHK = 12288;

constexpr int RING_BYTES = 131072;
constexpr int LDSCTL_OFF = RING_BYTES, MISC_OFF = LDSCTL_OFF + 320;
constexpr int TBL_OFF = LDSCTL_OFF + 1024;
constexpr int LDS_BYTES = 147456;

#define RLX_AGENT __ATOMIC_RELAXED, __HIP_MEMORY_SCOPE_AGENT
#define LDS_WAIT() asm volatile("s_waitcnt lgkmcnt(0)" ::: "memory")
#define VM_WAIT() asm volatile("s_waitcnt vmcnt(0)" ::: "memory")
__device__ __forceinline__ unsigned f2bf(float f) { unsigned u = __builtin_bit_cast(unsigned, f); return (u + 0x7fffu + ((u >> 16) & 1u)) >> 16; }
__device__ __forceinline__ unsigned pk2(float lo, float hi) { return f2bf(lo) | (f2bf(hi) << 16); }
__device__ __forceinline__ float bflo(unsigned w) { return __builtin_bit_cast(float, w << 16); }
__device__ __forceinline__ float bfhi(unsigned w) { return __builtin_bit_cast(float, w & 0xffff0000u); }
__device__ __forceinline__ float bf2f(bf16_t h) { return __builtin_bit_cast(float, (unsigned)h << 16); }
__device__ __forceinline__ unsigned cvt_pk_bf16(float lo, float hi) { unsigned r; asm volatile("v_cvt_pk_bf16_f32 %0, %1, %2" : "=v"(r) : "v"(lo), "v"(hi)); return r; }
__device__ __forceinline__ int tid_now(int wave_s) { int l; asm volatile("v_mbcnt_lo_u32_b32 %0, -1, 0\n\tv_mbcnt_hi_u32_b32 %0, -1, %0" : "=v"(l)); return wave_s * 64 + l; }
__device__ __forceinline__ int sgpr_now(int v) { asm volatile("" : "+s"(v)); return v; }
__device__ __forceinline__ float lane_xor_f(float v, int m, int lane) { return __builtin_bit_cast(float, __builtin_amdgcn_ds_bpermute((lane ^ m) << 2, __builtin_bit_cast(int, v))); }
__device__ __forceinline__ float wave_sum(float v, int lane) {
#pragma unroll
    for (int o = 1; o < 64; o <<= 1) v += lane_xor_f(v, o, lane);
    return v;
}

#define XB_TMO      128
#define XB_XCNT(j)  (256  + 64 * (j))
#define XB_XSUB(j)  (1280 + 64 * (j))
#define XB_XGEN(j)  (2304 + 64 * (j))
#define XB_TOP      3328
#define XB_TOPGEN   3392
#define XCD_BAR_WORDS 3456
#define XB_SPIN_CAP (1u << 18)
__device__ __forceinline__ unsigned xb_ld(unsigned* p)              { return __hip_atomic_load(p, __ATOMIC_RELAXED, __HIP_MEMORY_SCOPE_AGENT); }
__device__ __forceinline__ unsigned xb_add(unsigned* p, unsigned v) { return __hip_atomic_fetch_add(p, v, __ATOMIC_RELAXED, __HIP_MEMORY_SCOPE_AGENT); }
__device__ __forceinline__ unsigned xb_xcc_id() { return (unsigned)__builtin_amdgcn_s_getreg((3 << 11) | 20) & 0xFu; }
#define XB_SPIN(cond, bar) do { unsigned _sp = 0; while (cond) { __builtin_amdgcn_s_sleep(1); \
    if ((++_sp & 255u) == 0u) { if (xb_ld(&(bar)[XB_TMO])) break; if (_sp > XB_SPIN_CAP) { atomicAdd(&(bar)[XB_TMO], 1u); break; } } } } while (0)
struct XcdBarrier { unsigned* bar; unsigned x; volatile LAS unsigned* st; };
__device__ __forceinline__ XcdBarrier xcd_barrier_post(unsigned* bar, volatile LAS unsigned* st, bool leader) {
    XcdBarrier b; b.bar = bar; b.x = xb_xcc_id(); b.st = st;
    if (leader) (void)xb_add(&bar[XB_XCNT(b.x)], 1u);
    return b;
}
__device__ __forceinline__ void xcd_barrier_complete(unsigned* bar, unsigned x, unsigned& nloc, unsigned& nx) {
    const unsigned G = gridDim.x * gridDim.y * gridDim.z;
    unsigned sum, cnt, mine, sp = 0u;
    for (;;) {
        sum = 0u; cnt = 0u; mine = 0u;
#pragma unroll
        for (unsigned j = 0; j < 16; ++j) { const unsigned c = xb_ld(&bar[XB_XCNT(j)]); sum += c; cnt += (c > 0u) ? 1u : 0u; mine = (j == x) ? c : mine; }
        if (sum == G) break;
        __builtin_amdgcn_s_sleep(1);
        if ((++sp & 255u) == 0u) { if (xb_ld(&bar[XB_TMO])) break; if (sp > XB_SPIN_CAP) { atomicAdd(&bar[XB_TMO], 1u); break; } }
    }
    nloc = mine > 0u ? mine : 1u; nx = cnt > 0u ? cnt : 1u;
}
__device__ __forceinline__ void xcd_barrier(const XcdBarrier& b, bool leader) {
    asm volatile("s_waitcnt vmcnt(0)" ::: "memory");
    __syncthreads();
    if (leader) {
        unsigned* bar = b.bar;
        __builtin_amdgcn_s_waitcnt(0);
        unsigned nloc = b.st[0], nx = b.st[1];
        if (nloc == 0u) { xcd_barrier_complete(bar, b.x, nloc, nx); b.st[0] = nloc; b.st[1] = nx; }
        const unsigned old = xb_add(&bar[XB_XSUB(b.x)], 1u);
        const unsigned gen = old / nloc;
        if (old + 1u == (gen + 1u) * nloc) {
            __builtin_amdgcn_fence(__ATOMIC_RELEASE, "agent");
            asm volatile("s_waitcnt vmcnt(0)" ::: "memory");
            const unsigned og = xb_add(&bar[XB_TOP], 1u);
            const unsigned tg = og / nx;
            if (og + 1u == (tg + 1u) * nx) xb_add(&bar[XB_TOPGEN], 1u);
            else XB_SPIN(xb_ld(&bar[XB_TOPGEN]) == tg, bar);
            __builtin_amdgcn_fence(__ATOMIC_ACQUIRE, "agent");
            xb_add(&bar[XB_XGEN(b.x)], 1u);
            asm volatile("s_waitcnt vmcnt(0)" ::: "memory");
        } else {
            XB_SPIN(xb_ld(&bar[XB_XGEN(b.x)]) == gen, bar);
            __builtin_amdgcn_fence(__ATOMIC_ACQUIRE, "agent");
            asm volatile("s_waitcnt vmcnt(0)" ::: "memory");
        }
    }
    __syncthreads();
}

namespace pg8 {
constexpr int BM = 256, BK = 64, HALF = 128, HTB = HALF * BK * 2, NXCD = 8, WGM = 8;
__host__ __device__ __forceinline__ int lds_byte(int r, int c) { const int st = (r >> 4) * 2 + (c >> 5), rr = r & 15, cc = c & 31, ob = rr * 64 + cc * 2; return st * 1024 + (ob ^ (((ob >> 9) & 1) << 5)); }
__host__ __device__ __forceinline__ void stage_rc(int b, int& R, int& C) { const int st = b / 1024, sb = b % 1024, swz = sb ^ (((sb >> 9) & 1) << 5); R = (st >> 1) * 16 + swz / 64; C = (st & 1) * 32 + (swz % 64) / 2; }
__host__ __device__ __forceinline__ int perm32(int rho) { const int n = rho >> 4, i = rho & 15; return 8 * (i >> 2) + 4 * n + (i & 3); }

struct Unit { const char* A; const char* B; int pm, pn; };
struct Gemm { int lda, K; const int* rowidx; };

struct StaticOrder {
    int nM, nN, nwg, G, c; const char* A; const char* B; size_t astep, bstep;
    __device__ void init(const void* A_, int lda, const void* B_, int K, int M, int N, int G_, int c_) { nM = M / BM; nN = N / BM; nwg = nM * nN; G = G_; c = c_; A = (const char*)A_; B = (const char*)B_; astep = (size_t)BM * lda * 2; bstep = (size_t)BM * K * 2; }
    __device__ __forceinline__ bool next(int i, Unit& u) const {
        const long L = (long)i * G + c; if (L >= nwg) return false;
        int wgid = (int)L; { const int q = nwg / NXCD, r = nwg % NXCD, xcd = wgid % NXCD, off = wgid / NXCD; wgid = (xcd < r ? xcd * (q + 1) : r * (q + 1) + (xcd - r) * q) + off; }
        const int nig = WGM * nN, gid = wgid / nig, fm = gid * WGM, gsz = (nM - fm) < WGM ? (nM - fm) : WGM;
        u.pm = fm + ((wgid % nig) % gsz); u.pn = (wgid % nig) / gsz; u.A = A + (size_t)u.pm * astep; u.B = B + (size_t)u.pn * bstep; return true;
    }
};
struct GroupedOrder {
    int n_units, nN, G, c; const char* A; const char* B; size_t astep, bexp, bstep; const LAS int* tbl;
    __device__ __forceinline__ bool next(int i, Unit& u) const {
        const int L = i * G + c; if (L >= n_units) return false;
        const int tile = L / nN, pn = L - tile * nN; const int e = __builtin_amdgcn_readfirstlane(tbl[tile]);
        u.pm = tile; u.pn = pn; u.A = A + (size_t)tile * astep; u.B = B + (size_t)e * bexp + (size_t)pn * bstep; return true;
    }
};

typedef f32x4 Acc[2][2][4][2];

struct EpiBf16 {
    static constexpr bool PERM = true;
    bf16_t* O; int ldc; const float* rs;
    __device__ __forceinline__ void operator()(const Acc& acc, const Unit& u, int wr, int wc, int fr, int fq) const {
        const int row0 = u.pm * BM + wr * 64 + fr, col0 = u.pn * BM + wc * 32 + 8 * fq;
#pragma unroll
        for (int ai = 0; ai < 2; ++ai)
#pragma unroll
            for (int m = 0; m < 4; ++m) { const int row = row0 + ai * HALF + m * 16; bf16_t* rowp = O + (size_t)row * ldc + col0; const float r = rs ? rs[row] : 1.f;
#pragma unroll
                for (int bj = 0; bj < 2; ++bj) { const f32x4 v0 = acc[ai][bj][m][0] * r, v1 = acc[ai][bj][m][1] * r;
                    u32x4 w; w.x = cvt_pk_bf16(v0[0], v0[1]); w.y = cvt_pk_bf16(v0[2], v0[3]); w.z = cvt_pk_bf16(v1[0], v1[1]); w.w = cvt_pk_bf16(v1[2], v1[3]);
                    *(u32x4*)(rowp + bj * HALF) = w; } }
    }
};
struct EpiConvIn {
    static constexpr bool PERM = true;
    bf16_t* GBp; bf16_t* Zp; const float* rs;
    __device__ __forceinline__ void operator()(const Acc& acc, const Unit& u, int wr, int wc, int fr, int fq) const {
        const int row0 = u.pm * BM + wr * 64 + fr;
        if (u.pn < 4) {
            const int col0 = u.pn * BM + wc * 32 + 8 * fq;
#pragma unroll
            for (int ai = 0; ai < 2; ++ai)
#pragma unroll
                for (int m = 0; m < 4; ++m) { const int row = row0 + ai * HALF + m * 16; bf16_t* rowp = GBp + (size_t)row * DM + col0; const float r = rs[row];
#pragma unroll
                    for (int bj = 0; bj < 2; ++bj) { const f32x4 v0 = acc[ai][bj][m][0] * r, v1 = acc[ai][bj][m][1] * r;
                        u32x4 w; w.x = cvt_pk_bf16(v0[0], v0[1]); w.y = cvt_pk_bf16(v0[2], v0[3]); w.z = cvt_pk_bf16(v1[0], v1[1]); w.w = cvt_pk_bf16(v1[2], v1[3]);
                        *(u32x4*)(rowp + bj * HALF) = w; } }
        } else {
            const int col0 = (u.pn - 4) * HALF + wc * 32 + 8 * fq;
#pragma unroll
            for (int ai = 0; ai < 2; ++ai)
#pragma unroll
                for (int m = 0; m < 4; ++m) { const int row = row0 + ai * HALF + m * 16; bf16_t* rowp = Zp + (size_t)row * DM + col0; const float r = rs[row], r2 = r * r;
                    const f32x4 v0 = acc[ai][0][m][0] * acc[ai][1][m][0] * r2, v1 = acc[ai][0][m][1] * acc[ai][1][m][1] * r2;
                    u32x4 w; w.x = cvt_pk_bf16(v0[0], v0[1]); w.y = cvt_pk_bf16(v0[2], v0[3]); w.z = cvt_pk_bf16(v1[0], v1[1]); w.w = cvt_pk_bf16(v1[2], v1[3]);
                    *(u32x4*)rowp = w; }
        }
    }
};
__device__ __forceinline__ float silu_mul(float g, float u) { return g * __builtin_amdgcn_rcpf(1.f + __expf(-g)) * u; }
struct EpiSwiGLU {
    static constexpr bool PERM = true;
    bf16_t* Hd; const float* ss;
    __device__ __forceinline__ void operator()(const Acc& acc, const Unit& u, int wr, int wc, int fr, int fq) const {
        const int row0 = u.pm * BM + wr * 64 + fr, col0 = u.pn * HALF + wc * 32 + 8 * fq;
#pragma unroll
        for (int ai = 0; ai < 2; ++ai)
#pragma unroll
            for (int m = 0; m < 4; ++m) { const int row = row0 + ai * HALF + m * 16; bf16_t* rowp = Hd + (size_t)row * DFF + col0; const float r = ss[row];
                f32x4 v0, v1;
#pragma unroll
                for (int q = 0; q < 4; ++q) { v0[q] = silu_mul(acc[ai][0][m][0][q] * r, acc[ai][1][m][0][q] * r); v1[q] = silu_mul(acc[ai][0][m][1][q] * r, acc[ai][1][m][1][q] * r); }
                u32x4 w; w.x = cvt_pk_bf16(v0[0], v0[1]); w.y = cvt_pk_bf16(v0[2], v0[3]); w.z = cvt_pk_bf16(v1[0], v1[1]); w.w = cvt_pk_bf16(v1[2], v1[3]);
                *(u32x4*)rowp = w; }
    }
};
struct EpiResid {
    static constexpr bool PERM = true;
    bf16_t* XB; float* PSQ; int lane;
    __device__ __forceinline__ void operator()(const Acc& acc, const Unit& u, int wr, int wc, int fr, int fq) const {
        const int row0 = u.pm * BM + wr * 64 + fr, col0 = u.pn * BM + wc * 32 + 8 * fq;
#pragma unroll
        for (int ai = 0; ai < 2; ++ai)
#pragma unroll
            for (int m = 0; m < 4; ++m) { const int row = row0 + ai * HALF + m * 16; bf16_t* rowp = XB + (size_t)row * DM + col0; float ss = 0.f;
#pragma unroll
                for (int bj = 0; bj < 2; ++bj) { const u32x4 xv = *(const u32x4*)(rowp + bj * HALF);
                    const f32x4 v0 = acc[ai][bj][m][0] + (f32x4){bflo(xv.x), bfhi(xv.x), bflo(xv.y), bfhi(xv.y)}, v1 = acc[ai][bj][m][1] + (f32x4){bflo(xv.z), bfhi(xv.z), bflo(xv.w), bfhi(xv.w)};
                    ss += (v0[0] * v0[0] + v0[1] * v0[1]) + (v0[2] * v0[2] + v0[3] * v0[3]) + (v1[0] * v1[0] + v1[1] * v1[1]) + (v1[2] * v1[2] + v1[3] * v1[3]);
                    u32x4 w; w.x = cvt_pk_bf16(v0[0], v0[1]); w.y = cvt_pk_bf16(v0[2], v0[3]); w.z = cvt_pk_bf16(v1[0], v1[1]); w.w = cvt_pk_bf16(v1[2], v1[3]);
                    *(u32x4*)(rowp + bj * HALF) = w; }
                ss += lane_xor_f(ss, 16, lane); ss += lane_xor_f(ss, 32, lane);
                if (fq == 0) PSQ[(size_t)row * 16 + u.pn * 4 + wc] = ss; }
    }
};
struct EpiLogits {
    static constexpr bool PERM = false;
    float* LG; const float* rs;
    __device__ __forceinline__ void operator()(const Acc& acc, const Unit& u, int wr, int wc, int fr, int fq) const {
        const int row0 = u.pm * BM + wr * 64 + fr, col0 = wc * 32 + 4 * fq;
#pragma unroll
        for (int ai = 0; ai < 2; ++ai)
#pragma unroll
            for (int m = 0; m < 4; ++m) { const int row = row0 + ai * HALF + m * 16; const size_t off = (size_t)row * 128 + col0; const float r = rs[row];
#pragma unroll
                for (int n = 0; n < 2; ++n) *(f32x4*)(LG + off + n * 16) = acc[ai][0][m][n] * r; }
    }
};
struct EpiScatterY {
    static constexpr bool PERM = true;
    bf16_t* Y; const int* sdest; const float* sgate;
    __device__ __forceinline__ void operator()(const Acc& acc, const Unit& u, int wr, int wc, int fr, int fq) const {
        const int row0 = u.pm * BM + wr * 64 + fr, col0 = u.pn * BM + wc * 32 + 8 * fq;
#pragma unroll
        for (int ai = 0; ai < 2; ++ai)
#pragma unroll
            for (int m = 0; m < 4; ++m) { const int slot = row0 + ai * HALF + m * 16; const int d = sdest[slot]; const float g = sgate[slot];
                if (d >= 0) { bf16_t* rowp = Y + (size_t)d * DM + col0;
#pragma unroll
                    for (int bj = 0; bj < 2; ++bj) { const f32x4 v0 = acc[ai][bj][m][0] * g, v1 = acc[ai][bj][m][1] * g;
                        u32x4 w; w.x = cvt_pk_bf16(v0[0], v0[1]); w.y = cvt_pk_bf16(v0[2], v0[3]); w.z = cvt_pk_bf16(v1[0], v1[1]); w.w = cvt_pk_bf16(v1[2], v1[3]);
                        *(u32x4*)(rowp + bj * HALF) = w; } }
                asm volatile("" ::: "memory"); }
    }
};

template <bool GATHER = false, class Epi, class Sched>
__device__ __forceinline__ void gemm_phase(LAS unsigned char* lds, const Gemm g, const Sched& S, const Epi& E, int tid) {
    const int wid = __builtin_amdgcn_readfirstlane(tid >> 6), lane = tid & 63, wr = wid >> 2, wc = wid & 3, fr = lane & 15, fq = lane >> 4;
    const int K = g.K, lda = g.lda, nt = K / BK;
    unsigned voffA[2], voffB[2];
#pragma unroll
    for (int i = 0; i < 2; ++i) { int R, C; stage_rc(tid * 16 + i * 8192, R, C); const int Rb = Epi::PERM ? ((R & ~31) + perm32(R & 31)) : R;
        voffA[i] = (unsigned)(R * lda + C) * 2u; voffB[i] = (unsigned)(Rb * K + C) * 2u; }
    const size_t kstep = (size_t)(BK * 2);
    const size_t hstepA = (size_t)HALF * lda * 2, hstepB = (size_t)HALF * K * 2;
    unsigned goC[2][2] = {{0u, 0u}, {0u, 0u}}, goN[2][2] = {{0u, 0u}, {0u, 0u}}; int gR[2] = {0, 0}; unsigned gC[2] = {0u, 0u};
    if constexpr (GATHER) {
#pragma unroll
        for (int i = 0; i < 2; ++i) { int R, C; stage_rc(tid * 16 + i * 8192, R, C); gR[i] = R; gC[i] = (unsigned)C * 2u; } }
#define PG8_GO(dst, pm_) do { _Pragma("unroll") for (int h_ = 0; h_ < 2; ++h_) _Pragma("unroll") for (int i_ = 0; i_ < 2; ++i_) \
        dst[h_][i_] = (unsigned)g.rowidx[(pm_) * BM + h_ * HALF + gR[i_]] * (unsigned)(lda * 2) + gC[i_]; } while (0)
    const unsigned ldsw = (unsigned)wid * 1024u;
    const int aoff = lds_byte(wr * 64 + fr, fq * 8), boff = lds_byte(wc * 32 + fr, fq * 8);
#define PG8_SA(b, h) (((b) * 2 + (h)) * HTB)
#define PG8_SB(b, h) ((4 + (b) * 2 + (h)) * HTB)
#define PG8_STAGE(bufoff, gbase, voff) do { _Pragma("unroll") for (int _i = 0; _i < 2; ++_i) \
        __builtin_amdgcn_global_load_lds((const unsigned*)((const char*)(gbase) + (voff)[_i]), (LAS unsigned*)(lds + (bufoff) + ldsw + _i * 8192), 16, 0, 0); } while (0)
#define PG8_LDA(dst, b, h) do { _Pragma("unroll") for (int m = 0; m < 4; ++m) _Pragma("unroll") for (int k = 0; k < 2; ++k) dst[m][k] = *(const LAS bf16x8*)(lds + PG8_SA(b, h) + aoff + m * 2048 + k * 1024); } while (0)
#define PG8_LDB(dst, b, h) do { _Pragma("unroll") for (int n = 0; n < 2; ++n) _Pragma("unroll") for (int k = 0; k < 2; ++k) dst[n][k] = *(const LAS bf16x8*)(lds + PG8_SB(b, h) + boff + n * 2048 + k * 1024); } while (0)
#define PG8_MMA(ai, bj, At, Bt) do { __builtin_amdgcn_s_setprio(1); _Pragma("unroll") for (int m = 0; m < 4; ++m) _Pragma("unroll") for (int n = 0; n < 2; ++n) _Pragma("unroll") for (int k = 0; k < 2; ++k) \
        acc[ai][bj][m][n] = __builtin_amdgcn_mfma_f32_16x16x32_bf16(Bt[n][k], At[m][k], acc[ai][bj][m][n], 0, 0, 0); __builtin_amdgcn_s_setprio(0); } while (0)
#define PG8_WAIT_V(n) asm volatile("s_waitcnt vmcnt(" #n ")" ::: "memory")
#define PG8_WAIT_L(n) asm volatile("s_waitcnt lgkmcnt(" #n ")" ::: "memory")
#define PG8_BAR __builtin_amdgcn_s_barrier()
#define PG8_SCHED __builtin_amdgcn_sched_barrier(0)
    Unit cur, nxt; int ui = 0;
    if (!S.next(0, cur)) return;
    Acc acc;
#pragma unroll
    for (int a = 0; a < 2; ++a)
#pragma unroll
        for (int b = 0; b < 2; ++b)
#pragma unroll
            for (int m = 0; m < 4; ++m)
#pragma unroll
                for (int n = 0; n < 2; ++n) acc[a][b][m][n] = (f32x4){0.f, 0.f, 0.f, 0.f};
    bf16x8 At[4][2], B0[2][2], B1[2][2];
    const char* cA = cur.A; const char* cB = cur.B;
    if constexpr (GATHER) PG8_GO(goC, cur.pm);
    PG8_STAGE(PG8_SB(0, 0), cB, voffB); PG8_STAGE(PG8_SB(0, 1), cB + hstepB, voffB);
    if constexpr (GATHER) { PG8_STAGE(PG8_SA(0, 0), cA, goC[0]); PG8_STAGE(PG8_SA(0, 1), cA, goC[1]); } else { PG8_STAGE(PG8_SA(0, 0), cA, voffA); PG8_STAGE(PG8_SA(0, 1), cA + hstepA, voffA); }
    if (wr == 1) PG8_BAR;
    PG8_WAIT_V(2); PG8_BAR;
    PG8_STAGE(PG8_SB(1, 0), cB + kstep, voffB); if constexpr (GATHER) PG8_STAGE(PG8_SA(1, 0), cA + kstep, goC[0]); else PG8_STAGE(PG8_SA(1, 0), cA + kstep, voffA); PG8_STAGE(PG8_SB(1, 1), cB + hstepB + kstep, voffB);
    PG8_WAIT_V(6); PG8_BAR;
    for (;;) {
        const bool has_next = S.next(ui + 1, nxt);
        const char* nA = has_next ? nxt.A : cA; const char* nB = has_next ? nxt.B : cB;
        if constexpr (GATHER) { if (has_next) PG8_GO(goN, nxt.pm); else { goN[0][0] = goC[0][0]; goN[0][1] = goC[0][1]; goN[1][0] = goC[1][0]; goN[1][1] = goC[1][1]; } }
        for (int t = 0; t < nt; t += 2) {
            const bool last = (t == nt - 2);
            const char* a1 = cA + (size_t)(t + 1) * kstep;
            const char* a2 = last ? nA : cA + (size_t)(t + 2) * kstep; const char* b2 = last ? nB : cB + (size_t)(t + 2) * kstep;
            const char* a3 = a2 + kstep; const char* b3 = b2 + kstep;
            unsigned g2h0[2], g2h1[2];
            if constexpr (GATHER) { g2h0[0] = last ? goN[0][0] : goC[0][0]; g2h0[1] = last ? goN[0][1] : goC[0][1]; g2h1[0] = last ? goN[1][0] : goC[1][0]; g2h1[1] = last ? goN[1][1] : goC[1][1]; }
            PG8_LDB(B0, 0, 0); PG8_LDB(B1, 0, 1); PG8_SCHED; PG8_LDA(At, 0, 0); if constexpr (GATHER) PG8_STAGE(PG8_SA(1, 1), a1, goC[1]); else PG8_STAGE(PG8_SA(1, 1), a1 + hstepA, voffA);
            PG8_WAIT_V(8); PG8_WAIT_L(0); PG8_BAR; PG8_MMA(0, 0, At, B0); PG8_MMA(0, 1, At, B1); PG8_BAR; PG8_SCHED;
            PG8_LDA(At, 0, 1); PG8_STAGE(PG8_SB(0, 0), b2, voffB); PG8_STAGE(PG8_SB(0, 1), b2 + hstepB, voffB); if constexpr (GATHER) PG8_STAGE(PG8_SA(0, 0), a2, g2h0); else PG8_STAGE(PG8_SA(0, 0), a2, voffA);
            PG8_WAIT_V(8); PG8_WAIT_L(0); PG8_BAR; PG8_MMA(1, 0, At, B0); PG8_MMA(1, 1, At, B1); PG8_BAR; PG8_SCHED;
            PG8_LDB(B0, 1, 0); PG8_LDB(B1, 1, 1); PG8_SCHED; PG8_LDA(At, 1, 0); if constexpr (GATHER) PG8_STAGE(PG8_SA(0, 1), a2, g2h1); else PG8_STAGE(PG8_SA(0, 1), a2 + hstepA, voffA);
            PG8_WAIT_V(8); PG8_WAIT_L(0); PG8_BAR; PG8_MMA(0, 0, At, B0); PG8_MMA(0, 1, At, B1); PG8_BAR; PG8_SCHED;
            PG8_LDA(At, 1, 1); PG8_STAGE(PG8_SB(1, 0), b3, voffB); PG8_STAGE(PG8_SB(1, 1), b3 + hstepB, voffB); if constexpr (GATHER) PG8_STAGE(PG8_SA(1, 0), a3, g2h0); else PG8_STAGE(PG8_SA(1, 0), a3, voffA);
            PG8_WAIT_V(8); PG8_WAIT_L(0); PG8_BAR; PG8_MMA(1, 0, At, B0); PG8_MMA(1, 1, At, B1); PG8_BAR; PG8_SCHED;
        }
        if (wr == 0) PG8_BAR;
        E(acc, cur, wr, wc, fr, fq);
        if (!has_next) break;
#pragma unroll
        for (int a = 0; a < 2; ++a)
#pragma unroll
            for (int b = 0; b < 2; ++b)
#pragma unroll
                for (int m = 0; m < 4; ++m)
#pragma unroll
                    for (int n = 0; n < 2; ++n) acc[a][b][m][n] = (f32x4){0.f, 0.f, 0.f, 0.f};
        cur = nxt; cA = nA; cB = nB; ++ui;
        if constexpr (GATHER) { goC[0][0] = goN[0][0]; goC[0][1] = goN[0][1]; goC[1][0] = goN[1][0]; goC[1][1] = goN[1][1]; }
        if (wr == 1) PG8_BAR;
    }
    PG8_WAIT_V(0);
    PG8_BAR;
#undef PG8_GO
#undef PG8_SA
#undef PG8_SB
#undef PG8_STAGE
#undef PG8_LDA
#undef PG8_LDB
#undef PG8_MMA
#undef PG8_WAIT_V
#undef PG8_WAIT_L
#undef PG8_BAR
#undef PG8_SCHED
}
}

namespace att {
constexpr int NW = 8, QBLK = 32, KVBLK = 64;
constexpr float SCALE = 0.07216878364870322f;
constexpr float THR = 8.f;
#ifndef ATT_SDEPTH
#define ATT_SDEPTH 2
#endif
constexpr int SDEPTH = ATT_SDEPTH;
constexpr int KROW = 400;
constexpr int SHM_V = KVBLK * DV * 2, SHM_K = KVBLK * KROW;
#ifndef ATT_NQR
#define ATT_NQR 8
#endif
constexpr int NQR = ATT_NQR;
constexpr int QLROW = (12 - NQR) * 32 + 16;
constexpr int OFF_V = 0, OFF_K = 2 * SHM_V, OFF_WS = OFF_K + 2 * SHM_K, OFF_QL = OFF_WS + NW * 64 * 4, ATT_LDS = OFF_QL + NW * 32 * QLROW;
static_assert(ATT_LDS <= RING_BYTES, "attention LDS");
#define SBAR() __builtin_amdgcn_sched_barrier(0)
__device__ __forceinline__ int crow(int r, int hi) { return (r & 3) + 8 * (r >> 2) + 4 * hi; }
__device__ __forceinline__ void partialSM(f32x16& p0, f32x16& p1, float& m_reg, float& mn, float& alpha) {
    constexpr float C = SCALE * 1.4426950408889634f;
    float pmax = p0[0];
#pragma unroll
    for (int r = 1; r < 16; ++r) pmax = fmaxf(pmax, p0[r]);
#pragma unroll
    for (int r = 0; r < 16; ++r) pmax = fmaxf(pmax, p1[r]);
    { auto rr = __builtin_amdgcn_permlane32_swap(__float_as_uint(pmax), __float_as_uint(pmax), false, false);
      pmax = fmaxf(__uint_as_float(rr[0]), __uint_as_float(rr[1])); }
    if (__builtin_expect(__all(pmax - m_reg <= THR / SCALE), 1)) { mn = m_reg; alpha = 1.f; }
    else { mn = fmaxf(m_reg, pmax); alpha = __builtin_amdgcn_exp2f((m_reg - mn) * C); m_reg = mn; }
    const float mnC = -mn * C;
#pragma unroll
    for (int r = 0; r < 16; ++r) p0[r] = fmaf(p0[r], C, mnC);
#pragma unroll
    for (int r = 0; r < 16; ++r) p1[r] = fmaf(p1[r], C, mnC);
#pragma unroll
    for (int r = 0; r < 16; ++r) p0[r] = __builtin_amdgcn_exp2f(p0[r]);
}
__device__ __forceinline__ void finishSM(f32x16& p0, f32x16& p1, float alpha, float& l_reg, bf16x8& pa0, bf16x8& pa1, bf16x8& pa2, bf16x8& pa3) {
#pragma unroll
    for (int r = 0; r < 16; ++r) p1[r] = __builtin_amdgcn_exp2f(p1[r]);
    float ps = 0;
#pragma unroll
    for (int r = 0; r < 16; ++r) ps += p0[r];
#pragma unroll
    for (int r = 0; r < 16; ++r) ps += p1[r];
    { auto rr = __builtin_amdgcn_permlane32_swap(__float_as_uint(ps), __float_as_uint(ps), false, false);
      ps = __uint_as_float(rr[0]) + __uint_as_float(rr[1]); }
    l_reg = l_reg * alpha + ps;
#define PK4(P, BASE, OUT) do { unsigned a0 = cvt_pk_bf16(P[BASE + 0], P[BASE + 1]), a1 = cvt_pk_bf16(P[BASE + 2], P[BASE + 3]);   \
    unsigned b0 = cvt_pk_bf16(P[BASE + 4], P[BASE + 5]), b1 = cvt_pk_bf16(P[BASE + 6], P[BASE + 7]);                              \
    auto r0 = __builtin_amdgcn_permlane32_swap(a0, b0, false, false); auto r1 = __builtin_amdgcn_permlane32_swap(a1, b1, false, false); \
    u32x4 w = {r0[0], r1[0], r0[1], r1[1]}; OUT = *reinterpret_cast<bf16x8*>(&w); } while (0)
    PK4(p0, 0, pa0); PK4(p0, 8, pa1); PK4(p1, 0, pa2); PK4(p1, 8, pa3);
#undef PK4
}
__device__ __forceinline__ void qkt(f32x16& p0, f32x16& p1, const char* Ks, const bf16x8* qr, const char* ql, int r32, int hi) {
    p0 = f32x16{}; p1 = f32x16{};
#pragma unroll
    for (int d0 = 0; d0 < 12; ++d0) { const int cb = d0 * 32 + hi * 16;
        const bf16x8 b0 = *reinterpret_cast<const bf16x8*>(Ks + r32 * KROW + cb);
        const bf16x8 b1 = *reinterpret_cast<const bf16x8*>(Ks + (32 + r32) * KROW + cb);
        const bf16x8 qf = (d0 < NQR) ? qr[d0] : *reinterpret_cast<const bf16x8*>(ql + (d0 - NQR) * 32);
        p0 = __builtin_amdgcn_mfma_f32_32x32x16_bf16(b0, qf, p0, 0, 0, 0);
        p1 = __builtin_amdgcn_mfma_f32_32x32x16_bf16(b1, qf, p1, 0, 0, 0); }
}
__device__ __forceinline__ int v_st(int k, int c) { const int kk = (k & ~0xC) | ((k & 4) << 1) | ((k & 8) >> 1); return ((kk >> 3) * 4 + (c >> 5)) * 512 + ((kk & 7) * 32 + (c & 31)) * 2; }
__device__ __forceinline__ int v_rd_base(int lane) { return ((lane & 3) << 3) | (((lane >> 2) & 3) << 6) | (((lane >> 4) & 1) << 5) | (((lane >> 5) & 1) << 8); }
constexpr int v_rd_off(int d0, int ks, int half) { return d0 * 512 + ks * 4096 + half * 2048; }
template <int OFF> __device__ __forceinline__ s16x4 tr_read(int vb) {
    s16x4 r; asm volatile("ds_read_b64_tr_b16 %0, %1 offset:%2" : "=&v"(r) : "v"(vb), "i"(OFF) : "memory"); return r;
}
template <int D0> __device__ __forceinline__ void pv_one(f32x16& od, int vb, bf16x8 pa0, bf16x8 pa1, bf16x8 pa2, bf16x8 pa3) {
    const s16x4 l0 = tr_read<v_rd_off(D0, 0, 0)>(vb), h0 = tr_read<v_rd_off(D0, 0, 1)>(vb), l1 = tr_read<v_rd_off(D0, 1, 0)>(vb), h1 = tr_read<v_rd_off(D0, 1, 1)>(vb);
    const s16x4 l2 = tr_read<v_rd_off(D0, 2, 0)>(vb), h2 = tr_read<v_rd_off(D0, 2, 1)>(vb), l3 = tr_read<v_rd_off(D0, 3, 0)>(vb), h3 = tr_read<v_rd_off(D0, 3, 1)>(vb);
    asm volatile("s_waitcnt lgkmcnt(0)" ::: "memory"); SBAR();
#define PK(L, H) (bf16x8){L[0], L[1], L[2], L[3], H[0], H[1], H[2], H[3]}
    od = __builtin_amdgcn_mfma_f32_32x32x16_bf16(pa0, PK(l0, h0), od, 0, 0, 0);
    od = __builtin_amdgcn_mfma_f32_32x32x16_bf16(pa1, PK(l1, h1), od, 0, 0, 0);
    od = __builtin_amdgcn_mfma_f32_32x32x16_bf16(pa2, PK(l2, h2), od, 0, 0, 0);
    od = __builtin_amdgcn_mfma_f32_32x32x16_bf16(pa3, PK(l3, h3), od, 0, 0, 0);
#undef PK
}
__device__ __forceinline__ void pv_d0(f32x16* o, int vb, bf16x8 pa0, bf16x8 pa1, bf16x8 pa2, bf16x8 pa3) {
    pv_one<0>(o[0], vb, pa0, pa1, pa2, pa3); pv_one<1>(o[1], vb, pa0, pa1, pa2, pa3); pv_one<2>(o[2], vb, pa0, pa1, pa2, pa3); pv_one<3>(o[3], vb, pa0, pa1, pa2, pa3);
}
__device__ __forceinline__ void attn_unit(const bf16_t* __restrict__ Qb, const bf16_t* __restrict__ Kh, const bf16_t* __restrict__ Vh, bf16_t* __restrict__ Ob, char* lds, int tid) {
    const int wid = tid >> 6, lane = tid & 63, r32 = lane & 31, hi = lane >> 5;
    char* V_lds = lds + OFF_V; char* K_lds = lds + OFF_K;
    float* ws = (float*)(lds + OFF_WS) + wid * 64; float* li_l = ws; float* al_l = ws + 32;
    float m_reg = -1e30f, l_reg = 0; f32x16 o[4] = {}; bf16x8 qr[NQR];
    const bf16_t* Qw = Qb + (long)(wid * QBLK + r32) * DQK + hi * 8;
#pragma unroll
    for (int d0 = 0; d0 < NQR; ++d0) qr[d0] = *reinterpret_cast<const bf16x8*>(Qw + d0 * 16);
    char* ql = lds + OFF_QL + wid * (32 * QLROW) + r32 * QLROW + hi * 16;
#pragma unroll
    for (int d0 = NQR; d0 < 12; ++d0) *reinterpret_cast<bf16x8*>(ql + (d0 - NQR) * 32) = *reinterpret_cast<const bf16x8*>(Qw + d0 * 16);
    const int sr = tid >> 4, sc = (tid & 15) * 8, vst0 = v_st(sr, sc), vst1 = v_st(32 + sr, sc);
    int kst[3];
#pragma unroll
    for (int i = 0; i < 3; ++i) { const int q = tid + 512 * i; kst[i] = (q / 24) * KROW + (q % 24) * 16; }
    const int vb0 = (int)(uintptr_t)V_lds + v_rd_base(lane);
    struct { bf16x8 vs0, vs1, ks0, ks1, ks2; } sr_[SDEPTH];
#define SLOAD(i, k0) do { sr_[i].vs0 = *reinterpret_cast<const bf16x8*>(&Vh[(long)((k0) + sr) * DV + sc]); sr_[i].vs1 = *reinterpret_cast<const bf16x8*>(&Vh[(long)((k0) + 32 + sr) * DV + sc]); \
    const bf16_t* kp_ = Kh + (long)(k0) * DQK + tid * 8; sr_[i].ks0 = *reinterpret_cast<const bf16x8*>(kp_); sr_[i].ks1 = *reinterpret_cast<const bf16x8*>(kp_ + 4096); sr_[i].ks2 = *reinterpret_cast<const bf16x8*>(kp_ + 8192); } while (0)
#define SWRITE(b, i) do { *(bf16x8*)(V_lds + (b) * SHM_V + vst0) = sr_[i].vs0; *(bf16x8*)(V_lds + (b) * SHM_V + vst1) = sr_[i].vs1; \
    *(bf16x8*)(K_lds + (b) * SHM_K + kst[0]) = sr_[i].ks0; *(bf16x8*)(K_lds + (b) * SHM_K + kst[1]) = sr_[i].ks1; *(bf16x8*)(K_lds + (b) * SHM_K + kst[2]) = sr_[i].ks2; } while (0)
#define SWAIT() do { if constexpr (SDEPTH == 2) asm volatile("s_waitcnt vmcnt(5)" ::: "memory"); else asm volatile("s_waitcnt vmcnt(0)" ::: "memory"); } while (0)
#define RESC(a) do { if (__any((a) < 1.f)) { if (hi == 0) al_l[r32] = (a); asm volatile("s_waitcnt lgkmcnt(0)" ::: "memory"); \
    _Pragma("unroll") for (int d = 0; d < 4; ++d) _Pragma("unroll") for (int r = 0; r < 16; ++r) o[d][r] *= al_l[crow(r, hi)]; } } while (0)
    f32x16 pA0, pA1, pB0, pB1; float mnA, mnB, alA, alB; bf16x8 pa0, pa1, pa2, pa3; constexpr int NT = SEQ / KVBLK;
    constexpr int SE = 0, SO = SDEPTH - 1;
    SLOAD(SE, 0); asm volatile("s_waitcnt vmcnt(0)" ::: "memory"); SWRITE(0, SE); __syncthreads();
    qkt(pA0, pA1, K_lds, qr, ql, r32, hi); partialSM(pA0, pA1, m_reg, mnA, alA);
    SLOAD(SO, KVBLK); if constexpr (SDEPTH == 2) SLOAD(SE, 2 * KVBLK);
    SWAIT(); SWRITE(1, SO); __syncthreads();
    for (int j = 1; j + 1 < NT; j += 2) {
        SBAR(); qkt(pB0, pB1, K_lds + SHM_K, qr, ql, r32, hi);
        finishSM(pA0, pA1, alA, l_reg, pa0, pa1, pa2, pa3); SBAR();
        SLOAD(SO, (j + SDEPTH) * KVBLK); SBAR();
        pv_d0(o, vb0, pa0, pa1, pa2, pa3); partialSM(pB0, pB1, m_reg, mnB, alB);
        __syncthreads(); SWAIT(); SWRITE(0, SE);
        RESC(alB); __syncthreads();
        SBAR(); qkt(pA0, pA1, K_lds, qr, ql, r32, hi);
        finishSM(pB0, pB1, alB, l_reg, pa0, pa1, pa2, pa3); SBAR();
        if (SDEPTH == 1 || j + 3 < NT) SLOAD(SE, (j + 1 + SDEPTH) * KVBLK); SBAR();
        pv_d0(o, vb0 + SHM_V, pa0, pa1, pa2, pa3); partialSM(pA0, pA1, m_reg, mnA, alA);
        __syncthreads(); SWAIT(); SWRITE(1, SO);
        RESC(alA); __syncthreads();
    }
    SBAR(); qkt(pB0, pB1, K_lds + SHM_K, qr, ql, r32, hi);
    finishSM(pA0, pA1, alA, l_reg, pa0, pa1, pa2, pa3); SBAR();
    pv_d0(o, vb0, pa0, pa1, pa2, pa3); partialSM(pB0, pB1, m_reg, mnB, alB);
    __syncthreads(); RESC(alB);
    finishSM(pB0, pB1, alB, l_reg, pa0, pa1, pa2, pa3); SBAR();
    pv_d0(o, vb0 + SHM_V, pa0, pa1, pa2, pa3);
    if (hi == 0) li_l[r32] = l_reg; asm volatile("s_waitcnt lgkmcnt(0)" ::: "memory");
    float rli[16];
#pragma unroll
    for (int r = 0; r < 16; ++r) rli[r] = __builtin_amdgcn_rcpf(li_l[crow(r, hi)]);
    __syncthreads();
    bf16_t* ost = (bf16_t*)(lds + wid * 8192);
#pragma unroll
    for (int r = 0; r < 16; ++r) { const int orow = crow(r, hi);
#pragma unroll
        for (int d0 = 0; d0 < 4; ++d0) ost[orow * 128 + d0 * 32 + r32] = (bf16_t)f2bf(o[d0][r] * rli[r]); }
    asm volatile("s_waitcnt lgkmcnt(0)" ::: "memory");
    bf16_t* Ow = Ob + (long)(wid * QBLK) * DM;
#pragma unroll
    for (int i = 0; i < 8; ++i) { const int ch = lane + 64 * i, row = ch >> 4, c = ch & 15;
        const u32x4 v = *(const u32x4*)((const char*)ost + row * 256 + c * 16); *(u32x4*)(Ow + (long)row * DM + c * 8) = v; }
    __syncthreads();
#undef SLOAD
#undef SWRITE
#undef SWAIT
#undef RESC
#undef SBAR
}
}


namespace att8 {
typedef int i32x8 __attribute__((ext_vector_type(8)));
constexpr int NW = 8, QBLK = 32, KVBLK = 64;
constexpr float SCALE = 0.07216878364870322f;
constexpr float THR = 3.f;
constexpr float POFF = 4.f;
constexpr int KROW = 208, VROW = 80;
constexpr int SHM_K = KVBLK * KROW, SHM_V = DV * VROW;
constexpr int OFF_V = 0, OFF_K = 2 * SHM_V, OFF_WS = OFF_K + 3 * SHM_K, ATT_LDS = OFF_WS + NW * 64 * 4;
static_assert(ATT_LDS <= 65536, "O staging reuses [0, 64 KiB)");
#define SBAR() __builtin_amdgcn_sched_barrier(0)
__device__ __forceinline__ int crow(int r, int hi) { return (r & 3) + 8 * (r >> 2) + 4 * hi; }
__device__ __forceinline__ f32x16 mfma8(i32x8 a, i32x8 b, f32x16 c) { return __builtin_amdgcn_mfma_scale_f32_32x32x64_f8f6f4(a, b, c, 0, 0, 0, 0x7F7F7F7F, 0, 0x7F7F7F7F); }
__device__ __forceinline__ i32x8 ld32(const char* p) { const u32x4 a = *reinterpret_cast<const u32x4*>(p), b = *reinterpret_cast<const u32x4*>(p + 16); return (i32x8){(int)a.x, (int)a.y, (int)a.z, (int)a.w, (int)b.x, (int)b.y, (int)b.z, (int)b.w}; }
__device__ __forceinline__ void partialSM(f32x16& p0, f32x16& p1, float& m_reg, float& mn, float& alpha) {
    constexpr float C = SCALE * 1.4426950408889634f;
    float pmax = p0[0];
#pragma unroll
    for (int r = 1; r < 16; ++r) pmax = fmaxf(pmax, p0[r]);
#pragma unroll
    for (int r = 0; r < 16; ++r) pmax = fmaxf(pmax, p1[r]);
    { auto rr = __builtin_amdgcn_permlane32_swap(__float_as_uint(pmax), __float_as_uint(pmax), false, false);
      pmax = fmaxf(__uint_as_float(rr[0]), __uint_as_float(rr[1])); }
    if (__builtin_expect(__all(pmax - m_reg <= THR / SCALE), 1)) { mn = m_reg; alpha = 1.f; }
    else { mn = fmaxf(m_reg, pmax); alpha = __builtin_amdgcn_exp2f((m_reg - mn) * C); m_reg = mn; }
    const float mnC = POFF - mn * C;
#pragma unroll
    for (int r = 0; r < 16; ++r) p0[r] = fmaf(p0[r], C, mnC);
#pragma unroll
    for (int r = 0; r < 16; ++r) p1[r] = fmaf(p1[r], C, mnC);
#pragma unroll
    for (int r = 0; r < 16; ++r) p0[r] = __builtin_amdgcn_exp2f(p0[r]);
}
__device__ __forceinline__ void finishSM(f32x16& p0, f32x16& p1, float alpha, float& l_reg, i32x8& pa) {
#pragma unroll
    for (int r = 0; r < 16; ++r) p1[r] = __builtin_amdgcn_exp2f(p1[r]);
    float ps = 0;
#pragma unroll
    for (int r = 0; r < 16; ++r) ps += p0[r];
#pragma unroll
    for (int r = 0; r < 16; ++r) ps += p1[r];
    { auto rr = __builtin_amdgcn_permlane32_swap(__float_as_uint(ps), __float_as_uint(ps), false, false);
      ps = __uint_as_float(rr[0]) + __uint_as_float(rr[1]); }
    l_reg = l_reg * alpha + ps;
#pragma unroll
    for (int g = 0; g < 4; ++g) { int w = 0; w = __builtin_amdgcn_cvt_pk_fp8_f32(p0[4 * g], p0[4 * g + 1], w, false); w = __builtin_amdgcn_cvt_pk_fp8_f32(p0[4 * g + 2], p0[4 * g + 3], w, true); pa[g] = w; }
#pragma unroll
    for (int g = 0; g < 4; ++g) { int w = 0; w = __builtin_amdgcn_cvt_pk_fp8_f32(p1[4 * g], p1[4 * g + 1], w, false); w = __builtin_amdgcn_cvt_pk_fp8_f32(p1[4 * g + 2], p1[4 * g + 3], w, true); pa[4 + g] = w; }
}
__device__ __forceinline__ void qkt(f32x16& p0, f32x16& p1, const char* Ks, const i32x8* qr, int r32, int hi) {
    p0 = f32x16{}; p1 = f32x16{};
#pragma unroll
    for (int ks = 0; ks < 3; ++ks) { const int cb = ks * 64 + hi * 32;
        const i32x8 a0 = ld32(Ks + r32 * KROW + cb), a1 = ld32(Ks + (32 + r32) * KROW + cb);
        p0 = mfma8(a0, qr[ks], p0); p1 = mfma8(a1, qr[ks], p1); }
}
__device__ __forceinline__ void pv(f32x16* o, const char* Vs, i32x8 pa, int r32, int hi) {
#pragma unroll
    for (int d0 = 0; d0 < 4; ++d0) { const i32x8 b = ld32(Vs + (32 * d0 + r32) * VROW + hi * 32); o[d0] = mfma8(pa, b, o[d0]); }
}
__device__ __forceinline__ void attn_unit(const unsigned char* __restrict__ Qb, const unsigned char* __restrict__ Kh, const unsigned char* __restrict__ Vt, bf16_t* __restrict__ Ob, char* lds, int tid) {
    const int wid = tid >> 6, lane = tid & 63, r32 = lane & 31, hi = lane >> 5;
    char* V_lds = lds + OFF_V; char* K_lds = lds + OFF_K;
    float* ws = (float*)(lds + OFF_WS) + wid * 64; float* li_l = ws; float* al_l = ws + 32;
    float m_reg = -1e30f, l_reg = 0; f32x16 o[4] = {}; i32x8 qr[3];
    const unsigned char* Qw = Qb + (long)(wid * QBLK + r32) * DQK + hi * 32;
#pragma unroll
    for (int ks = 0; ks < 3; ++ks) qr[ks] = ld32((const char*)Qw + ks * 64);
    const int kst0 = (tid / 12) * KROW + (tid % 12) * 16, kst1 = ((tid + 512) / 12) * KROW + ((tid + 512) % 12) * 16, vst = (tid >> 2) * VROW + (tid & 3) * 16;
    const bool k2 = tid < 256;
    struct { u32x4 v, k0, k1; } sr_[2];
#define SLOAD(i, t) do { sr_[i].v = *reinterpret_cast<const u32x4*>(Vt + (long)(t) * 8192 + tid * 16); const unsigned char* kp_ = Kh + (long)(t) * 12288 + tid * 16; \
    sr_[i].k0 = *reinterpret_cast<const u32x4*>(kp_); if (k2) sr_[i].k1 = *reinterpret_cast<const u32x4*>(kp_ + 8192); } while (0)
#define SWRITE(b, i) do { *(u32x4*)(V_lds + (b) * SHM_V + vst) = sr_[i].v; *(u32x4*)(K_lds + (b) * SHM_K + kst0) = sr_[i].k0; if (k2) *(u32x4*)(K_lds + (b) * SHM_K + kst1) = sr_[i].k1; } while (0)
#define RESC(a) do { if (__any((a) < 1.f)) { if (hi == 0) al_l[r32] = (a); asm volatile("s_waitcnt lgkmcnt(0)" ::: "memory"); \
    _Pragma("unroll") for (int d = 0; d < 4; ++d) _Pragma("unroll") for (int r = 0; r < 16; ++r) o[d][r] *= al_l[crow(r, hi)]; } } while (0)
    f32x16 pA0, pA1, pB0, pB1; float mnA, mnB, alA, alB; i32x8 pa; constexpr int NT = SEQ / KVBLK;
    SLOAD(0, 0); asm volatile("s_waitcnt vmcnt(0)" ::: "memory"); SWRITE(0, 0); __syncthreads();
    qkt(pA0, pA1, K_lds, qr, r32, hi); partialSM(pA0, pA1, m_reg, mnA, alA);
    SLOAD(1, 1); SLOAD(0, 2);
    SWRITE(1, 1); __syncthreads();
    for (int j = 1; j + 1 < NT; j += 2) {
        SBAR(); qkt(pB0, pB1, K_lds + SHM_K, qr, r32, hi);
        finishSM(pA0, pA1, alA, l_reg, pa); SBAR();
        SLOAD(1, j + 2); SBAR();
        pv(o, V_lds, pa, r32, hi); partialSM(pB0, pB1, m_reg, mnB, alB);
        __syncthreads(); SWRITE(0, 0);
        RESC(alB); __syncthreads();
        SBAR(); qkt(pA0, pA1, K_lds, qr, r32, hi);
        finishSM(pB0, pB1, alB, l_reg, pa); SBAR();
        if (j + 3 < NT) SLOAD(0, j + 3); SBAR();
        pv(o, V_lds + SHM_V, pa, r32, hi); partialSM(pA0, pA1, m_reg, mnA, alA);
        __syncthreads(); SWRITE(1, 1);
        RESC(alA); __syncthreads();
    }
    SBAR(); qkt(pB0, pB1, K_lds + SHM_K, qr, r32, hi);
    finishSM(pA0, pA1, alA, l_reg, pa); SBAR();
    pv(o, V_lds, pa, r32, hi); partialSM(pB0, pB1, m_reg, mnB, alB);
    __syncthreads(); RESC(alB);
    finishSM(pB0, pB1, alB, l_reg, pa); SBAR();
    pv(o, V_lds + SHM_V, pa, r32, hi);
    if (hi == 0) li_l[r32] = l_reg; asm volatile("s_waitcnt lgkmcnt(0)" ::: "memory");
    float rli[16];
#pragma unroll
    for (int r = 0; r < 16; ++r) rli[r] = __builtin_amdgcn_rcpf(li_l[crow(r, hi)]);
    __syncthreads();
    bf16_t* ost = (bf16_t*)(lds + wid * 8192);
#pragma unroll
    for (int r = 0; r < 16; ++r) { const int orow = crow(r, hi);
#pragma unroll
        for (int d0 = 0; d0 < 4; ++d0) ost[orow * 128 + d0 * 32 + r32] = (bf16_t)f2bf(o[d0][r] * rli[r]); }
    asm volatile("s_waitcnt lgkmcnt(0)" ::: "memory");
    bf16_t* Ow = Ob + (long)(wid * QBLK) * DM;
#pragma unroll
    for (int i = 0; i < 8; ++i) { const int ch = lane + 64 * i, row = ch >> 4, c = ch & 15;
        const u32x4 v = *(const u32x4*)((const char*)ost + row * 256 + c * 16); *(u32x4*)(Ow + (long)row * DM + c * 8) = v; }
    __syncthreads();
#undef SLOAD
#undef SWRITE
#undef RESC
}

__device__ __forceinline__ float max3f(float a, float b, float c) { float r; asm("v_max3_f32 %0, %1, %2, %3" : "=v"(r) : "v"(a), "v"(b), "v"(c)); return r; }
__device__ __forceinline__ float max2f(float a, float b) { float r; asm("v_max_f32_e32 %0, %1, %2" : "=v"(r) : "v"(a), "v"(b)); return r; }
constexpr float THR2 = THR * 1.4426950408889634f;
__device__ __forceinline__ void softmax_seg(f32x16& p0, f32x16& p1, f32x16& negm, float& l_reg, f32x16* o, i32x8& pa, float* al_l, int r32, int hi) {
    float pmax = max3f(p0[0], p0[1], p0[2]);
#pragma unroll
    for (int r = 3; r < 15; r += 2) pmax = max3f(pmax, p0[r], p0[r + 1]);
    pmax = max3f(pmax, p0[15], p1[0]);
#pragma unroll
    for (int r = 1; r < 15; r += 2) pmax = max3f(pmax, p1[r], p1[r + 1]);
    pmax = max2f(pmax, p1[15]);
    { auto rr = __builtin_amdgcn_permlane32_swap(__float_as_uint(pmax), __float_as_uint(pmax), false, false);
      pmax = max2f(__uint_as_float(rr[0]), __uint_as_float(rr[1])); }
    float alpha = 1.f;
    if (!__builtin_expect(__all(pmax <= POFF + THR2), 1)) {
        const float d = fmaxf(pmax - POFF, 0.f);
        alpha = __builtin_amdgcn_exp2f(-d);
#pragma unroll
        for (int r = 0; r < 16; ++r) { p0[r] -= d; p1[r] -= d; negm[r] -= d; }
        if (hi == 0) al_l[r32] = alpha; asm volatile("s_waitcnt lgkmcnt(0)" ::: "memory");
#pragma unroll
        for (int dd = 0; dd < 4; ++dd)
#pragma unroll
            for (int r = 0; r < 16; ++r) o[dd][r] *= al_l[crow(r, hi)];
    }
    float ps = 0;
#pragma unroll
    for (int r = 0; r < 16; ++r) { p0[r] = __builtin_amdgcn_exp2f(p0[r]); ps += p0[r]; }
#pragma unroll
    for (int r = 0; r < 16; ++r) { p1[r] = __builtin_amdgcn_exp2f(p1[r]); ps += p1[r]; }
    { auto rr = __builtin_amdgcn_permlane32_swap(__float_as_uint(ps), __float_as_uint(ps), false, false);
      ps = __uint_as_float(rr[0]) + __uint_as_float(rr[1]); }
    l_reg = l_reg * alpha + ps;
#pragma unroll
    for (int g = 0; g < 4; ++g) { int w = 0; w = __builtin_amdgcn_cvt_pk_fp8_f32(p0[4 * g], p0[4 * g + 1], w, false); w = __builtin_amdgcn_cvt_pk_fp8_f32(p0[4 * g + 2], p0[4 * g + 3], w, true); pa[g] = w; }
#pragma unroll
    for (int g = 0; g < 4; ++g) { int w = 0; w = __builtin_amdgcn_cvt_pk_fp8_f32(p1[4 * g], p1[4 * g + 1], w, false); w = __builtin_amdgcn_cvt_pk_fp8_f32(p1[4 * g + 2], p1[4 * g + 3], w, true); pa[4 + g] = w; }
}
__device__ __forceinline__ f32x16 mfma8q(i32x8 a, i32x8 b, f32x16 c) { return __builtin_amdgcn_mfma_scale_f32_32x32x64_f8f6f4(a, b, c, 0, 0, 0, 0x7F7F7F7F, 0, 0x7C7C7C7C); }
constexpr int KPF = 2;
__device__ __forceinline__ void kfrag_load(i32x8 (&ka)[KPF][2], const char* Ks, int r32, int hi) {
#pragma unroll
    for (int ks = 0; ks < KPF; ++ks) { const int cb = ks * 64 + hi * 32; ka[ks][0] = ld32(Ks + r32 * KROW + cb); ka[ks][1] = ld32(Ks + (32 + r32) * KROW + cb); }
}
template <bool DO_QK, bool DO_PV>
__device__ __forceinline__ void mfma_seg(f32x16& p0, f32x16& p1, const f32x16& negm, f32x16* o, const i32x8 (&ka)[KPF][2], const char* Ks, const char* Vs, const i32x8* qr, i32x8 pa, int r32, int hi) {
    i32x8 vb[4], kr[3][2];
    if (DO_QK) {
#pragma unroll
        for (int ks = KPF; ks < 3; ++ks) { const int cb = ks * 64 + hi * 32; kr[ks][0] = ld32(Ks + r32 * KROW + cb); kr[ks][1] = ld32(Ks + (32 + r32) * KROW + cb); } }
    if (DO_PV) { vb[0] = ld32(Vs + r32 * VROW + hi * 32); vb[1] = ld32(Vs + (32 + r32) * VROW + hi * 32); }
    SBAR();
    if (DO_QK) {
#pragma unroll
        for (int ks = 0; ks < KPF; ++ks) { p0 = mfma8q(ka[ks][0], qr[ks], ks == 0 ? negm : p0); p1 = mfma8q(ka[ks][1], qr[ks], ks == 0 ? negm : p1); } }
    if (DO_PV) { vb[2] = ld32(Vs + (64 + r32) * VROW + hi * 32); vb[3] = ld32(Vs + (96 + r32) * VROW + hi * 32); }
    SBAR();
    if (DO_QK) {
#pragma unroll
        for (int ks = KPF; ks < 3; ++ks) { p0 = mfma8q(kr[ks][0], qr[ks], p0); p1 = mfma8q(kr[ks][1], qr[ks], p1); } }
    if (DO_PV) {
#pragma unroll
        for (int d0 = 0; d0 < 4; ++d0) o[d0] = mfma8(pa, vb[d0], o[d0]); }
}
__device__ __forceinline__ void attn_unit_pp(const unsigned char* __restrict__ Qb, const unsigned char* __restrict__ Kh, const unsigned char* __restrict__ Vt, bf16_t* __restrict__ Ob, char* lds, int tid) {
    const int wid = __builtin_amdgcn_readfirstlane(tid >> 6), lane = tid & 63, r32 = lane & 31, hi = lane >> 5;
    const bool halfB = wid >= 4;
    char* V_lds = lds + OFF_V; char* K_lds = lds + OFF_K;
    float* ws = (float*)(lds + OFF_WS) + wid * 64; float* li_l = ws; float* al_l = ws + 32;
    float l_reg = 0; f32x16 o[4] = {}; i32x8 qr[3]; f32x16 negm;
#pragma unroll
    for (int r = 0; r < 16; ++r) negm[r] = 60.f;
    const unsigned char* Qw = Qb + (long)(wid * QBLK + r32) * DQK + hi * 32;
#pragma unroll
    for (int ks = 0; ks < 3; ++ks) qr[ks] = ld32((const char*)Qw + ks * 64);
    const int kst0 = (tid / 12) * KROW + (tid % 12) * 16, kst1 = ((tid + 512) / 12) * KROW + ((tid + 512) % 12) * 16, vst = (tid >> 2) * VROW + (tid & 3) * 16;
    const bool k2 = wid < 4;
    constexpr int NT = SEQ / KVBLK;
    u32x4 sv, sk0, sk1 = {0u, 0u, 0u, 0u};
#define LOADK(t) do { const unsigned char* kp_ = Kh + (long)((t) < NT ? (t) : NT - 1) * 12288 + tid * 16; sk0 = *reinterpret_cast<const u32x4*>(kp_); if (k2) sk1 = *reinterpret_cast<const u32x4*>(kp_ + 8192); } while (0)
#define LOADV(t) do { sv = *reinterpret_cast<const u32x4*>(Vt + (long)((t) < NT ? (t) : NT - 1) * 8192 + tid * 16); } while (0)
#define WRITEK(b) do { *(u32x4*)(K_lds + (b) * SHM_K + kst0) = sk0; if (k2) *(u32x4*)(K_lds + (b) * SHM_K + kst1) = sk1; } while (0)
#define WRITEV(b) do { *(u32x4*)(V_lds + (b) * SHM_V + vst) = sv; } while (0)
#define BAR() do { SBAR(); __syncthreads(); SBAR(); } while (0)
    f32x16 p0, p1; i32x8 pa = {}; i32x8 ka[KPF][2];
    LOADK(0); WRITEK(0); LOADK(1); WRITEK(1); __syncthreads();
    LOADK(2); LOADV(0);
    kfrag_load(ka, K_lds, r32, hi);
    if (halfB) BAR();
    WRITEK(2); WRITEV(0); LOADK(3); LOADV(1);
    mfma_seg<true, false>(p0, p1, negm, o, ka, K_lds, V_lds, qr, pa, r32, hi);
    BAR();
    softmax_seg(p0, p1, negm, l_reg, o, pa, al_l, r32, hi);
    kfrag_load(ka, K_lds + SHM_K, r32, hi);
    BAR();
    int kb3 = 0, kb1 = 1, kb2 = 2;
    for (int t = 0; t < NT - 1; ++t) {
        WRITEK(kb3); WRITEV((t + 1) & 1); LOADK(t + 4); LOADV(t + 2);
        mfma_seg<true, true>(p0, p1, negm, o, ka, K_lds + kb1 * SHM_K, V_lds + (t & 1) * SHM_V, qr, pa, r32, hi);
        BAR();
        softmax_seg(p0, p1, negm, l_reg, o, pa, al_l, r32, hi);
        kfrag_load(ka, K_lds + kb2 * SHM_K, r32, hi);
        BAR();
        kb3 = (kb3 == 2) ? 0 : kb3 + 1; kb1 = (kb1 == 2) ? 0 : kb1 + 1; kb2 = (kb2 == 2) ? 0 : kb2 + 1;
    }
    mfma_seg<false, true>(p0, p1, negm, o, ka, K_lds, V_lds + ((NT - 1) & 1) * SHM_V, qr, pa, r32, hi);
    if (!halfB) BAR();
    if (hi == 0) li_l[r32] = l_reg; asm volatile("s_waitcnt lgkmcnt(0)" ::: "memory");
    float rli[16];
#pragma unroll
    for (int r = 0; r < 16; ++r) rli[r] = __builtin_amdgcn_rcpf(li_l[crow(r, hi)]);
    __syncthreads();
    bf16_t* ost = (bf16_t*)(lds + wid * 8192);
#pragma unroll
    for (int r = 0; r < 16; ++r) { const int orow = crow(r, hi);
#pragma unroll
        for (int d0 = 0; d0 < 4; ++d0) ost[orow * 128 + d0 * 32 + r32] = (bf16_t)f2bf(o[d0][r] * rli[r]); }
    asm volatile("s_waitcnt lgkmcnt(0)" ::: "memory");
    bf16_t* Ow = Ob + (long)(wid * QBLK) * DM;
#pragma unroll
    for (int i = 0; i < 8; ++i) { const int ch = lane + 64 * i, row = ch >> 4, c = ch & 15;
        const u32x4 v = *(const u32x4*)((const char*)ost + row * 256 + c * 16); *(u32x4*)(Ow + (long)row * DM + c * 8) = v; }
    __syncthreads();
#undef LOADK
#undef LOADV
#undef WRITEK
#undef WRITEV
#undef BAR
}
#undef SBAR
}

struct Args { const void* in[23]; float* out; unsigned char* ws; int ph_lo, ph_hi; };
enum { I_X = 0, I_POS, I_CNW, I_CWIN, I_CK, I_CWOUT, I_MNW, I_MWDOWN, I_MQLN, I_MKVLN, I_MWQ, I_MWKV, I_MQHN, I_MKHN, I_MWO, I_FNW, I_RWG, I_RBG, I_RWE, I_RBE, I_EWG, I_EWU, I_EWD };

struct CvtItem { const float* W; bf16_t* WT; const float* ksc; int K, N, k0, n0, drow0; };
__device__ __forceinline__ unsigned char* ldptr(int i);
constexpr int CVT_PER_J = 768 + 256 + 176 + 144 + 128 + 256;
constexpr int CVT_MIX = 2 * CVT_PER_J, CVT_EXP = MK_ENABLE_MOE ? 4 * NE * 288 : 0, CVT_ITEMS = CVT_MIX + CVT_EXP;
__device__ __forceinline__ void cvt_decode(int it, CvtItem& c, unsigned char* ws) {
    if (it < CVT_MIX) {
        const int j = it / CVT_PER_J; int r = it - j * CVT_PER_J; int kb, nb;
        if (r < 768) { c.K = 1024; c.N = 3072; c.W = (const float*)ldptr(I_CWIN) + (size_t)j * 1024 * 3072; c.WT = (bf16_t*)(ws + WS_WIN) + (size_t)j * 3072 * 1024; c.ksc = (const float*)ldptr(I_CNW) + j * 1024;
            kb = r / 48; nb = r % 48; const int n0 = nb * 64;
            if (n0 < 1024) c.drow0 = n0; else if (n0 < 2048) { const int q = n0 - 1024; c.drow0 = 1024 + (q >> 7) * 256 + (q & 127); } else { const int q = n0 - 2048; c.drow0 = 1024 + (q >> 7) * 256 + 128 + (q & 127); } }
        else if ((r -= 768) < 256) { c.K = 1024; c.N = 1024; c.W = (const float*)ldptr(I_CWOUT) + (size_t)j * 1024 * 1024; c.WT = (bf16_t*)(ws + WS_WOUTC) + (size_t)j * 1024 * 1024; c.ksc = nullptr; kb = r / 16; nb = r % 16; c.drow0 = nb * 64; }
        else if ((r -= 256) < 176) { c.K = 1024; c.N = LAT; c.W = (const float*)ldptr(I_MWDOWN) + (size_t)j * 1024 * LAT; c.WT = (bf16_t*)(ws + WS_WDOWN) + (size_t)j * LATP * 1024; c.ksc = (const float*)ldptr(I_MNW) + j * 1024; kb = r / 11; nb = r % 11; c.drow0 = nb * 64; }
        else if ((r -= 176) < 144) { c.K = QLR; c.N = NH * DQK; c.W = (const float*)ldptr(I_MWQ) + (size_t)j * QLR * NH * DQK; c.WT = (bf16_t*)(ws + WS_WQ + (size_t)j * 1536 * 1024); c.ksc = (const float*)ldptr(I_MQLN) + j * QLR; kb = r / 24; nb = r % 24; c.drow0 = nb * 64; }
        else if ((r -= 144) < 128) { c.K = KVLR; c.N = NH * 256; c.W = (const float*)ldptr(I_MWKV) + (size_t)j * KVLR * NH * 256; c.WT = (bf16_t*)(ws + WS_WKV) + (size_t)j * 2048 * 256; c.ksc = (const float*)ldptr(I_MKVLN) + j * KVLR; kb = r / 32; nb = r % 32; c.drow0 = nb * 64; }
        else { r -= 128; c.K = 1024; c.N = 1024; c.W = (const float*)ldptr(I_MWO) + (size_t)j * 1024 * 1024; c.WT = (bf16_t*)(ws + WS_WO) + (size_t)j * 1024 * 1024; c.ksc = nullptr; kb = r / 16; nb = r % 16; c.drow0 = nb * 64; }
        c.k0 = kb * 64; c.n0 = nb * 64;
    } else {
        const int r = it - CVT_MIX; const int le = r / 288, q = r - le * 288, L = le >> 6; const int kind = q / 96, idx = q - kind * 96; int kb, nb;
        if (kind < 2) { c.K = 1024; c.N = DFF; c.W = (const float*)ldptr(kind == 0 ? I_EWG : I_EWU) + (size_t)le * 1024 * DFF; c.WT = (bf16_t*)(ws + WS_WE1) + (size_t)le * 768 * 1024; c.ksc = (const float*)ldptr(I_FNW) + L * 1024;
            kb = idx / 6; nb = idx % 6; const int n0 = nb * 64; c.drow0 = (n0 >> 7) * 256 + kind * 128 + (n0 & 127); }
        else { c.K = DFF; c.N = 1024; c.W = (const float*)ldptr(I_EWD) + (size_t)le * DFF * 1024; c.WT = (bf16_t*)(ws + WS_WE2) + (size_t)le * 1024 * DFF; c.ksc = nullptr; kb = idx / 16; nb = idx % 16; c.drow0 = nb * 64; }
        c.k0 = kb * 64; c.n0 = nb * 64;
    }
}
__device__ __forceinline__ void cvt_load(const CvtItem& c, f32x4 (&v)[16], int lane) {
    const float* p = c.W + (size_t)(c.k0 + (lane >> 4)) * c.N + c.n0 + 4 * (lane & 15);
#pragma unroll
    for (int i = 0; i < 16; ++i) v[i] = *(const f32x4*)(p + (size_t)(4 * i) * c.N);
}
__device__ __forceinline__ void cvt_lds_write(LAS float* tile, const f32x4 (&v)[16], int lane) {
#pragma unroll
    for (int i = 0; i < 16; ++i) { const int r = 4 * i + (lane >> 4), n = 4 * (lane & 15), x = r & 31; LAS float* row = tile + r * 64;
        row[(n + 0) ^ x] = v[i].x; row[(n + 1) ^ x] = v[i].y; row[(n + 2) ^ x] = v[i].z; row[(n + 3) ^ x] = v[i].w; }
}
__device__ __forceinline__ void cvt_out(const CvtItem& c, const LAS float* tile, int lane) {
    const int cc = lane & 7, np = lane >> 3;
    f32x4 s0 = {1.f, 1.f, 1.f, 1.f}, s1 = {1.f, 1.f, 1.f, 1.f};
    if (c.ksc) { s0 = *(const f32x4*)(c.ksc + c.k0 + 8 * cc); s1 = *(const f32x4*)(c.ksc + c.k0 + 8 * cc + 4); }
#pragma unroll
    for (int jj = 0; jj < 8; ++jj) { const int n = np + 8 * jj; float t[8];
#pragma unroll
        for (int q = 0; q < 8; ++q) { const int k = 8 * cc + q; t[q] = tile[k * 64 + (n ^ (k & 31))]; }
        u32x4 o; o.x = pk2(t[0] * s0.x, t[1] * s0.y); o.y = pk2(t[2] * s0.z, t[3] * s0.w); o.z = pk2(t[4] * s1.x, t[5] * s1.y); o.w = pk2(t[6] * s1.z, t[7] * s1.w);
        *(GAS u32x4*)(c.WT + (size_t)(c.drow0 + n) * c.K + c.k0 + 8 * cc) = o; }
}

__device__ __forceinline__ void prologue_phase(LAS unsigned char* lds, int gw, int NGW, int wave, int lane, int gtid, int NGT) {
    unsigned char* ws = ldptr(24);
    LAS float* tile = (LAS float*)(lds + wave * 16384);
    {   CvtItem cur, nxt; f32x4 v[16]; int it = gw;
        if (it < CVT_ITEMS) { cvt_decode(it, cur, ws); cvt_load(cur, v, lane); }
        while (it < CVT_ITEMS) {
            cvt_lds_write(tile, v, lane);
            const int itn = it + NGW;
            if (itn < CVT_ITEMS) { cvt_decode(itn, nxt, ws); cvt_load(nxt, v, lane); }
            LDS_WAIT(); asm volatile("" ::: "memory");
            cvt_out(cur, tile, lane);
            LDS_WAIT(); asm volatile("" ::: "memory");
            cur = nxt; it = itn;
        }
    }
#if MK_ENABLE_MOE
    const float* fnw = (const float*)ldptr(I_FNW); const float* rwg = (const float*)ldptr(I_RWG); const float* rwe = (const float*)ldptr(I_RWE);
    for (int i = gtid; i < 4 * 256 * 128; i += NGT) {
        const int L = i >> 15, n = (i >> 7) & 255, k8 = (i & 127) * 8;
        u32x4 o = {0u, 0u, 0u, 0u};
        if (n < 72) { float v[8];
#pragma unroll
            for (int q = 0; q < 8; ++q) { const int k = k8 + q; const float g = fnw[L * 1024 + k];
                v[q] = g * (n < 8 ? rwg[((size_t)L * 1024 + k) * 8 + n] : rwe[((size_t)L * 1024 + k) * 64 + (n - 8)]); }
            o.x = pk2(v[0], v[1]); o.y = pk2(v[2], v[3]); o.z = pk2(v[4], v[5]); o.w = pk2(v[6], v[7]); }
        *(u32x4*)((bf16_t*)(ws + WS_WRT) + ((size_t)L * 256 + n) * 1024 + k8) = o;
    }
#endif
    for (int i = gtid; i < 2 * 64 * 128; i += NGT) { const int j = i >> 13, n = LAT + ((i >> 7) & 63), k8 = (i & 127) * 8;
        *(u32x4*)((bf16_t*)(ws + WS_WDOWN) + ((size_t)j * LATP + n) * 1024 + k8) = (u32x4){0u, 0u, 0u, 0u}; }
}

template <bool XF32_IN, bool F32_OUT>
__device__ __forceinline__ void resid_phase(const void* xin, const bf16_t* Y, void* xout, float* rinv, int gw, int NGW, int lane) {
    for (int m = gw; m < T; m += NGW) {
        f32x4 v[4];
        if constexpr (XF32_IN) { const f32x4* xr = (const f32x4*)((const float*)xin + (size_t)m * DM) + lane;
#pragma unroll
            for (int j = 0; j < 4; ++j) v[j] = xr[64 * j]; }
        else { const u32x2* xr = (const u32x2*)((const bf16_t*)xin + (size_t)m * DM) + lane;
#pragma unroll
            for (int j = 0; j < 4; ++j) { const u32x2 p = xr[64 * j]; v[j] = (f32x4){bflo(p.x), bfhi(p.x), bflo(p.y), bfhi(p.y)}; } }
        if (Y) { const u32x2* y0 = (const u32x2*)(Y + (size_t)(2 * m) * DM) + lane; const u32x2* y1 = y0 + 256;
#pragma unroll
            for (int j = 0; j < 4; ++j) { const u32x2 p = y0[64 * j], q = y1[64 * j];
                v[j].x += bflo(p.x) + bflo(q.x); v[j].y += bfhi(p.x) + bfhi(q.x); v[j].z += bflo(p.y) + bflo(q.y); v[j].w += bfhi(p.y) + bfhi(q.y); } }
        if constexpr (F32_OUT) { f32x4* xo = (f32x4*)((float*)xout + (size_t)m * DM) + lane;
#pragma unroll
            for (int j = 0; j < 4; ++j) xo[64 * j] = v[j]; }
        else { u32x2* xo = (u32x2*)((bf16_t*)xout + (size_t)m * DM) + lane;
#pragma unroll
            for (int j = 0; j < 4; ++j) { u32x2 w; w.x = pk2(v[j].x, v[j].y); w.y = pk2(v[j].z, v[j].w); xo[64 * j] = w; } }
        if (rinv) { float s = 0.f;
#pragma unroll
            for (int j = 0; j < 4; ++j) s += (v[j].x * v[j].x + v[j].y * v[j].y) + (v[j].z * v[j].z + v[j].w * v[j].w);
            const float r = 1.0f / sqrtf(wave_sum(s, lane) * (1.f / DM) + EPS);
            if (lane == 0) rinv[m] = r; }
    }
}

__device__ __forceinline__ void conv_phase(const bf16_t* GBp, const bf16_t* Zp, const float* ck, bf16_t* YCp, int gtid, int NGT) {
    for (int i = gtid; i < T * 128; i += NGT) {
        const int t = i >> 7, c8 = (i & 127) * 8, s = t & (SEQ - 1);
        const u32x4 zc = *(const u32x4*)(Zp + (size_t)t * DM + c8), g = *(const u32x4*)(GBp + (size_t)t * DM + c8);
        u32x4 zm = {0u, 0u, 0u, 0u}, zp = {0u, 0u, 0u, 0u};
        if (s > 0) zm = *(const u32x4*)(Zp + (size_t)(t - 1) * DM + c8);
        if (s < SEQ - 1) zp = *(const u32x4*)(Zp + (size_t)(t + 1) * DM + c8);
        const f32x4 k0a = *(const f32x4*)(ck + c8), k0b = *(const f32x4*)(ck + c8 + 4), k1a = *(const f32x4*)(ck + DM + c8), k1b = *(const f32x4*)(ck + DM + c8 + 4), k2a = *(const f32x4*)(ck + 2 * DM + c8), k2b = *(const f32x4*)(ck + 2 * DM + c8 + 4);
        float y[8];
#define CV(q, W, KA, LOHI) y[q] = LOHI(g.W) * (LOHI(zm.W) * k0##KA + LOHI(zc.W) * k1##KA + LOHI(zp.W) * k2##KA)
        CV(0, x, a[0], bflo); CV(1, x, a[1], bfhi); CV(2, y, a[2], bflo); CV(3, y, a[3], bfhi); CV(4, z, b[0], bflo); CV(5, z, b[1], bfhi); CV(6, w, b[2], bflo); CV(7, w, b[3], bfhi);
#undef CV
        u32x4 o; o.x = pk2(y[0], y[1]); o.y = pk2(y[2], y[3]); o.z = pk2(y[4], y[5]); o.w = pk2(y[6], y[7]);
        *(u32x4*)(YCp + (size_t)t * DM + c8) = o;
    }
}

__device__ __forceinline__ void qkprep_phase(const bf16_t* LATb, const bf16_t* QRAW, const bf16_t* KVRAW, const int* pos, const float* qhn, const float* khn,
                                             bf16_t* Qo, bf16_t* Ko, bf16_t* Vo, LAS unsigned char* lds, int gw, int NGW, int wave, int lane) {
    LAS unsigned char* sq = lds + wave * 10240;
    LAS float* cs = (LAS float*)(sq + 8704);
    const int h = lane >> 3, i8 = lane & 7;
    float gq[24], gk[24];
#pragma unroll
    for (int q = 0; q < 16; ++q) { gq[q] = qhn[16 * i8 + q]; gk[q] = khn[16 * i8 + q]; }
#pragma unroll
    for (int q = 0; q < 4; ++q) { gq[16 + q] = qhn[128 + 4 * i8 + q]; gq[20 + q] = qhn[160 + 4 * i8 + q]; gk[16 + q] = khn[128 + 4 * i8 + q]; gk[20 + q] = khn[160 + 4 * i8 + q]; }
    for (int t = gw; t < T; t += NGW) {
        const int b = t >> 14, s = t & (SEQ - 1);
        const u32x4* qs = (const u32x4*)(QRAW + (size_t)t * 1536); const u32x4* ks = (const u32x4*)(KVRAW + (size_t)t * 2048); const u32x4* ls = (const u32x4*)(LATb + (size_t)t * LATP);
        const u32x4 q0 = qs[lane], q1 = qs[lane + 64], q2 = qs[lane + 128], k0 = ks[lane], k1 = ks[lane + 64], k2 = ks[lane + 128], k3 = ks[lane + 192];
        const u32x4 l0 = ls[lane]; u32x4 l1 = {0u, 0u, 0u, 0u}; if (lane < 24) l1 = ls[lane + 64];
        LAS u32x4* d = (LAS u32x4*)sq;
        d[lane] = q0; d[lane + 64] = q1; d[lane + 128] = q2; d[192 + lane] = k0; d[192 + lane + 64] = k1; d[192 + lane + 128] = k2; d[192 + lane + 192] = k3;
        d[448 + lane] = l0; if (lane < 24) d[448 + lane + 64] = l1;
        float s0 = 0.f;
#define SS4(V_) (bflo(V_.x) * bflo(V_.x) + bfhi(V_.x) * bfhi(V_.x) + bflo(V_.y) * bflo(V_.y) + bfhi(V_.y) * bfhi(V_.y) + bflo(V_.z) * bflo(V_.z) + bfhi(V_.z) * bfhi(V_.z) + bflo(V_.w) * bflo(V_.w) + bfhi(V_.w) * bfhi(V_.w))
        s0 = SS4(l0); const float s1 = SS4(l1);
        const float ssq_q = wave_sum(lane < 48 ? s0 : 0.f, lane), ssq_kv = wave_sum((lane >= 48 ? s0 : 0.f) + (lane < 16 ? s1 : 0.f), lane);
        const float r_q = 1.0f / sqrtf(ssq_q * (1.f / QLR) + EPS), r_kv = 1.0f / sqrtf(ssq_kv * (1.f / KVLR) + EPS);
        if (lane < 32) { const float invf = powf(10000.f, -(float)lane * (1.f / 32.f)); const float ang = (float)pos[t] * invf;
            const double rev = (double)ang * 0.15915494309189535; const float fr = (float)(rev - floor(rev));
            cs[lane] = __builtin_amdgcn_cosf(fr); cs[32 + lane] = __builtin_amdgcn_sinf(fr); }
        LDS_WAIT(); asm volatile("" ::: "memory");
        float cj[4], sj[4];
#pragma unroll
        for (int q = 0; q < 4; ++q) { cj[q] = cs[4 * i8 + q]; sj[q] = cs[32 + 4 * i8 + q]; }
        {   const LAS bf16_t* qh = (const LAS bf16_t*)sq + h * DQK;
            const u32x4 a0 = *(const LAS u32x4*)(qh + 16 * i8), a1 = *(const LAS u32x4*)(qh + 16 * i8 + 8);
            const u32x2 r1 = *(const LAS u32x2*)(qh + 128 + 4 * i8), r2 = *(const LAS u32x2*)(qh + 160 + 4 * i8);
            float v[24];
            v[0] = bflo(a0.x); v[1] = bfhi(a0.x); v[2] = bflo(a0.y); v[3] = bfhi(a0.y); v[4] = bflo(a0.z); v[5] = bfhi(a0.z); v[6] = bflo(a0.w); v[7] = bfhi(a0.w);
            v[8] = bflo(a1.x); v[9] = bfhi(a1.x); v[10] = bflo(a1.y); v[11] = bfhi(a1.y); v[12] = bflo(a1.z); v[13] = bfhi(a1.z); v[14] = bflo(a1.w); v[15] = bfhi(a1.w);
            v[16] = bflo(r1.x); v[17] = bfhi(r1.x); v[18] = bflo(r1.y); v[19] = bfhi(r1.y); v[20] = bflo(r2.x); v[21] = bfhi(r2.x); v[22] = bflo(r2.y); v[23] = bfhi(r2.y);
            float ss = 0.f;
#pragma unroll
            for (int q = 0; q < 24; ++q) ss += v[q] * v[q];
            ss += lane_xor_f(ss, 1, lane); ss += lane_xor_f(ss, 2, lane); ss += lane_xor_f(ss, 4, lane);
            const float sc = r_q / sqrtf(r_q * r_q * ss * (1.f / DQK) + EPS);
#pragma unroll
            for (int q = 0; q < 24; ++q) v[q] *= sc * gq[q];
            bf16_t* qo = Qo + ((size_t)(b * NH + h) * SEQ + s) * DQK;
            u32x4 w0, w1; w0.x = pk2(v[0], v[1]); w0.y = pk2(v[2], v[3]); w0.z = pk2(v[4], v[5]); w0.w = pk2(v[6], v[7]); w1.x = pk2(v[8], v[9]); w1.y = pk2(v[10], v[11]); w1.z = pk2(v[12], v[13]); w1.w = pk2(v[14], v[15]);
            *(u32x4*)(qo + 16 * i8) = w0; *(u32x4*)(qo + 16 * i8 + 8) = w1;
            float o1[4], o2[4];
#pragma unroll
            for (int q = 0; q < 4; ++q) { o1[q] = v[16 + q] * cj[q] - v[20 + q] * sj[q]; o2[q] = v[20 + q] * cj[q] + v[16 + q] * sj[q]; }
            u32x2 e1, e2; e1.x = pk2(o1[0], o1[1]); e1.y = pk2(o1[2], o1[3]); e2.x = pk2(o2[0], o2[1]); e2.y = pk2(o2[2], o2[3]);
            *(u32x2*)(qo + 128 + 4 * i8) = e1; *(u32x2*)(qo + 160 + 4 * i8) = e2; }
        {   const LAS bf16_t* kh = (const LAS bf16_t*)(sq + 3072) + h * 256; const LAS bf16_t* lr = (const LAS bf16_t*)(sq + 7168) + 640;
            const u32x4 a0 = *(const LAS u32x4*)(kh + 16 * i8), a1 = *(const LAS u32x4*)(kh + 16 * i8 + 8);
            const u32x4 b0 = *(const LAS u32x4*)(kh + 128 + 16 * i8), b1 = *(const LAS u32x4*)(kh + 128 + 16 * i8 + 8);
            const u32x2 r1 = *(const LAS u32x2*)(lr + 4 * i8), r2 = *(const LAS u32x2*)(lr + 32 + 4 * i8);
            float v[24];
            v[0] = bflo(a0.x); v[1] = bfhi(a0.x); v[2] = bflo(a0.y); v[3] = bfhi(a0.y); v[4] = bflo(a0.z); v[5] = bfhi(a0.z); v[6] = bflo(a0.w); v[7] = bfhi(a0.w);
            v[8] = bflo(a1.x); v[9] = bfhi(a1.x); v[10] = bflo(a1.y); v[11] = bfhi(a1.y); v[12] = bflo(a1.z); v[13] = bfhi(a1.z); v[14] = bflo(a1.w); v[15] = bfhi(a1.w);
#pragma unroll
            for (int q = 0; q < 16; ++q) v[q] *= r_kv;
            v[16] = bflo(r1.x); v[17] = bfhi(r1.x); v[18] = bflo(r1.y); v[19] = bfhi(r1.y); v[20] = bflo(r2.x); v[21] = bfhi(r2.x); v[22] = bflo(r2.y); v[23] = bfhi(r2.y);
            float ss = 0.f;
#pragma unroll
            for (int q = 0; q < 24; ++q) ss += v[q] * v[q];
            ss += lane_xor_f(ss, 1, lane); ss += lane_xor_f(ss, 2, lane); ss += lane_xor_f(ss, 4, lane);
            const float sc = 1.0f / sqrtf(ss * (1.f / DQK) + EPS);
#pragma unroll
            for (int q = 0; q < 24; ++q) v[q] *= sc * gk[q];
            bf16_t* ko = Ko + ((size_t)(b * NH + h) * SEQ + s) * DQK;
            u32x4 w0, w1; w0.x = pk2(v[0], v[1]); w0.y = pk2(v[2], v[3]); w0.z = pk2(v[4], v[5]); w0.w = pk2(v[6], v[7]); w1.x = pk2(v[8], v[9]); w1.y = pk2(v[10], v[11]); w1.z = pk2(v[12], v[13]); w1.w = pk2(v[14], v[15]);
            *(u32x4*)(ko + 16 * i8) = w0; *(u32x4*)(ko + 16 * i8 + 8) = w1;
            float o1[4], o2[4];
#pragma unroll
            for (int q = 0; q < 4; ++q) { o1[q] = v[16 + q] * cj[q] - v[20 + q] * sj[q]; o2[q] = v[20 + q] * cj[q] + v[16 + q] * sj[q]; }
            u32x2 e1, e2; e1.x = pk2(o1[0], o1[1]); e1.y = pk2(o1[2], o1[3]); e2.x = pk2(o2[0], o2[1]); e2.y = pk2(o2[2], o2[3]);
            *(u32x2*)(ko + 128 + 4 * i8) = e1; *(u32x2*)(ko + 160 + 4 * i8) = e2;
            bf16_t* vo = Vo + ((size_t)(b * NH + h) * SEQ + s) * DV;
            u32x4 x0, x1;
            x0.x = pk2(bflo(b0.x) * r_kv, bfhi(b0.x) * r_kv); x0.y = pk2(bflo(b0.y) * r_kv, bfhi(b0.y) * r_kv); x0.z = pk2(bflo(b0.z) * r_kv, bfhi(b0.z) * r_kv); x0.w = pk2(bflo(b0.w) * r_kv, bfhi(b0.w) * r_kv);
            x1.x = pk2(bflo(b1.x) * r_kv, bfhi(b1.x) * r_kv); x1.y = pk2(bflo(b1.y) * r_kv, bfhi(b1.y) * r_kv); x1.z = pk2(bflo(b1.z) * r_kv, bfhi(b1.z) * r_kv); x1.w = pk2(bflo(b1.w) * r_kv, bfhi(b1.w) * r_kv);
            *(u32x4*)(vo + 16 * i8) = x0; *(u32x4*)(vo + 16 * i8 + 8) = x1; }
        LDS_WAIT(); asm volatile("" ::: "memory");
    }
#undef SS4
}


__device__ __forceinline__ unsigned pk4_fp8(float a, float b, float c, float d) { int w = 0; w = __builtin_amdgcn_cvt_pk_fp8_f32(a, b, w, false); w = __builtin_amdgcn_cvt_pk_fp8_f32(c, d, w, true); return (unsigned)w; }
__device__ __forceinline__ void ld16bf(const bf16_t* p, float* v) { const u32x4 a = *(const u32x4*)p, b = *(const u32x4*)(p + 8);
    v[0] = bflo(a.x); v[1] = bfhi(a.x); v[2] = bflo(a.y); v[3] = bfhi(a.y); v[4] = bflo(a.z); v[5] = bfhi(a.z); v[6] = bflo(a.w); v[7] = bfhi(a.w);
    v[8] = bflo(b.x); v[9] = bfhi(b.x); v[10] = bflo(b.y); v[11] = bfhi(b.y); v[12] = bflo(b.z); v[13] = bfhi(b.z); v[14] = bflo(b.w); v[15] = bfhi(b.w); }
__device__ __forceinline__ void ld4bf(const bf16_t* p, float* v) { const u32x2 a = *(const u32x2*)p; v[0] = bflo(a.x); v[1] = bfhi(a.x); v[2] = bflo(a.y); v[3] = bfhi(a.y); }
__device__ __forceinline__ void qkprep8_phase(const bf16_t* LATb, const bf16_t* QRAW, const bf16_t* KVRAW, const int* pos, const float* qhn, const float* khn,
                                              unsigned char* Q8, unsigned char* K8, unsigned char* VT8, LAS unsigned char* lds, int vcu, int G, int wave, int lane, int tid) {
    const int h = lane >> 3, i8 = lane & 7;
    float gq[24], gk[24], invf[4];
#pragma unroll
    for (int q = 0; q < 16; ++q) { gq[q] = qhn[16 * i8 + q]; gk[q] = khn[16 * i8 + q]; }
#pragma unroll
    for (int q = 0; q < 4; ++q) { gq[16 + q] = qhn[128 + 4 * i8 + q]; gq[20 + q] = qhn[160 + 4 * i8 + q]; gk[16 + q] = khn[128 + 4 * i8 + q]; gk[20 + q] = khn[160 + 4 * i8 + q];
        invf[q] = powf(10000.f, -(float)(4 * i8 + q) * (1.f / 32.f)); }
    for (int tile = vcu; tile < T / 64; tile += G) {
        for (int tt = 0; tt < 8; ++tt) {
            const int kk = wave * 8 + tt, t = tile * 64 + kk, b = t >> 14, s = t & (SEQ - 1);
            const u32x4* ls = (const u32x4*)(LATb + (size_t)t * LATP);
            const u32x4 l0 = ls[lane]; u32x4 l1 = {0u, 0u, 0u, 0u}; if (lane < 24) l1 = ls[lane + 64];
#define SS4(V_) (bflo(V_.x) * bflo(V_.x) + bfhi(V_.x) * bfhi(V_.x) + bflo(V_.y) * bflo(V_.y) + bfhi(V_.y) * bfhi(V_.y) + bflo(V_.z) * bflo(V_.z) + bfhi(V_.z) * bfhi(V_.z) + bflo(V_.w) * bflo(V_.w) + bfhi(V_.w) * bfhi(V_.w))
            const float s0 = SS4(l0), s1 = SS4(l1);
#undef SS4
            const float ssq_q = wave_sum(lane < 48 ? s0 : 0.f, lane), ssq_kv = wave_sum((lane >= 48 ? s0 : 0.f) + (lane < 16 ? s1 : 0.f), lane);
            const float r_q = 1.0f / sqrtf(ssq_q * (1.f / QLR) + EPS), r_kv = 1.0f / sqrtf(ssq_kv * (1.f / KVLR) + EPS);
            float cj[4], sj[4]; const float fpos = (float)pos[t];
#pragma unroll
            for (int q = 0; q < 4; ++q) { const float ang = fpos * invf[q]; const double rev = (double)ang * 0.15915494309189535; const float fr = (float)(rev - floor(rev));
                cj[q] = __builtin_amdgcn_cosf(fr); sj[q] = __builtin_amdgcn_sinf(fr); }
            const size_t orow = ((size_t)(b * NH + h) * SEQ + s) * DQK;
            {
                const bf16_t* qh = QRAW + (size_t)t * 1536 + h * DQK; float v[24];
                ld16bf(qh + 16 * i8, v); ld4bf(qh + 128 + 4 * i8, v + 16); ld4bf(qh + 160 + 4 * i8, v + 20);
                float ss = 0.f;
#pragma unroll
                for (int q = 0; q < 24; ++q) ss += v[q] * v[q];
                ss += lane_xor_f(ss, 1, lane); ss += lane_xor_f(ss, 2, lane); ss += lane_xor_f(ss, 4, lane);
                const float sc = r_q / sqrtf(r_q * r_q * ss * (1.f / DQK) + EPS) * (ATT_PP ? 8.f * 0.07216878364870322f * 1.4426950408889634f : 1.f);
#pragma unroll
                for (int q = 0; q < 24; ++q) v[q] *= sc * gq[q];
                u32x4 w; w.x = pk4_fp8(v[0], v[1], v[2], v[3]); w.y = pk4_fp8(v[4], v[5], v[6], v[7]); w.z = pk4_fp8(v[8], v[9], v[10], v[11]); w.w = pk4_fp8(v[12], v[13], v[14], v[15]);
                *(u32x4*)(Q8 + orow + 16 * i8) = w;
                float o1[4], o2[4];
#pragma unroll
                for (int q = 0; q < 4; ++q) { o1[q] = v[16 + q] * cj[q] - v[20 + q] * sj[q]; o2[q] = v[20 + q] * cj[q] + v[16 + q] * sj[q]; }
                *(unsigned*)(Q8 + orow + 128 + 4 * i8) = pk4_fp8(o1[0], o1[1], o1[2], o1[3]); *(unsigned*)(Q8 + orow + 160 + 4 * i8) = pk4_fp8(o2[0], o2[1], o2[2], o2[3]); }
            {
                const bf16_t* kh = KVRAW + (size_t)t * 2048 + h * 256; const bf16_t* lr = LATb + (size_t)t * LATP + 640; float v[24], vv[16];
                ld16bf(kh + 16 * i8, v); ld4bf(lr + 4 * i8, v + 16); ld4bf(lr + 32 + 4 * i8, v + 20); ld16bf(kh + 128 + 16 * i8, vv);
#pragma unroll
                for (int q = 0; q < 16; ++q) v[q] *= r_kv;
                float ss = 0.f;
#pragma unroll
                for (int q = 0; q < 24; ++q) ss += v[q] * v[q];
                ss += lane_xor_f(ss, 1, lane); ss += lane_xor_f(ss, 2, lane); ss += lane_xor_f(ss, 4, lane);
                const float sc = 1.0f / sqrtf(ss * (1.f / DQK) + EPS);
#pragma unroll
                for (int q = 0; q < 24; ++q) v[q] *= sc * gk[q];
                u32x4 w; w.x = pk4_fp8(v[0], v[1], v[2], v[3]); w.y = pk4_fp8(v[4], v[5], v[6], v[7]); w.z = pk4_fp8(v[8], v[9], v[10], v[11]); w.w = pk4_fp8(v[12], v[13], v[14], v[15]);
                *(u32x4*)(K8 + orow + 16 * i8) = w;
                float o1[4], o2[4];
#pragma unroll
                for (int q = 0; q < 4; ++q) { o1[q] = v[16 + q] * cj[q] - v[20 + q] * sj[q]; o2[q] = v[20 + q] * cj[q] + v[16 + q] * sj[q]; }
                *(unsigned*)(K8 + orow + 128 + 4 * i8) = pk4_fp8(o1[0], o1[1], o1[2], o1[3]); *(unsigned*)(K8 + orow + 160 + 4 * i8) = pk4_fp8(o2[0], o2[1], o2[2], o2[3]);
                const int low5 = kk & 31, hh = (low5 >> 2) & 1, rr = (low5 & 3) + 4 * (low5 >> 3), posb = hh * 32 + rr + 16 * (kk >> 5);
                LAS unsigned char* vt = lds + h * 8192 + (16 * i8) * 64 + posb;
#pragma unroll
                for (int q = 0; q < 4; ++q) { const unsigned w4 = pk4_fp8(vv[4 * q] * r_kv, vv[4 * q + 1] * r_kv, vv[4 * q + 2] * r_kv, vv[4 * q + 3] * r_kv);
                    vt[(4 * q) * 64] = (unsigned char)w4; vt[(4 * q + 1) * 64] = (unsigned char)(w4 >> 8); vt[(4 * q + 2) * 64] = (unsigned char)(w4 >> 16); vt[(4 * q + 3) * 64] = (unsigned char)(w4 >> 24); } }
        }
        __syncthreads();
        {   const int t0 = tile * 64, b = t0 >> 14, st = (t0 & (SEQ - 1)) >> 6;
#pragma unroll
            for (int i = 0; i < 8; ++i) { const int ch = tid + 512 * i, hh = ch >> 9, off = (ch & 511) * 16;
                *(u32x4*)(VT8 + ((size_t)(b * NH + hh) * (SEQ / 64) + st) * 8192 + off) = *(const LAS u32x4*)(lds + hh * 8192 + off); } }
        __syncthreads();
    }
}

__device__ __forceinline__ void route_phase(const float* LG, const float* bg, const float* be, gu32* cnt, int* eid, int* rank, float* gate, int gtid, int NGT) {
    for (int t = gtid; t < T; t += NGT) {
        const float* lg = LG + (size_t)t * 128;
        float gl[8];
        { const f32x4 a = *(const f32x4*)lg, b = *(const f32x4*)(lg + 4); gl[0] = a.x; gl[1] = a.y; gl[2] = a.z; gl[3] = a.w; gl[4] = b.x; gl[5] = b.y; gl[6] = b.z; gl[7] = b.w; }
        float gm = gl[0]; int gs = 0; float bm = gl[0] + bg[0];
#pragma unroll
        for (int q = 1; q < 8; ++q) { gm = fmaxf(gm, gl[q]); const float v = gl[q] + bg[q]; if (v > bm) { bm = v; gs = q; } }
        float gsum = 0.f, gsel = 0.f;
#pragma unroll
        for (int q = 0; q < 8; ++q) { const float e = __expf(gl[q] - gm); gsum += e; gsel = (q == gs) ? e : gsel; }
        const float g_gate = gsel / gsum;
        float el[8];
        { const f32x4 a = *(const f32x4*)(lg + 8 + gs * 8), b = *(const f32x4*)(lg + 12 + gs * 8); el[0] = a.x; el[1] = a.y; el[2] = a.z; el[3] = a.w; el[4] = b.x; el[5] = b.y; el[6] = b.z; el[7] = b.w; }
        int i0 = 0; float v0 = el[0] + be[gs * 8];
#pragma unroll
        for (int q = 1; q < 8; ++q) { const float v = el[q] + be[gs * 8 + q]; if (v > v0) { v0 = v; i0 = q; } }
        int i1 = -1; float v1 = -3.0e38f;
#pragma unroll
        for (int q = 0; q < 8; ++q) { const float v = el[q] + be[gs * 8 + q]; if (q != i0 && v > v1) { v1 = v; i1 = q; } }
        float l0 = 0.f, l1 = 0.f;
#pragma unroll
        for (int q = 0; q < 8; ++q) { l0 = (q == i0) ? el[q] : l0; l1 = (q == i1) ? el[q] : l1; }
        const float mm = fmaxf(l0, l1), p0 = __expf(l0 - mm), p1 = __expf(l1 - mm), inv = 1.f / (p0 + p1);
        const int e0 = gs * 8 + i0, e1 = gs * 8 + i1;
        const unsigned r0 = __hip_atomic_fetch_add(cnt + e0, 1u, RLX_AGENT), r1 = __hip_atomic_fetch_add(cnt + e1, 1u, RLX_AGENT);
        eid[2 * t] = e0; eid[2 * t + 1] = e1; rank[2 * t] = (int)r0; rank[2 * t + 1] = (int)r1; gate[2 * t] = g_gate * p0 * inv; gate[2 * t + 1] = g_gate * p1 * inv;
    }
}

__device__ __forceinline__ int build_tables(gu32* cnt, LAS int* tbl, LAS int* pstart, int tid) {
    if (tid < 64) {
        const int c = (int)__hip_atomic_load(cnt + tid, RLX_AGENT); const int pad = (c + 255) & ~255;
        int incl = pad;
#pragma unroll
        for (int o = 1; o < 64; o <<= 1) { const int v = __builtin_amdgcn_ds_bpermute((tid - o) << 2, incl); if (tid >= o) incl += v; }
        const int start = incl - pad; pstart[tid] = start; if (tid == 63) pstart[64] = incl;
        for (int q = start >> 8; q < (incl >> 8); ++q) tbl[q] = tid;
    }
    __syncthreads();
    return pstart[64] >> 8;
}

__device__ __forceinline__ void scatter_phase(const int* eid, const int* rank, const float* gate, const float* rinv, gu32* cnt, int* stok, int* sdest, float* sgate, float* sscale, const LAS int* pstart, int gtid, int NGT) {
    for (int a = gtid; a < NASSIGN; a += NGT) { const int slot = pstart[eid[a]] + rank[a]; stok[slot] = a >> 1; sdest[slot] = a; sgate[slot] = gate[a]; sscale[slot] = rinv[a >> 1]; }
    for (int i = gtid; i < NE * 256; i += NGT) { const int e = i >> 8, q = i & 255; const int c = (int)__hip_atomic_load(cnt + e, RLX_AGENT); const int pad = (c + 255) & ~255;
        if (c + q < pad) { const int slot = pstart[e] + c + q; stok[slot] = 0; sdest[slot] = -1; sgate[slot] = 0.f; sscale[slot] = 0.f; } }
}

constexpr int PTAB_OFF = MISC_OFF + 128;
__device__ __forceinline__ unsigned char* ldptr(int i) {
    extern __shared__ __attribute__((aligned(16))) unsigned char lds_raw[];
    volatile LAS unsigned* pt = (volatile LAS unsigned*)((LAS unsigned char*)lds_raw + PTAB_OFF) + 2 * sgpr_now(i);
    const unsigned lo = __builtin_amdgcn_readfirstlane(pt[0]), hi = __builtin_amdgcn_readfirstlane(pt[1]);
    return (unsigned char*)(GAS unsigned char*)(((unsigned long long)hi << 32) | lo);
}
#define P_IN(i) ((const float*)ldptr(i))
#define P_OUT() ((float*)ldptr(23))
#define P_WS() (ldptr(24))
__device__ __forceinline__ void grid_barrier(int tid) {
    extern __shared__ __attribute__((aligned(16))) unsigned char lds_raw[];
    XcdBarrier b; b.bar = (unsigned*)(P_WS() + WS_CTL) + CW_BAR; b.x = xb_xcc_id(); b.st = (volatile LAS unsigned*)((LAS unsigned char*)lds_raw + MISC_OFF) + 8;
    xcd_barrier(b, tid == 0);
}

__global__ void __launch_bounds__(NWAVES * 64, 2) fwd(Args args) {
    extern __shared__ __attribute__((aligned(16))) unsigned char lds_raw[];
    LAS unsigned char* lds = (LAS unsigned char*)lds_raw;
    for (int u = threadIdx.x; u < (LDS_BYTES - LDSCTL_OFF) / 4; u += NWAVES * 64) ((LAS unsigned*)(lds + LDSCTL_OFF))[u] = 0u;
    __syncthreads();
    if (threadIdx.x == 0) { LAS unsigned long long* pt = (LAS unsigned long long*)(lds + PTAB_OFF);
#pragma unroll
        for (int i = 0; i < 23; ++i) pt[i] = (unsigned long long)args.in[i];
        pt[23] = (unsigned long long)args.out; pt[24] = (unsigned long long)args.ws; }
    __syncthreads();
    const int lo = args.ph_lo, hi = args.ph_hi;
    if (hi - lo > 1) (void)xcd_barrier_post((unsigned*)(P_WS() + WS_CTL) + CW_BAR, (volatile LAS unsigned*)(lds + MISC_OFF) + 8, threadIdx.x == 0);
    const int wave_s = __builtin_amdgcn_readfirstlane((int)threadIdx.x >> 6);
#define IN(k) (lo <= (k) && (k) < hi)
#define SEAM(k) do { if (hi > (k) + 1) grid_barrier(TID); } while (0)
#define TID (tid_now(wave_s))
#define LANE (tid_now(wave_s) & 63)
#define WAVE (sgpr_now(wave_s))
#define GRID (sgpr_now((int)gridDim.x))
#define BX (sgpr_now((int)blockIdx.x))
#define VCU ((GRID % 8 == 0) ? (BX % 8) * (GRID / 8) + BX / 8 : BX)
#define GW (VCU * NWAVES + WAVE)
#define NGW (GRID * NWAVES)
#define GTID (BX * (NWAVES * 64) + TID)
#define NGT (GRID * NWAVES * 64)
#define TBL ((LAS int*)(lds + TBL_OFF))
#define PSTART (TBL + 384)

    if (IN(0)) { for (int rep = 0; rep < REP_PRO; ++rep) prologue_phase(lds, GW, NGW, WAVE, LANE, GTID, NGT); SEAM(0); }

    for (int L = 0; L < 4; ++L) {
        const int pb = 1 + 12 * L;
#define XBP ((bf16_t*)(ws + WS_XB))
#define RINVP ((float*)(ws + WS_RINV))
#define PSQP ((float*)(ws + WS_PSQ))
#define YP ((const bf16_t*)(ws + WS_Y))
        if (IN(pb + 0)) { unsigned char* ws = P_WS();
            if (L == 0) resid_phase<true, false>(P_IN(I_X), nullptr, XBP, RINVP, GW, NGW, LANE);
            else resid_phase<false, false>(XBP, MK_ENABLE_MOE ? YP : nullptr, XBP, RINVP, GW, NGW, LANE);
            SEAM(pb + 0); }
        if ((L & 1) == 0) {
            if (IN(pb + 1)) { unsigned char* ws = P_WS(); const int j = L >> 1;
                pg8::Gemm g{DM, DM, nullptr}; pg8::StaticOrder S; S.init(ws + WS_XB, DM, (bf16_t*)(ws + WS_WIN) + (size_t)j * 3072 * 1024, DM, T, 3072, GRID, BX);
                pg8::EpiConvIn E{(bf16_t*)(ws + WS_GB), (bf16_t*)(ws + WS_Z), RINVP}; for (int rep_ = 0; rep_ < REP_GEMM; ++rep_) pg8::gemm_phase(lds, g, S, E, TID); SEAM(pb + 1); }
            if (IN(pb + 2)) { unsigned char* ws = P_WS(); const int j = L >> 1;
                for (int rep_ = 0; rep_ < REP_THIN; ++rep_) conv_phase((const bf16_t*)(ws + WS_GB), (const bf16_t*)(ws + WS_Z), P_IN(I_CK) + j * 3 * DM, (bf16_t*)(ws + WS_YC), GTID, NGT); SEAM(pb + 2); }
            if (IN(pb + 3)) { unsigned char* ws = P_WS(); const int j = L >> 1;
                pg8::Gemm g{DM, DM, nullptr}; pg8::StaticOrder S; S.init(ws + WS_YC, DM, (bf16_t*)(ws + WS_WOUTC) + (size_t)j * 1024 * 1024, DM, T, DM, GRID, BX);
                pg8::EpiResid E{XBP, PSQP, LANE}; pg8::gemm_phase(lds, g, S, E, TID); SEAM(pb + 5); }
        } else {
            if (IN(pb + 1)) { unsigned char* ws = P_WS(); const int j = L >> 1;
                pg8::Gemm g{DM, DM, nullptr}; pg8::StaticOrder S; S.init(ws + WS_XB, DM, (bf16_t*)(ws + WS_WDOWN) + (size_t)j * LATP * 1024, DM, T, LATP, GRID, BX);
                pg8::EpiBf16 E{(bf16_t*)(ws + WS_LAT), LATP, RINVP}; for (int rep_ = 0; rep_ < REP_GEMM; ++rep_) pg8::gemm_phase(lds, g, S, E, TID); SEAM(pb + 1); }
            if (IN(pb + 2)) {
                { unsigned char* ws = P_WS(); const int j = L >> 1;
                  pg8::Gemm g{LATP, QLR, nullptr}; pg8::StaticOrder S; S.init(ws + WS_LAT, LATP, ws + WS_WQ + (size_t)j * 1536 * 1024, QLR, T, 1536, GRID, BX);
                  pg8::EpiBf16 E{(bf16_t*)(ws + WS_QRAW), 1536, nullptr}; for (int rep_ = 0; rep_ < REP_GEMM; ++rep_) pg8::gemm_phase(lds, g, S, E, TID); }
                { unsigned char* ws = P_WS(); const int j = L >> 1;
                  pg8::Gemm g{LATP, KVLR, nullptr}; pg8::StaticOrder S; S.init((bf16_t*)(ws + WS_LAT) + QLR, LATP, (bf16_t*)(ws + WS_WKV) + (size_t)j * 2048 * 256, KVLR, T, 2048, GRID, BX);
                  pg8::EpiBf16 E{(bf16_t*)(ws + WS_KVRAW), 2048, nullptr}; for (int rep_ = 0; rep_ < REP_GEMM; ++rep_) pg8::gemm_phase(lds, g, S, E, TID); }
                SEAM(pb + 2); }
#if ATT_FP8
            if (IN(pb + 3)) { unsigned char* ws = P_WS(); const int j = L >> 1;
                for (int rep_ = 0; rep_ < REP_THIN; ++rep_) qkprep8_phase((const bf16_t*)(ws + WS_LAT), (const bf16_t*)(ws + WS_QRAW), (const bf16_t*)(ws + WS_KVRAW), (const int*)P_IN(I_POS),
                              P_IN(I_MQHN) + j * DQK, P_IN(I_MKHN) + j * DQK, ws + WS_Q, ws + WS_K, ws + WS_V, lds, VCU, GRID, WAVE, LANE, TID); SEAM(pb + 3); }
#else
            if (IN(pb + 3)) { unsigned char* ws = P_WS(); const int j = L >> 1;
                qkprep_phase((const bf16_t*)(ws + WS_LAT), (const bf16_t*)(ws + WS_QRAW), (const bf16_t*)(ws + WS_KVRAW), (const int*)P_IN(I_POS),
                             P_IN(I_MQHN) + j * DQK, P_IN(I_MKHN) + j * DQK, (bf16_t*)(ws + WS_Q), (bf16_t*)(ws + WS_K), (bf16_t*)(ws + WS_V), lds, GW, NGW, WAVE, LANE); SEAM(pb + 3); }
#endif
            if (IN(pb + 4)) {
              for (int rep = 0; rep < REP_ATT; ++rep)
                for (int i = 0;; ++i) {
                    int bh, qb;
                    if (GRID == 256) { if (i >= 4) break; const int idx = i * 32 + (VCU & 31); bh = 2 * (VCU >> 5) + (idx >> 6); qb = idx & 63; }
                    else { const int k = i * GRID + BX; if (k >= NB * NH * 64) break; bh = k >> 6; qb = k & 63; }
                    const int b = bh >> 3, h = bh & 7; unsigned char* ws = P_WS();
#if ATT_FP8 && ATT_PP
                    att8::attn_unit_pp(ws + WS_Q + ((size_t)bh * SEQ + qb * 256) * DQK, ws + WS_K + (size_t)bh * SEQ * DQK, ws + WS_V + (size_t)bh * SEQ * DV,
                                       (bf16_t*)(ws + WS_O) + ((size_t)(b * SEQ + qb * 256)) * DM + h * DV, (char*)lds_raw, TID);
#elif ATT_FP8
                    att8::attn_unit(ws + WS_Q + ((size_t)bh * SEQ + qb * 256) * DQK, ws + WS_K + (size_t)bh * SEQ * DQK, ws + WS_V + (size_t)bh * SEQ * DV,
                                    (bf16_t*)(ws + WS_O) + ((size_t)(b * SEQ + qb * 256)) * DM + h * DV, (char*)lds_raw, TID);
#else
                    att::attn_unit((const bf16_t*)(ws + WS_Q) + ((size_t)bh * SEQ + qb * 256) * DQK, (const bf16_t*)(ws + WS_K) + (size_t)bh * SEQ * DQK, (const bf16_t*)(ws + WS_V) + (size_t)bh * SEQ * DV,
                                   (bf16_t*)(ws + WS_O) + ((size_t)(b * SEQ + qb * 256)) * DM + h * DV, (char*)lds_raw, TID);
#endif
                }
                SEAM(pb + 4); }
            if (IN(pb + 5)) { unsigned char* ws = P_WS(); const int j = L >> 1;
                pg8::Gemm g{DM, DM, nullptr}; pg8::StaticOrder S; S.init(ws + WS_O, DM, (bf16_t*)(ws + WS_WO) + (size_t)j * 1024 * 1024, DM, T, DM, GRID, BX);
                pg8::EpiResid E{XBP, PSQP, LANE}; pg8::gemm_phase(lds, g, S, E, TID); SEAM(pb + 5); }
        }
#if MK_ENABLE_MOE
#define CNT ((gu32*)(ws + WS_CTL) + CW_CNT + L * 64)
#define EID ((int*)(ws + WS_RT + RT_EID))
#define RANK ((int*)(ws + WS_RT + RT_RANK))
#define GATE ((float*)(ws + WS_RT + RT_GATE))
#define SDEST ((int*)(ws + WS_RT + RT_SDEST))
#define SGATE ((float*)(ws + WS_RT + RT_SGATE))
#define STOK ((int*)(ws + WS_RT + RT_STOK))
#define SSCALE ((float*)(ws + WS_RT + RT_SSCALE))
        if (IN(pb + 7)) { unsigned char* ws = P_WS();
            pg8::Gemm g{DM, DM, nullptr}; pg8::StaticOrder S; S.init(ws + WS_XB, DM, (bf16_t*)(ws + WS_WRT) + (size_t)L * 256 * 1024, DM, T, 256, GRID, BX);
            { pg8::Unit u0; const int t_ = TID;
              if (S.next(0, u0) && t_ < 256) { const f32x4* q = (const f32x4*)(PSQP + (size_t)(u0.pm * 256 + t_) * 16); const f32x4 a = q[0], b = q[1], c = q[2], d = q[3];
                  const float ssum = ((a.x + a.y) + (a.z + a.w)) + ((b.x + b.y) + (b.z + b.w)) + ((c.x + c.y) + (c.z + c.w)) + ((d.x + d.y) + (d.z + d.w));
                  RINVP[u0.pm * 256 + t_] = 1.0f / sqrtf(ssum * (1.f / DM) + EPS); }
              VM_WAIT(); __syncthreads(); }
            pg8::EpiLogits E{(float*)(ws + WS_LG), RINVP}; for (int rep_ = 0; rep_ < REP_GEMM; ++rep_) pg8::gemm_phase(lds, g, S, E, TID); SEAM(pb + 7); }
        if (IN(pb + 8)) { unsigned char* ws = P_WS();
            route_phase((const float*)(ws + WS_LG), P_IN(I_RBG) + L * 8, P_IN(I_RBE) + L * 64, CNT, EID, RANK, GATE, GTID, NGT); SEAM(pb + 8); }
        if (IN(pb + 9)) { unsigned char* ws = P_WS(); build_tables(CNT, TBL, PSTART, TID);
            scatter_phase(EID, RANK, GATE, RINVP, CNT, STOK, SDEST, SGATE, SSCALE, PSTART, GTID, NGT); SEAM(pb + 9); }
        if (IN(pb + 10)) { unsigned char* ws = P_WS(); const int ntiles = build_tables(CNT, TBL, PSTART, TID);
            pg8::Gemm g{DM, DM, STOK}; pg8::GroupedOrder S{ntiles * 3, 3, GRID, VCU, (const char*)(ws + WS_XB), (const char*)(ws + WS_WE1) + (size_t)L * NE * 768 * 1024 * 2, (size_t)0, (size_t)768 * 1024 * 2, (size_t)256 * 1024 * 2, TBL};
            pg8::EpiSwiGLU E{(bf16_t*)(ws + WS_HID), SSCALE}; for (int rep_ = 0; rep_ < REP_GEMM; ++rep_) pg8::gemm_phase<true>(lds, g, S, E, TID); SEAM(pb + 10); }
        if (IN(pb + 11)) { unsigned char* ws = P_WS(); const int ntiles = build_tables(CNT, TBL, PSTART, TID);
            pg8::Gemm g{DFF, DFF, nullptr}; pg8::GroupedOrder S{ntiles * 4, 4, GRID, VCU, (const char*)(ws + WS_HID), (const char*)(ws + WS_WE2) + (size_t)L * NE * 1024 * DFF * 2, (size_t)256 * DFF * 2, (size_t)1024 * DFF * 2, (size_t)256 * DFF * 2, TBL};
            pg8::EpiScatterY E{(bf16_t*)(ws + WS_Y), SDEST, SGATE}; for (int rep_ = 0; rep_ < REP_GEMM; ++rep_) pg8::gemm_phase(lds, g, S, E, TID); SEAM(pb + 11); }
#endif
    }
    if (IN(49)) { unsigned char* ws = P_WS(); resid_phase<false, true>(XBP, MK_ENABLE_MOE ? YP : nullptr, P_OUT(), nullptr, GW, NGW, LANE); }
#undef IN
#undef SEAM
}

extern "C" void kernel_launch(void* const* d_in, const int* in_sizes, int n_in, void* d_out, int out_size, void* d_ws, size_t ws_size, hipStream_t stream) {
    static int grid = 0;
    if (grid == 0) {
        if (n_in != 23 || out_size != T * DM || ws_size < WS_END) { fprintf(stderr, "kernel_launch: unexpected shapes: n_in %d out %d ws %zu (need %zu)\n", n_in, out_size, ws_size, (size_t)WS_END); grid = -1; return; }
        int dev = 0, cus = 0, per_cu = 0;
        if (hipGetDevice(&dev) != hipSuccess || hipDeviceGetAttribute(&cus, hipDeviceAttributeMultiprocessorCount, dev) != hipSuccess) { grid = -1; return; }
        if (hipFuncSetAttribute((const void*)fwd, hipFuncAttributeMaxDynamicSharedMemorySize, LDS_BYTES) != hipSuccess) { fprintf(stderr, "kernel_launch: hipFuncSetAttribute failed\n"); grid = -1; return; }
        if (hipOccupancyMaxActiveBlocksPerMultiprocessor(&per_cu, (const void*)fwd, NWAVES * 64, LDS_BYTES) != hipSuccess || per_cu < 1) fprintf(stderr, "kernel_launch: occupancy query says %d\n", per_cu);
        (void)hipGetLastError();
        grid = cus;
    }
    if (grid < 0) return;
    if (hipMemsetAsync((char*)d_ws + WS_CTL, 0, CTL_ZERO_BYTES, stream) != hipSuccess) return;
    Args a{};
    for (int i = 0; i < 23; ++i) a.in[i] = d_in[i];
    a.out = (float*)d_out; a.ws = (unsigned char*)d_ws;
#if MK_ONE_LAUNCH
    a.ph_lo = 0; a.ph_hi = 50;
    hipLaunchKernelGGL(fwd, dim3(grid), dim3(NWAVES * 64), LDS_BYTES, stream, a);
#else
    for (int p = 0; p < 50; ++p) {
        if (p >= 1 && p < 49) { const int L = (p - 1) / 12, k = (p - 1) % 12;
            if (k == 6) continue;
            if (k < 6 && (L & 1) == 0 && k > 3) continue;
            if (k > 6 && !MK_ENABLE_MOE) continue; }
        a.ph_lo = p; a.ph_hi = p + 1;
        hipLaunchKernelGGL(fwd, dim3(grid), dim3(NWAVES * 64), LDS_BYTES, stream, a);
    }
#endif
    const hipError_t le = hipPeekAtLastError();
    if (le != hipSuccess) fprintf(stderr, "kernel_launch: launch failed: %s\n", hipGetErrorName(le));
}
```

```cpp
#include <hip/hip_runtime.h>
#include <cstdio>
#include <cstdint>

#ifndef MK_ONE_LAUNCH
#define MK_ONE_LAUNCH 1
#endif

#define GAS __attribute__((address_space(1)))
#define LAS __attribute__((address_space(3)))
typedef unsigned short bf16_t;
typedef short bf16x8 __attribute__((ext_vector_type(8)));
typedef short s16x4 __attribute__((ext_vector_type(4)));
typedef float f32x2 __attribute__((ext_vector_type(2)));
typedef float f32x4 __attribute__((ext_vector_type(4)));
typedef float f32x16 __attribute__((ext_vector_type(16)));
typedef unsigned u32x2 __attribute__((ext_vector_type(2)));
typedef unsigned u32x4 __attribute__((ext_vector_type(4)));
typedef GAS unsigned gu32;

constexpr int DM = 1024, NB = 2, SEQ = 16384, T = NB * SEQ;
constexpr int NH = 8, QLR = 384, KVLR = 256, DNOPE = 128, DROPE = 64, DQK = 192, DV = 128, LAT = 704, LATP = 768;
constexpr int NE = 64, DFF = 384;
constexpr int NASSIGN = 2 * T;
constexpr int NSLOT = NASSIGN + NE * 256;
constexpr float EPS = 1e-6f;
constexpr int NWAVES = 8;

constexpr size_t MiB = 1u << 20;
constexpr size_t WS_CTL = 0, CTL_ZERO_BYTES = 1 * MiB;
constexpr size_t WS_WIN = 2 * MiB;
constexpr size_t WS_WOUTC = 14 * MiB;
constexpr size_t WS_WDOWN = 18 * MiB;
constexpr size_t WS_WQ = 21 * MiB;
constexpr size_t WS_WKV = 24 * MiB;
constexpr size_t WS_WO = 26 * MiB;
constexpr size_t WS_WRT = 30 * MiB;
constexpr size_t WS_WE1 = 32 * MiB;
constexpr size_t WS_WE2 = 416 * MiB;
constexpr size_t WS_XB = 608 * MiB;
constexpr size_t WS_RINV = 1202 * MiB;
constexpr size_t WS_PSQ = 1200 * MiB;
constexpr size_t WS_S = 672 * MiB;
constexpr size_t WS_GB = WS_S, WS_Z = WS_S + 64 * MiB, WS_YC = WS_S + 128 * MiB;
constexpr size_t WS_LAT = WS_S, WS_QRAW = WS_S + 48 * MiB, WS_KVRAW = WS_S + 144 * MiB;
constexpr size_t WS_Q = WS_S + 272 * MiB, WS_K = WS_S + 368 * MiB, WS_V = WS_S + 464 * MiB, WS_O = WS_QRAW;
constexpr size_t WS_HID = WS_S + 160 * MiB, WS_Y = WS_S + 224 * MiB;
constexpr size_t WS_SA = WS_S + 352 * MiB, WS_SG = WS_S + 360 * MiB, WS_SS = WS_S + 368 * MiB;
constexpr size_t WS_END = WS_S + 531 * MiB;
constexpr int CW_BAR = 4096  , CW_CNT = 8192  ;

constexpr int RING_BYTES = 131072;
constexpr int LDSCTL_OFF = RING_BYTES, MISC_OFF = LDSCTL_OFF + 320;
constexpr int TBL_OFF = LDSCTL_OFF + 1024;
constexpr int LDS_BYTES = 147456;

#define RLX_AGENT __ATOMIC_RELAXED, __HIP_MEMORY_SCOPE_AGENT
#define LDS_WAIT() asm volatile("s_waitcnt lgkmcnt(0)" ::: "memory")
#define VM_WAIT() asm volatile("s_waitcnt vmcnt(0)" ::: "memory")
__device__ __forceinline__ unsigned f2bf(float f) { unsigned u = __builtin_bit_cast(unsigned, f); return (u + 0x7fffu + ((u >> 16) & 1u)) >> 16; }
__device__ __forceinline__ unsigned pk2(float lo, float hi) { unsigned r; asm("v_cvt_pk_bf16_f32 %0, %1, %2" : "=v"(r) : "v"(lo), "v"(hi)); return r; }
__device__ __forceinline__ float bflo(unsigned w) { return __builtin_bit_cast(float, w << 16); }
__device__ __forceinline__ float bfhi(unsigned w) { return __builtin_bit_cast(float, w & 0xffff0000u); }
__device__ __forceinline__ float bf2f(bf16_t h) { return __builtin_bit_cast(float, (unsigned)h << 16); }
__device__ __forceinline__ unsigned cvt_pk_bf16(float lo, float hi) { unsigned r; asm volatile("v_cvt_pk_bf16_f32 %0, %1, %2" : "=v"(r) : "v"(lo), "v"(hi)); return r; }
__device__ __forceinline__ int tid_now(int wave_s) { int l; asm volatile("v_mbcnt_lo_u32_b32 %0, -1, 0\n\tv_mbcnt_hi_u32_b32 %0, -1, %0" : "=v"(l)); return wave_s * 64 + l; }
__device__ __forceinline__ int sgpr_now(int v) { asm volatile("" : "+s"(v)); return v; }
__device__ __forceinline__ float lane_xor_f(float v, int m, int lane) { return __builtin_bit_cast(float, __builtin_amdgcn_ds_bpermute((lane ^ m) << 2, __builtin_bit_cast(int, v))); }
__device__ __forceinline__ float wave_sum(float v, int lane) {
#pragma unroll
    for (int o = 1; o < 64; o <<= 1) v += lane_xor_f(v, o, lane);
    return v;
}

typedef float f32x2v __attribute__((ext_vector_type(2)));
__device__ __forceinline__ unsigned pk4_fp8(float a, float b, float c, float d) { int w = 0; w = __builtin_amdgcn_cvt_pk_fp8_f32(a, b, w, false); w = __builtin_amdgcn_cvt_pk_fp8_f32(c, d, w, true); return (unsigned)w; }
__device__ __forceinline__ void up4_fp8(unsigned w, float* v) { const f32x2v lo = __builtin_amdgcn_cvt_pk_f32_fp8((int)w, false), hi = __builtin_amdgcn_cvt_pk_f32_fp8((int)w, true); v[0] = lo.x; v[1] = lo.y; v[2] = hi.x; v[3] = hi.y; }

#define XB_TMO      128
#define XB_XCNT(j)  (256  + 64 * (j))
#define XB_XSUB(j)  (1280 + 64 * (j))
#define XB_XGEN(j)  (2304 + 64 * (j))
#define XB_TOP      3328
#define XB_TOPGEN   3392
#define XCD_BAR_WORDS 3456
#define XB_SPIN_CAP (1u << 18)
__device__ __forceinline__ unsigned xb_ld(unsigned* p)              { return __hip_atomic_load(p, __ATOMIC_RELAXED, __HIP_MEMORY_SCOPE_AGENT); }
__device__ __forceinline__ unsigned xb_add(unsigned* p, unsigned v) { asm volatile("" : "+v"(v)); return __hip_atomic_fetch_add(p, v, __ATOMIC_RELAXED, __HIP_MEMORY_SCOPE_AGENT); }
__device__ __forceinline__ unsigned xb_xcc_id() { return (unsigned)__builtin_amdgcn_s_getreg((3 << 11) | 20) & 0xFu; }
#define XB_SPIN(cond, bar) do { unsigned _sp = 0; while (cond) { __builtin_amdgcn_s_sleep(1); \
    if ((++_sp & 255u) == 0u) { if (xb_ld(&(bar)[XB_TMO])) break; if (_sp > XB_SPIN_CAP) { atomicAdd(&(bar)[XB_TMO], 1u); break; } } } } while (0)
struct XcdBarrier { unsigned* bar; unsigned x; volatile LAS unsigned* st; };
__device__ __forceinline__ XcdBarrier xcd_barrier_post(unsigned* bar, volatile LAS unsigned* st, bool leader) {
    XcdBarrier b; b.bar = bar; b.x = xb_xcc_id(); b.st = st;
    if (leader) (void)xb_add(&bar[XB_XCNT(b.x)], 1u);
    return b;
}
__device__ __forceinline__ void xcd_barrier_complete(unsigned* bar, unsigned x, unsigned& nloc, unsigned& nx) {
    const unsigned G = gridDim.x * gridDim.y * gridDim.z;
    unsigned sum, cnt, mine, sp = 0u;
    for (;;) {
        sum = 0u; cnt = 0u; mine = 0u;
#pragma unroll
        for (unsigned j = 0; j < 16; ++j) { const unsigned c = xb_ld(&bar[XB_XCNT(j)]); sum += c; cnt += (c > 0u) ? 1u : 0u; mine = (j == x) ? c : mine; }
        if (sum == G) break;
        __builtin_amdgcn_s_sleep(1);
        if ((++sp & 255u) == 0u) { if (xb_ld(&bar[XB_TMO])) break; if (sp > XB_SPIN_CAP) { atomicAdd(&bar[XB_TMO], 1u); break; } }
    }
    nloc = mine > 0u ? mine : 1u; nx = cnt > 0u ? cnt : 1u;
}
__device__ __forceinline__ void xcd_barrier(const XcdBarrier& b, bool leader) {
    asm volatile("s_waitcnt vmcnt(0)" ::: "memory");
    __syncthreads();
    if (leader) {
        unsigned* bar = b.bar;
        __builtin_amdgcn_s_waitcnt(0);
        unsigned nloc = b.st[0], nx = b.st[1];
        if (nloc == 0u) { xcd_barrier_complete(bar, b.x, nloc, nx); b.st[0] = nloc; b.st[1] = nx; }
        const unsigned old = xb_add(&bar[XB_XSUB(b.x)], 1u);
        const unsigned gen = old / nloc;
        if (old + 1u == (gen + 1u) * nloc) {
            __builtin_amdgcn_fence(__ATOMIC_RELEASE, "agent");
            asm volatile("s_waitcnt vmcnt(0)" ::: "memory");
            const unsigned og = xb_add(&bar[XB_TOP], 1u);
            const unsigned tg = og / nx;
            if (og + 1u == (tg + 1u) * nx) xb_add(&bar[XB_TOPGEN], 1u);
            else XB_SPIN(xb_ld(&bar[XB_TOPGEN]) == tg, bar);
            __builtin_amdgcn_fence(__ATOMIC_ACQUIRE, "agent");
            xb_add(&bar[XB_XGEN(b.x)], 1u);
            asm volatile("s_waitcnt vmcnt(0)" ::: "memory");
        } else {
            XB_SPIN(xb_ld(&bar[XB_XGEN(b.x)]) == gen, bar);
            __builtin_amdgcn_fence(__ATOMIC_ACQUIRE, "agent");
            asm volatile("s_waitcnt vmcnt(0)" ::: "memory");
        }
    }
    __syncthreads();
}

namespace pg8 {
constexpr int BM = 256, BK = 64, HALF = 128, HTB = HALF * BK * 2, NXCD = 8, WGM = 8;
__host__ __device__ __forceinline__ int lds_byte(int r, int c) { const int st = (r >> 4) * 2 + (c >> 5), rr = r & 15, cc = c & 31, ob = rr * 64 + cc * 2; return st * 1024 + (ob ^ (((ob >> 9) & 1) << 5)); }
__host__ __device__ __forceinline__ void stage_rc(int b_, int& R, int& C) { const unsigned b = (unsigned)b_, st = b >> 10, sb = b & 1023u, swz = sb ^ (((sb >> 9) & 1u) << 5); R = (int)((st >> 1) * 16u + (swz >> 6)); C = (int)((st & 1u) * 32u + ((swz & 63u) >> 1)); }
__host__ __device__ __forceinline__ int perm32(int rho) { const int n = rho >> 4, i = rho & 15; return 8 * (i >> 2) + 4 * n + (i & 3); }

struct Unit { const char* A; const char* B; int pm, pn, arow, nvalid; };
struct Gemm { int lda, K; const int* rowidx; };

struct StaticOrder {
    int nM, nN, nwg, G, c; const char* A; const char* B; size_t astep, bstep;
    __device__ void init(const void* A_, int lda, const void* B_, int K, int M, int N, int G_, int c_) { nM = M / BM; nN = N / BM; nwg = nM * nN; G = G_; c = c_; A = (const char*)A_; B = (const char*)B_; astep = (size_t)BM * lda * 2; bstep = (size_t)BM * K * 2; }
    __device__ __forceinline__ bool next(int i, Unit& u) const {
        const long L = (long)i * G + c; if (L >= nwg) return false;
        int wgid = (int)L; { const int q = nwg / NXCD, r = nwg % NXCD, xcd = wgid % NXCD, off = wgid / NXCD; wgid = (xcd < r ? xcd * (q + 1) : r * (q + 1) + (xcd - r) * q) + off; }
        const int nig = WGM * nN, gid = wgid / nig, fm = gid * WGM, gsz = (nM - fm) < WGM ? (nM - fm) : WGM;
        u.pm = fm + ((wgid % nig) % gsz); u.pn = (wgid % nig) / gsz; u.A = A + (size_t)u.pm * astep; u.B = B + (size_t)u.pn * bstep; u.arow = 0; u.nvalid = BM; return true;
    }
};
constexpr int ECAP = 32768;
struct GroupedOrder {
    int n_units, nN, G, c; const char* A; const char* B; size_t astep, bexp, bstep; const LAS int* tbl; const LAS int* cntl;
    __device__ __forceinline__ bool next(int i, Unit& u) const {
        const int L = i * G + c; if (L >= n_units) return false;
        const int tile = L / nN, pn = L - tile * nN; const int ei = __builtin_amdgcn_readfirstlane(tbl[tile]); const int e = ei >> 16, ti = ei & 0xffff;
        const int left = __builtin_amdgcn_readfirstlane(cntl[e]) - ti * BM;
        u.pm = tile; u.pn = pn; u.arow = e * ECAP + ti * BM; u.nvalid = left < BM ? left : BM; u.A = A + (size_t)tile * astep; u.B = B + (size_t)e * bexp + (size_t)pn * bstep; return true;
    }
};

typedef f32x4 Acc[2][2][4][2];

struct EpiBf16 {
    static constexpr bool PERM = true, AFTER_DRAIN = false;
    bf16_t* O; int ldc; const float* rs;
    __device__ __forceinline__ void operator()(const Acc& acc, const Unit& u, int wr, int wc, int fr, int fq) const {
        const int row0 = u.pm * BM + wr * 64 + fr, col0 = u.pn * BM + wc * 32 + 8 * fq;
#pragma unroll
        for (int ai = 0; ai < 2; ++ai)
#pragma unroll
            for (int m = 0; m < 4; ++m) { const int row = row0 + ai * HALF + m * 16; bf16_t* rowp = O + (size_t)row * ldc + col0; const float r = rs ? rs[row] : 1.f;
#pragma unroll
                for (int bj = 0; bj < 2; ++bj) { const f32x4 v0 = acc[ai][bj][m][0] * r, v1 = acc[ai][bj][m][1] * r;
                    u32x4 w; w.x = cvt_pk_bf16(v0[0], v0[1]); w.y = cvt_pk_bf16(v0[2], v0[3]); w.z = cvt_pk_bf16(v1[0], v1[1]); w.w = cvt_pk_bf16(v1[2], v1[3]);
                    *(u32x4*)(rowp + bj * HALF) = w; } }
    }
};
struct EpiFp8 {
    static constexpr bool PERM = true, AFTER_DRAIN = false;
    unsigned char* O; int ldc;
    __device__ __forceinline__ void operator()(const Acc& acc, const Unit& u, int wr, int wc, int fr, int fq) const {
        const int row0 = u.pm * BM + wr * 64 + fr, col0 = u.pn * BM + wc * 32 + 8 * fq;
#pragma unroll
        for (int ai = 0; ai < 2; ++ai)
#pragma unroll
            for (int m = 0; m < 4; ++m) { unsigned char* rowp = O + (size_t)(row0 + ai * HALF + m * 16) * ldc + col0;
#pragma unroll
                for (int bj = 0; bj < 2; ++bj) { const f32x4 v0 = acc[ai][bj][m][0], v1 = acc[ai][bj][m][1];
                    u32x2 w; w.x = pk4_fp8(v0[0], v0[1], v0[2], v0[3]); w.y = pk4_fp8(v1[0], v1[1], v1[2], v1[3]); *(u32x2*)(rowp + bj * HALF) = w; } }
    }
};
struct EpiConvIn {
    static constexpr bool PERM = true, AFTER_DRAIN = false;
    bf16_t* GBp; bf16_t* Zp; const float* rs;
    __device__ __forceinline__ void operator()(const Acc& acc, const Unit& u, int wr, int wc, int fr, int fq) const {
        const int row0 = u.pm * BM + wr * 64 + fr;
        if (u.pn < 4) {
            const int col0 = u.pn * BM + wc * 32 + 8 * fq;
#pragma unroll
            for (int ai = 0; ai < 2; ++ai)
#pragma unroll
                for (int m = 0; m < 4; ++m) { const int row = row0 + ai * HALF + m * 16; bf16_t* rowp = GBp + (size_t)row * DM + col0; const float r = rs[row];
#pragma unroll
                    for (int bj = 0; bj < 2; ++bj) { const f32x4 v0 = acc[ai][bj][m][0] * r, v1 = acc[ai][bj][m][1] * r;
                        u32x4 w; w.x = cvt_pk_bf16(v0[0], v0[1]); w.y = cvt_pk_bf16(v0[2], v0[3]); w.z = cvt_pk_bf16(v1[0], v1[1]); w.w = cvt_pk_bf16(v1[2], v1[3]);
                        *(u32x4*)(rowp + bj * HALF) = w; } }
        } else {
            const int col0 = (u.pn - 4) * HALF + wc * 32 + 8 * fq;
#pragma unroll
            for (int ai = 0; ai < 2; ++ai)
#pragma unroll
                for (int m = 0; m < 4; ++m) { const int row = row0 + ai * HALF + m * 16; bf16_t* rowp = Zp + (size_t)row * DM + col0; const float r = rs[row], r2 = r * r;
                    const f32x4 v0 = acc[ai][0][m][0] * acc[ai][1][m][0] * r2, v1 = acc[ai][0][m][1] * acc[ai][1][m][1] * r2;
                    u32x4 w; w.x = cvt_pk_bf16(v0[0], v0[1]); w.y = cvt_pk_bf16(v0[2], v0[3]); w.z = cvt_pk_bf16(v1[0], v1[1]); w.w = cvt_pk_bf16(v1[2], v1[3]);
                    *(u32x4*)rowp = w; }
        }
    }
};
__device__ __forceinline__ float silu_mul(float g, float u) { return g * __builtin_amdgcn_rcpf(1.f + __expf(-g)) * u; }
struct EpiSwiGLU {
    static constexpr bool PERM = true, AFTER_DRAIN = false;
    bf16_t* Hd; const float* ss;
    __device__ __forceinline__ void operator()(const Acc& acc, const Unit& u, int wr, int wc, int fr, int fq) const {
        const int row0 = u.pm * BM + wr * 64 + fr, col0 = u.pn * HALF + wc * 32 + 8 * fq;
#pragma unroll
        for (int ai = 0; ai < 2; ++ai)
#pragma unroll
            for (int m = 0; m < 4; ++m) { const int row = row0 + ai * HALF + m * 16; bf16_t* rowp = Hd + (size_t)row * DFF + col0; const float r = ss[u.arow + (row - u.pm * BM)];
                f32x4 v0, v1;
#pragma unroll
                for (int q = 0; q < 4; ++q) { v0[q] = silu_mul(acc[ai][0][m][0][q] * r, acc[ai][1][m][0][q] * r); v1[q] = silu_mul(acc[ai][0][m][1][q] * r, acc[ai][1][m][1][q] * r); }
                u32x4 w; w.x = cvt_pk_bf16(v0[0], v0[1]); w.y = cvt_pk_bf16(v0[2], v0[3]); w.z = cvt_pk_bf16(v1[0], v1[1]); w.w = cvt_pk_bf16(v1[2], v1[3]);
                *(u32x4*)rowp = w; }
    }
};
struct EpiResid {
    static constexpr bool PERM = true, AFTER_DRAIN = false;
    bf16_t* XB; float* PSQ; int lane;
    __device__ __forceinline__ void operator()(const Acc& acc, const Unit& u, int wr, int wc, int fr, int fq) const {
        const int row0 = u.pm * BM + wr * 64 + fr, col0 = u.pn * BM + wc * 32 + 8 * fq;
#pragma unroll
        for (int ai = 0; ai < 2; ++ai)
#pragma unroll
            for (int m = 0; m < 4; ++m) { const int row = row0 + ai * HALF + m * 16; bf16_t* rowp = XB + (size_t)row * DM + col0; float ss = 0.f;
#pragma unroll
                for (int bj = 0; bj < 2; ++bj) { const u32x4 xv = *(const u32x4*)(rowp + bj * HALF);
                    const f32x4 v0 = acc[ai][bj][m][0] + (f32x4){bflo(xv.x), bfhi(xv.x), bflo(xv.y), bfhi(xv.y)}, v1 = acc[ai][bj][m][1] + (f32x4){bflo(xv.z), bfhi(xv.z), bflo(xv.w), bfhi(xv.w)};
                    ss += (v0[0] * v0[0] + v0[1] * v0[1]) + (v0[2] * v0[2] + v0[3] * v0[3]) + (v1[0] * v1[0] + v1[1] * v1[1]) + (v1[2] * v1[2] + v1[3] * v1[3]);
                    u32x4 w; w.x = cvt_pk_bf16(v0[0], v0[1]); w.y = cvt_pk_bf16(v0[2], v0[3]); w.z = cvt_pk_bf16(v1[0], v1[1]); w.w = cvt_pk_bf16(v1[2], v1[3]);
                    *(u32x4*)(rowp + bj * HALF) = w; }
                ss += lane_xor_f(ss, 16, lane); ss += lane_xor_f(ss, 32, lane);
                if (fq == 0) PSQ[(size_t)row * 16 + u.pn * 4 + wc] = ss; }
    }
};
struct EpiRoute {
    static constexpr bool PERM = false, AFTER_DRAIN = true;
    const float* rs; const float* bg; const float* be; gu32* cnt; int* sa; float* sgate; float* sscale;
    __device__ __forceinline__ void fused(const Acc& acc, const Unit& u, int wr, int wc, int fr, int fq, LAS unsigned char* lds, int tid) const {
        LAS float* lg = (LAS float*)lds;
        if (wc < 3) {
#pragma unroll
            for (int ai = 0; ai < 2; ++ai)
#pragma unroll
                for (int m = 0; m < 4; ++m) { const int rl = ai * HALF + wr * 64 + m * 16 + fr; const float r = rs[u.pm * BM + rl];
#pragma unroll
                    for (int n = 0; n < 2; ++n) { const int c0 = wc * 32 + 16 * n + 4 * fq;
                        if (c0 < 72) { LAS float* d = lg + rl * 73 + c0; const f32x4 v = acc[ai][0][m][n] * r; d[0] = v[0]; d[1] = v[1]; d[2] = v[2]; d[3] = v[3]; } } } }
        __syncthreads();
        if (tid < 256) { const int t = u.pm * BM + tid; const LAS float* l = lg + tid * 73;
            float gl[8];
#pragma unroll
            for (int q = 0; q < 8; ++q) gl[q] = l[q];
            float gm = gl[0]; int gs = 0; float bm = gl[0] + bg[0];
#pragma unroll
            for (int q = 1; q < 8; ++q) { gm = fmaxf(gm, gl[q]); const float v = gl[q] + bg[q]; if (v > bm) { bm = v; gs = q; } }
            float gsum = 0.f, gsel = 0.f;
#pragma unroll
            for (int q = 0; q < 8; ++q) { const float e = __expf(gl[q] - gm); gsum += e; gsel = (q == gs) ? e : gsel; }
            const float g_gate = gsel / gsum;
            float el[8];
#pragma unroll
            for (int q = 0; q < 8; ++q) el[q] = l[8 + gs * 8 + q];
            int i0 = 0; float v0 = el[0] + be[gs * 8];
#pragma unroll
            for (int q = 1; q < 8; ++q) { const float v = el[q] + be[gs * 8 + q]; if (v > v0) { v0 = v; i0 = q; } }
            int i1 = -1; float v1 = -3.0e38f;
#pragma unroll
            for (int q = 0; q < 8; ++q) { const float v = el[q] + be[gs * 8 + q]; if (q != i0 && v > v1) { v1 = v; i1 = q; } }
            float l0 = 0.f, l1 = 0.f;
#pragma unroll
            for (int q = 0; q < 8; ++q) { l0 = (q == i0) ? el[q] : l0; l1 = (q == i1) ? el[q] : l1; }
            const float mm = fmaxf(l0, l1), p0 = __expf(l0 - mm), p1 = __expf(l1 - mm), inv = 1.f / (p0 + p1);
            const int e0 = gs * 8 + i0, e1 = gs * 8 + i1; const float rv = rs[t];
            unsigned one_ = 1u; asm volatile("" : "+v"(one_));
            const int s0 = e0 * ECAP + (int)__hip_atomic_fetch_add(cnt + e0, one_, RLX_AGENT), s1 = e1 * ECAP + (int)__hip_atomic_fetch_add(cnt + e1, one_, RLX_AGENT);
            sa[s0] = 2 * t; sgate[s0] = g_gate * p0 * inv; sscale[s0] = rv; sa[s1] = 2 * t + 1; sgate[s1] = g_gate * p1 * inv; sscale[s1] = rv; }
    }
};
struct EpiScatterY {
    static constexpr bool PERM = true, AFTER_DRAIN = false;
    unsigned char* Y; const int* sdest; const float* sgate;
    __device__ __forceinline__ void operator()(const Acc& acc, const Unit& u, int wr, int wc, int fr, int fq) const {
        const int col0 = u.pn * BM + wc * 32 + 8 * fq;
#pragma unroll
        for (int ai = 0; ai < 2; ++ai)
#pragma unroll
            for (int m = 0; m < 4; ++m) { const int rl = wr * 64 + fr + ai * HALF + m * 16; const bool ok = rl < u.nvalid; const int d = ok ? sdest[u.arow + rl] : 0; const float g = ok ? 16.f * sgate[u.arow + rl] : 0.f;
                if (ok) { unsigned char* rowp = Y + (size_t)d * DM + col0;
#pragma unroll
                    for (int bj = 0; bj < 2; ++bj) { const f32x4 v0 = acc[ai][bj][m][0] * g, v1 = acc[ai][bj][m][1] * g;
                        u32x2 w; w.x = pk4_fp8(v0[0], v0[1], v0[2], v0[3]); w.y = pk4_fp8(v1[0], v1[1], v1[2], v1[3]); *(u32x2*)(rowp + bj * HALF) = w; } }
                asm volatile("" ::: "memory"); }
    }
};

template <bool GATHER = false, class Epi, class Sched>
__device__ __forceinline__ void gemm_phase(LAS unsigned char* lds, const Gemm g, const Sched& S, const Epi& E, int tid) {
    const int wid = __builtin_amdgcn_readfirstlane(tid >> 6), lane = tid & 63, wr = wid >> 2, wc = wid & 3, fr = lane & 15, fq = lane >> 4;
    const int K = g.K, lda = g.lda, nt = K / BK;
    unsigned voffA[2], voffB[2];
#pragma unroll
    for (int i = 0; i < 2; ++i) { int R, C; stage_rc(tid * 16 + i * 8192, R, C); const int Rb = Epi::PERM ? ((R & ~31) + perm32(R & 31)) : R;
        voffA[i] = (unsigned)(R * lda + C) * 2u; voffB[i] = (unsigned)(Rb * K + C) * 2u; }
    const size_t kstep = (size_t)(BK * 2);
    const size_t hstepA = (size_t)HALF * lda * 2, hstepB = (size_t)HALF * K * 2;
    unsigned goC[2][2] = {{0u, 0u}, {0u, 0u}}, goN[2][2] = {{0u, 0u}, {0u, 0u}}; int gR[2] = {0, 0}; unsigned gC[2] = {0u, 0u};
    if constexpr (GATHER) {
#pragma unroll
        for (int i = 0; i < 2; ++i) { int R, C; stage_rc(tid * 16 + i * 8192, R, C); gR[i] = R; gC[i] = (unsigned)C * 2u; } }
#define PG8_GO(dst, un_) do { _Pragma("unroll") for (int h_ = 0; h_ < 2; ++h_) _Pragma("unroll") for (int i_ = 0; i_ < 2; ++i_) \
        { const int r_ = h_ * HALF + gR[i_]; const int a_ = r_ < (un_).nvalid ? g.rowidx[(un_).arow + r_] : 0; dst[h_][i_] = (unsigned)(a_ >> 1) * (unsigned)(lda * 2) + gC[i_]; } } while (0)
    const unsigned ldsw = (unsigned)wid * 1024u;
    const int aoff = lds_byte(wr * 64 + fr, fq * 8), boff = lds_byte(wc * 32 + fr, fq * 8);
#define PG8_SA(b, h) (((b) * 2 + (h)) * HTB)
#define PG8_SB(b, h) ((4 + (b) * 2 + (h)) * HTB)
#define PG8_STAGE(bufoff, gbase, voff) do { _Pragma("unroll") for (int _i = 0; _i < 2; ++_i) \
        __builtin_amdgcn_global_load_lds((const unsigned*)((const char*)(gbase) + (voff)[_i]), (LAS unsigned*)(lds + (bufoff) + ldsw + _i * 8192), 16, 0, 0); } while (0)
#define PG8_LDA(dst, b, h) do { _Pragma("unroll") for (int m = 0; m < 4; ++m) _Pragma("unroll") for (int k = 0; k < 2; ++k) dst[m][k] = *(const LAS bf16x8*)(lds + PG8_SA(b, h) + aoff + m * 2048 + k * 1024); } while (0)
#define PG8_LDB(dst, b, h) do { _Pragma("unroll") for (int n = 0; n < 2; ++n) _Pragma("unroll") for (int k = 0; k < 2; ++k) dst[n][k] = *(const LAS bf16x8*)(lds + PG8_SB(b, h) + boff + n * 2048 + k * 1024); } while (0)
#define PG8_MMA(ai, bj, At, Bt) do { __builtin_amdgcn_s_setprio(1); _Pragma("unroll") for (int m = 0; m < 4; ++m) _Pragma("unroll") for (int n = 0; n < 2; ++n) _Pragma("unroll") for (int k = 0; k < 2; ++k) \
        acc[ai][bj][m][n] = __builtin_amdgcn_mfma_f32_16x16x32_bf16(Bt[n][k], At[m][k], acc[ai][bj][m][n], 0, 0, 0); __builtin_amdgcn_s_setprio(0); } while (0)
#define PG8_WAIT_V(n) asm volatile("s_waitcnt vmcnt(" #n ")" ::: "memory")
#define PG8_WAIT_L(n) asm volatile("s_waitcnt lgkmcnt(" #n ")" ::: "memory")
#define PG8_BAR __builtin_amdgcn_s_barrier()
#define PG8_SCHED __builtin_amdgcn_sched_barrier(0)
    Unit cur, nxt; int ui = 0;
    if (!S.next(0, cur)) return;
    Acc acc;
#pragma unroll
    for (int a = 0; a < 2; ++a)
#pragma unroll
        for (int b = 0; b < 2; ++b)
#pragma unroll
            for (int m = 0; m < 4; ++m)
#pragma unroll
                for (int n = 0; n < 2; ++n) acc[a][b][m][n] = (f32x4){0.f, 0.f, 0.f, 0.f};
    bf16x8 At[4][2], B0[2][2], B1[2][2];
    const char* cA = cur.A; const char* cB = cur.B;
    if constexpr (GATHER) PG8_GO(goC, cur);
    PG8_STAGE(PG8_SB(0, 0), cB, voffB); PG8_STAGE(PG8_SB(0, 1), cB + hstepB, voffB);
    if constexpr (GATHER) { PG8_STAGE(PG8_SA(0, 0), cA, goC[0]); PG8_STAGE(PG8_SA(0, 1), cA, goC[1]); } else { PG8_STAGE(PG8_SA(0, 0), cA, voffA); PG8_STAGE(PG8_SA(0, 1), cA + hstepA, voffA); }
    if (wr == 1) PG8_BAR;
    PG8_WAIT_V(2); PG8_BAR;
    PG8_STAGE(PG8_SB(1, 0), cB + kstep, voffB); if constexpr (GATHER) PG8_STAGE(PG8_SA(1, 0), cA + kstep, goC[0]); else PG8_STAGE(PG8_SA(1, 0), cA + kstep, voffA); PG8_STAGE(PG8_SB(1, 1), cB + hstepB + kstep, voffB);
    PG8_WAIT_V(6); PG8_BAR;
    for (;;) {
        const bool has_next = S.next(ui + 1, nxt);
        const char* nA = has_next ? nxt.A : cA; const char* nB = has_next ? nxt.B : cB;
        if constexpr (GATHER) { if (has_next) PG8_GO(goN, nxt); else { goN[0][0] = goC[0][0]; goN[0][1] = goC[0][1]; goN[1][0] = goC[1][0]; goN[1][1] = goC[1][1]; } }
        for (int t = 0; t < nt; t += 2) {
            const bool last = (t == nt - 2);
            const char* a1 = cA + (size_t)(t + 1) * kstep;
            const char* a2 = last ? nA : cA + (size_t)(t + 2) * kstep; const char* b2 = last ? nB : cB + (size_t)(t + 2) * kstep;
            const char* a3 = a2 + kstep; const char* b3 = b2 + kstep;
            unsigned g2h0[2], g2h1[2];
            if constexpr (GATHER) { g2h0[0] = last ? goN[0][0] : goC[0][0]; g2h0[1] = last ? goN[0][1] : goC[0][1]; g2h1[0] = last ? goN[1][0] : goC[1][0]; g2h1[1] = last ? goN[1][1] : goC[1][1]; }
            PG8_LDB(B0, 0, 0); PG8_LDB(B1, 0, 1); PG8_SCHED; PG8_LDA(At, 0, 0); if constexpr (GATHER) PG8_STAGE(PG8_SA(1, 1), a1, goC[1]); else PG8_STAGE(PG8_SA(1, 1), a1 + hstepA, voffA);
            PG8_WAIT_V(8); PG8_WAIT_L(0); PG8_BAR; PG8_MMA(0, 0, At, B0); PG8_MMA(0, 1, At, B1); PG8_BAR; PG8_SCHED;
            PG8_LDA(At, 0, 1); PG8_STAGE(PG8_SB(0, 0), b2, voffB); PG8_STAGE(PG8_SB(0, 1), b2 + hstepB, voffB); if constexpr (GATHER) PG8_STAGE(PG8_SA(0, 0), a2, g2h0); else PG8_STAGE(PG8_SA(0, 0), a2, voffA);
            PG8_WAIT_V(8); PG8_WAIT_L(0); PG8_BAR; PG8_MMA(1, 0, At, B0); PG8_MMA(1, 1, At, B1); PG8_BAR; PG8_SCHED;
            PG8_LDB(B0, 1, 0); PG8_LDB(B1, 1, 1); PG8_SCHED; PG8_LDA(At, 1, 0); if constexpr (GATHER) PG8_STAGE(PG8_SA(0, 1), a2, g2h1); else PG8_STAGE(PG8_SA(0, 1), a2 + hstepA, voffA);
            PG8_WAIT_V(8); PG8_WAIT_L(0); PG8_BAR; PG8_MMA(0, 0, At, B0); PG8_MMA(0, 1, At, B1); PG8_BAR; PG8_SCHED;
            PG8_LDA(At, 1, 1); PG8_STAGE(PG8_SB(1, 0), b3, voffB); PG8_STAGE(PG8_SB(1, 1), b3 + hstepB, voffB); if constexpr (GATHER) PG8_STAGE(PG8_SA(1, 0), a3, g2h0); else PG8_STAGE(PG8_SA(1, 0), a3, voffA);
            PG8_WAIT_V(8); PG8_WAIT_L(0); PG8_BAR; PG8_MMA(1, 0, At, B0); PG8_MMA(1, 1, At, B1); PG8_BAR; PG8_SCHED;
        }
        if (wr == 0) PG8_BAR;
        if constexpr (!Epi::AFTER_DRAIN) E(acc, cur, wr, wc, fr, fq);
        if (!has_next) break;
#pragma unroll
        for (int a = 0; a < 2; ++a)
#pragma unroll
            for (int b = 0; b < 2; ++b)
#pragma unroll
                for (int m = 0; m < 4; ++m)
#pragma unroll
                    for (int n = 0; n < 2; ++n) acc[a][b][m][n] = (f32x4){0.f, 0.f, 0.f, 0.f};
        cur = nxt; cA = nA; cB = nB; ++ui;
        if constexpr (GATHER) { goC[0][0] = goN[0][0]; goC[0][1] = goN[0][1]; goC[1][0] = goN[1][0]; goC[1][1] = goN[1][1]; }
        if (wr == 1) PG8_BAR;
    }
    PG8_WAIT_V(0);
    PG8_BAR;
    if constexpr (Epi::AFTER_DRAIN) E.fused(acc, cur, wr, wc, fr, fq, lds, tid);
#undef PG8_GO
#undef PG8_SA
#undef PG8_SB
#undef PG8_STAGE
#undef PG8_LDA
#undef PG8_LDB
#undef PG8_MMA
#undef PG8_WAIT_V
#undef PG8_WAIT_L
#undef PG8_BAR
#undef PG8_SCHED
}
}


namespace att8 {
typedef int i32x8 __attribute__((ext_vector_type(8)));
constexpr int NW = 8, QBLK = 32, KVBLK = 64;
constexpr float SCALE = 0.07216878364870322f;
constexpr float THR = 3.f;
constexpr float POFF = 4.f;
constexpr int KROW = 208, VROW = 80;
constexpr int SHM_K = KVBLK * KROW, SHM_V = DV * VROW;
constexpr int OFF_V = 0, OFF_K = 2 * SHM_V, OFF_WS = OFF_K + 3 * SHM_K, ATT_LDS = OFF_WS + NW * 64 * 4;
static_assert(ATT_LDS <= 65536, "O staging reuses [0, 64 KiB)");
#define SBAR() __builtin_amdgcn_sched_barrier(0)
__device__ __forceinline__ int crow(int r, int hi) { return (r & 3) + 8 * (r >> 2) + 4 * hi; }
__device__ __forceinline__ f32x16 mfma8(i32x8 a, i32x8 b, f32x16 c) { return __builtin_amdgcn_mfma_scale_f32_32x32x64_f8f6f4(a, b, c, 0, 0, 0, 0x7F7F7F7F, 0, 0x7F7F7F7F); }
__device__ __forceinline__ i32x8 ld32(const char* p) { const u32x4 a = *reinterpret_cast<const u32x4*>(p), b = *reinterpret_cast<const u32x4*>(p + 16); return (i32x8){(int)a.x, (int)a.y, (int)a.z, (int)a.w, (int)b.x, (int)b.y, (int)b.z, (int)b.w}; }
__device__ __forceinline__ float max3f_first(float a, float b, float c) { float r; asm volatile("s_nop 3\n\tv_max3_f32 %0, %1, %2, %3" : "=v"(r) : "v"(a), "v"(b), "v"(c)); return r; }
__device__ __forceinline__ float max3f(float a, float b, float c) { float r; asm volatile("v_max3_f32 %0, %1, %2, %3" : "=v"(r) : "v"(a), "v"(b), "v"(c)); return r; }
__device__ __forceinline__ float max2f(float a, float b) { float r; asm volatile("v_max_f32_e32 %0, %1, %2" : "=v"(r) : "v"(a), "v"(b)); return r; }
constexpr float THR2 = THR * 1.4426950408889634f;
template <bool FIRST = false>
__device__ __forceinline__ void softmax_seg(f32x16& p0, f32x16& p1, f32x16& negm, float& l_reg, f32x16* o, i32x8& pa, float* al_l, int r32, int hi) {
    if constexpr (FIRST) asm volatile("s_nop 15\n\ts_nop 3" ::: "memory");
    float pmax = max3f_first(p0[0], p0[1], p0[2]);
#pragma unroll
    for (int r = 3; r < 15; r += 2) pmax = max3f(pmax, p0[r], p0[r + 1]);
    pmax = max3f(pmax, p0[15], p1[0]);
#pragma unroll
    for (int r = 1; r < 15; r += 2) pmax = max3f(pmax, p1[r], p1[r + 1]);
    pmax = max2f(pmax, p1[15]);
    { auto rr = __builtin_amdgcn_permlane32_swap(__float_as_uint(pmax), __float_as_uint(pmax), false, false);
      pmax = max2f(__uint_as_float(rr[0]), __uint_as_float(rr[1])); }
    float alpha = 1.f;
    if (!__builtin_expect(__all(pmax <= POFF + THR2), 1)) {
        const float d = fmaxf(pmax - POFF, 0.f);
        alpha = __builtin_amdgcn_exp2f(-d);
#pragma unroll
        for (int r = 0; r < 16; ++r) { p0[r] -= d; p1[r] -= d; negm[r] -= d; }
        if (hi == 0) al_l[r32] = alpha; asm volatile("s_waitcnt lgkmcnt(0)" ::: "memory");
#pragma unroll
        for (int dd = 0; dd < 4; ++dd)
#pragma unroll
            for (int r = 0; r < 16; ++r) o[dd][r] *= al_l[crow(r, hi)];
    }
    float ps = 0;
#pragma unroll
    for (int r = 0; r < 16; ++r) { p0[r] = __builtin_amdgcn_exp2f(p0[r]); ps += p0[r]; }
#pragma unroll
    for (int r = 0; r < 16; ++r) { p1[r] = __builtin_amdgcn_exp2f(p1[r]); ps += p1[r]; }
    { auto rr = __builtin_amdgcn_permlane32_swap(__float_as_uint(ps), __float_as_uint(ps), false, false);
      ps = __uint_as_float(rr[0]) + __uint_as_float(rr[1]); }
    l_reg = l_reg * alpha + ps;
#pragma unroll
    for (int g = 0; g < 4; ++g) { int w = 0; w = __builtin_amdgcn_cvt_pk_fp8_f32(p0[4 * g], p0[4 * g + 1], w, false); w = __builtin_amdgcn_cvt_pk_fp8_f32(p0[4 * g + 2], p0[4 * g + 3], w, true); pa[g] = w; }
#pragma unroll
    for (int g = 0; g < 4; ++g) { int w = 0; w = __builtin_amdgcn_cvt_pk_fp8_f32(p1[4 * g], p1[4 * g + 1], w, false); w = __builtin_amdgcn_cvt_pk_fp8_f32(p1[4 * g + 2], p1[4 * g + 3], w, true); pa[4 + g] = w; }
}
__device__ __forceinline__ f32x16 mfma8q(i32x8 a, i32x8 b, f32x16 c) { return __builtin_amdgcn_mfma_scale_f32_32x32x64_f8f6f4(a, b, c, 0, 0, 0, 0x7F7F7F7F, 0, 0x7C7C7C7C); }
constexpr int KPF = 2;
__device__ __forceinline__ void kfrag_load(i32x8 (&ka)[KPF][2], const char* Ks, int r32, int hi) {
#pragma unroll
    for (int ks = 0; ks < KPF; ++ks) { const int cb = ks * 64 + hi * 32; ka[ks][0] = ld32(Ks + r32 * KROW + cb); ka[ks][1] = ld32(Ks + (32 + r32) * KROW + cb); }
}
template <bool DO_QK, bool DO_PV>
__device__ __forceinline__ void mfma_seg(f32x16& p0, f32x16& p1, const f32x16& negm, f32x16* o, const i32x8 (&ka)[KPF][2], const char* Ks, const char* Vs, const i32x8* qr, i32x8 pa, int r32, int hi) {
    i32x8 vb[4], kr[3][2];
    if (DO_QK) {
#pragma unroll
        for (int ks = KPF; ks < 3; ++ks) { const int cb = ks * 64 + hi * 32; kr[ks][0] = ld32(Ks + r32 * KROW + cb); kr[ks][1] = ld32(Ks + (32 + r32) * KROW + cb); } }
    if (DO_PV) { vb[0] = ld32(Vs + r32 * VROW + hi * 32); vb[1] = ld32(Vs + (32 + r32) * VROW + hi * 32); }
    SBAR();
    __builtin_amdgcn_s_setprio(1);
    if (DO_QK) {
#pragma unroll
        for (int ks = 0; ks < KPF; ++ks) { p0 = mfma8q(ka[ks][0], qr[ks], ks == 0 ? negm : p0); p1 = mfma8q(ka[ks][1], qr[ks], ks == 0 ? negm : p1); } }
    if (DO_PV) { vb[2] = ld32(Vs + (64 + r32) * VROW + hi * 32); vb[3] = ld32(Vs + (96 + r32) * VROW + hi * 32); }
    SBAR();
    if (DO_QK) {
#pragma unroll
        for (int ks = KPF; ks < 3; ++ks) { p0 = mfma8q(kr[ks][0], qr[ks], p0); p1 = mfma8q(kr[ks][1], qr[ks], p1); } }
    SBAR();
    if (DO_PV) {
#pragma unroll
        for (int d0 = 0; d0 < 4; ++d0) o[d0] = mfma8(pa, vb[d0], o[d0]); }
    __builtin_amdgcn_s_setprio(0);
}
__device__ __forceinline__ void attn_unit_pp(const unsigned char* __restrict__ Qb, const unsigned char* __restrict__ Kh, const unsigned char* __restrict__ Vt, bf16_t* __restrict__ Ob, char* lds, int tid) {
    const int wid = __builtin_amdgcn_readfirstlane(tid >> 6), lane = tid & 63, r32 = lane & 31, hi = lane >> 5;
    const bool halfB = wid >= 4;
    char* V_lds = lds + OFF_V; char* K_lds = lds + OFF_K;
    float* ws = (float*)(lds + OFF_WS) + wid * 64; float* li_l = ws; float* al_l = ws + 32;
    float l_reg = 0; f32x16 o[4] = {}; i32x8 qr[3]; f32x16 negm;
    float m0_ = 60.f; asm volatile("" : "+v"(m0_));
#pragma unroll
    for (int r = 0; r < 16; ++r) negm[r] = m0_;
    const unsigned char* Qw = Qb + (long)(wid * QBLK + r32) * DQK + hi * 32;
#pragma unroll
    for (int ks = 0; ks < 3; ++ks) qr[ks] = ld32((const char*)Qw + ks * 64);
    const int kst0 = (tid / 12) * KROW + (tid % 12) * 16, kst1 = ((tid + 512) / 12) * KROW + ((tid + 512) % 12) * 16, vst = (tid >> 2) * VROW + (tid & 3) * 16;
    const bool k2 = wid < 4;
    constexpr int NT = SEQ / KVBLK;
    u32x4 sv, sk0, sk1 = {0u, 0u, 0u, 0u};
#define LOADK(t) do { const unsigned char* kp_ = Kh + (long)((t) < NT ? (t) : NT - 1) * 12288 + tid * 16; sk0 = *reinterpret_cast<const u32x4*>(kp_); if (k2) sk1 = *reinterpret_cast<const u32x4*>(kp_ + 8192); } while (0)
#define LOADV(t) do { sv = *reinterpret_cast<const u32x4*>(Vt + (long)((t) < NT ? (t) : NT - 1) * 8192 + tid * 16); } while (0)
#define WRITEK(b) do { *(u32x4*)(K_lds + (b) * SHM_K + kst0) = sk0; if (k2) *(u32x4*)(K_lds + (b) * SHM_K + kst1) = sk1; } while (0)
#define WRITEV(b) do { *(u32x4*)(V_lds + (b) * SHM_V + vst) = sv; } while (0)
#define BAR() do { SBAR(); __syncthreads(); SBAR(); } while (0)
    f32x16 p0, p1; i32x8 pa = {}; i32x8 ka[KPF][2];
    LOADK(0); WRITEK(0); LOADK(1); WRITEK(1); __syncthreads();
    LOADK(2); LOADV(0);
    kfrag_load(ka, K_lds, r32, hi);
    if (halfB) BAR();
    WRITEK(2); WRITEV(0); LOADK(3); LOADV(1);
    mfma_seg<true, false>(p0, p1, negm, o, ka, K_lds, V_lds, qr, pa, r32, hi);
    BAR();
    softmax_seg<true>(p0, p1, negm, l_reg, o, pa, al_l, r32, hi);
    kfrag_load(ka, K_lds + SHM_K, r32, hi);
    BAR();
    int kb3 = 0, kb1 = 1, kb2 = 2;
    for (int t = 0; t < NT - 1; ++t) {
        WRITEK(kb3); WRITEV((t + 1) & 1); LOADK(t + 4); LOADV(t + 2);
        mfma_seg<true, true>(p0, p1, negm, o, ka, K_lds + kb1 * SHM_K, V_lds + (t & 1) * SHM_V, qr, pa, r32, hi);
        BAR();
        softmax_seg(p0, p1, negm, l_reg, o, pa, al_l, r32, hi);
        kfrag_load(ka, K_lds + kb2 * SHM_K, r32, hi);
        BAR();
        kb3 = (kb3 == 2) ? 0 : kb3 + 1; kb1 = (kb1 == 2) ? 0 : kb1 + 1; kb2 = (kb2 == 2) ? 0 : kb2 + 1;
    }
    mfma_seg<false, true>(p0, p1, negm, o, ka, K_lds, V_lds + ((NT - 1) & 1) * SHM_V, qr, pa, r32, hi);
    if (!halfB) BAR();
    if (hi == 0) li_l[r32] = l_reg; asm volatile("s_waitcnt lgkmcnt(0)" ::: "memory");
    float rli[16];
#pragma unroll
    for (int r = 0; r < 16; ++r) rli[r] = __builtin_amdgcn_rcpf(li_l[crow(r, hi)]);
    __syncthreads();
    bf16_t* ost = (bf16_t*)(lds + wid * 8192);
#pragma unroll
    for (int r = 0; r < 16; ++r) { const int orow = crow(r, hi);
#pragma unroll
        for (int d0 = 0; d0 < 4; ++d0) ost[orow * 128 + d0 * 32 + r32] = (bf16_t)f2bf(o[d0][r] * rli[r]); }
    asm volatile("s_waitcnt lgkmcnt(0)" ::: "memory");
    bf16_t* Ow = Ob + (long)(wid * QBLK) * DM;
#pragma unroll
    for (int i = 0; i < 8; ++i) { const int ch = lane + 64 * i, row = ch >> 4, c = ch & 15;
        const u32x4 v = *(const u32x4*)((const char*)ost + row * 256 + c * 16); *(u32x4*)(Ow + (long)row * DM + c * 8) = v; }
    __syncthreads();
#undef LOADK
#undef LOADV
#undef WRITEK
#undef WRITEV
#undef BAR
}
#undef SBAR
}

struct Args { const void* in[23]; float* out; unsigned char* ws; int ph_lo, ph_hi; };
enum { I_X = 0, I_POS, I_CNW, I_CWIN, I_CK, I_CWOUT, I_MNW, I_MWDOWN, I_MQLN, I_MKVLN, I_MWQ, I_MWKV, I_MQHN, I_MKHN, I_MWO, I_FNW, I_RWG, I_RBG, I_RWE, I_RBE, I_EWG, I_EWU, I_EWD };

struct CvtItem { const float* W; bf16_t* WT; const float* ksc; int K, N, k0, n0, drow0; };
__device__ __forceinline__ unsigned char* ldptr(int i);
constexpr int CVT_PER_J = 768 + 256 + 176 + 144 + 128 + 256;
constexpr int CVT_MIX = 2 * CVT_PER_J, CVT_EXP = 4 * NE * 288, CVT_ITEMS = CVT_MIX + CVT_EXP;
__device__ __forceinline__ void cvt_decode(int it, CvtItem& c, unsigned char* ws) {
    if (it < CVT_MIX) {
        const int j = it / CVT_PER_J; int r = it - j * CVT_PER_J; int kb, nb;
        if (r < 768) { c.K = 1024; c.N = 3072; c.W = (const float*)ldptr(I_CWIN) + (size_t)j * 1024 * 3072; c.WT = (bf16_t*)(ws + WS_WIN) + (size_t)j * 3072 * 1024; c.ksc = (const float*)ldptr(I_CNW) + j * 1024;
            kb = r / 48; nb = r % 48; const int n0 = nb * 64;
            if (n0 < 1024) c.drow0 = n0; else if (n0 < 2048) { const int q = n0 - 1024; c.drow0 = 1024 + (q >> 7) * 256 + (q & 127); } else { const int q = n0 - 2048; c.drow0 = 1024 + (q >> 7) * 256 + 128 + (q & 127); } }
        else if ((r -= 768) < 256) { c.K = 1024; c.N = 1024; c.W = (const float*)ldptr(I_CWOUT) + (size_t)j * 1024 * 1024; c.WT = (bf16_t*)(ws + WS_WOUTC) + (size_t)j * 1024 * 1024; c.ksc = nullptr; kb = r / 16; nb = r % 16; c.drow0 = nb * 64; }
        else if ((r -= 256) < 176) { c.K = 1024; c.N = LAT; c.W = (const float*)ldptr(I_MWDOWN) + (size_t)j * 1024 * LAT; c.WT = (bf16_t*)(ws + WS_WDOWN) + (size_t)j * LATP * 1024; c.ksc = (const float*)ldptr(I_MNW) + j * 1024; kb = r / 11; nb = r % 11; c.drow0 = nb * 64; }
        else if ((r -= 176) < 144) { c.K = QLR; c.N = NH * DQK; c.W = (const float*)ldptr(I_MWQ) + (size_t)j * QLR * NH * DQK; c.WT = (bf16_t*)(ws + WS_WQ + (size_t)j * 1536 * 1024); c.ksc = (const float*)ldptr(I_MQLN) + j * QLR; kb = r / 24; nb = r % 24; c.drow0 = nb * 64; }
        else if ((r -= 144) < 128) { c.K = KVLR; c.N = NH * 256; c.W = (const float*)ldptr(I_MWKV) + (size_t)j * KVLR * NH * 256; c.WT = (bf16_t*)(ws + WS_WKV) + (size_t)j * 2048 * 256; c.ksc = (const float*)ldptr(I_MKVLN) + j * KVLR; kb = r / 32; nb = r % 32; c.drow0 = nb * 64; }
        else { r -= 128; c.K = 1024; c.N = 1024; c.W = (const float*)ldptr(I_MWO) + (size_t)j * 1024 * 1024; c.WT = (bf16_t*)(ws + WS_WO) + (size_t)j * 1024 * 1024; c.ksc = nullptr; kb = r / 16; nb = r % 16; c.drow0 = nb * 64; }
        c.k0 = kb * 64; c.n0 = nb * 64;
    } else {
        const int r = it - CVT_MIX; const int le = r / 288, q = r - le * 288, L = le >> 6; const int kind = q / 96, idx = q - kind * 96; int kb, nb;
        if (kind < 2) { c.K = 1024; c.N = DFF; c.W = (const float*)ldptr(kind == 0 ? I_EWG : I_EWU) + (size_t)le * 1024 * DFF; c.WT = (bf16_t*)(ws + WS_WE1) + (size_t)le * 768 * 1024; c.ksc = (const float*)ldptr(I_FNW) + L * 1024;
            kb = idx / 6; nb = idx % 6; const int n0 = nb * 64; c.drow0 = (n0 >> 7) * 256 + kind * 128 + (n0 & 127); }
        else { c.K = DFF; c.N = 1024; c.W = (const float*)ldptr(I_EWD) + (size_t)le * DFF * 1024; c.WT = (bf16_t*)(ws + WS_WE2) + (size_t)le * 1024 * DFF; c.ksc = nullptr; kb = idx / 16; nb = idx % 16; c.drow0 = nb * 64; }
        c.k0 = kb * 64; c.n0 = nb * 64;
    }
}
__device__ __forceinline__ void cvt_load(const CvtItem& c, f32x4 (&v)[16], int lane) {
    const float* p = c.W + (size_t)(c.k0 + (lane >> 4)) * c.N + c.n0 + 4 * (lane & 15);
#pragma unroll
    for (int i = 0; i < 16; ++i) v[i] = *(const f32x4*)(p + (size_t)(4 * i) * c.N);
}
__device__ __forceinline__ void cvt_lds_write(LAS float* tile, const f32x4 (&v)[16], int lane) {
#pragma unroll
    for (int i = 0; i < 16; ++i) { const int r = 4 * i + (lane >> 4), n = 4 * (lane & 15), x = r & 31; LAS float* row = tile + r * 64;
        row[(n + 0) ^ x] = v[i].x; row[(n + 1) ^ x] = v[i].y; row[(n + 2) ^ x] = v[i].z; row[(n + 3) ^ x] = v[i].w; }
}
__device__ __forceinline__ void cvt_out(const CvtItem& c, const LAS float* tile, int lane) {
    const int cc = lane & 7, np = lane >> 3;
    f32x4 s0 = {1.f, 1.f, 1.f, 1.f}, s1 = {1.f, 1.f, 1.f, 1.f};
    if (c.ksc) { s0 = *(const f32x4*)(c.ksc + c.k0 + 8 * cc); s1 = *(const f32x4*)(c.ksc + c.k0 + 8 * cc + 4); }
#pragma unroll
    for (int jj = 0; jj < 8; ++jj) { const int n = np + 8 * jj; float t[8];
#pragma unroll
        for (int q = 0; q < 8; ++q) { const int k = 8 * cc + q; t[q] = tile[k * 64 + (n ^ (k & 31))]; }
        u32x4 o; o.x = pk2(t[0] * s0.x, t[1] * s0.y); o.y = pk2(t[2] * s0.z, t[3] * s0.w); o.z = pk2(t[4] * s1.x, t[5] * s1.y); o.w = pk2(t[6] * s1.z, t[7] * s1.w);
        *(GAS u32x4*)(c.WT + (size_t)(c.drow0 + n) * c.K + c.k0 + 8 * cc) = o; }
}

__device__ __forceinline__ void prologue_phase(LAS unsigned char* lds, int gw, int NGW, int wave, int lane, int gtid, int NGT) {
    unsigned char* ws = ldptr(24);
    LAS float* tile = (LAS float*)(lds + wave * 16384);
    {   CvtItem cur, nxt; f32x4 v[16]; int it = gw;
        if (it < CVT_ITEMS) { cvt_decode(it, cur, ws); cvt_load(cur, v, lane); }
        while (it < CVT_ITEMS) {
            cvt_lds_write(tile, v, lane);
            const int itn = it + NGW;
            if (itn < CVT_ITEMS) { cvt_decode(itn, nxt, ws); cvt_load(nxt, v, lane); }
            LDS_WAIT(); asm volatile("" ::: "memory");
            cvt_out(cur, tile, lane);
            LDS_WAIT(); asm volatile("" ::: "memory");
            cur = nxt; it = itn;
        }
    }
    const float* fnw = (const float*)ldptr(I_FNW); const float* rwg = (const float*)ldptr(I_RWG); const float* rwe = (const float*)ldptr(I_RWE);
    for (int i = gtid; i < 4 * 256 * 128; i += NGT) {
        const int L = i >> 15, n = (i >> 7) & 255, k8 = (i & 127) * 8;
        u32x4 o = {0u, 0u, 0u, 0u};
        if (n < 72) { float v[8];
#pragma unroll
            for (int q = 0; q < 8; ++q) { const int k = k8 + q; const float g = fnw[L * 1024 + k];
                v[q] = g * (n < 8 ? rwg[((size_t)L * 1024 + k) * 8 + n] : rwe[((size_t)L * 1024 + k) * 64 + (n - 8)]); }
            o.x = pk2(v[0], v[1]); o.y = pk2(v[2], v[3]); o.z = pk2(v[4], v[5]); o.w = pk2(v[6], v[7]); }
        *(u32x4*)((bf16_t*)(ws + WS_WRT) + ((size_t)L * 256 + n) * 1024 + k8) = o;
    }
    for (int i = gtid; i < 2 * 64 * 128; i += NGT) { const int j = i >> 13, n = LAT + ((i >> 7) & 63), k8 = (i & 127) * 8;
        *(u32x4*)((bf16_t*)(ws + WS_WDOWN) + ((size_t)j * LATP + n) * 1024 + k8) = (u32x4){0u, 0u, 0u, 0u}; }
}

template <bool XF32_IN, bool F32_OUT>
__device__ __forceinline__ void resid_phase(const void* xin, const unsigned char* Y, void* xout, float* rinv, int gw, int NGW, int lane) {
    for (int m = gw; m < T; m += NGW) {
        f32x4 v[4];
        if constexpr (XF32_IN) { const f32x4* xr = (const f32x4*)((const float*)xin + (size_t)m * DM) + lane;
#pragma unroll
            for (int j = 0; j < 4; ++j) v[j] = xr[64 * j]; }
        else { const u32x2* xr = (const u32x2*)((const bf16_t*)xin + (size_t)m * DM) + lane;
#pragma unroll
            for (int j = 0; j < 4; ++j) { const u32x2 p = xr[64 * j]; v[j] = (f32x4){bflo(p.x), bfhi(p.x), bflo(p.y), bfhi(p.y)}; } }
        if (Y) { const unsigned* y0 = (const unsigned*)(Y + (size_t)(2 * m) * DM) + lane; const unsigned* y1 = y0 + 256;
#pragma unroll
            for (int j = 0; j < 4; ++j) { float p[4], q[4]; up4_fp8(y0[64 * j], p); up4_fp8(y1[64 * j], q);
                v[j].x += (p[0] + q[0]) * 0.0625f; v[j].y += (p[1] + q[1]) * 0.0625f; v[j].z += (p[2] + q[2]) * 0.0625f; v[j].w += (p[3] + q[3]) * 0.0625f; } }
        if constexpr (F32_OUT) { f32x4* xo = (f32x4*)((float*)xout + (size_t)m * DM) + lane;
#pragma unroll
            for (int j = 0; j < 4; ++j) xo[64 * j] = v[j]; }
        else { u32x2* xo = (u32x2*)((bf16_t*)xout + (size_t)m * DM) + lane;
#pragma unroll
            for (int j = 0; j < 4; ++j) { u32x2 w; w.x = pk2(v[j].x, v[j].y); w.y = pk2(v[j].z, v[j].w); xo[64 * j] = w; } }
        if (rinv) { float s = 0.f;
#pragma unroll
            for (int j = 0; j < 4; ++j) s += (v[j].x * v[j].x + v[j].y * v[j].y) + (v[j].z * v[j].z + v[j].w * v[j].w);
            const float r = 1.0f / sqrtf(wave_sum(s, lane) * (1.f / DM) + EPS);
            if (lane == 0) rinv[m] = r; }
    }
}

__device__ __forceinline__ void conv_phase(const bf16_t* GBp, const bf16_t* Zp, const float* ck, bf16_t* YCp, int gtid, int NGT) {
    for (int i = gtid; i < T * 128; i += NGT) {
        const int t = i >> 7, c8 = (i & 127) * 8, s = t & (SEQ - 1);
        const u32x4 zc = *(const u32x4*)(Zp + (size_t)t * DM + c8), g = *(const u32x4*)(GBp + (size_t)t * DM + c8);
        u32x4 zm = {0u, 0u, 0u, 0u}, zp = {0u, 0u, 0u, 0u};
        if (s > 0) zm = *(const u32x4*)(Zp + (size_t)(t - 1) * DM + c8);
        if (s < SEQ - 1) zp = *(const u32x4*)(Zp + (size_t)(t + 1) * DM + c8);
        const f32x4 k0a = *(const f32x4*)(ck + c8), k0b = *(const f32x4*)(ck + c8 + 4), k1a = *(const f32x4*)(ck + DM + c8), k1b = *(const f32x4*)(ck + DM + c8 + 4), k2a = *(const f32x4*)(ck + 2 * DM + c8), k2b = *(const f32x4*)(ck + 2 * DM + c8 + 4);
        float y[8];
#define CV(q, W, KA, LOHI) y[q] = LOHI(g.W) * (LOHI(zm.W) * k0##KA + LOHI(zc.W) * k1##KA + LOHI(zp.W) * k2##KA)
        CV(0, x, a[0], bflo); CV(1, x, a[1], bfhi); CV(2, y, a[2], bflo); CV(3, y, a[3], bfhi); CV(4, z, b[0], bflo); CV(5, z, b[1], bfhi); CV(6, w, b[2], bflo); CV(7, w, b[3], bfhi);
#undef CV
        u32x4 o; o.x = pk2(y[0], y[1]); o.y = pk2(y[2], y[3]); o.z = pk2(y[4], y[5]); o.w = pk2(y[6], y[7]);
        *(u32x4*)(YCp + (size_t)t * DM + c8) = o;
    }
}


__device__ __forceinline__ void ld16bf(const bf16_t* p, float* v) { const u32x4 a = *(const u32x4*)p, b = *(const u32x4*)(p + 8);
    v[0] = bflo(a.x); v[1] = bfhi(a.x); v[2] = bflo(a.y); v[3] = bfhi(a.y); v[4] = bflo(a.z); v[5] = bfhi(a.z); v[6] = bflo(a.w); v[7] = bfhi(a.w);
    v[8] = bflo(b.x); v[9] = bfhi(b.x); v[10] = bflo(b.y); v[11] = bfhi(b.y); v[12] = bflo(b.z); v[13] = bfhi(b.z); v[14] = bflo(b.w); v[15] = bfhi(b.w); }
__device__ __forceinline__ void ld16f8(const unsigned char* p, float* v) { const u32x4 a = *(const u32x4*)p; up4_fp8(a.x, v); up4_fp8(a.y, v + 4); up4_fp8(a.z, v + 8); up4_fp8(a.w, v + 12); }
__device__ __forceinline__ void ld4f8(const unsigned char* p, float* v) { up4_fp8(*(const unsigned*)p, v); }
__device__ __forceinline__ void ld4bf(const bf16_t* p, float* v) { const u32x2 a = *(const u32x2*)p; v[0] = bflo(a.x); v[1] = bfhi(a.x); v[2] = bflo(a.y); v[3] = bfhi(a.y); }
__device__ __forceinline__ void qkprep8_phase(const bf16_t* LATb, const unsigned char* QRAW, const unsigned char* KVRAW, const int* pos, const float* qhn, const float* khn,
                                              unsigned char* Q8, unsigned char* K8, unsigned char* VT8, LAS unsigned char* lds, int vcu, int G, int wave, int lane, int tid) {
    const int h = lane >> 3, i8 = lane & 7;
    float gq[24], gk[24], invf[4];
#pragma unroll
    for (int q = 0; q < 16; ++q) { gq[q] = qhn[16 * i8 + q]; gk[q] = khn[16 * i8 + q]; }
#pragma unroll
    for (int q = 0; q < 4; ++q) { gq[16 + q] = qhn[128 + 4 * i8 + q]; gq[20 + q] = qhn[160 + 4 * i8 + q]; gk[16 + q] = khn[128 + 4 * i8 + q]; gk[20 + q] = khn[160 + 4 * i8 + q];
        invf[q] = powf(10000.f, -(float)(4 * i8 + q) * (1.f / 32.f)); }
    for (int tile = vcu; tile < T / 64; tile += G) {
        for (int tt = 0; tt < 8; ++tt) {
            const int kk = wave * 8 + tt, t = tile * 64 + kk, b = t >> 14, s = t & (SEQ - 1);
            const u32x4* ls = (const u32x4*)(LATb + (size_t)t * LATP);
            const u32x4 l0 = ls[lane]; u32x4 l1 = {0u, 0u, 0u, 0u}; if (lane < 24) l1 = ls[lane + 64];
#define SS4(V_) (bflo(V_.x) * bflo(V_.x) + bfhi(V_.x) * bfhi(V_.x) + bflo(V_.y) * bflo(V_.y) + bfhi(V_.y) * bfhi(V_.y) + bflo(V_.z) * bflo(V_.z) + bfhi(V_.z) * bfhi(V_.z) + bflo(V_.w) * bflo(V_.w) + bfhi(V_.w) * bfhi(V_.w))
            const float s0 = SS4(l0), s1 = SS4(l1);
#undef SS4
            const float ssq_q = wave_sum(lane < 48 ? s0 : 0.f, lane), ssq_kv = wave_sum((lane >= 48 ? s0 : 0.f) + (lane < 16 ? s1 : 0.f), lane);
            const float r_q = 1.0f / sqrtf(ssq_q * (1.f / QLR) + EPS), r_kv = 1.0f / sqrtf(ssq_kv * (1.f / KVLR) + EPS);
            float cj[4], sj[4]; const float fpos = (float)pos[t];
#pragma unroll
            for (int q = 0; q < 4; ++q) { const float ang = fpos * invf[q]; const double rev = (double)ang * 0.15915494309189535; const float fr = (float)(rev - floor(rev));
                cj[q] = __builtin_amdgcn_cosf(fr); sj[q] = __builtin_amdgcn_sinf(fr); }
            const size_t orow = ((size_t)(b * NH + h) * SEQ + s) * DQK;
            {
                const unsigned char* qh = QRAW + (size_t)t * 1536 + h * DQK; float v[24];
                ld16f8(qh + 16 * i8, v); ld4f8(qh + 128 + 4 * i8, v + 16); ld4f8(qh + 160 + 4 * i8, v + 20);
                float ss = 0.f;
#pragma unroll
                for (int q = 0; q < 24; ++q) ss += v[q] * v[q];
                ss += lane_xor_f(ss, 1, lane); ss += lane_xor_f(ss, 2, lane); ss += lane_xor_f(ss, 4, lane);
                const float sc = r_q / sqrtf(r_q * r_q * ss * (1.f / DQK) + EPS) * (8.f * 0.07216878364870322f * 1.4426950408889634f);
#pragma unroll
                for (int q = 0; q < 24; ++q) v[q] *= sc * gq[q];
                u32x4 w; w.x = pk4_fp8(v[0], v[1], v[2], v[3]); w.y = pk4_fp8(v[4], v[5], v[6], v[7]); w.z = pk4_fp8(v[8], v[9], v[10], v[11]); w.w = pk4_fp8(v[12], v[13], v[14], v[15]);
                *(u32x4*)(Q8 + orow + 16 * i8) = w;
                float o1[4], o2[4];
#pragma unroll
                for (int q = 0; q < 4; ++q) { o1[q] = v[16 + q] * cj[q] - v[20 + q] * sj[q]; o2[q] = v[20 + q] * cj[q] + v[16 + q] * sj[q]; }
                *(unsigned*)(Q8 + orow + 128 + 4 * i8) = pk4_fp8(o1[0], o1[1], o1[2], o1[3]); *(unsigned*)(Q8 + orow + 160 + 4 * i8) = pk4_fp8(o2[0], o2[1], o2[2], o2[3]); }
            {
                const unsigned char* kh = KVRAW + (size_t)t * 2048 + h * 256; const bf16_t* lr = LATb + (size_t)t * LATP + 640; float v[24], vv[16];
                ld16f8(kh + 16 * i8, v); ld4bf(lr + 4 * i8, v + 16); ld4bf(lr + 32 + 4 * i8, v + 20); ld16f8(kh + 128 + 16 * i8, vv);
#pragma unroll
                for (int q = 0; q < 16; ++q) v[q] *= r_kv;
                float ss = 0.f;
#pragma unroll
                for (int q = 0; q < 24; ++q) ss += v[q] * v[q];
                ss += lane_xor_f(ss, 1, lane); ss += lane_xor_f(ss, 2, lane); ss += lane_xor_f(ss, 4, lane);
                const float sc = 1.0f / sqrtf(ss * (1.f / DQK) + EPS);
#pragma unroll
                for (int q = 0; q < 24; ++q) v[q] *= sc * gk[q];
                u32x4 w; w.x = pk4_fp8(v[0], v[1], v[2], v[3]); w.y = pk4_fp8(v[4], v[5], v[6], v[7]); w.z = pk4_fp8(v[8], v[9], v[10], v[11]); w.w = pk4_fp8(v[12], v[13], v[14], v[15]);
                *(u32x4*)(K8 + orow + 16 * i8) = w;
                float o1[4], o2[4];
#pragma unroll
                for (int q = 0; q < 4; ++q) { o1[q] = v[16 + q] * cj[q] - v[20 + q] * sj[q]; o2[q] = v[20 + q] * cj[q] + v[16 + q] * sj[q]; }
                *(unsigned*)(K8 + orow + 128 + 4 * i8) = pk4_fp8(o1[0], o1[1], o1[2], o1[3]); *(unsigned*)(K8 + orow + 160 + 4 * i8) = pk4_fp8(o2[0], o2[1], o2[2], o2[3]);
                const int low5 = kk & 31, hh = (low5 >> 2) & 1, rr = (low5 & 3) + 4 * (low5 >> 3), posb = hh * 32 + rr + 16 * (kk >> 5);
                LAS unsigned char* vt = lds + h * 8192 + (16 * i8) * 64 + posb;
#pragma unroll
                for (int q = 0; q < 4; ++q) { const unsigned w4 = pk4_fp8(vv[4 * q] * r_kv, vv[4 * q + 1] * r_kv, vv[4 * q + 2] * r_kv, vv[4 * q + 3] * r_kv);
                    vt[(4 * q) * 64] = (unsigned char)w4; vt[(4 * q + 1) * 64] = (unsigned char)(w4 >> 8); vt[(4 * q + 2) * 64] = (unsigned char)(w4 >> 16); vt[(4 * q + 3) * 64] = (unsigned char)(w4 >> 24); } }
        }
        __syncthreads();
        {   const int t0 = tile * 64, b = t0 >> 14, st = (t0 & (SEQ - 1)) >> 6;
#pragma unroll
            for (int i = 0; i < 8; ++i) { const int ch = tid + 512 * i, hh = ch >> 9, off = (ch & 511) * 16;
                *(u32x4*)(VT8 + ((size_t)(b * NH + hh) * (SEQ / 64) + st) * 8192 + off) = *(const LAS u32x4*)(lds + hh * 8192 + off); } }
        __syncthreads();
    }
}

__device__ __forceinline__ int build_tables(gu32* cnt, LAS int* tbl, LAS int* cntl, int tid) {
    if (tid < 64) {
        const int c = (int)__hip_atomic_load(cnt + tid, RLX_AGENT); const int nt = (c + 255) >> 8;
        int incl = nt;
#pragma unroll
        for (int o = 1; o < 64; o <<= 1) { const int v = __builtin_amdgcn_ds_bpermute((tid - o) << 2, incl); if (tid >= o) incl += v; }
        const int start = incl - nt; cntl[tid] = c; if (tid == 63) cntl[64] = incl;
        for (int q = 0; q < nt; ++q) tbl[start + q] = (tid << 16) | q;
    }
    __syncthreads();
    return cntl[64];
}

constexpr int PTAB_OFF = MISC_OFF + 128;
__device__ __forceinline__ unsigned char* ldptr(int i) {
    extern __shared__ __attribute__((aligned(16))) unsigned char lds_raw[];
    volatile LAS unsigned* pt = (volatile LAS unsigned*)((LAS unsigned char*)lds_raw + PTAB_OFF) + 2 * sgpr_now(i);
    const unsigned lo = __builtin_amdgcn_readfirstlane(pt[0]), hi = __builtin_amdgcn_readfirstlane(pt[1]);
    return (unsigned char*)(GAS unsigned char*)(((unsigned long long)hi << 32) | lo);
}
#define P_IN(i) ((const float*)ldptr(i))
#define P_OUT() ((float*)ldptr(23))
#define P_WS() (ldptr(24))
__device__ __forceinline__ void grid_barrier(int tid) {
    extern __shared__ __attribute__((aligned(16))) unsigned char lds_raw[];
    XcdBarrier b; b.bar = (unsigned*)(P_WS() + WS_CTL) + CW_BAR; b.x = xb_xcc_id(); b.st = (volatile LAS unsigned*)((LAS unsigned char*)lds_raw + MISC_OFF) + 8;
    xcd_barrier(b, tid == 0);
}

#define IN(k) (lo <= (k) && (k) < hi)
#define SEAM(k) do { if (hi > (k) + 1) grid_barrier(TID); } while (0)
#define TID (tid_now(wave_s))
#define LANE (tid_now(wave_s) & 63)
#define WAVE (sgpr_now(wave_s))
#define GRID (sgpr_now((int)gridDim.x))
#define BX (sgpr_now((int)blockIdx.x))
#define VCU ((GRID % 8 == 0) ? (BX % 8) * (GRID / 8) + BX / 8 : BX)
#define GW (VCU * NWAVES + WAVE)
#define NGW (GRID * NWAVES)
#define GTID (BX * (NWAVES * 64) + TID)
#define NGT (GRID * NWAVES * 64)
#define TBL ((LAS int*)(lds + TBL_OFF))
#define PSTART (TBL + 384)


template <int L>
__device__ __forceinline__ void layer_body(LAS unsigned char* lds, const int lo, const int hi, const int wave_s) {
    extern __shared__ __attribute__((aligned(16))) unsigned char lds_raw[];
        const int pb = 1 + 12 * L;
#define XBP ((bf16_t*)(ws + WS_XB))
#define RINVP ((float*)(ws + WS_RINV))
#define PSQP ((float*)(ws + WS_PSQ))
#define YP ((const unsigned char*)(ws + WS_Y))
        if (IN(pb + 0)) { unsigned char* ws = P_WS();
            if (L == 0) resid_phase<true, false>(P_IN(I_X), nullptr, XBP, RINVP, GW, NGW, LANE);
            else resid_phase<false, false>(XBP, YP, XBP, RINVP, GW, NGW, LANE);
            SEAM(pb + 0); }
        if ((L & 1) == 0) {
            if (IN(pb + 1)) { unsigned char* ws = P_WS(); const int j = L >> 1;
                pg8::Gemm g{DM, DM, nullptr}; pg8::StaticOrder S; S.init(ws + WS_XB, DM, (bf16_t*)(ws + WS_WIN) + (size_t)j * 3072 * 1024, DM, T, 3072, GRID, BX);
                pg8::EpiConvIn E{(bf16_t*)(ws + WS_GB), (bf16_t*)(ws + WS_Z), RINVP}; pg8::gemm_phase(lds, g, S, E, TID); SEAM(pb + 1); }
            if (IN(pb + 2)) { unsigned char* ws = P_WS(); const int j = L >> 1;
                conv_phase((const bf16_t*)(ws + WS_GB), (const bf16_t*)(ws + WS_Z), P_IN(I_CK) + j * 3 * DM, (bf16_t*)(ws + WS_YC), GTID, NGT); SEAM(pb + 2); }
            if (IN(pb + 3)) { unsigned char* ws = P_WS(); const int j = L >> 1;
                pg8::Gemm g{DM, DM, nullptr}; pg8::StaticOrder S; S.init(ws + WS_YC, DM, (bf16_t*)(ws + WS_WOUTC) + (size_t)j * 1024 * 1024, DM, T, DM, GRID, BX);
                pg8::EpiResid E{XBP, PSQP, LANE}; pg8::gemm_phase(lds, g, S, E, TID); SEAM(pb + 5); }
        } else {
            if (IN(pb + 1)) { unsigned char* ws = P_WS(); const int j = L >> 1;
                pg8::Gemm g{DM, DM, nullptr}; pg8::StaticOrder S; S.init(ws + WS_XB, DM, (bf16_t*)(ws + WS_WDOWN) + (size_t)j * LATP * 1024, DM, T, LATP, GRID, BX);
                pg8::EpiBf16 E{(bf16_t*)(ws + WS_LAT), LATP, RINVP}; pg8::gemm_phase(lds, g, S, E, TID); SEAM(pb + 1); }
            if (IN(pb + 2)) {
                { unsigned char* ws = P_WS(); const int j = L >> 1;
                  pg8::Gemm g{LATP, QLR, nullptr}; pg8::StaticOrder S; S.init(ws + WS_LAT, LATP, ws + WS_WQ + (size_t)j * 1536 * 1024, QLR, T, 1536, GRID, BX);
                  pg8::EpiFp8 E{ws + WS_QRAW, 1536}; pg8::gemm_phase(lds, g, S, E, TID); }
                { unsigned char* ws = P_WS(); const int j = L >> 1;
                  pg8::Gemm g{LATP, KVLR, nullptr}; pg8::StaticOrder S; S.init((bf16_t*)(ws + WS_LAT) + QLR, LATP, (bf16_t*)(ws + WS_WKV) + (size_t)j * 2048 * 256, KVLR, T, 2048, GRID, BX);
                  pg8::EpiFp8 E{ws + WS_KVRAW, 2048}; pg8::gemm_phase(lds, g, S, E, TID); }
                SEAM(pb + 2); }
            if (IN(pb + 3)) { unsigned char* ws = P_WS(); const int j = L >> 1;
                qkprep8_phase((const bf16_t*)(ws + WS_LAT), ws + WS_QRAW, ws + WS_KVRAW, (const int*)P_IN(I_POS),
                              P_IN(I_MQHN) + j * DQK, P_IN(I_MKHN) + j * DQK, ws + WS_Q, ws + WS_K, ws + WS_V, lds, VCU, GRID, WAVE, LANE, TID); SEAM(pb + 3); }
            if (IN(pb + 4)) {
                for (int i = 0;; ++i) {
                    int bh, qb;
                    if (GRID == 256) { if (i >= 4) break; const int idx = i * 32 + (VCU & 31); bh = 2 * (VCU >> 5) + (idx >> 6); qb = idx & 63; }
                    else { const int k = i * GRID + BX; if (k >= NB * NH * 64) break; bh = k >> 6; qb = k & 63; }
                    const int b = bh >> 3, h = bh & 7; unsigned char* ws = P_WS();
                    att8::attn_unit_pp(ws + WS_Q + ((size_t)bh * SEQ + qb * 256) * DQK, ws + WS_K + (size_t)bh * SEQ * DQK, ws + WS_V + (size_t)bh * SEQ * DV,
                                       (bf16_t*)(ws + WS_O) + ((size_t)(b * SEQ + qb * 256)) * DM + h * DV, (char*)lds_raw, TID);
                }
                SEAM(pb + 4); }
            if (IN(pb + 5)) { unsigned char* ws = P_WS(); const int j = L >> 1;
                pg8::Gemm g{DM, DM, nullptr}; pg8::StaticOrder S; S.init(ws + WS_O, DM, (bf16_t*)(ws + WS_WO) + (size_t)j * 1024 * 1024, DM, T, DM, GRID, BX);
                pg8::EpiResid E{XBP, PSQP, LANE}; pg8::gemm_phase(lds, g, S, E, TID); SEAM(pb + 5); }
        }
#define CNT ((gu32*)(ws + WS_CTL) + CW_CNT + L * 64)
        if (IN(pb + 7)) { unsigned char* ws = P_WS();
            pg8::Gemm g{DM, DM, nullptr}; pg8::StaticOrder S; S.init(ws + WS_XB, DM, (bf16_t*)(ws + WS_WRT) + (size_t)L * 256 * 1024, DM, T, 256, GRID, BX);
            { pg8::Unit u0; const int t_ = TID;
              if (S.next(0, u0) && t_ < 256) { const f32x4* q = (const f32x4*)(PSQP + (size_t)(u0.pm * 256 + t_) * 16); const f32x4 a = q[0], b = q[1], c = q[2], d = q[3];
                  const float ssum = ((a.x + a.y) + (a.z + a.w)) + ((b.x + b.y) + (b.z + b.w)) + ((c.x + c.y) + (c.z + c.w)) + ((d.x + d.y) + (d.z + d.w));
                  RINVP[u0.pm * 256 + t_] = 1.0f / sqrtf(ssum * (1.f / DM) + EPS); }
              VM_WAIT(); __syncthreads(); }
            pg8::EpiRoute E{RINVP, P_IN(I_RBG) + L * 8, P_IN(I_RBE) + L * 64, CNT, (int*)(ws + WS_SA), (float*)(ws + WS_SG), (float*)(ws + WS_SS)};
            pg8::gemm_phase(lds, g, S, E, TID); SEAM(pb + 9); }
        if (IN(pb + 10)) { unsigned char* ws = P_WS(); const int ntiles = build_tables(CNT, TBL, PSTART, TID);
            pg8::Gemm g{DM, DM, (const int*)(ws + WS_SA)}; pg8::GroupedOrder S{ntiles * 3, 3, GRID, VCU, (const char*)(ws + WS_XB), (const char*)(ws + WS_WE1) + (size_t)L * NE * 768 * 1024 * 2, (size_t)0, (size_t)768 * 1024 * 2, (size_t)256 * 1024 * 2, TBL, PSTART};
            pg8::EpiSwiGLU E{(bf16_t*)(ws + WS_HID), (const float*)(ws + WS_SS)}; pg8::gemm_phase<true>(lds, g, S, E, TID); SEAM(pb + 10); }
        if (IN(pb + 11)) { unsigned char* ws = P_WS(); const int ntiles = build_tables(CNT, TBL, PSTART, TID);
            pg8::Gemm g{DFF, DFF, nullptr}; pg8::GroupedOrder S{ntiles * 4, 4, GRID, VCU, (const char*)(ws + WS_HID), (const char*)(ws + WS_WE2) + (size_t)L * NE * 1024 * DFF * 2, (size_t)256 * DFF * 2, (size_t)1024 * DFF * 2, (size_t)256 * DFF * 2, TBL, PSTART};
            pg8::EpiScatterY E{ws + WS_Y, (const int*)(ws + WS_SA), (const float*)(ws + WS_SG)}; pg8::gemm_phase(lds, g, S, E, TID); SEAM(pb + 11); }
    }

__global__ void __launch_bounds__(NWAVES * 64, 2) fwd(Args args) {
    extern __shared__ __attribute__((aligned(16))) unsigned char lds_raw[];
    LAS unsigned char* lds = (LAS unsigned char*)lds_raw;
    for (int u = threadIdx.x; u < (LDS_BYTES - LDSCTL_OFF) / 4; u += NWAVES * 64) ((LAS unsigned*)(lds + LDSCTL_OFF))[u] = 0u;
    __syncthreads();
    if (threadIdx.x == 0) { LAS unsigned long long* pt = (LAS unsigned long long*)(lds + PTAB_OFF);
#pragma unroll
        for (int i = 0; i < 23; ++i) pt[i] = (unsigned long long)args.in[i];
        pt[23] = (unsigned long long)args.out; pt[24] = (unsigned long long)args.ws; }
    __syncthreads();
    const int lo = args.ph_lo, hi = args.ph_hi;
    if (hi - lo > 1) (void)xcd_barrier_post((unsigned*)(P_WS() + WS_CTL) + CW_BAR, (volatile LAS unsigned*)(lds + MISC_OFF) + 8, threadIdx.x == 0);
    const int wave_s = __builtin_amdgcn_readfirstlane((int)threadIdx.x >> 6);
    if (IN(0)) { prologue_phase(lds, GW, NGW, WAVE, LANE, GTID, NGT); SEAM(0); }

    layer_body<0>(lds, lo, hi, wave_s); layer_body<1>(lds, lo, hi, wave_s); layer_body<2>(lds, lo, hi, wave_s); layer_body<3>(lds, lo, hi, wave_s);
    if (IN(49)) { unsigned char* ws = P_WS(); resid_phase<false, true>(XBP, YP, P_OUT(), nullptr, GW, NGW, LANE);
    }
#undef IN
#undef SEAM
}

extern "C" void kernel_launch(void* const* d_in, const int* in_sizes, int n_in, void* d_out, int out_size, void* d_ws, size_t ws_size, hipStream_t stream) {
    static int grid = 0;
    if (grid == 0) {
        if (n_in != 23 || out_size != T * DM || ws_size < WS_END) { fprintf(stderr, "kernel_launch: unexpected shapes: n_in %d out %d ws %zu (need %zu)\n", n_in, out_size, ws_size, (size_t)WS_END); grid = -1; return; }
        int dev = 0, cus = 0, per_cu = 0;
        if (hipGetDevice(&dev) != hipSuccess || hipDeviceGetAttribute(&cus, hipDeviceAttributeMultiprocessorCount, dev) != hipSuccess) { grid = -1; return; }
        if (hipFuncSetAttribute((const void*)fwd, hipFuncAttributeMaxDynamicSharedMemorySize, LDS_BYTES) != hipSuccess) { fprintf(stderr, "kernel_launch: hipFuncSetAttribute failed\n"); grid = -1; return; }
        if (hipOccupancyMaxActiveBlocksPerMultiprocessor(&per_cu, (const void*)fwd, NWAVES * 64, LDS_BYTES) != hipSuccess || per_cu < 1) fprintf(stderr, "kernel_launch: occupancy query says %d\n", per_cu);
        (void)hipGetLastError();
        grid = cus;
    }
    if (grid < 0) return;
    if (hipMemsetAsync((char*)d_ws + WS_CTL, 0, CTL_ZERO_BYTES, stream) != hipSuccess) return;
    Args a{};
    for (int i = 0; i < 23; ++i) a.in[i] = d_in[i];
    a.out = (float*)d_out; a.ws = (unsigned char*)d_ws;
#if MK_ONE_LAUNCH
    a.ph_lo = 0; a.ph_hi = 50;
    hipLaunchKernelGGL(fwd, dim3(grid), dim3(NWAVES * 64), LDS_BYTES, stream, a);
#else
    for (int p = 0; p < 50; ++p) {
        if (p >= 1 && p < 49) { const int L = (p - 1) / 12, k = (p - 1) % 12;
            if (k == 6 || k == 8 || k == 9) continue;
            if (k < 6 && (L & 1) == 0 && k > 3) continue;
        }
        a.ph_lo = p; a.ph_hi = p + 1;
        hipLaunchKernelGGL(fwd, dim3(grid), dim3(NWAVES * 64), LDS_BYTES, stream, a);
    }
#endif
    const hipError_t le = hipPeekAtLastError();
    if (le != hipSuccess) fprintf(stderr, "kernel_launch: launch failed: %s\n", hipGetErrorName(le));
}
```

```cpp
#include <hip/hip_runtime.h>
#include <cstdio>
#include <cstdint>

#ifndef MK_ONE_LAUNCH
#define MK_ONE_LAUNCH 1
#endif

#define GAS __attribute__((address_space(1)))
#define LAS __attribute__((address_space(3)))
typedef unsigned short bf16_t;
typedef short bf16x8 __attribute__((ext_vector_type(8)));
typedef short s16x4 __attribute__((ext_vector_type(4)));
typedef float f32x2 __attribute__((ext_vector_type(2)));
typedef float f32x4 __attribute__((ext_vector_type(4)));
typedef float f32x16 __attribute__((ext_vector_type(16)));
typedef unsigned u32x2 __attribute__((ext_vector_type(2)));
typedef unsigned u32x4 __attribute__((ext_vector_type(4)));
typedef GAS unsigned gu32;

constexpr int DM = 1024, NB = 2, SEQ = 16384, T = NB * SEQ;
constexpr int NH = 8, QLR = 384, KVLR = 256, DNOPE = 128, DROPE = 64, DQK = 192, DV = 128, LAT = 704, LATP = 768;
constexpr int NE = 64, DFF = 384;
constexpr int NASSIGN = 2 * T;
constexpr int NSLOT = NASSIGN + NE * 256;
constexpr float EPS = 1e-6f;
constexpr int NWAVES = 8;

constexpr size_t MiB = 1u << 20;
constexpr size_t WS_CTL = 0, CTL_ZERO_BYTES = 1 * MiB;
constexpr size_t WS_WIN = 2 * MiB;
constexpr size_t WS_WOUTC = 14 * MiB;
constexpr size_t WS_WDOWN = 18 * MiB;
constexpr size_t WS_WQ = 21 * MiB;
constexpr size_t WS_WKV = 24 * MiB;
constexpr size_t WS_WO = 26 * MiB;
constexpr size_t WS_WRT = 30 * MiB;
constexpr size_t WS_WE1 = 32 * MiB;
constexpr size_t WS_WE2 = 416 * MiB;
constexpr size_t WS_XB = 608 * MiB;
constexpr size_t WS_RINV = 1202 * MiB;
constexpr size_t WS_PSQ = 1200 * MiB;
constexpr size_t WS_S = 672 * MiB;
constexpr size_t WS_GB = WS_S, WS_Z = WS_S + 64 * MiB, WS_YC = WS_S + 128 * MiB;
constexpr size_t WS_LAT = WS_S, WS_QRAW = WS_S + 48 * MiB, WS_KVRAW = WS_S + 144 * MiB;
constexpr size_t WS_Q = WS_S + 272 * MiB, WS_K = WS_S + 368 * MiB, WS_V = WS_S + 464 * MiB, WS_O = WS_QRAW;
constexpr size_t WS_HID = WS_S + 160 * MiB, WS_Y = WS_S + 224 * MiB;
constexpr size_t WS_SA = WS_S + 352 * MiB, WS_SG = WS_S + 360 * MiB, WS_SS = WS_S + 368 * MiB;
constexpr size_t WS_END = WS_S + 531 * MiB;
constexpr int CW_BAR = 4096  , CW_CNT = 8192  ;

constexpr int RING_BYTES = 131072;
constexpr int LDSCTL_OFF = RING_BYTES, MISC_OFF = LDSCTL_OFF + 320;
constexpr int TBL_OFF = LDSCTL_OFF + 1024;
constexpr int LDS_BYTES = 147456;

#define RLX_AGENT __ATOMIC_RELAXED, __HIP_MEMORY_SCOPE_AGENT
#define LDS_WAIT() asm volatile("s_waitcnt lgkmcnt(0)" ::: "memory")
#define VM_WAIT() asm volatile("s_waitcnt vmcnt(0)" ::: "memory")
__device__ __forceinline__ unsigned f2bf(float f) { unsigned u = __builtin_bit_cast(unsigned, f); return (u + 0x7fffu + ((u >> 16) & 1u)) >> 16; }
__device__ __forceinline__ unsigned pk2(float lo, float hi) { unsigned r; asm("v_cvt_pk_bf16_f32 %0, %1, %2" : "=v"(r) : "v"(lo), "v"(hi)); return r; }
__device__ __forceinline__ float bflo(unsigned w) { return __builtin_bit_cast(float, w << 16); }
__device__ __forceinline__ float bfhi(unsigned w) { return __builtin_bit_cast(float, w & 0xffff0000u); }
__device__ __forceinline__ float bf2f(bf16_t h) { return __builtin_bit_cast(float, (unsigned)h << 16); }
__device__ __forceinline__ unsigned cvt_pk_bf16(float lo, float hi) { unsigned r; asm volatile("v_cvt_pk_bf16_f32 %0, %1, %2" : "=v"(r) : "v"(lo), "v"(hi)); return r; }
__device__ __forceinline__ int tid_now(int wave_s) { int l; asm volatile("v_mbcnt_lo_u32_b32 %0, -1, 0\n\tv_mbcnt_hi_u32_b32 %0, -1, %0" : "=v"(l)); return wave_s * 64 + l; }
__device__ __forceinline__ int sgpr_now(int v) { asm volatile("" : "+s"(v)); return v; }
__device__ __forceinline__ float lane_xor_f(float v, int m, int lane) { return __builtin_bit_cast(float, __builtin_amdgcn_ds_bpermute((lane ^ m) << 2, __builtin_bit_cast(int, v))); }
__device__ __forceinline__ float wave_sum(float v, int lane) {
#pragma unroll
    for (int o = 1; o < 64; o <<= 1) v += lane_xor_f(v, o, lane);
    return v;
}

typedef float f32x2v __attribute__((ext_vector_type(2)));
__device__ __forceinline__ unsigned pk4_fp8(float a, float b, float c, float d) { int w = 0; w = __builtin_amdgcn_cvt_pk_fp8_f32(a, b, w, false); w = __builtin_amdgcn_cvt_pk_fp8_f32(c, d, w, true); return (unsigned)w; }
__device__ __forceinline__ void up4_fp8(unsigned w, float* v) { const f32x2v lo = __builtin_amdgcn_cvt_pk_f32_fp8((int)w, false), hi = __builtin_amdgcn_cvt_pk_f32_fp8((int)w, true); v[0] = lo.x; v[1] = lo.y; v[2] = hi.x; v[3] = hi.y; }

#define XB_TMO      128
#define XB_XCNT(j)  (256  + 64 * (j))
#define XB_XSUB(j)  (1280 + 64 * (j))
#define XB_XGEN(j)  (2304 + 64 * (j))
#define XB_TOP      3328
#define XB_TOPGEN   3392
#define XCD_BAR_WORDS 3456
#define XB_SPIN_CAP (1u << 18)
__device__ __forceinline__ unsigned xb_ld(unsigned* p)              { return __hip_atomic_load(p, __ATOMIC_RELAXED, __HIP_MEMORY_SCOPE_AGENT); }
__device__ __forceinline__ unsigned xb_add(unsigned* p, unsigned v) { asm volatile("" : "+v"(v)); return __hip_atomic_fetch_add(p, v, __ATOMIC_RELAXED, __HIP_MEMORY_SCOPE_AGENT); }
__device__ __forceinline__ unsigned xb_xcc_id() { return (unsigned)__builtin_amdgcn_s_getreg((3 << 11) | 20) & 0xFu; }
#define XB_SPIN(cond, bar) do { unsigned _sp = 0; while (cond) { __builtin_amdgcn_s_sleep(1); \
    if ((++_sp & 255u) == 0u) { if (xb_ld(&(bar)[XB_TMO])) break; if (_sp > XB_SPIN_CAP) { atomicAdd(&(bar)[XB_TMO], 1u); break; } } } } while (0)
struct XcdBarrier { unsigned* bar; unsigned x; volatile LAS unsigned* st; };
__device__ __forceinline__ XcdBarrier xcd_barrier_post(unsigned* bar, volatile LAS unsigned* st, bool leader) {
    XcdBarrier b; b.bar = bar; b.x = xb_xcc_id(); b.st = st;
    if (leader) (void)xb_add(&bar[XB_XCNT(b.x)], 1u);
    return b;
}
__device__ __forceinline__ void xcd_barrier_complete(unsigned* bar, unsigned x, unsigned& nloc, unsigned& nx) {
    const unsigned G = gridDim.x * gridDim.y * gridDim.z;
    unsigned sum, cnt, mine, sp = 0u;
    for (;;) {
        sum = 0u; cnt = 0u; mine = 0u;
#pragma unroll
        for (unsigned j = 0; j < 16; ++j) { const unsigned c = xb_ld(&bar[XB_XCNT(j)]); sum += c; cnt += (c > 0u) ? 1u : 0u; mine = (j == x) ? c : mine; }
        if (sum == G) break;
        __builtin_amdgcn_s_sleep(1);
        if ((++sp & 255u) == 0u) { if (xb_ld(&bar[XB_TMO])) break; if (sp > XB_SPIN_CAP) { atomicAdd(&bar[XB_TMO], 1u); break; } }
    }
    nloc = mine > 0u ? mine : 1u; nx = cnt > 0u ? cnt : 1u;
}
__device__ __forceinline__ void xcd_barrier(const XcdBarrier& b, bool leader) {
    asm volatile("s_waitcnt vmcnt(0)" ::: "memory");
    __syncthreads();
    if (leader) {
        unsigned* bar = b.bar;
        __builtin_amdgcn_s_waitcnt(0);
        unsigned nloc = b.st[0], nx = b.st[1];
        if (nloc == 0u) { xcd_barrier_complete(bar, b.x, nloc, nx); b.st[0] = nloc; b.st[1] = nx; }
        const unsigned old = xb_add(&bar[XB_XSUB(b.x)], 1u);
        const unsigned gen = old / nloc;
        if (old + 1u == (gen + 1u) * nloc) {
            __builtin_amdgcn_fence(__ATOMIC_RELEASE, "agent");
            asm volatile("s_waitcnt vmcnt(0)" ::: "memory");
            const unsigned og = xb_add(&bar[XB_TOP], 1u);
            const unsigned tg = og / nx;
            if (og + 1u == (tg + 1u) * nx) xb_add(&bar[XB_TOPGEN], 1u);
            else XB_SPIN(xb_ld(&bar[XB_TOPGEN]) == tg, bar);
            __builtin_amdgcn_fence(__ATOMIC_ACQUIRE, "agent");
            xb_add(&bar[XB_XGEN(b.x)], 1u);
            asm volatile("s_waitcnt vmcnt(0)" ::: "memory");
        } else {
            XB_SPIN(xb_ld(&bar[XB_XGEN(b.x)]) == gen, bar);
            __builtin_amdgcn_fence(__ATOMIC_ACQUIRE, "agent");
            asm volatile("s_waitcnt vmcnt(0)" ::: "memory");
        }
    }
    __syncthreads();
}

namespace pg8 {
constexpr int BM = 256, BK = 64, HALF = 128, HTB = HALF * BK * 2, NXCD = 8, WGM = 8;
__host__ __device__ __forceinline__ int lds_byte(int r, int c) { const int st = (r >> 4) * 2 + (c >> 5), rr = r & 15, cc = c & 31, ob = rr * 64 + cc * 2; return st * 1024 + (ob ^ (((ob >> 9) & 1) << 5)); }
__host__ __device__ __forceinline__ void stage_rc(int b_, int& R, int& C) { const unsigned b = (unsigned)b_, st = b >> 10, sb = b & 1023u, swz = sb ^ (((sb >> 9) & 1u) << 5); R = (int)((st >> 1) * 16u + (swz >> 6)); C = (int)((st & 1u) * 32u + ((swz & 63u) >> 1)); }
__host__ __device__ __forceinline__ int perm32(int rho) { const int n = rho >> 4, i = rho & 15; return 8 * (i >> 2) + 4 * n + (i & 3); }

struct Unit { const char* A; const char* B; int pm, pn, arow, nvalid; };
struct Gemm { int lda, K; const int* rowidx; };

struct StaticOrder {
    int nM, nN, nwg, G, c; const char* A; const char* B; size_t astep, bstep;
    __device__ void init(const void* A_, int lda, const void* B_, int K, int M, int N, int G_, int c_) { nM = M / BM; nN = N / BM; nwg = nM * nN; G = G_; c = c_; A = (const char*)A_; B = (const char*)B_; astep = (size_t)BM * lda * 2; bstep = (size_t)BM * K * 2; }
    __device__ __forceinline__ bool next(int i, Unit& u) const {
        const long L = (long)i * G + c; if (L >= nwg) return false;
        int wgid = (int)L; { const int q = nwg / NXCD, r = nwg % NXCD, xcd = wgid % NXCD, off = wgid / NXCD; wgid = (xcd < r ? xcd * (q + 1) : r * (q + 1) + (xcd - r) * q) + off; }
        const int nig = WGM * nN, gid = wgid / nig, fm = gid * WGM, gsz = (nM - fm) < WGM ? (nM - fm) : WGM;
        u.pm = fm + ((wgid % nig) % gsz); u.pn = (wgid % nig) / gsz; u.A = A + (size_t)u.pm * astep; u.B = B + (size_t)u.pn * bstep; u.arow = 0; u.nvalid = BM; return true;
    }
};
constexpr int ECAP = 32768;
struct GroupedOrder {
    int n_units, nN, G, c; const char* A; const char* B; size_t astep, bexp, bstep; const LAS int* tbl; const LAS int* cntl;
    __device__ __forceinline__ bool next(int i, Unit& u) const {
        const int L = i * G + c; if (L >= n_units) return false;
        const int tile = L / nN, pn = L - tile * nN; const int ei = __builtin_amdgcn_readfirstlane(tbl[tile]); const int e = ei >> 16, ti = ei & 0xffff;
        const int left = __builtin_amdgcn_readfirstlane(cntl[e]) - ti * BM;
        u.pm = tile; u.pn = pn; u.arow = e * ECAP + ti * BM; u.nvalid = left < BM ? left : BM; u.A = A + (size_t)tile * astep; u.B = B + (size_t)e * bexp + (size_t)pn * bstep; return true;
    }
};

typedef f32x4 Acc[2][2][4][2];

struct EpiBf16 {
    static constexpr bool PERM = true, AFTER_DRAIN = false; static constexpr bool P16 = false;
    bf16_t* O; int ldc; const float* rs;
    __device__ __forceinline__ void operator()(const Acc& acc, const Unit& u, int wr, int wc, int fr, int fq) const {
        const int row0 = u.pm * BM + wr * 64 + fr, col0 = u.pn * BM + wc * 32 + 8 * fq;
#pragma unroll
        for (int ai = 0; ai < 2; ++ai)
#pragma unroll
            for (int m = 0; m < 4; ++m) { const int row = row0 + ai * HALF + m * 16; bf16_t* rowp = O + (size_t)row * ldc + col0; const float r = rs ? rs[row] : 1.f;
#pragma unroll
                for (int bj = 0; bj < 2; ++bj) { const f32x4 v0 = acc[ai][bj][m][0] * r, v1 = acc[ai][bj][m][1] * r;
                    u32x4 w; w.x = cvt_pk_bf16(v0[0], v0[1]); w.y = cvt_pk_bf16(v0[2], v0[3]); w.z = cvt_pk_bf16(v1[0], v1[1]); w.w = cvt_pk_bf16(v1[2], v1[3]);
                    *(u32x4*)(rowp + bj * HALF) = w; } }
    }
};
struct EpiFp8 {
    static constexpr bool PERM = true, AFTER_DRAIN = false; static constexpr bool P16 = true;
    unsigned char* O; int ldc;
    __device__ __forceinline__ void operator()(const Acc& acc, const Unit& u, int wr, int wc, int fr, int fq) const {
        const int row0 = u.pm * BM + wr * 64 + fr, col0 = u.pn * BM + wc * 64 + 16 * fq;
#pragma unroll
        for (int ai = 0; ai < 2; ++ai)
#pragma unroll
            for (int m = 0; m < 4; ++m) { unsigned char* rowp = O + (size_t)(row0 + ai * HALF + m * 16) * ldc + col0;
                const f32x4 a0 = acc[ai][0][m][0], a1 = acc[ai][0][m][1], b0 = acc[ai][1][m][0], b1 = acc[ai][1][m][1];
                u32x4 w; w.x = pk4_fp8(a0[0], a0[1], a0[2], a0[3]); w.y = pk4_fp8(a1[0], a1[1], a1[2], a1[3]); w.z = pk4_fp8(b0[0], b0[1], b0[2], b0[3]); w.w = pk4_fp8(b1[0], b1[1], b1[2], b1[3]);
                *(u32x4*)rowp = w; }
    }
};
struct EpiConvIn {
    static constexpr bool PERM = true, AFTER_DRAIN = false; static constexpr bool P16 = false;
    bf16_t* GBp; bf16_t* Zp; const float* rs;
    __device__ __forceinline__ void operator()(const Acc& acc, const Unit& u, int wr, int wc, int fr, int fq) const {
        const int row0 = u.pm * BM + wr * 64 + fr;
        if (u.pn < 4) {
            const int col0 = u.pn * BM + wc * 32 + 8 * fq;
#pragma unroll
            for (int ai = 0; ai < 2; ++ai)
#pragma unroll
                for (int m = 0; m < 4; ++m) { const int row = row0 + ai * HALF + m * 16; bf16_t* rowp = GBp + (size_t)row * DM + col0; const float r = rs[row];
#pragma unroll
                    for (int bj = 0; bj < 2; ++bj) { const f32x4 v0 = acc[ai][bj][m][0] * r, v1 = acc[ai][bj][m][1] * r;
                        u32x4 w; w.x = cvt_pk_bf16(v0[0], v0[1]); w.y = cvt_pk_bf16(v0[2], v0[3]); w.z = cvt_pk_bf16(v1[0], v1[1]); w.w = cvt_pk_bf16(v1[2], v1[3]);
                        *(u32x4*)(rowp + bj * HALF) = w; } }
        } else {
            const int col0 = (u.pn - 4) * HALF + wc * 32 + 8 * fq;
#pragma unroll
            for (int ai = 0; ai < 2; ++ai)
#pragma unroll
                for (int m = 0; m < 4; ++m) { const int row = row0 + ai * HALF + m * 16; bf16_t* rowp = Zp + (size_t)row * DM + col0; const float r = rs[row], r2 = r * r;
                    const f32x4 v0 = acc[ai][0][m][0] * acc[ai][1][m][0] * r2, v1 = acc[ai][0][m][1] * acc[ai][1][m][1] * r2;
                    u32x4 w; w.x = cvt_pk_bf16(v0[0], v0[1]); w.y = cvt_pk_bf16(v0[2], v0[3]); w.z = cvt_pk_bf16(v1[0], v1[1]); w.w = cvt_pk_bf16(v1[2], v1[3]);
                    *(u32x4*)rowp = w; }
        }
    }
};
__device__ __forceinline__ float silu_mul(float g, float u) { return g * __builtin_amdgcn_rcpf(1.f + __expf(-g)) * u; }
struct EpiSwiGLU {
    static constexpr bool PERM = true, AFTER_DRAIN = false; static constexpr bool P16 = false;
    bf16_t* Hd; const float* ss;
    __device__ __forceinline__ void operator()(const Acc& acc, const Unit& u, int wr, int wc, int fr, int fq) const {
        const int row0 = u.pm * BM + wr * 64 + fr, col0 = u.pn * HALF + wc * 32 + 8 * fq;
#pragma unroll
        for (int ai = 0; ai < 2; ++ai)
#pragma unroll
            for (int m = 0; m < 4; ++m) { const int row = row0 + ai * HALF + m * 16; bf16_t* rowp = Hd + (size_t)row * DFF + col0; const float r = ss[u.arow + (row - u.pm * BM)];
                f32x4 v0, v1;
#pragma unroll
                for (int q = 0; q < 4; ++q) { v0[q] = silu_mul(acc[ai][0][m][0][q] * r, acc[ai][1][m][0][q] * r); v1[q] = silu_mul(acc[ai][0][m][1][q] * r, acc[ai][1][m][1][q] * r); }
                u32x4 w; w.x = cvt_pk_bf16(v0[0], v0[1]); w.y = cvt_pk_bf16(v0[2], v0[3]); w.z = cvt_pk_bf16(v1[0], v1[1]); w.w = cvt_pk_bf16(v1[2], v1[3]);
                *(u32x4*)rowp = w; }
    }
};
struct EpiResid {
    static constexpr bool PERM = true, AFTER_DRAIN = false; static constexpr bool P16 = false;
    bf16_t* XB; float* PSQ; int lane;
    __device__ __forceinline__ void operator()(const Acc& acc, const Unit& u, int wr, int wc, int fr, int fq) const {
        const int row0 = u.pm * BM + wr * 64 + fr, col0 = u.pn * BM + wc * 32 + 8 * fq;
#pragma unroll
        for (int ai = 0; ai < 2; ++ai)
#pragma unroll
            for (int m = 0; m < 4; ++m) { const int row = row0 + ai * HALF + m * 16; bf16_t* rowp = XB + (size_t)row * DM + col0; float ss = 0.f;
#pragma unroll
                for (int bj = 0; bj < 2; ++bj) { const u32x4 xv = *(const u32x4*)(rowp + bj * HALF);
                    const f32x4 v0 = acc[ai][bj][m][0] + (f32x4){bflo(xv.x), bfhi(xv.x), bflo(xv.y), bfhi(xv.y)}, v1 = acc[ai][bj][m][1] + (f32x4){bflo(xv.z), bfhi(xv.z), bflo(xv.w), bfhi(xv.w)};
                    ss += (v0[0] * v0[0] + v0[1] * v0[1]) + (v0[2] * v0[2] + v0[3] * v0[3]) + (v1[0] * v1[0] + v1[1] * v1[1]) + (v1[2] * v1[2] + v1[3] * v1[3]);
                    u32x4 w; w.x = cvt_pk_bf16(v0[0], v0[1]); w.y = cvt_pk_bf16(v0[2], v0[3]); w.z = cvt_pk_bf16(v1[0], v1[1]); w.w = cvt_pk_bf16(v1[2], v1[3]);
                    *(u32x4*)(rowp + bj * HALF) = w; }
                ss += lane_xor_f(ss, 16, lane); ss += lane_xor_f(ss, 32, lane);
                if (fq == 0) PSQ[(size_t)row * 16 + u.pn * 4 + wc] = ss; }
    }
};
struct EpiRoute {
    static constexpr bool PERM = false, AFTER_DRAIN = true; static constexpr bool P16 = false;
    const float* rs; const float* bg; const float* be; gu32* cnt; int* sa; float* sgate; float* sscale;
    __device__ __forceinline__ void fused(const Acc& acc, const Unit& u, int wr, int wc, int fr, int fq, LAS unsigned char* lds, int tid) const {
        LAS float* lg = (LAS float*)lds;
        if (wc < 3) {
#pragma unroll
            for (int ai = 0; ai < 2; ++ai)
#pragma unroll
                for (int m = 0; m < 4; ++m) { const int rl = ai * HALF + wr * 64 + m * 16 + fr; const float r = rs[u.pm * BM + rl];
#pragma unroll
                    for (int n = 0; n < 2; ++n) { const int c0 = wc * 32 + 16 * n + 4 * fq;
                        if (c0 < 72) { LAS float* d = lg + rl * 73 + c0; const f32x4 v = acc[ai][0][m][n] * r; d[0] = v[0]; d[1] = v[1]; d[2] = v[2]; d[3] = v[3]; } } } }
        __syncthreads();
        LAS unsigned* lc = (LAS unsigned*)(lds + 80 * 1024);
        if (tid < 64) lc[tid] = 0u;
        __syncthreads();
        int e0 = 0, e1 = 0; float rv = 0.f, w0 = 0.f, w1 = 0.f; unsigned r0 = 0u, r1 = 0u; const int t = u.pm * BM + tid;
        if (tid < 256) { const LAS float* l = lg + tid * 73;
            float gl[8];
#pragma unroll
            for (int q = 0; q < 8; ++q) gl[q] = l[q];
            float gm = gl[0]; int gs = 0; float bm = gl[0] + bg[0];
#pragma unroll
            for (int q = 1; q < 8; ++q) { gm = fmaxf(gm, gl[q]); const float v = gl[q] + bg[q]; if (v > bm) { bm = v; gs = q; } }
            float gsum = 0.f, gsel = 0.f;
#pragma unroll
            for (int q = 0; q < 8; ++q) { const float e = __expf(gl[q] - gm); gsum += e; gsel = (q == gs) ? e : gsel; }
            const float g_gate = gsel / gsum;
            float el[8];
#pragma unroll
            for (int q = 0; q < 8; ++q) el[q] = l[8 + gs * 8 + q];
            int i0 = 0; float v0 = el[0] + be[gs * 8];
#pragma unroll
            for (int q = 1; q < 8; ++q) { const float v = el[q] + be[gs * 8 + q]; if (v > v0) { v0 = v; i0 = q; } }
            int i1 = -1; float v1 = -3.0e38f;
#pragma unroll
            for (int q = 0; q < 8; ++q) { const float v = el[q] + be[gs * 8 + q]; if (q != i0 && v > v1) { v1 = v; i1 = q; } }
            float l0 = 0.f, l1 = 0.f;
#pragma unroll
            for (int q = 0; q < 8; ++q) { l0 = (q == i0) ? el[q] : l0; l1 = (q == i1) ? el[q] : l1; }
            const float mm = fmaxf(l0, l1), p0 = __expf(l0 - mm), p1 = __expf(l1 - mm), inv = 1.f / (p0 + p1);
            e0 = gs * 8 + i0; e1 = gs * 8 + i1; rv = rs[t]; w0 = g_gate * p0 * inv; w1 = g_gate * p1 * inv;
            unsigned one_ = 1u; asm volatile("" : "+v"(one_));
            r0 = __hip_atomic_fetch_add(lc + e0, one_, __ATOMIC_RELAXED, __HIP_MEMORY_SCOPE_WORKGROUP); r1 = __hip_atomic_fetch_add(lc + e1, one_, __ATOMIC_RELAXED, __HIP_MEMORY_SCOPE_WORKGROUP); }
        __syncthreads();
        if (tid < 64) { const unsigned n = lc[tid]; lc[64 + tid] = n ? __hip_atomic_fetch_add(cnt + 32 * tid, n, RLX_AGENT) : 0u; }
        __syncthreads();
        if (tid < 256) { const int s0 = e0 * ECAP + (int)(lc[64 + e0] + r0), s1 = e1 * ECAP + (int)(lc[64 + e1] + r1);
            sa[s0] = 2 * t; sgate[s0] = w0; sscale[s0] = rv; sa[s1] = 2 * t + 1; sgate[s1] = w1; sscale[s1] = rv; }
    }
};
struct EpiScatterY {
    static constexpr bool PERM = true, AFTER_DRAIN = false; static constexpr bool P16 = true;
    unsigned char* Y; const int* sdest; const float* sgate;
    __device__ __forceinline__ void operator()(const Acc& acc, const Unit& u, int wr, int wc, int fr, int fq) const {
        const int col0 = u.pn * BM + wc * 64 + 16 * fq;
#pragma unroll
        for (int ai = 0; ai < 2; ++ai)
#pragma unroll
            for (int m = 0; m < 4; ++m) { const int rl = wr * 64 + fr + ai * HALF + m * 16; const bool ok = rl < u.nvalid; const int d = ok ? sdest[u.arow + rl] : 0; const float g = ok ? 16.f * sgate[u.arow + rl] : 0.f;
                if (ok) { unsigned char* rowp = Y + (size_t)d * DM + col0;
                    const f32x4 a0 = acc[ai][0][m][0] * g, a1 = acc[ai][0][m][1] * g, b0 = acc[ai][1][m][0] * g, b1 = acc[ai][1][m][1] * g;
                    u32x4 w; w.x = pk4_fp8(a0[0], a0[1], a0[2], a0[3]); w.y = pk4_fp8(a1[0], a1[1], a1[2], a1[3]); w.z = pk4_fp8(b0[0], b0[1], b0[2], b0[3]); w.w = pk4_fp8(b1[0], b1[1], b1[2], b1[3]);
                    *(u32x4*)rowp = w; }
                asm volatile("" ::: "memory"); }
    }
};

template <bool GATHER = false, bool ONLY_B0 = false, class Epi, class Sched>
__device__ __forceinline__ void gemm_phase(LAS unsigned char* lds, const Gemm g, const Sched& S, const Epi& E, int tid) {
    const int wid = __builtin_amdgcn_readfirstlane(tid >> 6), lane = tid & 63, wr = wid >> 2, wc = wid & 3, fr = lane & 15, fq = lane >> 4;
    const int K = g.K, lda = g.lda, nt = K / BK;
    unsigned voffA[2], voffB[2];
#pragma unroll
    for (int i = 0; i < 2; ++i) { int R, C; stage_rc(tid * 16 + i * 8192, R, C); const int Rb = Epi::P16 ? (64 * ((R >> 5) & 3) + 16 * ((R >> 2) & 3) + 4 * ((R >> 4) & 1) + (R & 3)) : (Epi::PERM ? ((R & ~31) + perm32(R & 31)) : R);
        voffA[i] = (unsigned)(R * lda + C) * 2u; voffB[i] = (unsigned)(Rb * K + C) * 2u; }
    const size_t kstep = (size_t)(BK * 2);
    const size_t hstepA = (size_t)HALF * lda * 2, hstepB = (size_t)(Epi::P16 ? 8 : HALF) * K * 2;
    unsigned goC[2][2] = {{0u, 0u}, {0u, 0u}}, goN[2][2] = {{0u, 0u}, {0u, 0u}}; int gR[2] = {0, 0}; unsigned gC[2] = {0u, 0u};
    if constexpr (GATHER) {
#pragma unroll
        for (int i = 0; i < 2; ++i) { int R, C; stage_rc(tid * 16 + i * 8192, R, C); gR[i] = R; gC[i] = (unsigned)C * 2u; } }
#define PG8_GO(dst, un_) do { _Pragma("unroll") for (int h_ = 0; h_ < 2; ++h_) _Pragma("unroll") for (int i_ = 0; i_ < 2; ++i_) \
        { const int r_ = h_ * HALF + gR[i_]; const int a_ = r_ < (un_).nvalid ? g.rowidx[(un_).arow + r_] : 0; dst[h_][i_] = (unsigned)((a_ >> 1) & (T - 1)) * (unsigned)(lda * 2) + gC[i_]; } } while (0)
    const unsigned ldsw = (unsigned)wid * 1024u;
    const int aoff = lds_byte(wr * 64 + fr, fq * 8), boff = lds_byte(wc * 32 + fr, fq * 8);
#define PG8_SA(b, h) (((b) * 2 + (h)) * HTB)
#define PG8_SB(b, h) ((4 + (b) * 2 + (h)) * HTB)
#define PG8_STAGE(bufoff, gbase, voff) do { _Pragma("unroll") for (int _i = 0; _i < 2; ++_i) \
        __builtin_amdgcn_global_load_lds((const unsigned*)((const char*)(gbase) + (voff)[_i]), (LAS unsigned*)(lds + (bufoff) + ldsw + _i * 8192), 16, 0, 0); } while (0)
#define PG8_LDA(dst, b, h) do { _Pragma("unroll") for (int m = 0; m < 4; ++m) _Pragma("unroll") for (int k = 0; k < 2; ++k) dst[m][k] = *(const LAS bf16x8*)(lds + PG8_SA(b, h) + aoff + m * 2048 + k * 1024); } while (0)
#define PG8_LDB(dst, b, h) do { _Pragma("unroll") for (int n = 0; n < 2; ++n) _Pragma("unroll") for (int k = 0; k < 2; ++k) dst[n][k] = *(const LAS bf16x8*)(lds + PG8_SB(b, h) + boff + n * 2048 + k * 1024); } while (0)
#define PG8_MMA(ai, bj, At, Bt) do { __builtin_amdgcn_s_setprio(1); _Pragma("unroll") for (int m = 0; m < 4; ++m) _Pragma("unroll") for (int n = 0; n < 2; ++n) _Pragma("unroll") for (int k = 0; k < 2; ++k) \
        acc[ai][bj][m][n] = __builtin_amdgcn_mfma_f32_16x16x32_bf16(Bt[n][k], At[m][k], acc[ai][bj][m][n], 0, 0, 0); __builtin_amdgcn_s_setprio(0); } while (0)
#define PG8_WAIT_V(n) asm volatile("s_waitcnt vmcnt(" #n ")" ::: "memory")
#define PG8_WAIT_L(n) asm volatile("s_waitcnt lgkmcnt(" #n ")" ::: "memory")
#define PG8_BAR __builtin_amdgcn_s_barrier()
#define PG8_SCHED __builtin_amdgcn_sched_barrier(0)
    Unit cur, nxt; int ui = 0;
    if (!S.next(0, cur)) return;
    Acc acc;
#pragma unroll
    for (int a = 0; a < 2; ++a)
#pragma unroll
        for (int b = 0; b < 2; ++b)
#pragma unroll
            for (int m = 0; m < 4; ++m)
#pragma unroll
                for (int n = 0; n < 2; ++n) acc[a][b][m][n] = (f32x4){0.f, 0.f, 0.f, 0.f};
    bf16x8 At[4][2], B0[2][2], B1[2][2];
    const char* cA = cur.A; const char* cB = cur.B;
    if constexpr (GATHER) PG8_GO(goC, cur);
    PG8_STAGE(PG8_SB(0, 0), cB, voffB); PG8_STAGE(PG8_SB(0, 1), cB + hstepB, voffB);
    if constexpr (GATHER) { PG8_STAGE(PG8_SA(0, 0), cA, goC[0]); PG8_STAGE(PG8_SA(0, 1), cA, goC[1]); } else { PG8_STAGE(PG8_SA(0, 0), cA, voffA); PG8_STAGE(PG8_SA(0, 1), cA + hstepA, voffA); }
    if (wr == 1) PG8_BAR;
    PG8_WAIT_V(2); PG8_BAR;
    PG8_STAGE(PG8_SB(1, 0), cB + kstep, voffB); if constexpr (GATHER) PG8_STAGE(PG8_SA(1, 0), cA + kstep, goC[0]); else PG8_STAGE(PG8_SA(1, 0), cA + kstep, voffA); PG8_STAGE(PG8_SB(1, 1), cB + hstepB + kstep, voffB);
    PG8_WAIT_V(6); PG8_BAR;
    for (;;) {
        const bool has_next = S.next(ui + 1, nxt);
        const char* nA = has_next ? nxt.A : cA; const char* nB = has_next ? nxt.B : cB;
        if constexpr (GATHER) { if (has_next) PG8_GO(goN, nxt); else { goN[0][0] = goC[0][0]; goN[0][1] = goC[0][1]; goN[1][0] = goC[1][0]; goN[1][1] = goC[1][1]; } }
        for (int t = 0; t < nt; t += 2) {
            const bool last = (t == nt - 2);
            const char* a1 = cA + (size_t)(t + 1) * kstep;
            const char* a2 = last ? nA : cA + (size_t)(t + 2) * kstep; const char* b2 = last ? nB : cB + (size_t)(t + 2) * kstep;
            const char* a3 = a2 + kstep; const char* b3 = b2 + kstep;
            unsigned g2h0[2], g2h1[2];
            if constexpr (GATHER) { g2h0[0] = last ? goN[0][0] : goC[0][0]; g2h0[1] = last ? goN[0][1] : goC[0][1]; g2h1[0] = last ? goN[1][0] : goC[1][0]; g2h1[1] = last ? goN[1][1] : goC[1][1]; }
            PG8_LDB(B0, 0, 0); if constexpr (!ONLY_B0) PG8_LDB(B1, 0, 1); PG8_SCHED; PG8_LDA(At, 0, 0); if constexpr (GATHER) PG8_STAGE(PG8_SA(1, 1), a1, goC[1]); else PG8_STAGE(PG8_SA(1, 1), a1 + hstepA, voffA);
            PG8_WAIT_V(8); PG8_WAIT_L(0); PG8_BAR; PG8_MMA(0, 0, At, B0); if constexpr (!ONLY_B0) PG8_MMA(0, 1, At, B1); PG8_BAR; PG8_SCHED;
            PG8_LDA(At, 0, 1); PG8_STAGE(PG8_SB(0, 0), b2, voffB); PG8_STAGE(PG8_SB(0, 1), b2 + hstepB, voffB); if constexpr (GATHER) PG8_STAGE(PG8_SA(0, 0), a2, g2h0); else PG8_STAGE(PG8_SA(0, 0), a2, voffA);
            PG8_WAIT_V(8); PG8_WAIT_L(0); PG8_BAR; PG8_MMA(1, 0, At, B0); if constexpr (!ONLY_B0) PG8_MMA(1, 1, At, B1); PG8_BAR; PG8_SCHED;
            PG8_LDB(B0, 1, 0); if constexpr (!ONLY_B0) PG8_LDB(B1, 1, 1); PG8_SCHED; PG8_LDA(At, 1, 0); if constexpr (GATHER) PG8_STAGE(PG8_SA(0, 1), a2, g2h1); else PG8_STAGE(PG8_SA(0, 1), a2 + hstepA, voffA);
            PG8_WAIT_V(8); PG8_WAIT_L(0); PG8_BAR; PG8_MMA(0, 0, At, B0); if constexpr (!ONLY_B0) PG8_MMA(0, 1, At, B1); PG8_BAR; PG8_SCHED;
            PG8_LDA(At, 1, 1); PG8_STAGE(PG8_SB(1, 0), b3, voffB); PG8_STAGE(PG8_SB(1, 1), b3 + hstepB, voffB); if constexpr (GATHER) PG8_STAGE(PG8_SA(1, 0), a3, g2h0); else PG8_STAGE(PG8_SA(1, 0), a3, voffA);
            PG8_WAIT_V(8); PG8_WAIT_L(0); PG8_BAR; PG8_MMA(1, 0, At, B0); if constexpr (!ONLY_B0) PG8_MMA(1, 1, At, B1); PG8_BAR; PG8_SCHED;
        }
        if (wr == 0) PG8_BAR;
        if constexpr (!Epi::AFTER_DRAIN) E(acc, cur, wr, wc, fr, fq);
        if (!has_next) break;
#pragma unroll
        for (int a = 0; a < 2; ++a)
#pragma unroll
            for (int b = 0; b < 2; ++b)
#pragma unroll
                for (int m = 0; m < 4; ++m)
#pragma unroll
                    for (int n = 0; n < 2; ++n) acc[a][b][m][n] = (f32x4){0.f, 0.f, 0.f, 0.f};
        cur = nxt; cA = nA; cB = nB; ++ui;
        if constexpr (GATHER) { goC[0][0] = goN[0][0]; goC[0][1] = goN[0][1]; goC[1][0] = goN[1][0]; goC[1][1] = goN[1][1]; }
        if (wr == 1) PG8_BAR;
    }
    PG8_WAIT_V(0);
    PG8_BAR;
    if constexpr (Epi::AFTER_DRAIN) E.fused(acc, cur, wr, wc, fr, fq, lds, tid);
#undef PG8_GO
#undef PG8_SA
#undef PG8_SB
#undef PG8_STAGE
#undef PG8_LDA
#undef PG8_LDB
#undef PG8_MMA
#undef PG8_WAIT_V
#undef PG8_WAIT_L
#undef PG8_BAR
#undef PG8_SCHED
}
}


namespace att8 {
typedef int i32x8 __attribute__((ext_vector_type(8)));
constexpr int NW = 8, QBLK = 32, KVBLK = 64;
constexpr float SCALE = 0.07216878364870322f;
constexpr float POFF = 3.f;
constexpr float PLIM = 448.f;
constexpr int KROW = 208, VROW = 80;
constexpr int SHM_K = KVBLK * KROW, SHM_V = DV * VROW;
constexpr int OFF_V = 0, OFF_K = 2 * SHM_V, OFF_WS = OFF_K + 3 * SHM_K, ATT_LDS = OFF_WS + NW * 64 * 4;
static_assert(ATT_LDS <= 65536, "O staging reuses [0, 64 KiB)");
#define SBAR() __builtin_amdgcn_sched_barrier(0)
__device__ __forceinline__ int crow(int r, int hi) { return (r & 3) + 8 * (r >> 2) + 4 * hi; }
__device__ __forceinline__ f32x16 mfma8(i32x8 a, i32x8 b, f32x16 c) { return __builtin_amdgcn_mfma_scale_f32_32x32x64_f8f6f4(a, b, c, 0, 0, 0, 0x7F7F7F7F, 0, 0x7F7F7F7F); }
__device__ __forceinline__ i32x8 ld32(const char* p) { const u32x4 a = *reinterpret_cast<const u32x4*>(p), b = *reinterpret_cast<const u32x4*>(p + 16); return (i32x8){(int)a.x, (int)a.y, (int)a.z, (int)a.w, (int)b.x, (int)b.y, (int)b.z, (int)b.w}; }
template <bool FIRST = false>
__device__ __forceinline__ void softmax_seg(f32x16& p0, f32x16& p1, f32x16& negm, float& l_reg, f32x16* o, i32x8& pa, float* al_l, int r32, int hi) {
    float ps = 0;
#pragma unroll
    for (int r = 0; r < 16; ++r) { p0[r] = __builtin_amdgcn_exp2f(p0[r]); ps += p0[r]; }
    asm volatile("" :: "v"(pa));
#pragma unroll
    for (int r = 0; r < 16; ++r) { p1[r] = __builtin_amdgcn_exp2f(p1[r]); ps += p1[r]; }
    if (FIRST || !__builtin_expect(__all(ps <= PLIM), 1)) {
        float alpha;
        float pm = fmaxf(p0[0], p1[0]);
#pragma unroll
        for (int r = 1; r < 16; ++r) pm = fmaxf(pm, fmaxf(p0[r], p1[r]));
        { auto rr = __builtin_amdgcn_permlane32_swap(__float_as_uint(pm), __float_as_uint(pm), false, false);
          pm = fmaxf(__uint_as_float(rr[0]), __uint_as_float(rr[1])); }
        const float d = __builtin_ceilf(fmaxf(__builtin_amdgcn_logf(pm) - POFF, 0.f));
        alpha = __builtin_amdgcn_exp2f(-d);
#pragma unroll
        for (int r = 0; r < 16; ++r) { p0[r] *= alpha; p1[r] *= alpha; negm[r] -= d; }
        ps *= alpha; l_reg *= alpha;
        if (hi == 0) al_l[r32] = alpha; asm volatile("s_waitcnt lgkmcnt(0)" ::: "memory");
#pragma unroll
        for (int dd = 0; dd < 4; ++dd)
#pragma unroll
            for (int r = 0; r < 16; ++r) o[dd][r] *= al_l[crow(r, hi)];
    }
    asm("v_add_f32_e32 %0, %0, %1" : "+v"(l_reg) : "v"(ps));
#pragma unroll
    for (int g = 0; g < 4; ++g) { int w = pa[g]; w = __builtin_amdgcn_cvt_pk_fp8_f32(p0[4 * g], p0[4 * g + 1], w, false); w = __builtin_amdgcn_cvt_pk_fp8_f32(p0[4 * g + 2], p0[4 * g + 3], w, true); pa[g] = w; }
#pragma unroll
    for (int g = 0; g < 4; ++g) { int w = pa[4 + g]; w = __builtin_amdgcn_cvt_pk_fp8_f32(p1[4 * g], p1[4 * g + 1], w, false); w = __builtin_amdgcn_cvt_pk_fp8_f32(p1[4 * g + 2], p1[4 * g + 3], w, true); pa[4 + g] = w; }
}
__device__ __forceinline__ f32x16 mfma8q(i32x8 a, i32x8 b, f32x16 c) { return __builtin_amdgcn_mfma_scale_f32_32x32x64_f8f6f4(a, b, c, 0, 0, 0, 0x7F7F7F7F, 0, 0x7C7C7C7C); }
constexpr int KPF = 2;
__device__ __forceinline__ void kfrag_load(i32x8 (&ka)[KPF][2], const char* Ks, int r32, int hi) {
#pragma unroll
    for (int ks = 0; ks < KPF; ++ks) { const int cb = ks * 64 + hi * 32; ka[ks][0] = ld32(Ks + r32 * KROW + cb); ka[ks][1] = ld32(Ks + (32 + r32) * KROW + cb); }
}
#define SGB(mask, n) __builtin_amdgcn_sched_group_barrier(mask, n, 0)
template <bool DO_QK, bool DO_PV, typename StageF>
__device__ __forceinline__ void mfma_seg(f32x16& p0, f32x16& p1, const f32x16& negm, f32x16* o, const i32x8 (&ka)[KPF][2], const char* Ks, const char* Vs, const i32x8* qr, i32x8 pa, int r32, int hi, StageF&& stage) {
    static_assert(KPF == 2, "gap placement below is written for two prefetched k-steps");
    i32x8 vb[4], kr[2];
    __builtin_amdgcn_s_setprio(1);
    SBAR();
    if (DO_PV) stage();
    if (DO_QK) { const int cb = 2 * 64 + hi * 32; kr[0] = ld32(Ks + r32 * KROW + cb); kr[1] = ld32(Ks + (32 + r32) * KROW + cb); }
    if (DO_PV) {
#pragma unroll
        for (int d0 = 0; d0 < 4; ++d0) vb[d0] = ld32(Vs + (32 * d0 + r32) * VROW + hi * 32); }
    if (!DO_PV) stage();
    if (DO_QK) { p0 = mfma8q(ka[0][0], qr[0], negm); p1 = mfma8q(ka[0][1], qr[0], negm); p0 = mfma8q(ka[1][0], qr[1], p0); p1 = mfma8q(ka[1][1], qr[1], p1);
                 p0 = mfma8q(kr[0], qr[2], p0); p1 = mfma8q(kr[1], qr[2], p1); }
    if (DO_QK && DO_PV) { SGB(0x008, 1); SGB(0x200, 3); SGB(0x020, 3); SGB(0x008, 1); SGB(0x100, 4); SGB(0x008, 1); SGB(0x100, 4); SGB(0x008, 1); SGB(0x100, 4); SGB(0x008, 2); }
    else if (DO_QK) { SGB(0x008, 1); SGB(0x100, 4); SGB(0x008, 1); SGB(0x200, 3); SGB(0x020, 3); SGB(0x008, 4); }
    SBAR();
    if (DO_PV) {
#pragma unroll
        for (int d0 = 0; d0 < 4; ++d0) o[d0] = mfma8(pa, vb[d0], o[d0]); }
    SBAR();
    __builtin_amdgcn_s_setprio(0);
}
#undef SGB
__device__ __forceinline__ void attn_unit_pp(const unsigned char* __restrict__ Qb, const unsigned char* __restrict__ Kh, const unsigned char* __restrict__ Vt, bf16_t* __restrict__ Ob, char* lds, int tid) {
    const int wid = __builtin_amdgcn_readfirstlane(tid >> 6), lane = tid & 63, r32 = lane & 31, hi = lane >> 5;
    const bool halfB = wid >= 4;
    char* V_lds = lds + OFF_V; char* K_lds = lds + OFF_K;
    float* ws = (float*)(lds + OFF_WS) + wid * 64; float* li_l = ws; float* al_l = ws + 32;
    float l_reg = 0; f32x16 o[4] = {}; i32x8 qr[3]; f32x16 negm;
    float m0_ = 60.f; asm volatile("" : "+v"(m0_));
#pragma unroll
    for (int r = 0; r < 16; ++r) negm[r] = m0_;
    const unsigned char* Qw = Qb + (long)(wid * QBLK + r32) * DQK + hi * 32;
#pragma unroll
    for (int ks = 0; ks < 3; ++ks) qr[ks] = ld32((const char*)Qw + ks * 64);
    const int kst0 = (tid / 12) * KROW + (tid % 12) * 16, kst1 = ((8192 + tid * 8) / 192) * KROW + ((8192 + tid * 8) % 192), vst = (tid >> 2) * VROW + (tid & 3) * 16;
    constexpr int NT = SEQ / KVBLK;
    u32x4 sv, sk0; u32x2 sk1;
    const __amdgpu_buffer_rsrc_t rsK = __builtin_amdgcn_make_buffer_rsrc((void*)Kh, (short)0, SEQ * DQK, 0x00020000), rsV = __builtin_amdgcn_make_buffer_rsrc((void*)Vt, (short)0, SEQ * DV, 0x00020000);
    const unsigned goff0 = (unsigned)tid * 16u, goff1 = (unsigned)tid * 8u + 8192u;
#define LOADK(t) do { const unsigned so_ = (unsigned)((t) < NT ? (t) : NT - 1) * 12288u; sk0 = __builtin_amdgcn_raw_buffer_load_b128(rsK, goff0, so_, 0); sk1 = __builtin_amdgcn_raw_buffer_load_b64(rsK, goff1, so_, 0); } while (0)
#define LOADV(t) do { sv = __builtin_amdgcn_raw_buffer_load_b128(rsV, goff0, (unsigned)((t) < NT ? (t) : NT - 1) * 8192u, 0); } while (0)
#define WRITEK(b) do { *(u32x4*)(K_lds + (b) * SHM_K + kst0) = sk0; *(u32x2*)(K_lds + (b) * SHM_K + kst1) = sk1; } while (0)
#define WRITEV(b) do { *(u32x4*)(V_lds + (b) * SHM_V + vst) = sv; } while (0)
#define BAR() do { SBAR(); __syncthreads(); SBAR(); } while (0)
    f32x16 p0, p1; i32x8 pa = {}; i32x8 ka[KPF][2];
    LOADK(0); WRITEK(0); LOADK(1); WRITEK(1); __syncthreads();
    LOADK(2); LOADV(0);
    kfrag_load(ka, K_lds, r32, hi);
#define CBAR(flag) do { SBAR(); asm volatile("" : "+v"(p0), "+v"(p1)); asm volatile("" : "+v"(o[0]), "+v"(o[1]), "+v"(o[2]), "+v"(o[3])); asm volatile("" : "+v"(pa)); SBAR(); if (flag) { __syncthreads(); } SBAR(); } while (0)
    const bool fB = halfB, fA = !halfB;
    mfma_seg<true, false>(p0, p1, negm, o, ka, K_lds, V_lds, qr, pa, r32, hi, [&]() { WRITEK(2); WRITEV(0); LOADK(3); LOADV(1); });
    CBAR(fB);
    softmax_seg<true>(p0, p1, negm, l_reg, o, pa, al_l, r32, hi);
    kfrag_load(ka, K_lds + SHM_K, r32, hi);
    CBAR(fA);
    int kb3 = 0, kb1 = 1, kb2 = 2;
    for (int t = 0; t < NT - 1; ++t) {
        mfma_seg<true, true>(p0, p1, negm, o, ka, K_lds + kb1 * SHM_K, V_lds + (t & 1) * SHM_V, qr, pa, r32, hi, [&]() { WRITEK(kb3); WRITEV((t + 1) & 1); LOADK(t + 4); LOADV(t + 2); });
        CBAR(fB);
        softmax_seg(p0, p1, negm, l_reg, o, pa, al_l, r32, hi);
        kfrag_load(ka, K_lds + kb2 * SHM_K, r32, hi);
        CBAR(fA);
        kb3 = (kb3 == 2) ? 0 : kb3 + 1; kb1 = (kb1 == 2) ? 0 : kb1 + 1; kb2 = (kb2 == 2) ? 0 : kb2 + 1;
    }
    mfma_seg<false, true>(p0, p1, negm, o, ka, K_lds, V_lds + ((NT - 1) & 1) * SHM_V, qr, pa, r32, hi, []() {});
#undef CBAR
    { auto rr = __builtin_amdgcn_permlane32_swap(__float_as_uint(l_reg), __float_as_uint(l_reg), false, false); l_reg = __uint_as_float(rr[0]) + __uint_as_float(rr[1]); }
    if (hi == 0) li_l[r32] = l_reg; asm volatile("s_waitcnt lgkmcnt(0)" ::: "memory");
    float rli[16];
#pragma unroll
    for (int r = 0; r < 16; ++r) rli[r] = __builtin_amdgcn_rcpf(li_l[crow(r, hi)]);
    __syncthreads();
    bf16_t* ost = (bf16_t*)(lds + wid * 8192);
#pragma unroll
    for (int r = 0; r < 16; ++r) { const int orow = crow(r, hi);
#pragma unroll
        for (int d0 = 0; d0 < 4; ++d0) ost[orow * 128 + d0 * 32 + r32] = (bf16_t)f2bf(o[d0][r] * rli[r]); }
    asm volatile("s_waitcnt lgkmcnt(0)" ::: "memory");
    bf16_t* Ow = Ob + (long)(wid * QBLK) * DM;
#pragma unroll
    for (int i = 0; i < 8; ++i) { const int ch = lane + 64 * i, row = ch >> 4, c = ch & 15;
        const u32x4 v = *(const u32x4*)((const char*)ost + row * 256 + c * 16); *(u32x4*)(Ow + (long)row * DM + c * 8) = v; }
    __syncthreads();
#undef LOADK
#undef LOADV
#undef WRITEK
#undef WRITEV
#undef BAR
}
#undef SBAR
}

struct Args { const void* in[23]; float* out; unsigned char* ws; int ph_lo, ph_hi; };
enum { I_X = 0, I_POS, I_CNW, I_CWIN, I_CK, I_CWOUT, I_MNW, I_MWDOWN, I_MQLN, I_MKVLN, I_MWQ, I_MWKV, I_MQHN, I_MKHN, I_MWO, I_FNW, I_RWG, I_RBG, I_RWE, I_RBE, I_EWG, I_EWU, I_EWD };

struct CvtItem { const float* W; bf16_t* WT; const float* ksc; int K, N, k0, n0, drow0; };
__device__ __forceinline__ unsigned char* ldptr(int i);
constexpr int CVT_PER_J = 768 + 256 + 176 + 144 + 128 + 256;
constexpr int CVT_MIX = 2 * CVT_PER_J, CVT_EXP = 4 * NE * 288, CVT_ITEMS = CVT_MIX + CVT_EXP;
__device__ __forceinline__ void cvt_decode(int it, CvtItem& c, unsigned char* ws) {
    if (it < CVT_MIX) {
        const int j = it / CVT_PER_J; int r = it - j * CVT_PER_J; int kb, nb;
        if (r < 768) { c.K = 1024; c.N = 3072; c.W = (const float*)ldptr(I_CWIN) + (size_t)j * 1024 * 3072; c.WT = (bf16_t*)(ws + WS_WIN) + (size_t)j * 3072 * 1024; c.ksc = (const float*)ldptr(I_CNW) + j * 1024;
            kb = r / 48; nb = r % 48; const int n0 = nb * 64;
            if (n0 < 1024) c.drow0 = n0; else if (n0 < 2048) { const int q = n0 - 1024; c.drow0 = 1024 + (q >> 7) * 256 + (q & 127); } else { const int q = n0 - 2048; c.drow0 = 1024 + (q >> 7) * 256 + 128 + (q & 127); } }
        else if ((r -= 768) < 256) { c.K = 1024; c.N = 1024; c.W = (const float*)ldptr(I_CWOUT) + (size_t)j * 1024 * 1024; c.WT = (bf16_t*)(ws + WS_WOUTC) + (size_t)j * 1024 * 1024; c.ksc = nullptr; kb = r / 16; nb = r % 16; c.drow0 = nb * 64; }
        else if ((r -= 256) < 176) { c.K = 1024; c.N = LAT; c.W = (const float*)ldptr(I_MWDOWN) + (size_t)j * 1024 * LAT; c.WT = (bf16_t*)(ws + WS_WDOWN) + (size_t)j * LATP * 1024; c.ksc = (const float*)ldptr(I_MNW) + j * 1024; kb = r / 11; nb = r % 11; c.drow0 = nb * 64; }
        else if ((r -= 176) < 144) { c.K = QLR; c.N = NH * DQK; c.W = (const float*)ldptr(I_MWQ) + (size_t)j * QLR * NH * DQK; c.WT = (bf16_t*)(ws + WS_WQ + (size_t)j * 1536 * 1024); c.ksc = (const float*)ldptr(I_MQLN) + j * QLR; kb = r / 24; nb = r % 24; c.drow0 = nb * 64; }
        else if ((r -= 144) < 128) { c.K = KVLR; c.N = NH * 256; c.W = (const float*)ldptr(I_MWKV) + (size_t)j * KVLR * NH * 256; c.WT = (bf16_t*)(ws + WS_WKV) + (size_t)j * 2048 * 256; c.ksc = (const float*)ldptr(I_MKVLN) + j * KVLR; kb = r / 32; nb = r % 32; c.drow0 = nb * 64; }
        else { r -= 128; c.K = 1024; c.N = 1024; c.W = (const float*)ldptr(I_MWO) + (size_t)j * 1024 * 1024; c.WT = (bf16_t*)(ws + WS_WO) + (size_t)j * 1024 * 1024; c.ksc = nullptr; kb = r / 16; nb = r % 16; c.drow0 = nb * 64; }
        c.k0 = kb * 64; c.n0 = nb * 64;
    } else {
        const int r = it - CVT_MIX; const int le = r / 288, q = r - le * 288, L = le >> 6; const int kind = q / 96, idx = q - kind * 96; int kb, nb;
        if (kind < 2) { c.K = 1024; c.N = DFF; c.W = (const float*)ldptr(kind == 0 ? I_EWG : I_EWU) + (size_t)le * 1024 * DFF; c.WT = (bf16_t*)(ws + WS_WE1) + (size_t)le * 768 * 1024; c.ksc = (const float*)ldptr(I_FNW) + L * 1024;
            kb = idx / 6; nb = idx % 6; const int n0 = nb * 64; c.drow0 = (n0 >> 7) * 256 + kind * 128 + (n0 & 127); }
        else { c.K = DFF; c.N = 1024; c.W = (const float*)ldptr(I_EWD) + (size_t)le * DFF * 1024; c.WT = (bf16_t*)(ws + WS_WE2) + (size_t)le * 1024 * DFF; c.ksc = nullptr; kb = idx / 16; nb = idx % 16; c.drow0 = nb * 64; }
        c.k0 = kb * 64; c.n0 = nb * 64;
    }
}
__device__ __forceinline__ void cvt_load(const CvtItem& c, f32x4 (&v)[16], int lane) {
    const float* p = c.W + (size_t)(c.k0 + (lane >> 4)) * c.N + c.n0 + 4 * (lane & 15);
#pragma unroll
    for (int i = 0; i < 16; ++i) v[i] = *(const f32x4*)(p + (size_t)(4 * i) * c.N);
}
__device__ __forceinline__ void cvt_lds_write(LAS float* tile, const f32x4 (&v)[16], int lane) {
#pragma unroll
    for (int i = 0; i < 16; ++i) { const int r = 4 * i + (lane >> 4), n = 4 * (lane & 15), x = r & 31; LAS float* row = tile + r * 64;
        row[(n + 0) ^ x] = v[i].x; row[(n + 1) ^ x] = v[i].y; row[(n + 2) ^ x] = v[i].z; row[(n + 3) ^ x] = v[i].w; }
}
__device__ __forceinline__ void cvt_out(const CvtItem& c, const LAS float* tile, int lane) {
    const int cc = lane & 7, np = lane >> 3;
    f32x4 s0 = {1.f, 1.f, 1.f, 1.f}, s1 = {1.f, 1.f, 1.f, 1.f};
    if (c.ksc) { s0 = *(const f32x4*)(c.ksc + c.k0 + 8 * cc); s1 = *(const f32x4*)(c.ksc + c.k0 + 8 * cc + 4); }
#pragma unroll
    for (int jj = 0; jj < 8; ++jj) { const int n = np + 8 * jj; float t[8];
#pragma unroll
        for (int q = 0; q < 8; ++q) { const int k = 8 * cc + q; t[q] = tile[k * 64 + (n ^ (k & 31))]; }
        u32x4 o; o.x = pk2(t[0] * s0.x, t[1] * s0.y); o.y = pk2(t[2] * s0.z, t[3] * s0.w); o.z = pk2(t[4] * s1.x, t[5] * s1.y); o.w = pk2(t[6] * s1.z, t[7] * s1.w);
        *(GAS u32x4*)(c.WT + (size_t)(c.drow0 + n) * c.K + c.k0 + 8 * cc) = o; }
}

constexpr int CVT_LAYER = NE * 288, CVT_W3 = 5120, CVT_WR = 3072, CVT_WG = 3072;
__host__ __device__ constexpr int cvt_layer_end(int Tl) { return CVT_MIX + (Tl + 1) * CVT_LAYER; }
__host__ __device__ constexpr int cvt_deferred(int Tl) { return CVT_WR + ((Tl & 1) ? CVT_WG : 0) + (Tl == 1 ? CVT_WR : 0) + CVT_W3; }
template <class Map>
__device__ __forceinline__ void cvt_loop(LAS unsigned char* lds, int count, int widx, int nw, int wave, int lane, Map map) {
    unsigned char* ws = ldptr(24);
    LAS float* tile = (LAS float*)(lds + wave * 16384);
    CvtItem cur, nxt; f32x4 v[16]; int it = widx;
    if (it < count) { cvt_decode(map(it), cur, ws); cvt_load(cur, v, lane); }
    while (it < count) {
        cvt_lds_write(tile, v, lane);
        const int itn = it + nw;
        if (itn < count) { cvt_decode(map(itn), nxt, ws); cvt_load(nxt, v, lane); }
        LDS_WAIT(); asm volatile("" ::: "memory");
        cvt_out(cur, tile, lane);
        LDS_WAIT(); asm volatile("" ::: "memory");
        cur = nxt; it = itn;
    }
}
__device__ __forceinline__ void cvt_window(LAS unsigned char* lds, int first, int count, int bx, int grid, int wave, int lane) {
    if (grid != 256 || bx < 128) return;
    cvt_loop(lds, count, (bx - 128) * NWAVES + wave, 128 * NWAVES, wave, lane, [first](int i) { return first + i; });
}
__device__ __forceinline__ void prologue_phase(LAS unsigned char* lds, int gw, int NGW, int wave, int lane, int gtid, int NGT, int grid) {
    unsigned char* ws = ldptr(24);
    {
        const int D1 = (grid == 256) ? cvt_deferred(1) : 0, D2 = (grid == 256) ? cvt_deferred(2) : 0, D3 = (grid == 256) ? cvt_deferred(3) : 0;
        const int s1 = cvt_layer_end(1) - D1, s2 = s1 + (cvt_layer_end(2) - D2 - cvt_layer_end(1));
        cvt_loop(lds, CVT_ITEMS - D1 - D2 - D3, gw, NGW, wave, lane, [=](int i) { return i < s1 ? i : (i < s2 ? i + D1 : i + D1 + D2); });
    }
    const float* fnw = (const float*)ldptr(I_FNW); const float* rwg = (const float*)ldptr(I_RWG); const float* rwe = (const float*)ldptr(I_RWE);
    for (int i = gtid; i < 4 * 256 * 128; i += NGT) {
        const int L = i >> 15, n = (i >> 7) & 255, k8 = (i & 127) * 8;
        u32x4 o = {0u, 0u, 0u, 0u};
        if (n < 72) { float v[8];
#pragma unroll
            for (int q = 0; q < 8; ++q) { const int k = k8 + q; const float g = fnw[L * 1024 + k];
                v[q] = g * (n < 8 ? rwg[((size_t)L * 1024 + k) * 8 + n] : rwe[((size_t)L * 1024 + k) * 64 + (n - 8)]); }
            o.x = pk2(v[0], v[1]); o.y = pk2(v[2], v[3]); o.z = pk2(v[4], v[5]); o.w = pk2(v[6], v[7]); }
        *(u32x4*)((bf16_t*)(ws + WS_WRT) + ((size_t)L * 256 + n) * 1024 + k8) = o;
    }
    for (int i = gtid; i < 2 * 64 * 128; i += NGT) { const int j = i >> 13, n = LAT + ((i >> 7) & 63), k8 = (i & 127) * 8;
        *(u32x4*)((bf16_t*)(ws + WS_WDOWN) + ((size_t)j * LATP + n) * 1024 + k8) = (u32x4){0u, 0u, 0u, 0u}; }
}

template <bool XF32_IN, bool F32_OUT>
__device__ __forceinline__ void resid_phase(const void* xin, const unsigned char* Y, void* xout, float* rinv, int gw, int NGW, int lane) {
    for (int m = gw; m < T; m += NGW) {
        f32x4 v[4];
        if constexpr (XF32_IN) { const f32x4* xr = (const f32x4*)((const float*)xin + (size_t)m * DM) + lane;
#pragma unroll
            for (int j = 0; j < 4; ++j) v[j] = xr[64 * j]; }
        else { const u32x2* xr = (const u32x2*)((const bf16_t*)xin + (size_t)m * DM) + lane;
#pragma unroll
            for (int j = 0; j < 4; ++j) { const u32x2 p = xr[64 * j]; v[j] = (f32x4){bflo(p.x), bfhi(p.x), bflo(p.y), bfhi(p.y)}; } }
        if (Y) { const unsigned* y0 = (const unsigned*)(Y + (size_t)(2 * m) * DM) + lane; const unsigned* y1 = y0 + 256;
#pragma unroll
            for (int j = 0; j < 4; ++j) { float p[4], q[4]; up4_fp8(y0[64 * j], p); up4_fp8(y1[64 * j], q);
                v[j].x += (p[0] + q[0]) * 0.0625f; v[j].y += (p[1] + q[1]) * 0.0625f; v[j].z += (p[2] + q[2]) * 0.0625f; v[j].w += (p[3] + q[3]) * 0.0625f; } }
        if constexpr (F32_OUT) { f32x4* xo = (f32x4*)((float*)xout + (size_t)m * DM) + lane;
#pragma unroll
            for (int j = 0; j < 4; ++j) xo[64 * j] = v[j]; }
        else { u32x2* xo = (u32x2*)((bf16_t*)xout + (size_t)m * DM) + lane;
#pragma unroll
            for (int j = 0; j < 4; ++j) { u32x2 w; w.x = pk2(v[j].x, v[j].y); w.y = pk2(v[j].z, v[j].w); xo[64 * j] = w; } }
        if (rinv) { float s = 0.f;
#pragma unroll
            for (int j = 0; j < 4; ++j) s += (v[j].x * v[j].x + v[j].y * v[j].y) + (v[j].z * v[j].z + v[j].w * v[j].w);
            const float r = 1.0f / sqrtf(wave_sum(s, lane) * (1.f / DM) + EPS);
            if (lane == 0) rinv[m] = r; }
    }
}

__device__ __forceinline__ void conv_phase(const bf16_t* GBp, const bf16_t* Zp, const float* ck, bf16_t* YCp, int gtid, int NGT) {
    for (int i = gtid; i < T * 128; i += NGT) {
        const int t = i >> 7, c8 = (i & 127) * 8, s = t & (SEQ - 1);
        const u32x4 zc = *(const u32x4*)(Zp + (size_t)t * DM + c8), g = *(const u32x4*)(GBp + (size_t)t * DM + c8);
        u32x4 zm = {0u, 0u, 0u, 0u}, zp = {0u, 0u, 0u, 0u};
        if (s > 0) zm = *(const u32x4*)(Zp + (size_t)(t - 1) * DM + c8);
        if (s < SEQ - 1) zp = *(const u32x4*)(Zp + (size_t)(t + 1) * DM + c8);
        const f32x4 k0a = *(const f32x4*)(ck + c8), k0b = *(const f32x4*)(ck + c8 + 4), k1a = *(const f32x4*)(ck + DM + c8), k1b = *(const f32x4*)(ck + DM + c8 + 4), k2a = *(const f32x4*)(ck + 2 * DM + c8), k2b = *(const f32x4*)(ck + 2 * DM + c8 + 4);
        float y[8];
#define CV(q, W, KA, LOHI) y[q] = LOHI(g.W) * (LOHI(zm.W) * k0##KA + LOHI(zc.W) * k1##KA + LOHI(zp.W) * k2##KA)
        CV(0, x, a[0], bflo); CV(1, x, a[1], bfhi); CV(2, y, a[2], bflo); CV(3, y, a[3], bfhi); CV(4, z, b[0], bflo); CV(5, z, b[1], bfhi); CV(6, w, b[2], bflo); CV(7, w, b[3], bfhi);
#undef CV
        u32x4 o; o.x = pk2(y[0], y[1]); o.y = pk2(y[2], y[3]); o.z = pk2(y[4], y[5]); o.w = pk2(y[6], y[7]);
        *(u32x4*)(YCp + (size_t)t * DM + c8) = o;
    }
}


__device__ __forceinline__ void ld16bf(const bf16_t* p, float* v) { const u32x4 a = *(const u32x4*)p, b = *(const u32x4*)(p + 8);
    v[0] = bflo(a.x); v[1] = bfhi(a.x); v[2] = bflo(a.y); v[3] = bfhi(a.y); v[4] = bflo(a.z); v[5] = bfhi(a.z); v[6] = bflo(a.w); v[7] = bfhi(a.w);
    v[8] = bflo(b.x); v[9] = bfhi(b.x); v[10] = bflo(b.y); v[11] = bfhi(b.y); v[12] = bflo(b.z); v[13] = bfhi(b.z); v[14] = bflo(b.w); v[15] = bfhi(b.w); }
__device__ __forceinline__ void ld16f8(const unsigned char* p, float* v) { const u32x4 a = *(const u32x4*)p; up4_fp8(a.x, v); up4_fp8(a.y, v + 4); up4_fp8(a.z, v + 8); up4_fp8(a.w, v + 12); }
__device__ __forceinline__ void ld4f8(const unsigned char* p, float* v) { up4_fp8(*(const unsigned*)p, v); }
__device__ __forceinline__ void ld4bf(const bf16_t* p, float* v) { const u32x2 a = *(const u32x2*)p; v[0] = bflo(a.x); v[1] = bfhi(a.x); v[2] = bflo(a.y); v[3] = bfhi(a.y); }
constexpr int QK_VP = 1040;
struct QkIn { u32x4 l0, l1, q16, k16, v16; u32x2 ra, rb; unsigned qa, qb; int pos; };
__device__ __forceinline__ void qk_load(QkIn& in, int t, const bf16_t* LATb, const unsigned char* QRAW, const unsigned char* KVRAW, const int* pos, int lane) {
    const int h = lane >> 3, i8 = lane & 7;
    const u32x4* ls = (const u32x4*)(LATb + (size_t)t * LATP);
    in.l0 = ls[lane]; in.l1 = (u32x4){0u, 0u, 0u, 0u}; if (lane < 24) in.l1 = ls[lane + 64];
    const unsigned char* qh = QRAW + (size_t)t * 1536 + h * DQK;
    in.q16 = *(const u32x4*)(qh + 16 * i8); in.qa = *(const unsigned*)(qh + 128 + 4 * i8); in.qb = *(const unsigned*)(qh + 160 + 4 * i8);
    const unsigned char* kh = KVRAW + (size_t)t * 2048 + h * 256;
    in.k16 = *(const u32x4*)(kh + 16 * i8); in.v16 = *(const u32x4*)(kh + 128 + 16 * i8);
    const bf16_t* lr = LATb + (size_t)t * LATP + 640;
    in.ra = *(const u32x2*)(lr + 4 * i8); in.rb = *(const u32x2*)(lr + 32 + 4 * i8);
    in.pos = pos[t];
}
__device__ __forceinline__ void up16_fp8(const u32x4 a, float* v) { up4_fp8(a.x, v); up4_fp8(a.y, v + 4); up4_fp8(a.z, v + 8); up4_fp8(a.w, v + 12); }
__device__ __forceinline__ void up4_bf(const u32x2 a, float* v) { v[0] = bflo(a.x); v[1] = bfhi(a.x); v[2] = bflo(a.y); v[3] = bfhi(a.y); }
__device__ __forceinline__ void qkprep8_phase(const bf16_t* LATb, const unsigned char* QRAW, const unsigned char* KVRAW, const int* pos, const float* qhn, const float* khn,
                                              unsigned char* Q8, unsigned char* K8, unsigned char* VT8, LAS unsigned char* lds, int vcu, int G, int wave, int lane, int tid) {
    const int h = lane >> 3, i8 = lane & 7;
    float gq[24], gk[24], invf[4];
#pragma unroll
    for (int q = 0; q < 16; ++q) { gq[q] = qhn[16 * i8 + q]; gk[q] = khn[16 * i8 + q]; }
#pragma unroll
    for (int q = 0; q < 4; ++q) { gq[16 + q] = qhn[128 + 4 * i8 + q]; gq[20 + q] = qhn[160 + 4 * i8 + q]; gk[16 + q] = khn[128 + 4 * i8 + q]; gk[20 + q] = khn[160 + 4 * i8 + q];
        invf[q] = powf(10000.f, -(float)(4 * i8 + q) * (1.f / 32.f)); }
    QkIn cur, nxt;
    if (vcu < T / 64) qk_load(cur, vcu * 64 + wave * 8, LATb, QRAW, KVRAW, pos, lane);
    for (int tile = vcu; tile < T / 64; tile += G) {
        for (int tt = 0; tt < 8; ++tt) {
            const int kk = wave * 8 + tt, t = tile * 64 + kk, b = t >> 14, s = t & (SEQ - 1);
            { const int tn = (tt < 7) ? t + 1 : (tile + G) * 64 + wave * 8; if (tn < T) qk_load(nxt, tn, LATb, QRAW, KVRAW, pos, lane); }
            const u32x4 l0 = cur.l0, l1 = cur.l1;
#define SS4(V_) (bflo(V_.x) * bflo(V_.x) + bfhi(V_.x) * bfhi(V_.x) + bflo(V_.y) * bflo(V_.y) + bfhi(V_.y) * bfhi(V_.y) + bflo(V_.z) * bflo(V_.z) + bfhi(V_.z) * bfhi(V_.z) + bflo(V_.w) * bflo(V_.w) + bfhi(V_.w) * bfhi(V_.w))
            const float s0 = SS4(l0), s1 = SS4(l1);
#undef SS4
            const float ssq_q = wave_sum(lane < 48 ? s0 : 0.f, lane), ssq_kv = wave_sum((lane >= 48 ? s0 : 0.f) + (lane < 16 ? s1 : 0.f), lane);
            const float r_q = __builtin_amdgcn_rsqf(ssq_q * (1.f / QLR) + EPS), r_kv = __builtin_amdgcn_rsqf(ssq_kv * (1.f / KVLR) + EPS);
            float cj[4], sj[4]; const float fpos = (float)cur.pos;
#pragma unroll
            for (int q = 0; q < 4; ++q) { const float ang = fpos * invf[q]; const double rev = (double)ang * 0.15915494309189535; const float fr = (float)(rev - floor(rev));
                cj[q] = __builtin_amdgcn_cosf(fr); sj[q] = __builtin_amdgcn_sinf(fr); }
            const size_t orow = ((size_t)(b * NH + h) * SEQ + s) * DQK;
            {
                float v[24];
                up16_fp8(cur.q16, v); up4_fp8(cur.qa, v + 16); up4_fp8(cur.qb, v + 20);
                float ss = 0.f;
#pragma unroll
                for (int q = 0; q < 24; ++q) ss += v[q] * v[q];
                ss += lane_xor_f(ss, 1, lane); ss += lane_xor_f(ss, 2, lane); ss += lane_xor_f(ss, 4, lane);
                const float sc = r_q * __builtin_amdgcn_rsqf(r_q * r_q * ss * (1.f / DQK) + EPS) * (8.f * 0.07216878364870322f * 1.4426950408889634f);
#pragma unroll
                for (int q = 0; q < 24; ++q) v[q] *= sc * gq[q];
                u32x4 w; w.x = pk4_fp8(v[0], v[1], v[2], v[3]); w.y = pk4_fp8(v[4], v[5], v[6], v[7]); w.z = pk4_fp8(v[8], v[9], v[10], v[11]); w.w = pk4_fp8(v[12], v[13], v[14], v[15]);
                *(u32x4*)(Q8 + orow + 16 * i8) = w;
                float o1[4], o2[4];
#pragma unroll
                for (int q = 0; q < 4; ++q) { o1[q] = v[16 + q] * cj[q] - v[20 + q] * sj[q]; o2[q] = v[20 + q] * cj[q] + v[16 + q] * sj[q]; }
                *(unsigned*)(Q8 + orow + 128 + 4 * i8) = pk4_fp8(o1[0], o1[1], o1[2], o1[3]); *(unsigned*)(Q8 + orow + 160 + 4 * i8) = pk4_fp8(o2[0], o2[1], o2[2], o2[3]); }
            {
                float v[24], vv[16];
                up16_fp8(cur.k16, v); up4_bf(cur.ra, v + 16); up4_bf(cur.rb, v + 20); up16_fp8(cur.v16, vv);
#pragma unroll
                for (int q = 0; q < 16; ++q) v[q] *= r_kv;
                float ss = 0.f;
#pragma unroll
                for (int q = 0; q < 24; ++q) ss += v[q] * v[q];
                ss += lane_xor_f(ss, 1, lane); ss += lane_xor_f(ss, 2, lane); ss += lane_xor_f(ss, 4, lane);
                const float sc = __builtin_amdgcn_rsqf(ss * (1.f / DQK) + EPS);
#pragma unroll
                for (int q = 0; q < 24; ++q) v[q] *= sc * gk[q];
                u32x4 w; w.x = pk4_fp8(v[0], v[1], v[2], v[3]); w.y = pk4_fp8(v[4], v[5], v[6], v[7]); w.z = pk4_fp8(v[8], v[9], v[10], v[11]); w.w = pk4_fp8(v[12], v[13], v[14], v[15]);
                *(u32x4*)(K8 + orow + 16 * i8) = w;
                float o1[4], o2[4];
#pragma unroll
                for (int q = 0; q < 4; ++q) { o1[q] = v[16 + q] * cj[q] - v[20 + q] * sj[q]; o2[q] = v[20 + q] * cj[q] + v[16 + q] * sj[q]; }
                *(unsigned*)(K8 + orow + 128 + 4 * i8) = pk4_fp8(o1[0], o1[1], o1[2], o1[3]); *(unsigned*)(K8 + orow + 160 + 4 * i8) = pk4_fp8(o2[0], o2[1], o2[2], o2[3]);
                u32x4 wv; wv.x = pk4_fp8(vv[0] * r_kv, vv[1] * r_kv, vv[2] * r_kv, vv[3] * r_kv); wv.y = pk4_fp8(vv[4] * r_kv, vv[5] * r_kv, vv[6] * r_kv, vv[7] * r_kv);
                wv.z = pk4_fp8(vv[8] * r_kv, vv[9] * r_kv, vv[10] * r_kv, vv[11] * r_kv); wv.w = pk4_fp8(vv[12] * r_kv, vv[13] * r_kv, vv[14] * r_kv, vv[15] * r_kv);
                *(LAS u32x4*)(lds + kk * QK_VP + h * 128 + 16 * i8) = wv; }
            cur = nxt;
        }
        __syncthreads();
        {
            const int t0 = tile * 64, b = t0 >> 14, st = (t0 & (SEQ - 1)) >> 6;
#pragma unroll
            for (int it = 0; it < 2; ++it) { const int item = tid + 512 * it, c = item & 3, n4 = (item >> 2) & 31, hh = item >> 7;
                const LAS unsigned char* src = lds + hh * 128 + n4 * 4; unsigned o[4][4];
#pragma unroll
                for (int j = 0; j < 4; ++j) { const int kb = 32 * (c & 1) + 8 * j + 4 * (c >> 1);
                    const unsigned d0 = *(const LAS unsigned*)(src + (kb + 0) * QK_VP), d1 = *(const LAS unsigned*)(src + (kb + 1) * QK_VP), d2 = *(const LAS unsigned*)(src + (kb + 2) * QK_VP), d3 = *(const LAS unsigned*)(src + (kb + 3) * QK_VP);
                    const unsigned t0_ = __builtin_amdgcn_perm(d1, d0, 0x05010400u), t1_ = __builtin_amdgcn_perm(d1, d0, 0x07030602u), t2_ = __builtin_amdgcn_perm(d3, d2, 0x05010400u), t3_ = __builtin_amdgcn_perm(d3, d2, 0x07030602u);
                    o[0][j] = __builtin_amdgcn_perm(t2_, t0_, 0x05040100u); o[1][j] = __builtin_amdgcn_perm(t2_, t0_, 0x07060302u); o[2][j] = __builtin_amdgcn_perm(t3_, t1_, 0x05040100u); o[3][j] = __builtin_amdgcn_perm(t3_, t1_, 0x07060302u); }
                unsigned char* dst = VT8 + ((size_t)(b * NH + hh) * (SEQ / 64) + st) * 8192 + (4 * n4) * 64 + 16 * c;
#pragma unroll
                for (int r = 0; r < 4; ++r) *(u32x4*)(dst + r * 64) = (u32x4){o[r][0], o[r][1], o[r][2], o[r][3]}; } }
        __syncthreads();
    }
}

__device__ __forceinline__ int build_tables(gu32* cnt, LAS int* tbl, LAS int* cntl, int tid) {
    if (tid < 64) {
        const int c = (int)__hip_atomic_load(cnt + 32 * tid, RLX_AGENT); const int nt = (c + 255) >> 8;
        int incl = nt;
#pragma unroll
        for (int o = 1; o < 64; o <<= 1) { const int v = __builtin_amdgcn_ds_bpermute((tid - o) << 2, incl); if (tid >= o) incl += v; }
        const int start = incl - nt; cntl[tid] = c; if (tid == 63) cntl[64] = incl;
        for (int q = 0; q < nt; ++q) tbl[start + q] = (tid << 16) | q;
    }
    __syncthreads();
    return cntl[64];
}

constexpr int PTAB_OFF = MISC_OFF + 128;
__device__ __forceinline__ unsigned char* ldptr(int i) {
    extern __shared__ __attribute__((aligned(16))) unsigned char lds_raw[];
    volatile LAS unsigned* pt = (volatile LAS unsigned*)((LAS unsigned char*)lds_raw + PTAB_OFF) + 2 * sgpr_now(i);
    const unsigned lo = __builtin_amdgcn_readfirstlane(pt[0]), hi = __builtin_amdgcn_readfirstlane(pt[1]);
    return (unsigned char*)(GAS unsigned char*)(((unsigned long long)hi << 32) | lo);
}
#define P_IN(i) ((const float*)ldptr(i))
#define P_OUT() ((float*)ldptr(23))
#define P_WS() (ldptr(24))
__device__ __forceinline__ void grid_barrier(int tid) {
    extern __shared__ __attribute__((aligned(16))) unsigned char lds_raw[];
    XcdBarrier b; b.bar = (unsigned*)(P_WS() + WS_CTL) + CW_BAR; b.x = xb_xcc_id(); b.st = (volatile LAS unsigned*)((LAS unsigned char*)lds_raw + MISC_OFF) + 8;
    xcd_barrier(b, tid == 0);
}

#define IN(k) (lo <= (k) && (k) < hi)
#define SEAM(k) do { if (hi > (k) + 1) grid_barrier(TID); } while (0)
#define TID (tid_now(wave_s))
#define LANE (tid_now(wave_s) & 63)
#define WAVE (sgpr_now(wave_s))
#define GRID (sgpr_now((int)gridDim.x))
#define BX (sgpr_now((int)blockIdx.x))
#define VCU ((GRID % 8 == 0) ? (BX % 8) * (GRID / 8) + BX / 8 : BX)
#define GW (VCU * NWAVES + WAVE)
#define NGW (GRID * NWAVES)
#define GTID (BX * (NWAVES * 64) + TID)
#define NGT (GRID * NWAVES * 64)
#define TBL ((LAS int*)(lds + TBL_OFF))
#define PSTART (TBL + 384)


template <int L>
__device__ __forceinline__ void layer_body(LAS unsigned char* lds, const int lo, const int hi, const int wave_s) {
    extern __shared__ __attribute__((aligned(16))) unsigned char lds_raw[];
        const int pb = 1 + 12 * L;
#define XBP ((bf16_t*)(ws + WS_XB))
#define RINVP ((float*)(ws + WS_RINV))
#define PSQP ((float*)(ws + WS_PSQ))
#define YP ((const unsigned char*)(ws + WS_Y))
        if (IN(pb + 0)) { unsigned char* ws = P_WS();
            if (L == 0) resid_phase<true, false>(P_IN(I_X), nullptr, XBP, RINVP, GW, NGW, LANE);
            else resid_phase<false, false>(XBP, YP, XBP, RINVP, GW, NGW, LANE);
            SEAM(pb + 0); }
        if ((L & 1) == 0) {
            if (IN(pb + 1)) { unsigned char* ws = P_WS(); const int j = L >> 1;
                pg8::Gemm g{DM, DM, nullptr}; pg8::StaticOrder S; S.init(ws + WS_XB, DM, (bf16_t*)(ws + WS_WIN) + (size_t)j * 3072 * 1024, DM, T, 3072, GRID, BX);
                pg8::EpiConvIn E{(bf16_t*)(ws + WS_GB), (bf16_t*)(ws + WS_Z), RINVP}; pg8::gemm_phase(lds, g, S, E, TID); SEAM(pb + 1); }
            if (IN(pb + 2)) { unsigned char* ws = P_WS(); const int j = L >> 1;
                conv_phase((const bf16_t*)(ws + WS_GB), (const bf16_t*)(ws + WS_Z), P_IN(I_CK) + j * 3 * DM, (bf16_t*)(ws + WS_YC), GTID, NGT); SEAM(pb + 2); }
            if (IN(pb + 3)) { unsigned char* ws = P_WS(); const int j = L >> 1;
                pg8::Gemm g{DM, DM, nullptr}; pg8::StaticOrder S; S.init(ws + WS_YC, DM, (bf16_t*)(ws + WS_WOUTC) + (size_t)j * 1024 * 1024, DM, T, DM, GRID, BX);
                pg8::EpiResid E{XBP, PSQP, LANE}; pg8::gemm_phase(lds, g, S, E, TID); SEAM(pb + 5); }
        } else {
            if (IN(pb + 1)) { unsigned char* ws = P_WS(); const int j = L >> 1;
                pg8::Gemm g{DM, DM, nullptr}; pg8::StaticOrder S; S.init(ws + WS_XB, DM, (bf16_t*)(ws + WS_WDOWN) + (size_t)j * LATP * 1024, DM, T, LATP, GRID, BX);
                pg8::EpiBf16 E{(bf16_t*)(ws + WS_LAT), LATP, RINVP}; pg8::gemm_phase(lds, g, S, E, TID);
                cvt_window(lds, cvt_layer_end(L) - CVT_WR - CVT_WG, CVT_WG, BX, GRID, WAVE, LANE);
                SEAM(pb + 1); }
            if (IN(pb + 2)) {
                { unsigned char* ws = P_WS(); const int j = L >> 1;
                  pg8::Gemm g{LATP, QLR, nullptr}; pg8::StaticOrder S; S.init(ws + WS_LAT, LATP, ws + WS_WQ + (size_t)j * 1536 * 1024, QLR, T, 1536, GRID, BX);
                  pg8::EpiFp8 E{ws + WS_QRAW, 1536}; pg8::gemm_phase(lds, g, S, E, TID); }
                { unsigned char* ws = P_WS(); const int j = L >> 1;
                  pg8::Gemm g{LATP, KVLR, nullptr}; pg8::StaticOrder S; S.init((bf16_t*)(ws + WS_LAT) + QLR, LATP, (bf16_t*)(ws + WS_WKV) + (size_t)j * 2048 * 256, KVLR, T, 2048, GRID, BX);
                  pg8::EpiFp8 E{ws + WS_KVRAW, 2048}; pg8::gemm_phase(lds, g, S, E, TID); }
                SEAM(pb + 2); }
            if (IN(pb + 3)) { unsigned char* ws = P_WS(); const int j = L >> 1;
                qkprep8_phase((const bf16_t*)(ws + WS_LAT), ws + WS_QRAW, ws + WS_KVRAW, (const int*)P_IN(I_POS),
                              P_IN(I_MQHN) + j * DQK, P_IN(I_MKHN) + j * DQK, ws + WS_Q, ws + WS_K, ws + WS_V, lds, VCU, GRID, WAVE, LANE, TID); SEAM(pb + 3); }
            if (IN(pb + 4)) {
                for (int i = 0;; ++i) {
                    int bh, qb;
                    if (GRID == 256) { if (i >= 4) break; const int idx = i * 32 + (VCU & 31); bh = 2 * (VCU >> 5) + (idx >> 6); qb = idx & 63; }
                    else { const int k = i * GRID + BX; if (k >= NB * NH * 64) break; bh = k >> 6; qb = k & 63; }
                    const int b = bh >> 3, h = bh & 7; unsigned char* ws = P_WS();
                    att8::attn_unit_pp(ws + WS_Q + ((size_t)bh * SEQ + qb * 256) * DQK, ws + WS_K + (size_t)bh * SEQ * DQK, ws + WS_V + (size_t)bh * SEQ * DV,
                                       (bf16_t*)(ws + WS_O) + ((size_t)(b * SEQ + qb * 256)) * DM + h * DV, (char*)lds_raw, TID);
                }
                SEAM(pb + 4); }
            if (IN(pb + 5)) { unsigned char* ws = P_WS(); const int j = L >> 1;
                pg8::Gemm g{DM, DM, nullptr}; pg8::StaticOrder S; S.init(ws + WS_O, DM, (bf16_t*)(ws + WS_WO) + (size_t)j * 1024 * 1024, DM, T, DM, GRID, BX);
                pg8::EpiResid E{XBP, PSQP, LANE}; pg8::gemm_phase(lds, g, S, E, TID); SEAM(pb + 5); }
        }
#define CNT ((gu32*)(ws + WS_CTL) + CW_CNT + L * 64 * 32)
        if (IN(pb + 7)) { unsigned char* ws = P_WS();
            pg8::Gemm g{DM, DM, nullptr}; pg8::StaticOrder S; S.init(ws + WS_XB, DM, (bf16_t*)(ws + WS_WRT) + (size_t)L * 256 * 1024, DM, T, 256, GRID, BX);
            { pg8::Unit u0; const int t_ = TID;
              if (S.next(0, u0) && t_ < 256) { const f32x4* q = (const f32x4*)(PSQP + (size_t)(u0.pm * 256 + t_) * 16); const f32x4 a = q[0], b = q[1], c = q[2], d = q[3];
                  const float ssum = ((a.x + a.y) + (a.z + a.w)) + ((b.x + b.y) + (b.z + b.w)) + ((c.x + c.y) + (c.z + c.w)) + ((d.x + d.y) + (d.z + d.w));
                  RINVP[u0.pm * 256 + t_] = 1.0f / sqrtf(ssum * (1.f / DM) + EPS); }
              VM_WAIT(); __syncthreads(); }
            pg8::EpiRoute E{RINVP, P_IN(I_RBG) + L * 8, P_IN(I_RBE) + L * 64, CNT, (int*)(ws + WS_SA), (float*)(ws + WS_SG), (float*)(ws + WS_SS)};
            pg8::gemm_phase<false, true>(lds, g, S, E, TID);
            cvt_window(lds, cvt_layer_end(L == 0 ? 1 : L) - (L == 0 ? 2 * CVT_WR + CVT_WG : CVT_WR), CVT_WR, BX, GRID, WAVE, LANE);
            SEAM(pb + 9); }
        if (IN(pb + 10)) { unsigned char* ws = P_WS(); const int ntiles = build_tables(CNT, TBL, PSTART, TID);
            pg8::Gemm g{DM, DM, (const int*)(ws + WS_SA)}; pg8::GroupedOrder S{ntiles * 3, 3, GRID, VCU, (const char*)(ws + WS_XB), (const char*)(ws + WS_WE1) + (size_t)L * NE * 768 * 1024 * 2, (size_t)0, (size_t)768 * 1024 * 2, (size_t)256 * 1024 * 2, TBL, PSTART};
            pg8::EpiSwiGLU E{(bf16_t*)(ws + WS_HID), (const float*)(ws + WS_SS)}; pg8::gemm_phase<true, false>(lds, g, S, E, TID);
            if (L < 3 && GRID == 256) {
                const int n_units = ntiles * 3, rounds = (n_units + 255) >> 8, nidle = rounds * 256 - n_units, first = cvt_layer_end(L + 1) - cvt_deferred(L + 1);
                if (nidle >= 32) { const int j = (rounds - 1) * 256 + VCU - n_units; if (j >= 0) cvt_loop(lds, CVT_W3, j * NWAVES + WAVE, nidle * NWAVES, WAVE, LANE, [first](int i) { return first + i; }); }
                else cvt_loop(lds, CVT_W3, VCU * NWAVES + WAVE, 256 * NWAVES, WAVE, LANE, [first](int i) { return first + i; });
            }
            SEAM(pb + 10); }
        if (IN(pb + 11)) { unsigned char* ws = P_WS(); const int ntiles = build_tables(CNT, TBL, PSTART, TID);
            pg8::Gemm g{DFF, DFF, nullptr}; pg8::GroupedOrder S{ntiles * 4, 4, GRID, VCU, (const char*)(ws + WS_HID), (const char*)(ws + WS_WE2) + (size_t)L * NE * 1024 * DFF * 2, (size_t)256 * DFF * 2, (size_t)1024 * DFF * 2, (size_t)256 * DFF * 2, TBL, PSTART};
            pg8::EpiScatterY E{ws + WS_Y, (const int*)(ws + WS_SA), (const float*)(ws + WS_SG)}; pg8::gemm_phase(lds, g, S, E, TID); SEAM(pb + 11); }
    }

__global__ void __launch_bounds__(NWAVES * 64, 2) fwd(Args args) {
    extern __shared__ __attribute__((aligned(16))) unsigned char lds_raw[];
    LAS unsigned char* lds = (LAS unsigned char*)lds_raw;
    for (int u = threadIdx.x; u < (LDS_BYTES - LDSCTL_OFF) / 4; u += NWAVES * 64) ((LAS unsigned*)(lds + LDSCTL_OFF))[u] = 0u;
    __syncthreads();
    if (threadIdx.x == 0) { LAS unsigned long long* pt = (LAS unsigned long long*)(lds + PTAB_OFF);
#pragma unroll
        for (int i = 0; i < 23; ++i) pt[i] = (unsigned long long)args.in[i];
        pt[23] = (unsigned long long)args.out; pt[24] = (unsigned long long)args.ws; }
    __syncthreads();
    const int lo = args.ph_lo, hi = args.ph_hi;
    if (hi - lo > 1) (void)xcd_barrier_post((unsigned*)(P_WS() + WS_CTL) + CW_BAR, (volatile LAS unsigned*)(lds + MISC_OFF) + 8, threadIdx.x == 0);
    const int wave_s = __builtin_amdgcn_readfirstlane((int)threadIdx.x >> 6);
    if (IN(0)) { prologue_phase(lds, GW, NGW, WAVE, LANE, GTID, NGT, GRID); SEAM(0); }

    layer_body<0>(lds, lo, hi, wave_s); layer_body<1>(lds, lo, hi, wave_s); layer_body<2>(lds, lo, hi, wave_s); layer_body<3>(lds, lo, hi, wave_s);
    if (IN(49)) { unsigned char* ws = P_WS(); resid_phase<false, true>(XBP, YP, P_OUT(), nullptr, GW, NGW, LANE);
    }
#undef IN
#undef SEAM
}

extern "C" void kernel_launch(void* const* d_in, const int* in_sizes, int n_in, void* d_out, int out_size, void* d_ws, size_t ws_size, hipStream_t stream) {
    static int grid = 0;
    if (grid == 0) {
        if (n_in != 23 || out_size != T * DM || ws_size < WS_END) { fprintf(stderr, "kernel_launch: unexpected shapes: n_in %d out %d ws %zu (need %zu)\n", n_in, out_size, ws_size, (size_t)WS_END); grid = -1; return; }
        int dev = 0, cus = 0, per_cu = 0;
        if (hipGetDevice(&dev) != hipSuccess || hipDeviceGetAttribute(&cus, hipDeviceAttributeMultiprocessorCount, dev) != hipSuccess) { grid = -1; return; }
        if (hipFuncSetAttribute((const void*)fwd, hipFuncAttributeMaxDynamicSharedMemorySize, LDS_BYTES) != hipSuccess) { fprintf(stderr, "kernel_launch: hipFuncSetAttribute failed\n"); grid = -1; return; }
        if (hipOccupancyMaxActiveBlocksPerMultiprocessor(&per_cu, (const void*)fwd, NWAVES * 64, LDS_BYTES) != hipSuccess || per_cu < 1) fprintf(stderr, "kernel_launch: occupancy query says %d\n", per_cu);
        (void)hipGetLastError();
        grid = cus;
    }
    if (grid < 0) return;
    if (hipMemsetAsync((char*)d_ws + WS_CTL, 0, CTL_ZERO_BYTES, stream) != hipSuccess) return;
    Args a{};
    for (int i = 0; i < 23; ++i) a.in[i] = d_in[i];
    a.out = (float*)d_out; a.ws = (unsigned char*)d_ws;
#if MK_ONE_LAUNCH
    a.ph_lo = 0; a.ph_hi = 50;
    hipLaunchKernelGGL(fwd, dim3(grid), dim3(NWAVES * 64), LDS_BYTES, stream, a);
#else
    for (int p = 0; p < 50; ++p) {
        if (p >= 1 && p < 49) { const int L = (p - 1) / 12, k = (p - 1) % 12;
            if (k == 6 || k == 8 || k == 9) continue;
            if (k < 6 && (L & 1) == 0 && k > 3) continue;
        }
        a.ph_lo = p; a.ph_hi = p + 1;
        hipLaunchKernelGGL(fwd, dim3(grid), dim3(NWAVES * 64), LDS_BYTES, stream, a);
    }
#endif
    const hipError_t le = hipPeekAtLastError();
    if (le != hipSuccess) fprintf(stderr, "kernel_launch: launch failed: %s\n", hipGetErrorName(le));
}
```

```cpp
#include <hip/hip_runtime.h>
#include <cstdio>
#include <cstdint>

#ifndef MK_ONE_LAUNCH
#define MK_ONE_LAUNCH 1
#endif

#define GAS __attribute__((address_space(1)))
#define LAS __attribute__((address_space(3)))
typedef unsigned short bf16_t;
typedef short bf16x8 __attribute__((ext_vector_type(8)));
typedef short s16x4 __attribute__((ext_vector_type(4)));
typedef float f32x2 __attribute__((ext_vector_type(2)));
typedef float f32x4 __attribute__((ext_vector_type(4)));
typedef float f32x16 __attribute__((ext_vector_type(16)));
typedef unsigned u32x2 __attribute__((ext_vector_type(2)));
typedef unsigned u32x4 __attribute__((ext_vector_type(4)));
typedef GAS unsigned gu32;

constexpr int DM = 1024, NB = 2, SEQ = 16384, T = NB * SEQ;
constexpr int NH = 8, QLR = 384, KVLR = 256, DNOPE = 128, DROPE = 64, DQK = 192, DV = 128, LAT = 704, LATP = 768;
constexpr int NE = 64, DFF = 384;
constexpr int NASSIGN = 2 * T;
constexpr int NSLOT = NASSIGN + NE * 256;
constexpr float EPS = 1e-6f;
constexpr int NWAVES = 8;

constexpr size_t MiB = 1u << 20;
constexpr size_t WS_CTL = 0, CTL_ZERO_BYTES = 1 * MiB;
constexpr size_t WS_WIN = 2 * MiB;
constexpr size_t WS_WOUTC = 14 * MiB;
constexpr size_t WS_WDOWN = 18 * MiB;
constexpr size_t WS_WQ = 21 * MiB;
constexpr size_t WS_WKV = 24 * MiB;
constexpr size_t WS_WO = 26 * MiB;
constexpr size_t WS_WRT = 30 * MiB;
constexpr size_t WS_WE1 = 32 * MiB;
constexpr size_t WS_WE2 = 416 * MiB;
constexpr size_t WS_XB = 608 * MiB;
constexpr size_t WS_RINV = 1202 * MiB;
constexpr size_t WS_PSQ = 1200 * MiB;
constexpr size_t WS_S = 672 * MiB;
constexpr size_t WS_GB = WS_S, WS_Z = WS_S + 64 * MiB, WS_YC = WS_S + 128 * MiB;
constexpr size_t WS_LAT = WS_S, WS_QRAW = WS_S + 48 * MiB, WS_KVRAW = WS_S + 144 * MiB;
constexpr size_t WS_Q = WS_S + 272 * MiB, WS_K = WS_S + 368 * MiB, WS_V = WS_S + 464 * MiB, WS_O = WS_QRAW;
constexpr size_t WS_HID = WS_S + 160 * MiB, WS_Y = WS_S + 224 * MiB;
constexpr size_t WS_SA = WS_S + 352 * MiB, WS_SG = WS_S + 360 * MiB, WS_SS = WS_S + 368 * MiB;
constexpr size_t WS_END = WS_S + 531 * MiB;
constexpr int CW_BAR = 4096  , CW_CNT = 8192  ;

constexpr int RING_BYTES = 131072;
constexpr int LDSCTL_OFF = RING_BYTES, MISC_OFF = LDSCTL_OFF + 320;
constexpr int TBL_OFF = LDSCTL_OFF + 1024;
constexpr int LDS_BYTES = 147456;

#define RLX_AGENT __ATOMIC_RELAXED, __HIP_MEMORY_SCOPE_AGENT
#define LDS_WAIT() asm volatile("s_waitcnt lgkmcnt(0)" ::: "memory")
#define VM_WAIT() asm volatile("s_waitcnt vmcnt(0)" ::: "memory")
__device__ __forceinline__ unsigned f2bf(float f) { unsigned u = __builtin_bit_cast(unsigned, f); return (u + 0x7fffu + ((u >> 16) & 1u)) >> 16; }
__device__ __forceinline__ unsigned pk2(float lo, float hi) { unsigned r; asm("v_cvt_pk_bf16_f32 %0, %1, %2" : "=v"(r) : "v"(lo), "v"(hi)); return r; }
__device__ __forceinline__ float bflo(unsigned w) { return __builtin_bit_cast(float, w << 16); }
__device__ __forceinline__ float bfhi(unsigned w) { return __builtin_bit_cast(float, w & 0xffff0000u); }
__device__ __forceinline__ float bf2f(bf16_t h) { return __builtin_bit_cast(float, (unsigned)h << 16); }
__device__ __forceinline__ unsigned cvt_pk_bf16(float lo, float hi) { unsigned r; asm volatile("v_cvt_pk_bf16_f32 %0, %1, %2" : "=v"(r) : "v"(lo), "v"(hi)); return r; }
__device__ __forceinline__ int tid_now(int wave_s) { int l; asm volatile("v_mbcnt_lo_u32_b32 %0, -1, 0\n\tv_mbcnt_hi_u32_b32 %0, -1, %0" : "=v"(l)); return wave_s * 64 + l; }
__device__ __forceinline__ int sgpr_now(int v) { asm volatile("" : "+s"(v)); return v; }
__device__ __forceinline__ float lane_xor_f(float v, int m, int lane) { return __builtin_bit_cast(float, __builtin_amdgcn_ds_bpermute((lane ^ m) << 2, __builtin_bit_cast(int, v))); }
__device__ __forceinline__ float wave_sum(float v, int lane) {
#pragma unroll
    for (int o = 1; o < 64; o <<= 1) v += lane_xor_f(v, o, lane);
    return v;
}

typedef float f32x2v __attribute__((ext_vector_type(2)));
__device__ __forceinline__ unsigned pk4_fp8(float a, float b, float c, float d) { int w = 0; w = __builtin_amdgcn_cvt_pk_fp8_f32(a, b, w, false); w = __builtin_amdgcn_cvt_pk_fp8_f32(c, d, w, true); return (unsigned)w; }
__device__ __forceinline__ void up4_fp8(unsigned w, float* v) { const f32x2v lo = __builtin_amdgcn_cvt_pk_f32_fp8((int)w, false), hi = __builtin_amdgcn_cvt_pk_f32_fp8((int)w, true); v[0] = lo.x; v[1] = lo.y; v[2] = hi.x; v[3] = hi.y; }

#define XB_TMO      128
#define XB_XCNT(j)  (256  + 64 * (j))
#define XB_XSUB(j)  (1280 + 64 * (j))
#define XB_XGEN(j)  (2304 + 64 * (j))
#define XB_TOP      3328
#define XB_TOPGEN   3392
#define XCD_BAR_WORDS 3456
#define XB_SPIN_CAP (1u << 18)
__device__ __forceinline__ unsigned xb_ld(unsigned* p)              { return __hip_atomic_load(p, __ATOMIC_RELAXED, __HIP_MEMORY_SCOPE_AGENT); }
__device__ __forceinline__ unsigned xb_add(unsigned* p, unsigned v) { asm volatile("" : "+v"(v)); return __hip_atomic_fetch_add(p, v, __ATOMIC_RELAXED, __HIP_MEMORY_SCOPE_AGENT); }
__device__ __forceinline__ unsigned xb_xcc_id() { return (unsigned)__builtin_amdgcn_s_getreg((3 << 11) | 20) & 0xFu; }
#define XB_SPIN(cond, bar) do { unsigned _sp = 0; while (cond) { __builtin_amdgcn_s_sleep(1); \
    if ((++_sp & 255u) == 0u) { if (xb_ld(&(bar)[XB_TMO])) break; if (_sp > XB_SPIN_CAP) { atomicAdd(&(bar)[XB_TMO], 1u); break; } } } } while (0)
struct XcdBarrier { unsigned* bar; unsigned x; volatile LAS unsigned* st; };
__device__ __forceinline__ XcdBarrier xcd_barrier_post(unsigned* bar, volatile LAS unsigned* st, bool leader) {
    XcdBarrier b; b.bar = bar; b.x = xb_xcc_id(); b.st = st;
    if (leader) (void)xb_add(&bar[XB_XCNT(b.x)], 1u);
    return b;
}
__device__ __forceinline__ void xcd_barrier_complete(unsigned* bar, unsigned x, unsigned& nloc, unsigned& nx) {
    const unsigned G = gridDim.x * gridDim.y * gridDim.z;
    unsigned sum, cnt, mine, sp = 0u;
    for (;;) {
        sum = 0u; cnt = 0u; mine = 0u;
#pragma unroll
        for (unsigned j = 0; j < 16; ++j) { const unsigned c = xb_ld(&bar[XB_XCNT(j)]); sum += c; cnt += (c > 0u) ? 1u : 0u; mine = (j == x) ? c : mine; }
        if (sum == G) break;
        __builtin_amdgcn_s_sleep(1);
        if ((++sp & 255u) == 0u) { if (xb_ld(&bar[XB_TMO])) break; if (sp > XB_SPIN_CAP) { atomicAdd(&bar[XB_TMO], 1u); break; } }
    }
    nloc = mine > 0u ? mine : 1u; nx = cnt > 0u ? cnt : 1u;
}
__device__ __forceinline__ void xcd_barrier(const XcdBarrier& b, bool leader) {
    asm volatile("s_waitcnt vmcnt(0)" ::: "memory");
    __syncthreads();
    if (leader) {
        unsigned* bar = b.bar;
        __builtin_amdgcn_s_waitcnt(0);
        unsigned nloc = b.st[0], nx = b.st[1];
        if (nloc == 0u) { xcd_barrier_complete(bar, b.x, nloc, nx); b.st[0] = nloc; b.st[1] = nx; }
        const unsigned old = xb_add(&bar[XB_XSUB(b.x)], 1u);
        const unsigned gen = old / nloc;
        if (old + 1u == (gen + 1u) * nloc) {
            __builtin_amdgcn_fence(__ATOMIC_RELEASE, "agent");
            asm volatile("s_waitcnt vmcnt(0)" ::: "memory");
            const unsigned og = xb_add(&bar[XB_TOP], 1u);
            const unsigned tg = og / nx;
            if (og + 1u == (tg + 1u) * nx) xb_add(&bar[XB_TOPGEN], 1u);
            else XB_SPIN(xb_ld(&bar[XB_TOPGEN]) == tg, bar);
            __builtin_amdgcn_fence(__ATOMIC_ACQUIRE, "agent");
            xb_add(&bar[XB_XGEN(b.x)], 1u);
            asm volatile("s_waitcnt vmcnt(0)" ::: "memory");
        } else {
            XB_SPIN(xb_ld(&bar[XB_XGEN(b.x)]) == gen, bar);
            __builtin_amdgcn_fence(__ATOMIC_ACQUIRE, "agent");
            asm volatile("s_waitcnt vmcnt(0)" ::: "memory");
        }
    }
    __syncthreads();
}

namespace pg8 {
constexpr int BM = 256, BK = 64, HALF = 128, HTB = HALF * BK * 2, NXCD = 8, WGM = 8;
__host__ __device__ __forceinline__ int lds_byte(int r, int c) { const int st = (r >> 4) * 2 + (c >> 5), rr = r & 15, cc = c & 31, ob = rr * 64 + cc * 2; return st * 1024 + (ob ^ (((ob >> 9) & 1) << 5)); }
__host__ __device__ __forceinline__ void stage_rc(int b_, int& R, int& C) { const unsigned b = (unsigned)b_, st = b >> 10, sb = b & 1023u, swz = sb ^ (((sb >> 9) & 1u) << 5); R = (int)((st >> 1) * 16u + (swz >> 6)); C = (int)((st & 1u) * 32u + ((swz & 63u) >> 1)); }
__host__ __device__ __forceinline__ int perm32(int rho) { const int n = rho >> 4, i = rho & 15; return 8 * (i >> 2) + 4 * n + (i & 3); }

struct Unit { const char* A; const char* B; int pm, pn, arow, nvalid; };
struct Gemm { int lda, K; const int* rowidx; };

struct StaticOrder {
    int nM, nN, nwg, G, c; const char* A; const char* B; size_t astep, bstep;
    __device__ void init(const void* A_, int lda, const void* B_, int K, int M, int N, int G_, int c_) { nM = M / BM; nN = N / BM; nwg = nM * nN; G = G_; c = c_; A = (const char*)A_; B = (const char*)B_; astep = (size_t)BM * lda * 2; bstep = (size_t)BM * K * 2; }
    __device__ __forceinline__ bool next(int i, Unit& u) const {
        const long L = (long)i * G + c; if (L >= nwg) return false;
        int wgid = (int)L; { const int q = nwg / NXCD, r = nwg % NXCD, xcd = wgid % NXCD, off = wgid / NXCD; wgid = (xcd < r ? xcd * (q + 1) : r * (q + 1) + (xcd - r) * q) + off; }
        const int nig = WGM * nN, gid = wgid / nig, fm = gid * WGM, gsz = (nM - fm) < WGM ? (nM - fm) : WGM;
        u.pm = fm + ((wgid % nig) % gsz); u.pn = (wgid % nig) / gsz; u.A = A + (size_t)u.pm * astep; u.B = B + (size_t)u.pn * bstep; u.arow = 0; u.nvalid = BM; return true;
    }
};
constexpr int ECAP = 32768;
struct GroupedOrder {
    int n_units, nN, G, c; const char* A; const char* B; size_t astep, bexp, bstep; const LAS int* tbl; const LAS int* cntl;
    __device__ __forceinline__ bool next(int i, Unit& u) const {
        const int L = i * G + c; if (L >= n_units) return false;
        const int tile = L / nN, pn = L - tile * nN; const int ei = __builtin_amdgcn_readfirstlane(tbl[tile]); const int e = ei >> 16, ti = ei & 0xffff;
        const int left = __builtin_amdgcn_readfirstlane(cntl[e]) - ti * BM;
        u.pm = tile; u.pn = pn; u.arow = e * ECAP + ti * BM; u.nvalid = left < BM ? left : BM; u.A = A + (size_t)tile * astep; u.B = B + (size_t)e * bexp + (size_t)pn * bstep; return true;
    }
};

typedef f32x4 Acc[2][2][4][2];

struct EpiBf16 {
    static constexpr bool PERM = true, AFTER_DRAIN = false; static constexpr bool P16 = false;
    bf16_t* O; int ldc; const float* rs;
    __device__ __forceinline__ void operator()(const Acc& acc, const Unit& u, int wr, int wc, int fr, int fq) const {
        const int row0 = u.pm * BM + wr * 64 + fr, col0 = u.pn * BM + wc * 32 + 8 * fq;
#pragma unroll
        for (int ai = 0; ai < 2; ++ai)
#pragma unroll
            for (int m = 0; m < 4; ++m) { const int row = row0 + ai * HALF + m * 16; bf16_t* rowp = O + (size_t)row * ldc + col0; const float r = rs ? rs[row] : 1.f;
#pragma unroll
                for (int bj = 0; bj < 2; ++bj) { const f32x4 v0 = acc[ai][bj][m][0] * r, v1 = acc[ai][bj][m][1] * r;
                    u32x4 w; w.x = cvt_pk_bf16(v0[0], v0[1]); w.y = cvt_pk_bf16(v0[2], v0[3]); w.z = cvt_pk_bf16(v1[0], v1[1]); w.w = cvt_pk_bf16(v1[2], v1[3]);
                    *(u32x4*)(rowp + bj * HALF) = w; } }
    }
};
struct EpiFp8 {
    static constexpr bool PERM = true, AFTER_DRAIN = false; static constexpr bool P16 = true;
    unsigned char* O; int ldc;
    __device__ __forceinline__ void operator()(const Acc& acc, const Unit& u, int wr, int wc, int fr, int fq) const {
        const int row0 = u.pm * BM + wr * 64 + fr, col0 = u.pn * BM + wc * 64 + 16 * fq;
#pragma unroll
        for (int ai = 0; ai < 2; ++ai)
#pragma unroll
            for (int m = 0; m < 4; ++m) { unsigned char* rowp = O + (size_t)(row0 + ai * HALF + m * 16) * ldc + col0;
                const f32x4 a0 = acc[ai][0][m][0], a1 = acc[ai][0][m][1], b0 = acc[ai][1][m][0], b1 = acc[ai][1][m][1];
                u32x4 w; w.x = pk4_fp8(a0[0], a0[1], a0[2], a0[3]); w.y = pk4_fp8(a1[0], a1[1], a1[2], a1[3]); w.z = pk4_fp8(b0[0], b0[1], b0[2], b0[3]); w.w = pk4_fp8(b1[0], b1[1], b1[2], b1[3]);
                *(u32x4*)rowp = w; }
    }
};
struct EpiConvIn {
    static constexpr bool PERM = true, AFTER_DRAIN = false; static constexpr bool P16 = false;
    bf16_t* GBp; bf16_t* Zp; const float* rs;
    __device__ __forceinline__ void operator()(const Acc& acc, const Unit& u, int wr, int wc, int fr, int fq) const {
        const int row0 = u.pm * BM + wr * 64 + fr;
        if (u.pn < 4) {
            const int col0 = u.pn * BM + wc * 32 + 8 * fq;
#pragma unroll
            for (int ai = 0; ai < 2; ++ai)
#pragma unroll
                for (int m = 0; m < 4; ++m) { const int row = row0 + ai * HALF + m * 16; bf16_t* rowp = GBp + (size_t)row * DM + col0; const float r = rs[row];
#pragma unroll
                    for (int bj = 0; bj < 2; ++bj) { const f32x4 v0 = acc[ai][bj][m][0] * r, v1 = acc[ai][bj][m][1] * r;
                        u32x4 w; w.x = cvt_pk_bf16(v0[0], v0[1]); w.y = cvt_pk_bf16(v0[2], v0[3]); w.z = cvt_pk_bf16(v1[0], v1[1]); w.w = cvt_pk_bf16(v1[2], v1[3]);
                        *(u32x4*)(rowp + bj * HALF) = w; } }
        } else {
            const int col0 = (u.pn - 4) * HALF + wc * 32 + 8 * fq;
#pragma unroll
            for (int ai = 0; ai < 2; ++ai)
#pragma unroll
                for (int m = 0; m < 4; ++m) { const int row = row0 + ai * HALF + m * 16; bf16_t* rowp = Zp + (size_t)row * DM + col0; const float r = rs[row], r2 = r * r;
                    const f32x4 v0 = acc[ai][0][m][0] * acc[ai][1][m][0] * r2, v1 = acc[ai][0][m][1] * acc[ai][1][m][1] * r2;
                    u32x4 w; w.x = cvt_pk_bf16(v0[0], v0[1]); w.y = cvt_pk_bf16(v0[2], v0[3]); w.z = cvt_pk_bf16(v1[0], v1[1]); w.w = cvt_pk_bf16(v1[2], v1[3]);
                    *(u32x4*)rowp = w; }
        }
    }
};
__device__ __forceinline__ float silu_mul(float g, float u) { return g * __builtin_amdgcn_rcpf(1.f + __expf(-g)) * u; }
struct EpiSwiGLU {
    static constexpr bool PERM = true, AFTER_DRAIN = false; static constexpr bool P16 = false;
    bf16_t* Hd; const float* ss;
    __device__ __forceinline__ void operator()(const Acc& acc, const Unit& u, int wr, int wc, int fr, int fq) const {
        const int row0 = u.pm * BM + wr * 64 + fr, col0 = u.pn * HALF + wc * 32 + 8 * fq;
#pragma unroll
        for (int ai = 0; ai < 2; ++ai)
#pragma unroll
            for (int m = 0; m < 4; ++m) { const int row = row0 + ai * HALF + m * 16; bf16_t* rowp = Hd + (size_t)row * DFF + col0; const float r = ss[u.arow + (row - u.pm * BM)];
                f32x4 v0, v1;
#pragma unroll
                for (int q = 0; q < 4; ++q) { v0[q] = silu_mul(acc[ai][0][m][0][q] * r, acc[ai][1][m][0][q] * r); v1[q] = silu_mul(acc[ai][0][m][1][q] * r, acc[ai][1][m][1][q] * r); }
                u32x4 w; w.x = cvt_pk_bf16(v0[0], v0[1]); w.y = cvt_pk_bf16(v0[2], v0[3]); w.z = cvt_pk_bf16(v1[0], v1[1]); w.w = cvt_pk_bf16(v1[2], v1[3]);
                *(u32x4*)rowp = w; }
    }
};
struct EpiResid {
    static constexpr bool PERM = true, AFTER_DRAIN = false; static constexpr bool P16 = false;
    bf16_t* XB; float* PSQ; int lane;
    __device__ __forceinline__ void operator()(const Acc& acc, const Unit& u, int wr, int wc, int fr, int fq) const {
        const int row0 = u.pm * BM + wr * 64 + fr, col0 = u.pn * BM + wc * 32 + 8 * fq;
#pragma unroll
        for (int ai = 0; ai < 2; ++ai)
#pragma unroll
            for (int m = 0; m < 4; ++m) { const int row = row0 + ai * HALF + m * 16; bf16_t* rowp = XB + (size_t)row * DM + col0; float ss = 0.f;
#pragma unroll
                for (int bj = 0; bj < 2; ++bj) { const u32x4 xv = *(const u32x4*)(rowp + bj * HALF);
                    const f32x4 v0 = acc[ai][bj][m][0] + (f32x4){bflo(xv.x), bfhi(xv.x), bflo(xv.y), bfhi(xv.y)}, v1 = acc[ai][bj][m][1] + (f32x4){bflo(xv.z), bfhi(xv.z), bflo(xv.w), bfhi(xv.w)};
                    ss += (v0[0] * v0[0] + v0[1] * v0[1]) + (v0[2] * v0[2] + v0[3] * v0[3]) + (v1[0] * v1[0] + v1[1] * v1[1]) + (v1[2] * v1[2] + v1[3] * v1[3]);
                    u32x4 w; w.x = cvt_pk_bf16(v0[0], v0[1]); w.y = cvt_pk_bf16(v0[2], v0[3]); w.z = cvt_pk_bf16(v1[0], v1[1]); w.w = cvt_pk_bf16(v1[2], v1[3]);
                    *(u32x4*)(rowp + bj * HALF) = w; }
                ss += lane_xor_f(ss, 16, lane); ss += lane_xor_f(ss, 32, lane);
                if (fq == 0) PSQ[(size_t)row * 16 + u.pn * 4 + wc] = ss; }
    }
};
struct EpiRoute {
    static constexpr bool PERM = false, AFTER_DRAIN = true; static constexpr bool P16 = false;
    const float* rs; const float* bg; const float* be; gu32* cnt; int* sa; float* sgate; float* sscale;
    __device__ __forceinline__ void fused(const Acc& acc, const Unit& u, int wr, int wc, int fr, int fq, LAS unsigned char* lds, int tid) const {
        LAS float* lg = (LAS float*)lds;
        if (wc < 3) {
#pragma unroll
            for (int ai = 0; ai < 2; ++ai)
#pragma unroll
                for (int m = 0; m < 4; ++m) { const int rl = ai * HALF + wr * 64 + m * 16 + fr; const float r = rs[u.pm * BM + rl];
#pragma unroll
                    for (int n = 0; n < 2; ++n) { const int c0 = wc * 32 + 16 * n + 4 * fq;
                        if (c0 < 72) { LAS float* d = lg + rl * 73 + c0; const f32x4 v = acc[ai][0][m][n] * r; d[0] = v[0]; d[1] = v[1]; d[2] = v[2]; d[3] = v[3]; } } } }
        __syncthreads();
        LAS unsigned* lc = (LAS unsigned*)(lds + 80 * 1024);
        if (tid < 64) lc[tid] = 0u;
        __syncthreads();
        int e0 = 0, e1 = 0; float rv = 0.f, w0 = 0.f, w1 = 0.f; unsigned r0 = 0u, r1 = 0u; const int t = u.pm * BM + tid;
        if (tid < 256) { const LAS float* l = lg + tid * 73;
            float gl[8];
#pragma unroll
            for (int q = 0; q < 8; ++q) gl[q] = l[q];
            float gm = gl[0]; int gs = 0; float bm = gl[0] + bg[0];
#pragma unroll
            for (int q = 1; q < 8; ++q) { gm = fmaxf(gm, gl[q]); const float v = gl[q] + bg[q]; if (v > bm) { bm = v; gs = q; } }
            float gsum = 0.f, gsel = 0.f;
#pragma unroll
            for (int q = 0; q < 8; ++q) { const float e = __expf(gl[q] - gm); gsum += e; gsel = (q == gs) ? e : gsel; }
            const float g_gate = gsel / gsum;
            float el[8];
#pragma unroll
            for (int q = 0; q < 8; ++q) el[q] = l[8 + gs * 8 + q];
            int i0 = 0; float v0 = el[0] + be[gs * 8];
#pragma unroll
            for (int q = 1; q < 8; ++q) { const float v = el[q] + be[gs * 8 + q]; if (v > v0) { v0 = v; i0 = q; } }
            int i1 = -1; float v1 = -3.0e38f;
#pragma unroll
            for (int q = 0; q < 8; ++q) { const float v = el[q] + be[gs * 8 + q]; if (q != i0 && v > v1) { v1 = v; i1 = q; } }
            float l0 = 0.f, l1 = 0.f;
#pragma unroll
            for (int q = 0; q < 8; ++q) { l0 = (q == i0) ? el[q] : l0; l1 = (q == i1) ? el[q] : l1; }
            const float mm = fmaxf(l0, l1), p0 = __expf(l0 - mm), p1 = __expf(l1 - mm), inv = 1.f / (p0 + p1);
            e0 = gs * 8 + i0; e1 = gs * 8 + i1; rv = rs[t]; w0 = g_gate * p0 * inv; w1 = g_gate * p1 * inv;
            unsigned one_ = 1u; asm volatile("" : "+v"(one_));
            r0 = __hip_atomic_fetch_add(lc + e0, one_, __ATOMIC_RELAXED, __HIP_MEMORY_SCOPE_WORKGROUP); r1 = __hip_atomic_fetch_add(lc + e1, one_, __ATOMIC_RELAXED, __HIP_MEMORY_SCOPE_WORKGROUP); }
        __syncthreads();
        if (tid < 64) { const unsigned n = lc[tid]; lc[64 + tid] = n ? __hip_atomic_fetch_add(cnt + 32 * tid, n, RLX_AGENT) : 0u; }
        __syncthreads();
        if (tid < 256) { const int s0 = e0 * ECAP + (int)(lc[64 + e0] + r0), s1 = e1 * ECAP + (int)(lc[64 + e1] + r1);
            sa[s0] = 2 * t; sgate[s0] = w0; sscale[s0] = rv; sa[s1] = 2 * t + 1; sgate[s1] = w1; sscale[s1] = rv; }
    }
};
struct EpiScatterY {
    static constexpr bool PERM = true, AFTER_DRAIN = false; static constexpr bool P16 = true;
    unsigned char* Y; const int* sdest; const float* sgate;
    __device__ __forceinline__ void operator()(const Acc& acc, const Unit& u, int wr, int wc, int fr, int fq) const {
        const int col0 = u.pn * BM + wc * 64 + 16 * fq;
#pragma unroll
        for (int ai = 0; ai < 2; ++ai)
#pragma unroll
            for (int m = 0; m < 4; ++m) { const int rl = wr * 64 + fr + ai * HALF + m * 16; const bool ok = rl < u.nvalid; const int d = ok ? sdest[u.arow + rl] : 0; const float g = ok ? 16.f * sgate[u.arow + rl] : 0.f;
                if (ok) { unsigned char* rowp = Y + (size_t)d * DM + col0;
                    const f32x4 a0 = acc[ai][0][m][0] * g, a1 = acc[ai][0][m][1] * g, b0 = acc[ai][1][m][0] * g, b1 = acc[ai][1][m][1] * g;
                    u32x4 w; w.x = pk4_fp8(a0[0], a0[1], a0[2], a0[3]); w.y = pk4_fp8(a1[0], a1[1], a1[2], a1[3]); w.z = pk4_fp8(b0[0], b0[1], b0[2], b0[3]); w.w = pk4_fp8(b1[0], b1[1], b1[2], b1[3]);
                    *(u32x4*)rowp = w; }
                asm volatile("" ::: "memory"); }
    }
};

template <bool GATHER = false, bool ONLY_B0 = false, class Epi, class Sched>
__device__ __forceinline__ void gemm_phase(LAS unsigned char* lds, const Gemm g, const Sched& S, const Epi& E, int tid) {
    const int wid = __builtin_amdgcn_readfirstlane(tid >> 6), lane = tid & 63, wr = wid >> 2, wc = wid & 3, fr = lane & 15, fq = lane >> 4;
    const int K = g.K, lda = g.lda, nt = K / BK;
    unsigned voffA[2], voffB[2];
#pragma unroll
    for (int i = 0; i < 2; ++i) { int R, C; stage_rc(tid * 16 + i * 8192, R, C); const int Rb = Epi::P16 ? (64 * ((R >> 5) & 3) + 16 * ((R >> 2) & 3) + 4 * ((R >> 4) & 1) + (R & 3)) : (Epi::PERM ? ((R & ~31) + perm32(R & 31)) : R);
        voffA[i] = (unsigned)(R * lda + C) * 2u; voffB[i] = (unsigned)(Rb * K + C) * 2u; }
    const size_t kstep = (size_t)(BK * 2);
    const size_t hstepA = (size_t)HALF * lda * 2, hstepB = (size_t)(Epi::P16 ? 8 : HALF) * K * 2;
    unsigned goC[2][2] = {{0u, 0u}, {0u, 0u}}, goN[2][2] = {{0u, 0u}, {0u, 0u}}; int gR[2] = {0, 0}; unsigned gC[2] = {0u, 0u};
    if constexpr (GATHER) {
#pragma unroll
        for (int i = 0; i < 2; ++i) { int R, C; stage_rc(tid * 16 + i * 8192, R, C); gR[i] = R; gC[i] = (unsigned)C * 2u; } }
#define PG8_GO(dst, un_) do { _Pragma("unroll") for (int h_ = 0; h_ < 2; ++h_) _Pragma("unroll") for (int i_ = 0; i_ < 2; ++i_) \
        { const int r_ = h_ * HALF + gR[i_]; const int a_ = r_ < (un_).nvalid ? g.rowidx[(un_).arow + r_] : 0; dst[h_][i_] = (unsigned)((a_ >> 1) & (T - 1)) * (unsigned)(lda * 2) + gC[i_]; } } while (0)
    const unsigned ldsw = (unsigned)wid * 1024u;
    const int aoff = lds_byte(wr * 64 + fr, fq * 8), boff = lds_byte(wc * 32 + fr, fq * 8);
#define PG8_SA(b, h) (((b) * 2 + (h)) * HTB)
#define PG8_SB(b, h) ((4 + (b) * 2 + (h)) * HTB)
#define PG8_STAGE(bufoff, gbase, voff) do { _Pragma("unroll") for (int _i = 0; _i < 2; ++_i) \
        __builtin_amdgcn_global_load_lds((const unsigned*)((const char*)(gbase) + (voff)[_i]), (LAS unsigned*)(lds + (bufoff) + ldsw + _i * 8192), 16, 0, 0); } while (0)
#define PG8_LDA(dst, b, h) do { _Pragma("unroll") for (int m = 0; m < 4; ++m) _Pragma("unroll") for (int k = 0; k < 2; ++k) dst[m][k] = *(const LAS bf16x8*)(lds + PG8_SA(b, h) + aoff + m * 2048 + k * 1024); } while (0)
#define PG8_LDB(dst, b, h) do { _Pragma("unroll") for (int n = 0; n < 2; ++n) _Pragma("unroll") for (int k = 0; k < 2; ++k) dst[n][k] = *(const LAS bf16x8*)(lds + PG8_SB(b, h) + boff + n * 2048 + k * 1024); } while (0)
#define PG8_MMA(ai, bj, At, Bt) do { __builtin_amdgcn_s_setprio(1); _Pragma("unroll") for (int m = 0; m < 4; ++m) _Pragma("unroll") for (int n = 0; n < 2; ++n) _Pragma("unroll") for (int k = 0; k < 2; ++k) \
        acc[ai][bj][m][n] = __builtin_amdgcn_mfma_f32_16x16x32_bf16(Bt[n][k], At[m][k], acc[ai][bj][m][n], 0, 0, 0); __builtin_amdgcn_s_setprio(0); } while (0)
#define PG8_WAIT_V(n) asm volatile("s_waitcnt vmcnt(" #n ")" ::: "memory")
#define PG8_WAIT_L(n) asm volatile("s_waitcnt lgkmcnt(" #n ")" ::: "memory")
#define PG8_BAR __builtin_amdgcn_s_barrier()
#define PG8_SCHED __builtin_amdgcn_sched_barrier(0)
    Unit cur, nxt; int ui = 0;
    if (!S.next(0, cur)) return;
    Acc acc;
#pragma unroll
    for (int a = 0; a < 2; ++a)
#pragma unroll
        for (int b = 0; b < 2; ++b)
#pragma unroll
            for (int m = 0; m < 4; ++m)
#pragma unroll
                for (int n = 0; n < 2; ++n) acc[a][b][m][n] = (f32x4){0.f, 0.f, 0.f, 0.f};
    bf16x8 At[4][2], B0[2][2], B1[2][2];
    const char* cA = cur.A; const char* cB = cur.B;
    if constexpr (GATHER) PG8_GO(goC, cur);
    PG8_STAGE(PG8_SB(0, 0), cB, voffB); PG8_STAGE(PG8_SB(0, 1), cB + hstepB, voffB);
    if constexpr (GATHER) { PG8_STAGE(PG8_SA(0, 0), cA, goC[0]); PG8_STAGE(PG8_SA(0, 1), cA, goC[1]); } else { PG8_STAGE(PG8_SA(0, 0), cA, voffA); PG8_STAGE(PG8_SA(0, 1), cA + hstepA, voffA); }
    if (wr == 1) PG8_BAR;
    PG8_WAIT_V(2); PG8_BAR;
    PG8_STAGE(PG8_SB(1, 0), cB + kstep, voffB); if constexpr (GATHER) PG8_STAGE(PG8_SA(1, 0), cA + kstep, goC[0]); else PG8_STAGE(PG8_SA(1, 0), cA + kstep, voffA); PG8_STAGE(PG8_SB(1, 1), cB + hstepB + kstep, voffB);
    PG8_WAIT_V(6); PG8_BAR;
    for (;;) {
        const bool has_next = S.next(ui + 1, nxt);
        const char* nA = has_next ? nxt.A : cA; const char* nB = has_next ? nxt.B : cB;
        if constexpr (GATHER) { if (has_next) PG8_GO(goN, nxt); else { goN[0][0] = goC[0][0]; goN[0][1] = goC[0][1]; goN[1][0] = goC[1][0]; goN[1][1] = goC[1][1]; } }
        for (int t = 0; t < nt; t += 2) {
            const bool last = (t == nt - 2);
            const char* a1 = cA + (size_t)(t + 1) * kstep;
            const char* a2 = last ? nA : cA + (size_t)(t + 2) * kstep; const char* b2 = last ? nB : cB + (size_t)(t + 2) * kstep;
            const char* a3 = a2 + kstep; const char* b3 = b2 + kstep;
            unsigned g2h0[2], g2h1[2];
            if constexpr (GATHER) { g2h0[0] = last ? goN[0][0] : goC[0][0]; g2h0[1] = last ? goN[0][1] : goC[0][1]; g2h1[0] = last ? goN[1][0] : goC[1][0]; g2h1[1] = last ? goN[1][1] : goC[1][1]; }
            PG8_LDB(B0, 0, 0); if constexpr (!ONLY_B0) PG8_LDB(B1, 0, 1); PG8_SCHED; PG8_LDA(At, 0, 0); if constexpr (GATHER) PG8_STAGE(PG8_SA(1, 1), a1, goC[1]); else PG8_STAGE(PG8_SA(1, 1), a1 + hstepA, voffA);
            PG8_WAIT_V(8); PG8_WAIT_L(0); PG8_BAR; PG8_MMA(0, 0, At, B0); if constexpr (!ONLY_B0) PG8_MMA(0, 1, At, B1); PG8_BAR; PG8_SCHED;
            PG8_LDA(At, 0, 1); PG8_STAGE(PG8_SB(0, 0), b2, voffB); PG8_STAGE(PG8_SB(0, 1), b2 + hstepB, voffB); if constexpr (GATHER) PG8_STAGE(PG8_SA(0, 0), a2, g2h0); else PG8_STAGE(PG8_SA(0, 0), a2, voffA);
            PG8_WAIT_V(8); PG8_WAIT_L(0); PG8_BAR; PG8_MMA(1, 0, At, B0); if constexpr (!ONLY_B0) PG8_MMA(1, 1, At, B1); PG8_BAR; PG8_SCHED;
            PG8_LDB(B0, 1, 0); if constexpr (!ONLY_B0) PG8_LDB(B1, 1, 1); PG8_SCHED; PG8_LDA(At, 1, 0); if constexpr (GATHER) PG8_STAGE(PG8_SA(0, 1), a2, g2h1); else PG8_STAGE(PG8_SA(0, 1), a2 + hstepA, voffA);
            PG8_WAIT_V(8); PG8_WAIT_L(0); PG8_BAR; PG8_MMA(0, 0, At, B0); if constexpr (!ONLY_B0) PG8_MMA(0, 1, At, B1); PG8_BAR; PG8_SCHED;
            PG8_LDA(At, 1, 1); PG8_STAGE(PG8_SB(1, 0), b3, voffB); PG8_STAGE(PG8_SB(1, 1), b3 + hstepB, voffB); if constexpr (GATHER) PG8_STAGE(PG8_SA(1, 0), a3, g2h0); else PG8_STAGE(PG8_SA(1, 0), a3, voffA);
            PG8_WAIT_V(8); PG8_WAIT_L(0); PG8_BAR; PG8_MMA(1, 0, At, B0); if constexpr (!ONLY_B0) PG8_MMA(1, 1, At, B1); PG8_BAR; PG8_SCHED;
        }
        if (wr == 0) PG8_BAR;
        if constexpr (!Epi::AFTER_DRAIN) E(acc, cur, wr, wc, fr, fq);
        if (!has_next) break;
#pragma unroll
        for (int a = 0; a < 2; ++a)
#pragma unroll
            for (int b = 0; b < 2; ++b)
#pragma unroll
                for (int m = 0; m < 4; ++m)
#pragma unroll
                    for (int n = 0; n < 2; ++n) acc[a][b][m][n] = (f32x4){0.f, 0.f, 0.f, 0.f};
        cur = nxt; cA = nA; cB = nB; ++ui;
        if constexpr (GATHER) { goC[0][0] = goN[0][0]; goC[0][1] = goN[0][1]; goC[1][0] = goN[1][0]; goC[1][1] = goN[1][1]; }
        if (wr == 1) PG8_BAR;
    }
    PG8_WAIT_V(0);
    PG8_BAR;
    if constexpr (Epi::AFTER_DRAIN) E.fused(acc, cur, wr, wc, fr, fq, lds, tid);
#undef PG8_GO
#undef PG8_SA
#undef PG8_SB
#undef PG8_STAGE
#undef PG8_LDA
#undef PG8_LDB
#undef PG8_MMA
#undef PG8_WAIT_V
#undef PG8_WAIT_L
#undef PG8_BAR
#undef PG8_SCHED
}
}


namespace att8 {
typedef int i32x8 __attribute__((ext_vector_type(8)));
constexpr int NW = 8, QBLK = 32, KVBLK = 64;
constexpr float SCALE = 0.07216878364870322f;
constexpr float POFF = 3.f;
constexpr float PLIM = 448.f;
constexpr int KROW = 208, VROW = 80;
constexpr int SHM_K = KVBLK * KROW, SHM_V = DV * VROW;
constexpr int OFF_V = 0, OFF_K = 2 * SHM_V, OFF_WS = OFF_K + 3 * SHM_K, ATT_LDS = OFF_WS + NW * 64 * 4;
static_assert(ATT_LDS <= 65536, "O staging reuses [0, 64 KiB)");
#define SBAR() __builtin_amdgcn_sched_barrier(0)
__device__ __forceinline__ int crow(int r, int hi) { return (r & 3) + 8 * (r >> 2) + 4 * hi; }
__device__ __forceinline__ f32x16 mfma8(i32x8 a, i32x8 b, f32x16 c) { return __builtin_amdgcn_mfma_scale_f32_32x32x64_f8f6f4(a, b, c, 0, 0, 0, 0x7F7F7F7F, 0, 0x7F7F7F7F); }
__device__ __forceinline__ i32x8 ld32(const char* p) { const u32x4 a = *reinterpret_cast<const u32x4*>(p), b = *reinterpret_cast<const u32x4*>(p + 16); return (i32x8){(int)a.x, (int)a.y, (int)a.z, (int)a.w, (int)b.x, (int)b.y, (int)b.z, (int)b.w}; }
template <bool FIRST = false>
__device__ __forceinline__ void softmax_seg(f32x16& p0, f32x16& p1, f32x16& negm, float& l_reg, f32x16* o, i32x8& pa, float* al_l, int r32, int hi) {
    float ps = 0;
#pragma unroll
    for (int r = 0; r < 16; ++r) { p0[r] = __builtin_amdgcn_exp2f(p0[r]); ps += p0[r]; }
    asm volatile("" :: "v"(pa));
#pragma unroll
    for (int r = 0; r < 16; ++r) { p1[r] = __builtin_amdgcn_exp2f(p1[r]); ps += p1[r]; }
    if (FIRST || !__builtin_expect(__all(ps <= PLIM), 1)) {
        float alpha;
        float pm = fmaxf(p0[0], p1[0]);
#pragma unroll
        for (int r = 1; r < 16; ++r) pm = fmaxf(pm, fmaxf(p0[r], p1[r]));
        { auto rr = __builtin_amdgcn_permlane32_swap(__float_as_uint(pm), __float_as_uint(pm), false, false);
          pm = fmaxf(__uint_as_float(rr[0]), __uint_as_float(rr[1])); }
        const float d = __builtin_ceilf(fmaxf(__builtin_amdgcn_logf(pm) - POFF, 0.f));
        alpha = __builtin_amdgcn_exp2f(-d);
#pragma unroll
        for (int r = 0; r < 16; ++r) { p0[r] *= alpha; p1[r] *= alpha; negm[r] -= d; }
        ps *= alpha; l_reg *= alpha;
        if (hi == 0) al_l[r32] = alpha; asm volatile("s_waitcnt lgkmcnt(0)" ::: "memory");
#pragma unroll
        for (int dd = 0; dd < 4; ++dd)
#pragma unroll
            for (int r = 0; r < 16; ++r) o[dd][r] *= al_l[crow(r, hi)];
    }
    asm("v_add_f32_e32 %0, %0, %1" : "+v"(l_reg) : "v"(ps));
#pragma unroll
    for (int g = 0; g < 4; ++g) { int w = pa[g]; w = __builtin_amdgcn_cvt_pk_fp8_f32(p0[4 * g], p0[4 * g + 1], w, false); w = __builtin_amdgcn_cvt_pk_fp8_f32(p0[4 * g + 2], p0[4 * g + 3], w, true); pa[g] = w; }
#pragma unroll
    for (int g = 0; g < 4; ++g) { int w = pa[4 + g]; w = __builtin_amdgcn_cvt_pk_fp8_f32(p1[4 * g], p1[4 * g + 1], w, false); w = __builtin_amdgcn_cvt_pk_fp8_f32(p1[4 * g + 2], p1[4 * g + 3], w, true); pa[4 + g] = w; }
}
__device__ __forceinline__ f32x16 mfma8q(i32x8 a, i32x8 b, f32x16 c) { return __builtin_amdgcn_mfma_scale_f32_32x32x64_f8f6f4(a, b, c, 0, 0, 0, 0x7F7F7F7F, 0, 0x7C7C7C7C); }
constexpr int KPF = 2;
__device__ __forceinline__ void kfrag_load(i32x8 (&ka)[KPF][2], const char* Ks, int r32, int hi) {
#pragma unroll
    for (int ks = 0; ks < KPF; ++ks) { const int cb = ks * 64 + hi * 32; ka[ks][0] = ld32(Ks + r32 * KROW + cb); ka[ks][1] = ld32(Ks + (32 + r32) * KROW + cb); }
}
#define SGB(mask, n) __builtin_amdgcn_sched_group_barrier(mask, n, 0)
template <bool DO_QK, bool DO_PV, typename StageF>
__device__ __forceinline__ void mfma_seg(f32x16& p0, f32x16& p1, const f32x16& negm, f32x16* o, const i32x8 (&ka)[KPF][2], const char* Ks, const char* Vs, const i32x8* qr, i32x8 pa, int r32, int hi, StageF&& stage) {
    static_assert(KPF == 2, "gap placement below is written for two prefetched k-steps");
    i32x8 vb[4], kr[2];
    __builtin_amdgcn_s_setprio(1);
    SBAR();
    if (DO_PV) stage();
    if (DO_QK) { const int cb = 2 * 64 + hi * 32; kr[0] = ld32(Ks + r32 * KROW + cb); kr[1] = ld32(Ks + (32 + r32) * KROW + cb); }
    if (DO_PV) {
#pragma unroll
        for (int d0 = 0; d0 < 4; ++d0) vb[d0] = ld32(Vs + (32 * d0 + r32) * VROW + hi * 32); }
    if (!DO_PV) stage();
    if (DO_QK) { p0 = mfma8q(ka[0][0], qr[0], negm); p1 = mfma8q(ka[0][1], qr[0], negm); p0 = mfma8q(ka[1][0], qr[1], p0); p1 = mfma8q(ka[1][1], qr[1], p1);
                 p0 = mfma8q(kr[0], qr[2], p0); p1 = mfma8q(kr[1], qr[2], p1); }
    if (DO_QK && DO_PV) { SGB(0x008, 1); SGB(0x200, 3); SGB(0x020, 3); SGB(0x008, 1); SGB(0x100, 4); SGB(0x008, 1); SGB(0x100, 4); SGB(0x008, 1); SGB(0x100, 4); SGB(0x008, 2); }
    else if (DO_QK) { SGB(0x008, 1); SGB(0x100, 4); SGB(0x008, 1); SGB(0x200, 3); SGB(0x020, 3); SGB(0x008, 4); }
    SBAR();
    if (DO_PV) {
#pragma unroll
        for (int d0 = 0; d0 < 4; ++d0) o[d0] = mfma8(pa, vb[d0], o[d0]); }
    SBAR();
    __builtin_amdgcn_s_setprio(0);
}
#undef SGB
__device__ __forceinline__ void attn_unit_pp(const unsigned char* __restrict__ Qb, const unsigned char* __restrict__ Kh, const unsigned char* __restrict__ Vt, bf16_t* __restrict__ Ob, char* lds, int tid) {
    const int wid = __builtin_amdgcn_readfirstlane(tid >> 6), lane = tid & 63, r32 = lane & 31, hi = lane >> 5;
    const bool halfB = wid >= 4;
    char* V_lds = lds + OFF_V; char* K_lds = lds + OFF_K;
    float* ws = (float*)(lds + OFF_WS) + wid * 64; float* li_l = ws; float* al_l = ws + 32;
    float l_reg = 0; f32x16 o[4] = {}; i32x8 qr[3]; f32x16 negm;
    float m0_ = 60.f; asm volatile("" : "+v"(m0_));
#pragma unroll
    for (int r = 0; r < 16; ++r) negm[r] = m0_;
    const unsigned char* Qw = Qb + (long)(wid * QBLK + r32) * DQK + hi * 32;
#pragma unroll
    for (int ks = 0; ks < 3; ++ks) qr[ks] = ld32((const char*)Qw + ks * 64);
    const int kst0 = (tid / 12) * KROW + (tid % 12) * 16, kst1 = ((8192 + tid * 8) / 192) * KROW + ((8192 + tid * 8) % 192), vst = (tid >> 2) * VROW + (tid & 3) * 16;
    constexpr int NT = SEQ / KVBLK;
    u32x4 sv, sk0; u32x2 sk1;
    const __amdgpu_buffer_rsrc_t rsK = __builtin_amdgcn_make_buffer_rsrc((void*)Kh, (short)0, SEQ * DQK, 0x00020000), rsV = __builtin_amdgcn_make_buffer_rsrc((void*)Vt, (short)0, SEQ * DV, 0x00020000);
    const unsigned goff0 = (unsigned)tid * 16u, goff1 = (unsigned)tid * 8u + 8192u;
#define LOADK(t) do { const unsigned so_ = (unsigned)((t) < NT ? (t) : NT - 1) * 12288u; sk0 = __builtin_amdgcn_raw_buffer_load_b128(rsK, goff0, so_, 0); sk1 = __builtin_amdgcn_raw_buffer_load_b64(rsK, goff1, so_, 0); } while (0)
#define LOADV(t) do { sv = __builtin_amdgcn_raw_buffer_load_b128(rsV, goff0, (unsigned)((t) < NT ? (t) : NT - 1) * 8192u, 0); } while (0)
#define WRITEK(b) do { *(u32x4*)(K_lds + (b) * SHM_K + kst0) = sk0; *(u32x2*)(K_lds + (b) * SHM_K + kst1) = sk1; } while (0)
#define WRITEV(b) do { *(u32x4*)(V_lds + (b) * SHM_V + vst) = sv; } while (0)
#define BAR() do { SBAR(); __syncthreads(); SBAR(); } while (0)
    f32x16 p0, p1; i32x8 pa = {}; i32x8 ka[KPF][2];
    LOADK(0); WRITEK(0); LOADK(1); WRITEK(1); __syncthreads();
    LOADK(2); LOADV(0);
    kfrag_load(ka, K_lds, r32, hi);
#define CBAR(flag) do { SBAR(); asm volatile("" : "+v"(p0), "+v"(p1)); asm volatile("" : "+v"(o[0]), "+v"(o[1]), "+v"(o[2]), "+v"(o[3])); asm volatile("" : "+v"(pa)); SBAR(); if (flag) { __syncthreads(); } SBAR(); } while (0)
    const bool fB = halfB, fA = !halfB;
    mfma_seg<true, false>(p0, p1, negm, o, ka, K_lds, V_lds, qr, pa, r32, hi, [&]() { WRITEK(2); WRITEV(0); LOADK(3); LOADV(1); });
    CBAR(fB);
    softmax_seg<true>(p0, p1, negm, l_reg, o, pa, al_l, r32, hi);
    kfrag_load(ka, K_lds + SHM_K, r32, hi);
    CBAR(fA);
    int kb3 = 0, kb1 = 1, kb2 = 2;
    for (int t = 0; t < NT - 1; ++t) {
        mfma_seg<true, true>(p0, p1, negm, o, ka, K_lds + kb1 * SHM_K, V_lds + (t & 1) * SHM_V, qr, pa, r32, hi, [&]() { WRITEK(kb3); WRITEV((t + 1) & 1); LOADK(t + 4); LOADV(t + 2); });
        CBAR(fB);
        softmax_seg(p0, p1, negm, l_reg, o, pa, al_l, r32, hi);
        kfrag_load(ka, K_lds + kb2 * SHM_K, r32, hi);
        CBAR(fA);
        kb3 = (kb3 == 2) ? 0 : kb3 + 1; kb1 = (kb1 == 2) ? 0 : kb1 + 1; kb2 = (kb2 == 2) ? 0 : kb2 + 1;
    }
    mfma_seg<false, true>(p0, p1, negm, o, ka, K_lds, V_lds + ((NT - 1) & 1) * SHM_V, qr, pa, r32, hi, []() {});
#undef CBAR
    { auto rr = __builtin_amdgcn_permlane32_swap(__float_as_uint(l_reg), __float_as_uint(l_reg), false, false); l_reg = __uint_as_float(rr[0]) + __uint_as_float(rr[1]); }
    if (hi == 0) li_l[r32] = l_reg; asm volatile("s_waitcnt lgkmcnt(0)" ::: "memory");
    float rli[16];
#pragma unroll
    for (int r = 0; r < 16; ++r) rli[r] = __builtin_amdgcn_rcpf(li_l[crow(r, hi)]);
    __syncthreads();
    bf16_t* ost = (bf16_t*)(lds + wid * 8192);
#pragma unroll
    for (int r = 0; r < 16; ++r) { const int orow = crow(r, hi);
#pragma unroll
        for (int d0 = 0; d0 < 4; ++d0) ost[orow * 128 + d0 * 32 + r32] = (bf16_t)f2bf(o[d0][r] * rli[r]); }
    asm volatile("s_waitcnt lgkmcnt(0)" ::: "memory");
    bf16_t* Ow = Ob + (long)(wid * QBLK) * DM;
#pragma unroll
    for (int i = 0; i < 8; ++i) { const int ch = lane + 64 * i, row = ch >> 4, c = ch & 15;
        const u32x4 v = *(const u32x4*)((const char*)ost + row * 256 + c * 16); *(u32x4*)(Ow + (long)row * DM + c * 8) = v; }
    __syncthreads();
#undef LOADK
#undef LOADV
#undef WRITEK
#undef WRITEV
#undef BAR
}
#undef SBAR
}

struct Args { const void* in[23]; float* out; unsigned char* ws; int ph_lo, ph_hi; };
enum { I_X = 0, I_POS, I_CNW, I_CWIN, I_CK, I_CWOUT, I_MNW, I_MWDOWN, I_MQLN, I_MKVLN, I_MWQ, I_MWKV, I_MQHN, I_MKHN, I_MWO, I_FNW, I_RWG, I_RBG, I_RWE, I_RBE, I_EWG, I_EWU, I_EWD };

struct CvtItem { const float* W; bf16_t* WT; const float* ksc; int K, N, k0, n0, drow0; };
__device__ __forceinline__ unsigned char* ldptr(int i);
constexpr int CVT_PER_J = 768 + 256 + 176 + 144 + 128 + 256;
constexpr int CVT_MIX = 2 * CVT_PER_J, CVT_EXP = 4 * NE * 288, CVT_ITEMS = CVT_MIX + CVT_EXP;
__device__ __forceinline__ void cvt_decode(int it, CvtItem& c, unsigned char* ws) {
    if (it < CVT_MIX) {
        const int j = it / CVT_PER_J; int r = it - j * CVT_PER_J; int kb, nb;
        if (r < 768) { c.K = 1024; c.N = 3072; c.W = (const float*)ldptr(I_CWIN) + (size_t)j * 1024 * 3072; c.WT = (bf16_t*)(ws + WS_WIN) + (size_t)j * 3072 * 1024; c.ksc = (const float*)ldptr(I_CNW) + j * 1024;
            kb = r / 48; nb = r % 48; const int n0 = nb * 64;
            if (n0 < 1024) c.drow0 = n0; else if (n0 < 2048) { const int q = n0 - 1024; c.drow0 = 1024 + (q >> 7) * 256 + (q & 127); } else { const int q = n0 - 2048; c.drow0 = 1024 + (q >> 7) * 256 + 128 + (q & 127); } }
        else if ((r -= 768) < 256) { c.K = 1024; c.N = 1024; c.W = (const float*)ldptr(I_CWOUT) + (size_t)j * 1024 * 1024; c.WT = (bf16_t*)(ws + WS_WOUTC) + (size_t)j * 1024 * 1024; c.ksc = nullptr; kb = r / 16; nb = r % 16; c.drow0 = nb * 64; }
        else if ((r -= 256) < 176) { c.K = 1024; c.N = LAT; c.W = (const float*)ldptr(I_MWDOWN) + (size_t)j * 1024 * LAT; c.WT = (bf16_t*)(ws + WS_WDOWN) + (size_t)j * LATP * 1024; c.ksc = (const float*)ldptr(I_MNW) + j * 1024; kb = r / 11; nb = r % 11; c.drow0 = nb * 64; }
        else if ((r -= 176) < 144) { c.K = QLR; c.N = NH * DQK; c.W = (const float*)ldptr(I_MWQ) + (size_t)j * QLR * NH * DQK; c.WT = (bf16_t*)(ws + WS_WQ + (size_t)j * 1536 * 1024); c.ksc = (const float*)ldptr(I_MQLN) + j * QLR; kb = r / 24; nb = r % 24; c.drow0 = nb * 64; }
        else if ((r -= 144) < 128) { c.K = KVLR; c.N = NH * 256; c.W = (const float*)ldptr(I_MWKV) + (size_t)j * KVLR * NH * 256; c.WT = (bf16_t*)(ws + WS_WKV) + (size_t)j * 2048 * 256; c.ksc = (const float*)ldptr(I_MKVLN) + j * KVLR; kb = r / 32; nb = r % 32; c.drow0 = nb * 64; }
        else { r -= 128; c.K = 1024; c.N = 1024; c.W = (const float*)ldptr(I_MWO) + (size_t)j * 1024 * 1024; c.WT = (bf16_t*)(ws + WS_WO) + (size_t)j * 1024 * 1024; c.ksc = nullptr; kb = r / 16; nb = r % 16; c.drow0 = nb * 64; }
        c.k0 = kb * 64; c.n0 = nb * 64;
    } else {
        const int r = it - CVT_MIX; const int le = r / 288, q = r - le * 288, L = le >> 6; const int kind = q / 96, idx = q - kind * 96; int kb, nb;
        if (kind < 2) { c.K = 1024; c.N = DFF; c.W = (const float*)ldptr(kind == 0 ? I_EWG : I_EWU) + (size_t)le * 1024 * DFF; c.WT = (bf16_t*)(ws + WS_WE1) + (size_t)le * 768 * 1024; c.ksc = (const float*)ldptr(I_FNW) + L * 1024;
            kb = idx / 6; nb = idx % 6; const int n0 = nb * 64; c.drow0 = (n0 >> 7) * 256 + kind * 128 + (n0 & 127); }
        else { c.K = DFF; c.N = 1024; c.W = (const float*)ldptr(I_EWD) + (size_t)le * DFF * 1024; c.WT = (bf16_t*)(ws + WS_WE2) + (size_t)le * 1024 * DFF; c.ksc = nullptr; kb = idx / 16; nb = idx % 16; c.drow0 = nb * 64; }
        c.k0 = kb * 64; c.n0 = nb * 64;
    }
}
__device__ __forceinline__ void cvt_load(const CvtItem& c, f32x4 (&v)[16], int lane) {
    const float* p = c.W + (size_t)(c.k0 + (lane >> 4)) * c.N + c.n0 + 4 * (lane & 15);
#pragma unroll
    for (int i = 0; i < 16; ++i) v[i] = *(const f32x4*)(p + (size_t)(4 * i) * c.N);
}
__device__ __forceinline__ void cvt_lds_write(LAS float* tile, const f32x4 (&v)[16], int lane) {
#pragma unroll
    for (int i = 0; i < 16; ++i) { const int r = 4 * i + (lane >> 4), n = 4 * (lane & 15), x = r & 31; LAS float* row = tile + r * 64;
        row[(n + 0) ^ x] = v[i].x; row[(n + 1) ^ x] = v[i].y; row[(n + 2) ^ x] = v[i].z; row[(n + 3) ^ x] = v[i].w; }
}
__device__ __forceinline__ void cvt_out(const CvtItem& c, const LAS float* tile, int lane) {
    const int cc = lane & 7, np = lane >> 3;
    f32x4 s0 = {1.f, 1.f, 1.f, 1.f}, s1 = {1.f, 1.f, 1.f, 1.f};
    if (c.ksc) { s0 = *(const f32x4*)(c.ksc + c.k0 + 8 * cc); s1 = *(const f32x4*)(c.ksc + c.k0 + 8 * cc + 4); }
#pragma unroll
    for (int jj = 0; jj < 8; ++jj) { const int n = np + 8 * jj; float t[8];
#pragma unroll
        for (int q = 0; q < 8; ++q) { const int k = 8 * cc + q; t[q] = tile[k * 64 + (n ^ (k & 31))]; }
        u32x4 o; o.x = pk2(t[0] * s0.x, t[1] * s0.y); o.y = pk2(t[2] * s0.z, t[3] * s0.w); o.z = pk2(t[4] * s1.x, t[5] * s1.y); o.w = pk2(t[6] * s1.z, t[7] * s1.w);
        *(GAS u32x4*)(c.WT + (size_t)(c.drow0 + n) * c.K + c.k0 + 8 * cc) = o; }
}

constexpr int CVT_LAYER = NE * 288, CVT_W4 = 1024, CVT_W3 = 5120, CVT_WR = 2048, CVT_WG = 3072;
__host__ __device__ constexpr int cvt_layer_end(int Tl) { return CVT_MIX + (Tl + 1) * CVT_LAYER; }
__host__ __device__ constexpr int cvt_deferred(int Tl) { return CVT_WR + ((Tl & 1) ? CVT_WG : 0) + (Tl == 1 ? CVT_WR : 0) + CVT_W3 + CVT_W4; }
template <class Map>
__device__ __forceinline__ void cvt_loop(LAS unsigned char* lds, int count, int widx, int nw, int wave, int lane, Map map) {
    unsigned char* ws = ldptr(24);
    LAS float* tile = (LAS float*)(lds + wave * 16384);
    CvtItem cur, nxt; f32x4 v[16]; int it = widx;
    if (it < count) { cvt_decode(map(it), cur, ws); cvt_load(cur, v, lane); }
    while (it < count) {
        cvt_lds_write(tile, v, lane);
        const int itn = it + nw;
        if (itn < count) { cvt_decode(map(itn), nxt, ws); cvt_load(nxt, v, lane); }
        LDS_WAIT(); asm volatile("" ::: "memory");
        cvt_out(cur, tile, lane);
        LDS_WAIT(); asm volatile("" ::: "memory");
        cur = nxt; it = itn;
    }
}
__device__ __forceinline__ void cvt_window(LAS unsigned char* lds, int first, int count, int bx, int grid, int wave, int lane) {
    if (grid != 256 || bx < 128) return;
    cvt_loop(lds, count, (bx - 128) * NWAVES + wave, 128 * NWAVES, wave, lane, [first](int i) { return first + i; });
}
__device__ __forceinline__ void prologue_phase(LAS unsigned char* lds, int gw, int NGW, int wave, int lane, int gtid, int NGT, int grid) {
    unsigned char* ws = ldptr(24);
    {
        const int D1 = (grid == 256) ? cvt_deferred(1) : 0, D2 = (grid == 256) ? cvt_deferred(2) : 0, D3 = (grid == 256) ? cvt_deferred(3) : 0;
        const int s1 = cvt_layer_end(1) - D1, s2 = s1 + (cvt_layer_end(2) - D2 - cvt_layer_end(1));
        cvt_loop(lds, CVT_ITEMS - D1 - D2 - D3, gw, NGW, wave, lane, [=](int i) { return i < s1 ? i : (i < s2 ? i + D1 : i + D1 + D2); });
    }
    const float* fnw = (const float*)ldptr(I_FNW); const float* rwg = (const float*)ldptr(I_RWG); const float* rwe = (const float*)ldptr(I_RWE);
    for (int i = gtid; i < 4 * 256 * 128; i += NGT) {
        const int L = i >> 15, n = (i >> 7) & 255, k8 = (i & 127) * 8;
        u32x4 o = {0u, 0u, 0u, 0u};
        if (n < 72) { float v[8];
#pragma unroll
            for (int q = 0; q < 8; ++q) { const int k = k8 + q; const float g = fnw[L * 1024 + k];
                v[q] = g * (n < 8 ? rwg[((size_t)L * 1024 + k) * 8 + n] : rwe[((size_t)L * 1024 + k) * 64 + (n - 8)]); }
            o.x = pk2(v[0], v[1]); o.y = pk2(v[2], v[3]); o.z = pk2(v[4], v[5]); o.w = pk2(v[6], v[7]); }
        *(u32x4*)((bf16_t*)(ws + WS_WRT) + ((size_t)L * 256 + n) * 1024 + k8) = o;
    }
    for (int i = gtid; i < 2 * 64 * 128; i += NGT) { const int j = i >> 13, n = LAT + ((i >> 7) & 63), k8 = (i & 127) * 8;
        *(u32x4*)((bf16_t*)(ws + WS_WDOWN) + ((size_t)j * LATP + n) * 1024 + k8) = (u32x4){0u, 0u, 0u, 0u}; }
}

template <bool XF32_IN, bool F32_OUT>
__device__ __forceinline__ void resid_phase(const void* xin, const unsigned char* Y, void* xout, float* rinv, int gw, int NGW, int lane) {
    for (int m = gw; m < T; m += NGW) {
        f32x4 v[4];
        if constexpr (XF32_IN) { const f32x4* xr = (const f32x4*)((const float*)xin + (size_t)m * DM) + lane;
#pragma unroll
            for (int j = 0; j < 4; ++j) v[j] = xr[64 * j]; }
        else { const u32x2* xr = (const u32x2*)((const bf16_t*)xin + (size_t)m * DM) + lane;
#pragma unroll
            for (int j = 0; j < 4; ++j) { const u32x2 p = xr[64 * j]; v[j] = (f32x4){bflo(p.x), bfhi(p.x), bflo(p.y), bfhi(p.y)}; } }
        if (Y) { const unsigned* y0 = (const unsigned*)(Y + (size_t)(2 * m) * DM) + lane; const unsigned* y1 = y0 + 256;
#pragma unroll
            for (int j = 0; j < 4; ++j) { float p[4], q[4]; up4_fp8(y0[64 * j], p); up4_fp8(y1[64 * j], q);
                v[j].x += (p[0] + q[0]) * 0.0625f; v[j].y += (p[1] + q[1]) * 0.0625f; v[j].z += (p[2] + q[2]) * 0.0625f; v[j].w += (p[3] + q[3]) * 0.0625f; } }
        if constexpr (F32_OUT) { f32x4* xo = (f32x4*)((float*)xout + (size_t)m * DM) + lane;
#pragma unroll
            for (int j = 0; j < 4; ++j) xo[64 * j] = v[j]; }
        else { u32x2* xo = (u32x2*)((bf16_t*)xout + (size_t)m * DM) + lane;
#pragma unroll
            for (int j = 0; j < 4; ++j) { u32x2 w; w.x = pk2(v[j].x, v[j].y); w.y = pk2(v[j].z, v[j].w); xo[64 * j] = w; } }
        if (rinv) { float s = 0.f;
#pragma unroll
            for (int j = 0; j < 4; ++j) s += (v[j].x * v[j].x + v[j].y * v[j].y) + (v[j].z * v[j].z + v[j].w * v[j].w);
            const float r = 1.0f / sqrtf(wave_sum(s, lane) * (1.f / DM) + EPS);
            if (lane == 0) rinv[m] = r; }
    }
}

__device__ __forceinline__ void conv_phase(const bf16_t* GBp, const bf16_t* Zp, const float* ck, bf16_t* YCp, int gtid, int NGT) {
    for (int i = gtid; i < T * 128; i += NGT) {
        const int t = i >> 7, c8 = (i & 127) * 8, s = t & (SEQ - 1);
        const u32x4 zc = *(const u32x4*)(Zp + (size_t)t * DM + c8), g = *(const u32x4*)(GBp + (size_t)t * DM + c8);
        u32x4 zm = {0u, 0u, 0u, 0u}, zp = {0u, 0u, 0u, 0u};
        if (s > 0) zm = *(const u32x4*)(Zp + (size_t)(t - 1) * DM + c8);
        if (s < SEQ - 1) zp = *(const u32x4*)(Zp + (size_t)(t + 1) * DM + c8);
        const f32x4 k0a = *(const f32x4*)(ck + c8), k0b = *(const f32x4*)(ck + c8 + 4), k1a = *(const f32x4*)(ck + DM + c8), k1b = *(const f32x4*)(ck + DM + c8 + 4), k2a = *(const f32x4*)(ck + 2 * DM + c8), k2b = *(const f32x4*)(ck + 2 * DM + c8 + 4);
        float y[8];
#define CV(q, W, KA, LOHI) y[q] = LOHI(g.W) * (LOHI(zm.W) * k0##KA + LOHI(zc.W) * k1##KA + LOHI(zp.W) * k2##KA)
        CV(0, x, a[0], bflo); CV(1, x, a[1], bfhi); CV(2, y, a[2], bflo); CV(3, y, a[3], bfhi); CV(4, z, b[0], bflo); CV(5, z, b[1], bfhi); CV(6, w, b[2], bflo); CV(7, w, b[3], bfhi);
#undef CV
        u32x4 o; o.x = pk2(y[0], y[1]); o.y = pk2(y[2], y[3]); o.z = pk2(y[4], y[5]); o.w = pk2(y[6], y[7]);
        *(u32x4*)(YCp + (size_t)t * DM + c8) = o;
    }
}


__device__ __forceinline__ void ld16bf(const bf16_t* p, float* v) { const u32x4 a = *(const u32x4*)p, b = *(const u32x4*)(p + 8);
    v[0] = bflo(a.x); v[1] = bfhi(a.x); v[2] = bflo(a.y); v[3] = bfhi(a.y); v[4] = bflo(a.z); v[5] = bfhi(a.z); v[6] = bflo(a.w); v[7] = bfhi(a.w);
    v[8] = bflo(b.x); v[9] = bfhi(b.x); v[10] = bflo(b.y); v[11] = bfhi(b.y); v[12] = bflo(b.z); v[13] = bfhi(b.z); v[14] = bflo(b.w); v[15] = bfhi(b.w); }
__device__ __forceinline__ void ld16f8(const unsigned char* p, float* v) { const u32x4 a = *(const u32x4*)p; up4_fp8(a.x, v); up4_fp8(a.y, v + 4); up4_fp8(a.z, v + 8); up4_fp8(a.w, v + 12); }
__device__ __forceinline__ void ld4f8(const unsigned char* p, float* v) { up4_fp8(*(const unsigned*)p, v); }
__device__ __forceinline__ void ld4bf(const bf16_t* p, float* v) { const u32x2 a = *(const u32x2*)p; v[0] = bflo(a.x); v[1] = bfhi(a.x); v[2] = bflo(a.y); v[3] = bfhi(a.y); }
constexpr int QK_VP = 1040;
struct QkIn { u32x4 l0, l1, q16, k16, v16; u32x2 ra, rb; unsigned qa, qb; int pos; };
__device__ __forceinline__ void qk_load(QkIn& in, int t, const bf16_t* LATb, const unsigned char* QRAW, const unsigned char* KVRAW, const int* pos, int lane) {
    const int h = lane >> 3, i8 = lane & 7;
    const u32x4* ls = (const u32x4*)(LATb + (size_t)t * LATP);
    in.l0 = ls[lane]; in.l1 = (u32x4){0u, 0u, 0u, 0u}; if (lane < 24) in.l1 = ls[lane + 64];
    const unsigned char* qh = QRAW + (size_t)t * 1536 + h * DQK;
    in.q16 = *(const u32x4*)(qh + 16 * i8); in.qa = *(const unsigned*)(qh + 128 + 4 * i8); in.qb = *(const unsigned*)(qh + 160 + 4 * i8);
    const unsigned char* kh = KVRAW + (size_t)t * 2048 + h * 256;
    in.k16 = *(const u32x4*)(kh + 16 * i8); in.v16 = *(const u32x4*)(kh + 128 + 16 * i8);
    const bf16_t* lr = LATb + (size_t)t * LATP + 640;
    in.ra = *(const u32x2*)(lr + 4 * i8); in.rb = *(const u32x2*)(lr + 32 + 4 * i8);
    in.pos = pos[t];
}
__device__ __forceinline__ void up16_fp8(const u32x4 a, float* v) { up4_fp8(a.x, v); up4_fp8(a.y, v + 4); up4_fp8(a.z, v + 8); up4_fp8(a.w, v + 12); }
__device__ __forceinline__ void up4_bf(const u32x2 a, float* v) { v[0] = bflo(a.x); v[1] = bfhi(a.x); v[2] = bflo(a.y); v[3] = bfhi(a.y); }
__device__ __forceinline__ void qkprep8_phase(const bf16_t* LATb, const unsigned char* QRAW, const unsigned char* KVRAW, const int* pos, const float* qhn, const float* khn,
                                              unsigned char* Q8, unsigned char* K8, unsigned char* VT8, LAS unsigned char* lds, int vcu, int G, int wave, int lane, int tid) {
    const int h = lane >> 3, i8 = lane & 7;
    float gq[24], gk[24], invf[4];
#pragma unroll
    for (int q = 0; q < 16; ++q) { gq[q] = qhn[16 * i8 + q]; gk[q] = khn[16 * i8 + q]; }
#pragma unroll
    for (int q = 0; q < 4; ++q) { gq[16 + q] = qhn[128 + 4 * i8 + q]; gq[20 + q] = qhn[160 + 4 * i8 + q]; gk[16 + q] = khn[128 + 4 * i8 + q]; gk[20 + q] = khn[160 + 4 * i8 + q];
        invf[q] = powf(10000.f, -(float)(4 * i8 + q) * (1.f / 32.f)); }
    QkIn cur, nxt;
    if (vcu < T / 64) qk_load(cur, vcu * 64 + wave * 8, LATb, QRAW, KVRAW, pos, lane);
    for (int tile = vcu; tile < T / 64; tile += G) {
        for (int tt = 0; tt < 8; ++tt) {
            const int kk = wave * 8 + tt, t = tile * 64 + kk, b = t >> 14, s = t & (SEQ - 1);
            { const int tn = (tt < 7) ? t + 1 : (tile + G) * 64 + wave * 8; if (tn < T) qk_load(nxt, tn, LATb, QRAW, KVRAW, pos, lane); }
            const u32x4 l0 = cur.l0, l1 = cur.l1;
#define SS4(V_) (bflo(V_.x) * bflo(V_.x) + bfhi(V_.x) * bfhi(V_.x) + bflo(V_.y) * bflo(V_.y) + bfhi(V_.y) * bfhi(V_.y) + bflo(V_.z) * bflo(V_.z) + bfhi(V_.z) * bfhi(V_.z) + bflo(V_.w) * bflo(V_.w) + bfhi(V_.w) * bfhi(V_.w))
            const float s0 = SS4(l0), s1 = SS4(l1);
#undef SS4
            const float ssq_q = wave_sum(lane < 48 ? s0 : 0.f, lane), ssq_kv = wave_sum((lane >= 48 ? s0 : 0.f) + (lane < 16 ? s1 : 0.f), lane);
            const float r_q = __builtin_amdgcn_rsqf(ssq_q * (1.f / QLR) + EPS), r_kv = __builtin_amdgcn_rsqf(ssq_kv * (1.f / KVLR) + EPS);
            float cj[4], sj[4]; const float fpos = (float)cur.pos;
#pragma unroll
            for (int q = 0; q < 4; ++q) { const float ang = fpos * invf[q]; const double rev = (double)ang * 0.15915494309189535; const float fr = (float)(rev - floor(rev));
                cj[q] = __builtin_amdgcn_cosf(fr); sj[q] = __builtin_amdgcn_sinf(fr); }
            const size_t orow = ((size_t)(b * NH + h) * SEQ + s) * DQK;
            {
                float v[24];
                up16_fp8(cur.q16, v); up4_fp8(cur.qa, v + 16); up4_fp8(cur.qb, v + 20);
                float ss = 0.f;
#pragma unroll
                for (int q = 0; q < 24; ++q) ss += v[q] * v[q];
                ss += lane_xor_f(ss, 1, lane); ss += lane_xor_f(ss, 2, lane); ss += lane_xor_f(ss, 4, lane);
                const float sc = r_q * __builtin_amdgcn_rsqf(r_q * r_q * ss * (1.f / DQK) + EPS) * (8.f * 0.07216878364870322f * 1.4426950408889634f);
#pragma unroll
                for (int q = 0; q < 24; ++q) v[q] *= sc * gq[q];
                u32x4 w; w.x = pk4_fp8(v[0], v[1], v[2], v[3]); w.y = pk4_fp8(v[4], v[5], v[6], v[7]); w.z = pk4_fp8(v[8], v[9], v[10], v[11]); w.w = pk4_fp8(v[12], v[13], v[14], v[15]);
                *(u32x4*)(Q8 + orow + 16 * i8) = w;
                float o1[4], o2[4];
#pragma unroll
                for (int q = 0; q < 4; ++q) { o1[q] = v[16 + q] * cj[q] - v[20 + q] * sj[q]; o2[q] = v[20 + q] * cj[q] + v[16 + q] * sj[q]; }
                *(unsigned*)(Q8 + orow + 128 + 4 * i8) = pk4_fp8(o1[0], o1[1], o1[2], o1[3]); *(unsigned*)(Q8 + orow + 160 + 4 * i8) = pk4_fp8(o2[0], o2[1], o2[2], o2[3]); }
            {
                float v[24], vv[16];
                up16_fp8(cur.k16, v); up4_bf(cur.ra, v + 16); up4_bf(cur.rb, v + 20); up16_fp8(cur.v16, vv);
#pragma unroll
                for (int q = 0; q < 16; ++q) v[q] *= r_kv;
                float ss = 0.f;
#pragma unroll
                for (int q = 0; q < 24; ++q) ss += v[q] * v[q];
                ss += lane_xor_f(ss, 1, lane); ss += lane_xor_f(ss, 2, lane); ss += lane_xor_f(ss, 4, lane);
                const float sc = __builtin_amdgcn_rsqf(ss * (1.f / DQK) + EPS);
#pragma unroll
                for (int q = 0; q < 24; ++q) v[q] *= sc * gk[q];
                u32x4 w; w.x = pk4_fp8(v[0], v[1], v[2], v[3]); w.y = pk4_fp8(v[4], v[5], v[6], v[7]); w.z = pk4_fp8(v[8], v[9], v[10], v[11]); w.w = pk4_fp8(v[12], v[13], v[14], v[15]);
                *(u32x4*)(K8 + orow + 16 * i8) = w;
                float o1[4], o2[4];
#pragma unroll
                for (int q = 0; q < 4; ++q) { o1[q] = v[16 + q] * cj[q] - v[20 + q] * sj[q]; o2[q] = v[20 + q] * cj[q] + v[16 + q] * sj[q]; }
                *(unsigned*)(K8 + orow + 128 + 4 * i8) = pk4_fp8(o1[0], o1[1], o1[2], o1[3]); *(unsigned*)(K8 + orow + 160 + 4 * i8) = pk4_fp8(o2[0], o2[1], o2[2], o2[3]);
                u32x4 wv; wv.x = pk4_fp8(vv[0] * r_kv, vv[1] * r_kv, vv[2] * r_kv, vv[3] * r_kv); wv.y = pk4_fp8(vv[4] * r_kv, vv[5] * r_kv, vv[6] * r_kv, vv[7] * r_kv);
                wv.z = pk4_fp8(vv[8] * r_kv, vv[9] * r_kv, vv[10] * r_kv, vv[11] * r_kv); wv.w = pk4_fp8(vv[12] * r_kv, vv[13] * r_kv, vv[14] * r_kv, vv[15] * r_kv);
                *(LAS u32x4*)(lds + kk * QK_VP + h * 128 + 16 * i8) = wv; }
            cur = nxt;
        }
        __syncthreads();
        {
            const int t0 = tile * 64, b = t0 >> 14, st = (t0 & (SEQ - 1)) >> 6;
#pragma unroll
            for (int it = 0; it < 2; ++it) { const int item = tid + 512 * it, c = item & 3, n4 = (item >> 2) & 31, hh = item >> 7;
                const LAS unsigned char* src = lds + hh * 128 + n4 * 4; unsigned o[4][4];
#pragma unroll
                for (int j = 0; j < 4; ++j) { const int kb = 32 * (c & 1) + 8 * j + 4 * (c >> 1);
                    const unsigned d0 = *(const LAS unsigned*)(src + (kb + 0) * QK_VP), d1 = *(const LAS unsigned*)(src + (kb + 1) * QK_VP), d2 = *(const LAS unsigned*)(src + (kb + 2) * QK_VP), d3 = *(const LAS unsigned*)(src + (kb + 3) * QK_VP);
                    const unsigned t0_ = __builtin_amdgcn_perm(d1, d0, 0x05010400u), t1_ = __builtin_amdgcn_perm(d1, d0, 0x07030602u), t2_ = __builtin_amdgcn_perm(d3, d2, 0x05010400u), t3_ = __builtin_amdgcn_perm(d3, d2, 0x07030602u);
                    o[0][j] = __builtin_amdgcn_perm(t2_, t0_, 0x05040100u); o[1][j] = __builtin_amdgcn_perm(t2_, t0_, 0x07060302u); o[2][j] = __builtin_amdgcn_perm(t3_, t1_, 0x05040100u); o[3][j] = __builtin_amdgcn_perm(t3_, t1_, 0x07060302u); }
                unsigned char* dst = VT8 + ((size_t)(b * NH + hh) * (SEQ / 64) + st) * 8192 + (4 * n4) * 64 + 16 * c;
#pragma unroll
                for (int r = 0; r < 4; ++r) *(u32x4*)(dst + r * 64) = (u32x4){o[r][0], o[r][1], o[r][2], o[r][3]}; } }
        __syncthreads();
    }
}

__device__ __forceinline__ int build_tables(gu32* cnt, LAS int* tbl, LAS int* cntl, int tid) {
    if (tid < 64) {
        const int c = (int)__hip_atomic_load(cnt + 32 * tid, RLX_AGENT); const int nt = (c + 255) >> 8;
        int incl = nt;
#pragma unroll
        for (int o = 1; o < 64; o <<= 1) { const int v = __builtin_amdgcn_ds_bpermute((tid - o) << 2, incl); if (tid >= o) incl += v; }
        const int start = incl - nt; cntl[tid] = c; if (tid == 63) cntl[64] = incl;
        for (int q = 0; q < nt; ++q) tbl[start + q] = (tid << 16) | q;
    }
    __syncthreads();
    return cntl[64];
}

constexpr int PTAB_OFF = MISC_OFF + 128;
__device__ __forceinline__ unsigned char* ldptr(int i) {
    extern __shared__ __attribute__((aligned(16))) unsigned char lds_raw[];
    volatile LAS unsigned* pt = (volatile LAS unsigned*)((LAS unsigned char*)lds_raw + PTAB_OFF) + 2 * sgpr_now(i);
    const unsigned lo = __builtin_amdgcn_readfirstlane(pt[0]), hi = __builtin_amdgcn_readfirstlane(pt[1]);
    return (unsigned char*)(GAS unsigned char*)(((unsigned long long)hi << 32) | lo);
}
#define P_IN(i) ((const float*)ldptr(i))
#define P_OUT() ((float*)ldptr(23))
#define P_WS() (ldptr(24))
__device__ __forceinline__ void grid_barrier(int tid) {
    extern __shared__ __attribute__((aligned(16))) unsigned char lds_raw[];
    XcdBarrier b; b.bar = (unsigned*)(P_WS() + WS_CTL) + CW_BAR; b.x = xb_xcc_id(); b.st = (volatile LAS unsigned*)((LAS unsigned char*)lds_raw + MISC_OFF) + 8;
    xcd_barrier(b, tid == 0);
}

#define IN(k) (lo <= (k) && (k) < hi)
#define SEAM(k) do { if (hi > (k) + 1) grid_barrier(TID); } while (0)
#define TID (tid_now(wave_s))
#define LANE (tid_now(wave_s) & 63)
#define WAVE (sgpr_now(wave_s))
#define GRID (sgpr_now((int)gridDim.x))
#define BX (sgpr_now((int)blockIdx.x))
#define VCU ((GRID % 8 == 0) ? (BX % 8) * (GRID / 8) + BX / 8 : BX)
#define GW (VCU * NWAVES + WAVE)
#define NGW (GRID * NWAVES)
#define GTID (BX * (NWAVES * 64) + TID)
#define NGT (GRID * NWAVES * 64)
#define TBL ((LAS int*)(lds + TBL_OFF))
#define PSTART (TBL + 384)


template <int L>
__device__ __forceinline__ void layer_body(LAS unsigned char* lds, const int lo, const int hi, const int wave_s) {
    extern __shared__ __attribute__((aligned(16))) unsigned char lds_raw[];
        const int pb = 1 + 12 * L;
#define XBP ((bf16_t*)(ws + WS_XB))
#define RINVP ((float*)(ws + WS_RINV))
#define PSQP ((float*)(ws + WS_PSQ))
#define YP ((const unsigned char*)(ws + WS_Y))
        if (IN(pb + 0)) { unsigned char* ws = P_WS();
            if (L == 0) resid_phase<true, false>(P_IN(I_X), nullptr, XBP, RINVP, GW, NGW, LANE);
            else resid_phase<false, false>(XBP, YP, XBP, RINVP, GW, NGW, LANE);
            SEAM(pb + 0); }
        if ((L & 1) == 0) {
            if (IN(pb + 1)) { unsigned char* ws = P_WS(); const int j = L >> 1;
                pg8::Gemm g{DM, DM, nullptr}; pg8::StaticOrder S; S.init(ws + WS_XB, DM, (bf16_t*)(ws + WS_WIN) + (size_t)j * 3072 * 1024, DM, T, 3072, GRID, BX);
                pg8::EpiConvIn E{(bf16_t*)(ws + WS_GB), (bf16_t*)(ws + WS_Z), RINVP}; pg8::gemm_phase(lds, g, S, E, TID); SEAM(pb + 1); }
            if (IN(pb + 2)) { unsigned char* ws = P_WS(); const int j = L >> 1;
                conv_phase((const bf16_t*)(ws + WS_GB), (const bf16_t*)(ws + WS_Z), P_IN(I_CK) + j * 3 * DM, (bf16_t*)(ws + WS_YC), GTID, NGT); SEAM(pb + 2); }
            if (IN(pb + 3)) { unsigned char* ws = P_WS(); const int j = L >> 1;
                pg8::Gemm g{DM, DM, nullptr}; pg8::StaticOrder S; S.init(ws + WS_YC, DM, (bf16_t*)(ws + WS_WOUTC) + (size_t)j * 1024 * 1024, DM, T, DM, GRID, BX);
                pg8::EpiResid E{XBP, PSQP, LANE}; pg8::gemm_phase(lds, g, S, E, TID); SEAM(pb + 5); }
        } else {
            if (IN(pb + 1)) { unsigned char* ws = P_WS(); const int j = L >> 1;
                pg8::Gemm g{DM, DM, nullptr}; pg8::StaticOrder S; S.init(ws + WS_XB, DM, (bf16_t*)(ws + WS_WDOWN) + (size_t)j * LATP * 1024, DM, T, LATP, GRID, BX);
                pg8::EpiBf16 E{(bf16_t*)(ws + WS_LAT), LATP, RINVP}; pg8::gemm_phase(lds, g, S, E, TID);
                cvt_window(lds, cvt_layer_end(L) - CVT_WR - CVT_WG, CVT_WG, BX, GRID, WAVE, LANE);
                SEAM(pb + 1); }
            if (IN(pb + 2)) {
                { unsigned char* ws = P_WS(); const int j = L >> 1;
                  pg8::Gemm g{LATP, QLR, nullptr}; pg8::StaticOrder S; S.init(ws + WS_LAT, LATP, ws + WS_WQ + (size_t)j * 1536 * 1024, QLR, T, 1536, GRID, BX);
                  pg8::EpiFp8 E{ws + WS_QRAW, 1536}; pg8::gemm_phase(lds, g, S, E, TID); }
                { unsigned char* ws = P_WS(); const int j = L >> 1;
                  pg8::Gemm g{LATP, KVLR, nullptr}; pg8::StaticOrder S; S.init((bf16_t*)(ws + WS_LAT) + QLR, LATP, (bf16_t*)(ws + WS_WKV) + (size_t)j * 2048 * 256, KVLR, T, 2048, GRID, BX);
                  pg8::EpiFp8 E{ws + WS_KVRAW, 2048}; pg8::gemm_phase(lds, g, S, E, TID); }
                SEAM(pb + 2); }
            if (IN(pb + 3)) { unsigned char* ws = P_WS(); const int j = L >> 1;
                qkprep8_phase((const bf16_t*)(ws + WS_LAT), ws + WS_QRAW, ws + WS_KVRAW, (const int*)P_IN(I_POS),
                              P_IN(I_MQHN) + j * DQK, P_IN(I_MKHN) + j * DQK, ws + WS_Q, ws + WS_K, ws + WS_V, lds, VCU, GRID, WAVE, LANE, TID); SEAM(pb + 3); }
            if (IN(pb + 4)) {
                for (int i = 0;; ++i) {
                    int bh, qb;
                    if (GRID == 256) { if (i >= 4) break; const int idx = i * 32 + (VCU & 31); bh = 2 * (VCU >> 5) + (idx >> 6); qb = idx & 63; }
                    else { const int k = i * GRID + BX; if (k >= NB * NH * 64) break; bh = k >> 6; qb = k & 63; }
                    const int b = bh >> 3, h = bh & 7; unsigned char* ws = P_WS();
                    att8::attn_unit_pp(ws + WS_Q + ((size_t)bh * SEQ + qb * 256) * DQK, ws + WS_K + (size_t)bh * SEQ * DQK, ws + WS_V + (size_t)bh * SEQ * DV,
                                       (bf16_t*)(ws + WS_O) + ((size_t)(b * SEQ + qb * 256)) * DM + h * DV, (char*)lds_raw, TID);
                }
                SEAM(pb + 4); }
            if (IN(pb + 5)) { unsigned char* ws = P_WS(); const int j = L >> 1;
                pg8::Gemm g{DM, DM, nullptr}; pg8::StaticOrder S; S.init(ws + WS_O, DM, (bf16_t*)(ws + WS_WO) + (size_t)j * 1024 * 1024, DM, T, DM, GRID, BX);
                pg8::EpiResid E{XBP, PSQP, LANE}; pg8::gemm_phase(lds, g, S, E, TID); SEAM(pb + 5); }
        }
#define CNT ((gu32*)(ws + WS_CTL) + CW_CNT + L * 64 * 32)
        if (IN(pb + 7)) { unsigned char* ws = P_WS();
            pg8::Gemm g{DM, DM, nullptr}; pg8::StaticOrder S; S.init(ws + WS_XB, DM, (bf16_t*)(ws + WS_WRT) + (size_t)L * 256 * 1024, DM, T, 256, GRID, BX);
            { pg8::Unit u0; const int t_ = TID;
              if (S.next(0, u0) && t_ < 256) { const f32x4* q = (const f32x4*)(PSQP + (size_t)(u0.pm * 256 + t_) * 16); const f32x4 a = q[0], b = q[1], c = q[2], d = q[3];
                  const float ssum = ((a.x + a.y) + (a.z + a.w)) + ((b.x + b.y) + (b.z + b.w)) + ((c.x + c.y) + (c.z + c.w)) + ((d.x + d.y) + (d.z + d.w));
                  RINVP[u0.pm * 256 + t_] = 1.0f / sqrtf(ssum * (1.f / DM) + EPS); }
              VM_WAIT(); __syncthreads(); }
            pg8::EpiRoute E{RINVP, P_IN(I_RBG) + L * 8, P_IN(I_RBE) + L * 64, CNT, (int*)(ws + WS_SA), (float*)(ws + WS_SG), (float*)(ws + WS_SS)};
            pg8::gemm_phase<false, true>(lds, g, S, E, TID);
            cvt_window(lds, cvt_layer_end(L == 0 ? 1 : L) - (L == 0 ? 2 * CVT_WR + CVT_WG : CVT_WR), CVT_WR, BX, GRID, WAVE, LANE);
            SEAM(pb + 9); }
        if (IN(pb + 10)) { unsigned char* ws = P_WS(); const int ntiles = build_tables(CNT, TBL, PSTART, TID);
            pg8::Gemm g{DM, DM, (const int*)(ws + WS_SA)}; pg8::GroupedOrder S{ntiles * 3, 3, GRID, VCU, (const char*)(ws + WS_XB), (const char*)(ws + WS_WE1) + (size_t)L * NE * 768 * 1024 * 2, (size_t)0, (size_t)768 * 1024 * 2, (size_t)256 * 1024 * 2, TBL, PSTART};
            pg8::EpiSwiGLU E{(bf16_t*)(ws + WS_HID), (const float*)(ws + WS_SS)}; pg8::gemm_phase<true, false>(lds, g, S, E, TID);
            if (L < 3 && GRID == 256) {
                const int n_units = ntiles * 3, rounds = (n_units + 255) >> 8, nidle = rounds * 256 - n_units, first = cvt_layer_end(L + 1) - cvt_deferred(L + 1) + CVT_W4;
                if (nidle >= 32) { const int j = (rounds - 1) * 256 + VCU - n_units; if (j >= 0) cvt_loop(lds, CVT_W3, j * NWAVES + WAVE, nidle * NWAVES, WAVE, LANE, [first](int i) { return first + i; }); }
                else cvt_loop(lds, CVT_W3, VCU * NWAVES + WAVE, 256 * NWAVES, WAVE, LANE, [first](int i) { return first + i; });
            }
            SEAM(pb + 10); }
        if (IN(pb + 11)) { unsigned char* ws = P_WS(); const int ntiles = build_tables(CNT, TBL, PSTART, TID);
            pg8::Gemm g{DFF, DFF, nullptr}; pg8::GroupedOrder S{ntiles * 4, 4, GRID, VCU, (const char*)(ws + WS_HID), (const char*)(ws + WS_WE2) + (size_t)L * NE * 1024 * DFF * 2, (size_t)256 * DFF * 2, (size_t)1024 * DFF * 2, (size_t)256 * DFF * 2, TBL, PSTART};
            pg8::EpiScatterY E{ws + WS_Y, (const int*)(ws + WS_SA), (const float*)(ws + WS_SG)}; pg8::gemm_phase(lds, g, S, E, TID);
            if (L < 3 && GRID == 256) {
                const int n_units = ntiles * 4, rounds = (n_units + 255) >> 8, nidle = rounds * 256 - n_units, first = cvt_layer_end(L + 1) - cvt_deferred(L + 1);
                if (nidle >= 32) { const int j = (rounds - 1) * 256 + VCU - n_units; if (j >= 0) cvt_loop(lds, CVT_W4, j * NWAVES + WAVE, nidle * NWAVES, WAVE, LANE, [first](int i) { return first + i; }); }
                else cvt_loop(lds, CVT_W4, VCU * NWAVES + WAVE, 256 * NWAVES, WAVE, LANE, [first](int i) { return first + i; });
            }
            SEAM(pb + 11); }
    }

__global__ void __launch_bounds__(NWAVES * 64, 2) fwd(Args args) {
    extern __shared__ __attribute__((aligned(16))) unsigned char lds_raw[];
    LAS unsigned char* lds = (LAS unsigned char*)lds_raw;
    for (int u = threadIdx.x; u < (LDS_BYTES - LDSCTL_OFF) / 4; u += NWAVES * 64) ((LAS unsigned*)(lds + LDSCTL_OFF))[u] = 0u;
    __syncthreads();
    if (threadIdx.x == 0) { LAS unsigned long long* pt = (LAS unsigned long long*)(lds + PTAB_OFF);
#pragma unroll
        for (int i = 0; i < 23; ++i) pt[i] = (unsigned long long)args.in[i];
        pt[23] = (unsigned long long)args.out; pt[24] = (unsigned long long)args.ws; }
    __syncthreads();
    const int lo = args.ph_lo, hi = args.ph_hi;
    if (hi - lo > 1) (void)xcd_barrier_post((unsigned*)(P_WS() + WS_CTL) + CW_BAR, (volatile LAS unsigned*)(lds + MISC_OFF) + 8, threadIdx.x == 0);
    const int wave_s = __builtin_amdgcn_readfirstlane((int)threadIdx.x >> 6);
    if (IN(0)) { prologue_phase(lds, GW, NGW, WAVE, LANE, GTID, NGT, GRID); SEAM(0); }

    layer_body<0>(lds, lo, hi, wave_s); layer_body<1>(lds, lo, hi, wave_s); layer_body<2>(lds, lo, hi, wave_s); layer_body<3>(lds, lo, hi, wave_s);
    if (IN(49)) { unsigned char* ws = P_WS(); resid_phase<false, true>(XBP, YP, P_OUT(), nullptr, GW, NGW, LANE);
    }
#undef IN
#undef SEAM
}

extern "C" void kernel_launch(void* const* d_in, const int* in_sizes, int n_in, void* d_out, int out_size, void* d_ws, size_t ws_size, hipStream_t stream) {
    static int grid = 0;
    if (grid == 0) {
        if (n_in != 23 || out_size != T * DM || ws_size < WS_END) { fprintf(stderr, "kernel_launch: unexpected shapes: n_in %d out %d ws %zu (need %zu)\n", n_in, out_size, ws_size, (size_t)WS_END); grid = -1; return; }
        int dev = 0, cus = 0, per_cu = 0;
        if (hipGetDevice(&dev) != hipSuccess || hipDeviceGetAttribute(&cus, hipDeviceAttributeMultiprocessorCount, dev) != hipSuccess) { grid = -1; return; }
        if (hipFuncSetAttribute((const void*)fwd, hipFuncAttributeMaxDynamicSharedMemorySize, LDS_BYTES) != hipSuccess) { fprintf(stderr, "kernel_launch: hipFuncSetAttribute failed\n"); grid = -1; return; }
        if (hipOccupancyMaxActiveBlocksPerMultiprocessor(&per_cu, (const void*)fwd, NWAVES * 64, LDS_BYTES) != hipSuccess || per_cu < 1) fprintf(stderr, "kernel_launch: occupancy query says %d\n", per_cu);
        (void)hipGetLastError();
        grid = cus;
    }
    if (grid < 0) return;
    if (hipMemsetAsync((char*)d_ws + WS_CTL, 0, CTL_ZERO_BYTES, stream) != hipSuccess) return;
    Args a{};
    for (int i = 0; i < 23; ++i) a.in[i] = d_in[i];
    a.out = (float*)d_out; a.ws = (unsigned char*)d_ws;
#if MK_ONE_LAUNCH
    a.ph_lo = 0; a.ph_hi = 50;
    hipLaunchKernelGGL(fwd, dim3(grid), dim3(NWAVES * 64), LDS_BYTES, stream, a);
#else
    for (int p = 0; p < 50; ++p) {
        if (p >= 1 && p < 49) { const int L = (p - 1) / 12, k = (p - 1) % 12;
            if (k == 6 || k == 8 || k == 9) continue;
            if (k < 6 && (L & 1) == 0 && k > 3) continue;
        }
        a.ph_lo = p; a.ph_hi = p + 1;
        hipLaunchKernelGGL(fwd, dim3(grid), dim3(NWAVES * 64), LDS_BYTES, stream, a);
    }
#endif
    const hipError_t le = hipPeekAtLastError();
    if (le != hipSuccess) fprintf(stderr, "kernel_launch: launch failed: %s\n", hipGetErrorName(le));
}
```

```cpp
#include <hip/hip_runtime.h>
#include <cstdio>
#include <cstdint>

#ifndef MK_ONE_LAUNCH
#define MK_ONE_LAUNCH 1
#endif

#define GAS __attribute__((address_space(1)))
#define LAS __attribute__((address_space(3)))
typedef unsigned short bf16_t;
typedef short bf16x8 __attribute__((ext_vector_type(8)));
typedef short s16x4 __attribute__((ext_vector_type(4)));
typedef float f32x2 __attribute__((ext_vector_type(2)));
typedef float f32x4 __attribute__((ext_vector_type(4)));
typedef float f32x16 __attribute__((ext_vector_type(16)));
typedef unsigned u32x2 __attribute__((ext_vector_type(2)));
typedef unsigned u32x4 __attribute__((ext_vector_type(4)));
typedef GAS unsigned gu32;

constexpr int DM = 1024, NB = 2, SEQ = 16384, T = NB * SEQ;
constexpr int NH = 8, QLR = 384, KVLR = 256, DNOPE = 128, DROPE = 64, DQK = 192, DV = 128, LAT = 704, LATP = 768;
constexpr int NE = 64, DFF = 384;
constexpr int NASSIGN = 2 * T;
constexpr int NSLOT = NASSIGN + NE * 256;
constexpr float EPS = 1e-6f;
constexpr int NWAVES = 8;

constexpr size_t MiB = 1u << 20;
constexpr size_t WS_CTL = 0, CTL_ZERO_BYTES = 1 * MiB;
constexpr size_t WS_WIN = 2 * MiB;
constexpr size_t WS_WOUTC = 14 * MiB;
constexpr size_t WS_WDOWN = 18 * MiB;
constexpr size_t WS_WQ = 21 * MiB;
constexpr size_t WS_WKV = 24 * MiB;
constexpr size_t WS_WO = 26 * MiB;
constexpr size_t WS_WRT = 30 * MiB;
constexpr size_t WS_WE1 = 32 * MiB;
constexpr size_t WS_WE2 = 416 * MiB;
constexpr size_t WS_XB = 608 * MiB;
constexpr size_t WS_RINV = 1202 * MiB;
constexpr size_t WS_PSQ = 1200 * MiB;
constexpr size_t WS_S = 672 * MiB;
constexpr size_t WS_GB = WS_S, WS_Z = WS_S + 64 * MiB, WS_YC = WS_S + 128 * MiB;
constexpr size_t WS_LAT = WS_S, WS_QRAW = WS_S + 48 * MiB, WS_KVRAW = WS_S + 144 * MiB;
constexpr size_t WS_Q = WS_S + 272 * MiB, WS_K = WS_S + 368 * MiB, WS_V = WS_S + 464 * MiB, WS_O = WS_QRAW;
constexpr size_t WS_HID = WS_S + 160 * MiB, WS_Y = WS_S + 224 * MiB;
constexpr size_t WS_SA = WS_S + 352 * MiB, WS_SG = WS_S + 360 * MiB, WS_SS = WS_S + 368 * MiB;
constexpr size_t WS_END = WS_S + 531 * MiB;
constexpr int CW_BAR = 4096  , CW_CNT = 8192  ;

constexpr int RING_BYTES = 131072;
constexpr int LDSCTL_OFF = RING_BYTES, MISC_OFF = LDSCTL_OFF + 320;
constexpr int TBL_OFF = LDSCTL_OFF + 1024;
constexpr int LDS_BYTES = 147456;

#define RLX_AGENT __ATOMIC_RELAXED, __HIP_MEMORY_SCOPE_AGENT
#define LDS_WAIT() asm volatile("s_waitcnt lgkmcnt(0)" ::: "memory")
#define VM_WAIT() asm volatile("s_waitcnt vmcnt(0)" ::: "memory")
__device__ __forceinline__ unsigned f2bf(float f) { unsigned u = __builtin_bit_cast(unsigned, f); return (u + 0x7fffu + ((u >> 16) & 1u)) >> 16; }
__device__ __forceinline__ unsigned pk2(float lo, float hi) { unsigned r; asm("v_cvt_pk_bf16_f32 %0, %1, %2" : "=v"(r) : "v"(lo), "v"(hi)); return r; }
__device__ __forceinline__ float bflo(unsigned w) { return __builtin_bit_cast(float, w << 16); }
__device__ __forceinline__ float bfhi(unsigned w) { return __builtin_bit_cast(float, w & 0xffff0000u); }
__device__ __forceinline__ float bf2f(bf16_t h) { return __builtin_bit_cast(float, (unsigned)h << 16); }
__device__ __forceinline__ unsigned cvt_pk_bf16(float lo, float hi) { unsigned r; asm volatile("v_cvt_pk_bf16_f32 %0, %1, %2" : "=v"(r) : "v"(lo), "v"(hi)); return r; }
__device__ __forceinline__ int tid_now(int wave_s) { int l; asm volatile("v_mbcnt_lo_u32_b32 %0, -1, 0\n\tv_mbcnt_hi_u32_b32 %0, -1, %0" : "=v"(l)); return wave_s * 64 + l; }
__device__ __forceinline__ int sgpr_now(int v) { asm volatile("" : "+s"(v)); return v; }
__device__ __forceinline__ float lane_xor_f(float v, int m, int lane) { return __builtin_bit_cast(float, __builtin_amdgcn_ds_bpermute((lane ^ m) << 2, __builtin_bit_cast(int, v))); }
__device__ __forceinline__ float wave_sum(float v, int lane) {
#pragma unroll
    for (int o = 1; o < 64; o <<= 1) v += lane_xor_f(v, o, lane);
    return v;
}

typedef float f32x2v __attribute__((ext_vector_type(2)));
__device__ __forceinline__ unsigned pk4_fp8(float a, float b, float c, float d) { int w = 0; w = __builtin_amdgcn_cvt_pk_fp8_f32(a, b, w, false); w = __builtin_amdgcn_cvt_pk_fp8_f32(c, d, w, true); return (unsigned)w; }
__device__ __forceinline__ void up4_fp8(unsigned w, float* v) { const f32x2v lo = __builtin_amdgcn_cvt_pk_f32_fp8((int)w, false), hi = __builtin_amdgcn_cvt_pk_f32_fp8((int)w, true); v[0] = lo.x; v[1] = lo.y; v[2] = hi.x; v[3] = hi.y; }

#define XB_TMO      128
#define XB_XCNT(j)  (256  + 64 * (j))
#define XB_XSUB(j)  (1280 + 64 * (j))
#define XB_XGEN(j)  (2304 + 64 * (j))
#define XB_TOP      3328
#define XB_TOPGEN   3392
#define XCD_BAR_WORDS 3456
#define XB_SPIN_CAP (1u << 18)
__device__ __forceinline__ unsigned xb_ld(unsigned* p)              { return __hip_atomic_load(p, __ATOMIC_RELAXED, __HIP_MEMORY_SCOPE_AGENT); }
__device__ __forceinline__ unsigned xb_add(unsigned* p, unsigned v) { asm volatile("" : "+v"(v)); return __hip_atomic_fetch_add(p, v, __ATOMIC_RELAXED, __HIP_MEMORY_SCOPE_AGENT); }
__device__ __forceinline__ unsigned xb_xcc_id() { return (unsigned)__builtin_amdgcn_s_getreg((3 << 11) | 20) & 0xFu; }
#define XB_SPIN(cond, bar) do { unsigned _sp = 0; while (cond) { __builtin_amdgcn_s_sleep(1); \
    if ((++_sp & 255u) == 0u) { if (xb_ld(&(bar)[XB_TMO])) break; if (_sp > XB_SPIN_CAP) { atomicAdd(&(bar)[XB_TMO], 1u); break; } } } } while (0)
struct XcdBarrier { unsigned* bar; unsigned x; volatile LAS unsigned* st; };
__device__ __forceinline__ XcdBarrier xcd_barrier_post(unsigned* bar, volatile LAS unsigned* st, bool leader) {
    XcdBarrier b; b.bar = bar; b.x = xb_xcc_id(); b.st = st;
    if (leader) (void)xb_add(&bar[XB_XCNT(b.x)], 1u);
    return b;
}
__device__ __forceinline__ void xcd_barrier_complete(unsigned* bar, unsigned x, unsigned& nloc, unsigned& nx) {
    const unsigned G = gridDim.x * gridDim.y * gridDim.z;
    unsigned sum, cnt, mine, sp = 0u;
    for (;;) {
        sum = 0u; cnt = 0u; mine = 0u;
#pragma unroll
        for (unsigned j = 0; j < 16; ++j) { const unsigned c = xb_ld(&bar[XB_XCNT(j)]); sum += c; cnt += (c > 0u) ? 1u : 0u; mine = (j == x) ? c : mine; }
        if (sum == G) break;
        __builtin_amdgcn_s_sleep(1);
        if ((++sp & 255u) == 0u) { if (xb_ld(&bar[XB_TMO])) break; if (sp > XB_SPIN_CAP) { atomicAdd(&bar[XB_TMO], 1u); break; } }
    }
    nloc = mine > 0u ? mine : 1u; nx = cnt > 0u ? cnt : 1u;
}
__device__ __forceinline__ void xcd_barrier(const XcdBarrier& b, bool leader) {
    asm volatile("s_waitcnt vmcnt(0)" ::: "memory");
    __syncthreads();
    if (leader) {
        unsigned* bar = b.bar;
        __builtin_amdgcn_s_waitcnt(0);
        unsigned nloc = b.st[0], nx = b.st[1];
        if (nloc == 0u) { xcd_barrier_complete(bar, b.x, nloc, nx); b.st[0] = nloc; b.st[1] = nx; }
        const unsigned old = xb_add(&bar[XB_XSUB(b.x)], 1u);
        const unsigned gen = old / nloc;
        if (old + 1u == (gen + 1u) * nloc) {
            __builtin_amdgcn_fence(__ATOMIC_RELEASE, "agent");
            asm volatile("s_waitcnt vmcnt(0)" ::: "memory");
            const unsigned og = xb_add(&bar[XB_TOP], 1u);
            const unsigned tg = og / nx;
            if (og + 1u == (tg + 1u) * nx) xb_add(&bar[XB_TOPGEN], 1u);
            else XB_SPIN(xb_ld(&bar[XB_TOPGEN]) == tg, bar);
            __builtin_amdgcn_fence(__ATOMIC_ACQUIRE, "agent");
            xb_add(&bar[XB_XGEN(b.x)], 1u);
            asm volatile("s_waitcnt vmcnt(0)" ::: "memory");
        } else {
            XB_SPIN(xb_ld(&bar[XB_XGEN(b.x)]) == gen, bar);
            __builtin_amdgcn_fence(__ATOMIC_ACQUIRE, "agent");
            asm volatile("s_waitcnt vmcnt(0)" ::: "memory");
        }
    }
    __syncthreads();
}

namespace pg8 {
constexpr int BM = 256, BK = 64, HALF = 128, HTB = HALF * BK * 2, NXCD = 8, WGM = 8;
__host__ __device__ __forceinline__ int lds_byte(int r, int c) { const int st = (r >> 4) * 2 + (c >> 5), rr = r & 15, cc = c & 31, ob = rr * 64 + cc * 2; return st * 1024 + (ob ^ (((ob >> 9) & 1) << 5)); }
__host__ __device__ __forceinline__ void stage_rc(int b_, int& R, int& C) { const unsigned b = (unsigned)b_, st = b >> 10, sb = b & 1023u, swz = sb ^ (((sb >> 9) & 1u) << 5); R = (int)((st >> 1) * 16u + (swz >> 6)); C = (int)((st & 1u) * 32u + ((swz & 63u) >> 1)); }
__host__ __device__ __forceinline__ int perm32(int rho) { const int n = rho >> 4, i = rho & 15; return 8 * (i >> 2) + 4 * n + (i & 3); }

struct Unit { const char* A; const char* B; int pm, pn, arow, nvalid; };
struct Gemm { int lda, K; const int* rowidx; };

struct StaticOrder {
    int nM, nN, nwg, G, c; const char* A; const char* B; size_t astep, bstep;
    __device__ void init(const void* A_, int lda, const void* B_, int K, int M, int N, int G_, int c_) { nM = M / BM; nN = N / BM; nwg = nM * nN; G = G_; c = c_; A = (const char*)A_; B = (const char*)B_; astep = (size_t)BM * lda * 2; bstep = (size_t)BM * K * 2; }
    __device__ __forceinline__ bool next(int i, Unit& u) const {
        const long L = (long)i * G + c; if (L >= nwg) return false;
        int wgid = (int)L; { const int q = nwg / NXCD, r = nwg % NXCD, xcd = wgid % NXCD, off = wgid / NXCD; wgid = (xcd < r ? xcd * (q + 1) : r * (q + 1) + (xcd - r) * q) + off; }
        const int nig = WGM * nN, gid = wgid / nig, fm = gid * WGM, gsz = (nM - fm) < WGM ? (nM - fm) : WGM;
        u.pm = fm + ((wgid % nig) % gsz); u.pn = (wgid % nig) / gsz; u.A = A + (size_t)u.pm * astep; u.B = B + (size_t)u.pn * bstep; u.arow = 0; u.nvalid = BM; return true;
    }
};
constexpr int ECAP = 32768;
struct GroupedOrder {
    int n_units, nN, G, c; const char* A; const char* B; size_t astep, bexp, bstep; const LAS int* tbl; const LAS int* cntl;
    __device__ __forceinline__ bool next(int i, Unit& u) const {
        const int L = i * G + c; if (L >= n_units) return false;
        const int tile = L / nN, pn = L - tile * nN; const int ei = __builtin_amdgcn_readfirstlane(tbl[tile]); const int e = ei >> 16, ti = ei & 0xffff;
        const int left = __builtin_amdgcn_readfirstlane(cntl[e]) - ti * BM;
        u.pm = tile; u.pn = pn; u.arow = e * ECAP + ti * BM; u.nvalid = left < BM ? left : BM; u.A = A + (size_t)tile * astep; u.B = B + (size_t)e * bexp + (size_t)pn * bstep; return true;
    }
};

typedef f32x4 Acc[2][2][4][2];

struct EpiBf16 {
    static constexpr bool PERM = true, AFTER_DRAIN = false; static constexpr bool P16 = false;
    bf16_t* O; int ldc; const float* rs;
    __device__ __forceinline__ void operator()(const Acc& acc, const Unit& u, int wr, int wc, int fr, int fq) const {
        const int row0 = u.pm * BM + wr * 64 + fr, col0 = u.pn * BM + wc * 32 + 8 * fq;
        float rq[2][4];
#pragma unroll
        for (int ai = 0; ai < 2; ++ai)
#pragma unroll
            for (int m = 0; m < 4; ++m) rq[ai][m] = rs ? rs[row0 + ai * HALF + m * 16] : 1.f;
#pragma unroll
        for (int ai = 0; ai < 2; ++ai)
#pragma unroll
            for (int m = 0; m < 4; ++m) { const int row = row0 + ai * HALF + m * 16; bf16_t* rowp = O + (size_t)row * ldc + col0; const float r = rq[ai][m];
#pragma unroll
                for (int bj = 0; bj < 2; ++bj) { const f32x4 v0 = acc[ai][bj][m][0] * r, v1 = acc[ai][bj][m][1] * r;
                    u32x4 w; w.x = cvt_pk_bf16(v0[0], v0[1]); w.y = cvt_pk_bf16(v0[2], v0[3]); w.z = cvt_pk_bf16(v1[0], v1[1]); w.w = cvt_pk_bf16(v1[2], v1[3]);
                    *(u32x4*)(rowp + bj * HALF) = w; } }
    }
};
struct EpiFp8 {
    static constexpr bool PERM = true, AFTER_DRAIN = false; static constexpr bool P16 = true;
    unsigned char* O; int ldc;
    __device__ __forceinline__ void operator()(const Acc& acc, const Unit& u, int wr, int wc, int fr, int fq) const {
        const int row0 = u.pm * BM + wr * 64 + fr, col0 = u.pn * BM + wc * 64 + 16 * fq;
#pragma unroll
        for (int ai = 0; ai < 2; ++ai)
#pragma unroll
            for (int m = 0; m < 4; ++m) { unsigned char* rowp = O + (size_t)(row0 + ai * HALF + m * 16) * ldc + col0;
                const f32x4 a0 = acc[ai][0][m][0], a1 = acc[ai][0][m][1], b0 = acc[ai][1][m][0], b1 = acc[ai][1][m][1];
                u32x4 w; w.x = pk4_fp8(a0[0], a0[1], a0[2], a0[3]); w.y = pk4_fp8(a1[0], a1[1], a1[2], a1[3]); w.z = pk4_fp8(b0[0], b0[1], b0[2], b0[3]); w.w = pk4_fp8(b1[0], b1[1], b1[2], b1[3]);
                *(u32x4*)rowp = w; }
    }
};
struct EpiConvIn {
    static constexpr bool PERM = true, AFTER_DRAIN = false; static constexpr bool P16 = false;
    bf16_t* GBp; bf16_t* Zp; const float* rs;
    __device__ __forceinline__ void operator()(const Acc& acc, const Unit& u, int wr, int wc, int fr, int fq) const {
        const int row0 = u.pm * BM + wr * 64 + fr;
        float rq[2][4];
#pragma unroll
        for (int ai = 0; ai < 2; ++ai)
#pragma unroll
            for (int m = 0; m < 4; ++m) rq[ai][m] = rs[row0 + ai * HALF + m * 16];
        if (u.pn < 4) {
            const int col0 = u.pn * BM + wc * 32 + 8 * fq;
#pragma unroll
            for (int ai = 0; ai < 2; ++ai)
#pragma unroll
                for (int m = 0; m < 4; ++m) { const int row = row0 + ai * HALF + m * 16; bf16_t* rowp = GBp + (size_t)row * DM + col0; const float r = rq[ai][m];
#pragma unroll
                    for (int bj = 0; bj < 2; ++bj) { const f32x4 v0 = acc[ai][bj][m][0] * r, v1 = acc[ai][bj][m][1] * r;
                        u32x4 w; w.x = cvt_pk_bf16(v0[0], v0[1]); w.y = cvt_pk_bf16(v0[2], v0[3]); w.z = cvt_pk_bf16(v1[0], v1[1]); w.w = cvt_pk_bf16(v1[2], v1[3]);
                        *(u32x4*)(rowp + bj * HALF) = w; } }
        } else {
            const int col0 = (u.pn - 4) * HALF + wc * 32 + 8 * fq;
#pragma unroll
            for (int ai = 0; ai < 2; ++ai)
#pragma unroll
                for (int m = 0; m < 4; ++m) { const int row = row0 + ai * HALF + m * 16; bf16_t* rowp = Zp + (size_t)row * DM + col0; const float r = rq[ai][m], r2 = r * r;
                    const f32x4 v0 = acc[ai][0][m][0] * acc[ai][1][m][0] * r2, v1 = acc[ai][0][m][1] * acc[ai][1][m][1] * r2;
                    u32x4 w; w.x = cvt_pk_bf16(v0[0], v0[1]); w.y = cvt_pk_bf16(v0[2], v0[3]); w.z = cvt_pk_bf16(v1[0], v1[1]); w.w = cvt_pk_bf16(v1[2], v1[3]);
                    *(u32x4*)rowp = w; }
        }
    }
};
__device__ __forceinline__ float silu_mul(float g, float u) { return g * __builtin_amdgcn_rcpf(1.f + __expf(-g)) * u; }
struct EpiSwiGLU {
    static constexpr bool PERM = true, AFTER_DRAIN = false; static constexpr bool P16 = false;
    bf16_t* Hd; const float* ss;
    __device__ __forceinline__ void operator()(const Acc& acc, const Unit& u, int wr, int wc, int fr, int fq) const {
        const int row0 = u.pm * BM + wr * 64 + fr, col0 = u.pn * HALF + wc * 32 + 8 * fq;
        float rq[2][4];
#pragma unroll
        for (int ai = 0; ai < 2; ++ai)
#pragma unroll
            for (int m = 0; m < 4; ++m) rq[ai][m] = ss[u.arow + wr * 64 + fr + ai * HALF + m * 16];
#pragma unroll
        for (int ai = 0; ai < 2; ++ai)
#pragma unroll
            for (int m = 0; m < 4; ++m) { const int row = row0 + ai * HALF + m * 16; bf16_t* rowp = Hd + (size_t)row * DFF + col0; const float r = rq[ai][m];
                f32x4 v0, v1;
#pragma unroll
                for (int q = 0; q < 4; ++q) { v0[q] = silu_mul(acc[ai][0][m][0][q] * r, acc[ai][1][m][0][q] * r); v1[q] = silu_mul(acc[ai][0][m][1][q] * r, acc[ai][1][m][1][q] * r); }
                u32x4 w; w.x = cvt_pk_bf16(v0[0], v0[1]); w.y = cvt_pk_bf16(v0[2], v0[3]); w.z = cvt_pk_bf16(v1[0], v1[1]); w.w = cvt_pk_bf16(v1[2], v1[3]);
                *(u32x4*)rowp = w; }
    }
};
struct EpiResid {
    static constexpr bool PERM = true, AFTER_DRAIN = false; static constexpr bool P16 = false;
    bf16_t* XB; float* PSQ; int lane;
    __device__ __forceinline__ void operator()(const Acc& acc, const Unit& u, int wr, int wc, int fr, int fq) const {
        const int row0 = u.pm * BM + wr * 64 + fr, col0 = u.pn * BM + wc * 32 + 8 * fq;
        u32x4 xq[2][4][2];
#pragma unroll
        for (int ai = 0; ai < 2; ++ai)
#pragma unroll
            for (int m = 0; m < 4; ++m)
#pragma unroll
                for (int bj = 0; bj < 2; ++bj) xq[ai][m][bj] = *(const u32x4*)(XB + (size_t)(row0 + ai * HALF + m * 16) * DM + col0 + bj * HALF);
#pragma unroll
        for (int ai = 0; ai < 2; ++ai)
#pragma unroll
            for (int m = 0; m < 4; ++m) { const int row = row0 + ai * HALF + m * 16; bf16_t* rowp = XB + (size_t)row * DM + col0; float ss = 0.f;
#pragma unroll
                for (int bj = 0; bj < 2; ++bj) { const u32x4 xv = xq[ai][m][bj];
                    const f32x4 v0 = acc[ai][bj][m][0] + (f32x4){bflo(xv.x), bfhi(xv.x), bflo(xv.y), bfhi(xv.y)}, v1 = acc[ai][bj][m][1] + (f32x4){bflo(xv.z), bfhi(xv.z), bflo(xv.w), bfhi(xv.w)};
                    ss += (v0[0] * v0[0] + v0[1] * v0[1]) + (v0[2] * v0[2] + v0[3] * v0[3]) + (v1[0] * v1[0] + v1[1] * v1[1]) + (v1[2] * v1[2] + v1[3] * v1[3]);
                    u32x4 w; w.x = cvt_pk_bf16(v0[0], v0[1]); w.y = cvt_pk_bf16(v0[2], v0[3]); w.z = cvt_pk_bf16(v1[0], v1[1]); w.w = cvt_pk_bf16(v1[2], v1[3]);
                    *(u32x4*)(rowp + bj * HALF) = w; }
                ss += lane_xor_f(ss, 16, lane); ss += lane_xor_f(ss, 32, lane);
                if (fq == 0) PSQ[(size_t)row * 16 + u.pn * 4 + wc] = ss; }
    }
};
struct EpiRoute {
    static constexpr bool PERM = false, AFTER_DRAIN = true; static constexpr bool P16 = false;
    const float* rs; const float* bg; const float* be; gu32* cnt; int* sa; float* sgate; float* sscale;
    __device__ __forceinline__ void fused(const Acc& acc, const Unit& u, int wr, int wc, int fr, int fq, LAS unsigned char* lds, int tid) const {
        LAS float* lg = (LAS float*)lds;
        if (wc < 3) {
#pragma unroll
            for (int ai = 0; ai < 2; ++ai)
#pragma unroll
                for (int m = 0; m < 4; ++m) { const int rl = ai * HALF + wr * 64 + m * 16 + fr; const float r = rs[u.pm * BM + rl];
#pragma unroll
                    for (int n = 0; n < 2; ++n) { const int c0 = wc * 32 + 16 * n + 4 * fq;
                        if (c0 < 72) { LAS float* d = lg + rl * 73 + c0; const f32x4 v = acc[ai][0][m][n] * r; d[0] = v[0]; d[1] = v[1]; d[2] = v[2]; d[3] = v[3]; } } } }
        __syncthreads();
        LAS unsigned* lc = (LAS unsigned*)(lds + 80 * 1024);
        if (tid < 64) lc[tid] = 0u;
        __syncthreads();
        int e0 = 0, e1 = 0; float rv = 0.f, w0 = 0.f, w1 = 0.f; unsigned r0 = 0u, r1 = 0u; const int t = u.pm * BM + tid;
        if (tid < 256) { const LAS float* l = lg + tid * 73;
            float gl[8];
#pragma unroll
            for (int q = 0; q < 8; ++q) gl[q] = l[q];
            float gm = gl[0]; int gs = 0; float bm = gl[0] + bg[0];
#pragma unroll
            for (int q = 1; q < 8; ++q) { gm = fmaxf(gm, gl[q]); const float v = gl[q] + bg[q]; if (v > bm) { bm = v; gs = q; } }
            float gsum = 0.f, gsel = 0.f;
#pragma unroll
            for (int q = 0; q < 8; ++q) { const float e = __expf(gl[q] - gm); gsum += e; gsel = (q == gs) ? e : gsel; }
            const float g_gate = gsel / gsum;
            float el[8];
#pragma unroll
            for (int q = 0; q < 8; ++q) el[q] = l[8 + gs * 8 + q];
            int i0 = 0; float v0 = el[0] + be[gs * 8];
#pragma unroll
            for (int q = 1; q < 8; ++q) { const float v = el[q] + be[gs * 8 + q]; if (v > v0) { v0 = v; i0 = q; } }
            int i1 = -1; float v1 = -3.0e38f;
#pragma unroll
            for (int q = 0; q < 8; ++q) { const float v = el[q] + be[gs * 8 + q]; if (q != i0 && v > v1) { v1 = v; i1 = q; } }
            float l0 = 0.f, l1 = 0.f;
#pragma unroll
            for (int q = 0; q < 8; ++q) { l0 = (q == i0) ? el[q] : l0; l1 = (q == i1) ? el[q] : l1; }
            const float mm = fmaxf(l0, l1), p0 = __expf(l0 - mm), p1 = __expf(l1 - mm), inv = 1.f / (p0 + p1);
            e0 = gs * 8 + i0; e1 = gs * 8 + i1; rv = rs[t]; w0 = g_gate * p0 * inv; w1 = g_gate * p1 * inv;
            unsigned one_ = 1u; asm volatile("" : "+v"(one_));
            r0 = __hip_atomic_fetch_add(lc + e0, one_, __ATOMIC_RELAXED, __HIP_MEMORY_SCOPE_WORKGROUP); r1 = __hip_atomic_fetch_add(lc + e1, one_, __ATOMIC_RELAXED, __HIP_MEMORY_SCOPE_WORKGROUP); }
        __syncthreads();
        if (tid < 64) { const unsigned n = lc[tid]; lc[64 + tid] = n ? __hip_atomic_fetch_add(cnt + 32 * tid, n, RLX_AGENT) : 0u; }
        __syncthreads();
        if (tid < 256) { const int s0 = e0 * ECAP + (int)(lc[64 + e0] + r0), s1 = e1 * ECAP + (int)(lc[64 + e1] + r1);
            sa[s0] = 2 * t; sgate[s0] = w0; sscale[s0] = rv; sa[s1] = 2 * t + 1; sgate[s1] = w1; sscale[s1] = rv; }
    }
};
struct EpiScatterY {
    static constexpr bool PERM = true, AFTER_DRAIN = false; static constexpr bool P16 = true;
    unsigned char* Y; const int* sdest; const float* sgate;
    __device__ __forceinline__ void operator()(const Acc& acc, const Unit& u, int wr, int wc, int fr, int fq) const {
        const int col0 = u.pn * BM + wc * 64 + 16 * fq;
#pragma unroll
        for (int ai = 0; ai < 2; ++ai)
#pragma unroll
            for (int m = 0; m < 4; ++m) { const int rl = wr * 64 + fr + ai * HALF + m * 16; const bool ok = rl < u.nvalid; const int d = ok ? sdest[u.arow + rl] : 0; const float g = ok ? 16.f * sgate[u.arow + rl] : 0.f;
                if (ok) { unsigned char* rowp = Y + (size_t)d * DM + col0;
                    const f32x4 a0 = acc[ai][0][m][0] * g, a1 = acc[ai][0][m][1] * g, b0 = acc[ai][1][m][0] * g, b1 = acc[ai][1][m][1] * g;
                    u32x4 w; w.x = pk4_fp8(a0[0], a0[1], a0[2], a0[3]); w.y = pk4_fp8(a1[0], a1[1], a1[2], a1[3]); w.z = pk4_fp8(b0[0], b0[1], b0[2], b0[3]); w.w = pk4_fp8(b1[0], b1[1], b1[2], b1[3]);
                    *(u32x4*)rowp = w; }
                asm volatile("" ::: "memory"); }
    }
};

template <bool GATHER = false, bool ONLY_B0 = false, class Epi, class Sched>
__device__ __forceinline__ void gemm_phase(LAS unsigned char* lds, const Gemm g, const Sched& S, const Epi& E, int tid) {
    const int wid = __builtin_amdgcn_readfirstlane(tid >> 6), lane = tid & 63, wr = wid >> 2, wc = wid & 3, fr = lane & 15, fq = lane >> 4;
    const int K = g.K, lda = g.lda, nt = K / BK;
    unsigned voffA[2], voffB[2];
#pragma unroll
    for (int i = 0; i < 2; ++i) { int R, C; stage_rc(tid * 16 + i * 8192, R, C); const int Rb = Epi::P16 ? (64 * ((R >> 5) & 3) + 16 * ((R >> 2) & 3) + 4 * ((R >> 4) & 1) + (R & 3)) : (Epi::PERM ? ((R & ~31) + perm32(R & 31)) : R);
        voffA[i] = (unsigned)(R * lda + C) * 2u; voffB[i] = (unsigned)(Rb * K + C) * 2u; }
    const size_t kstep = (size_t)(BK * 2);
    const size_t hstepA = (size_t)HALF * lda * 2, hstepB = (size_t)(Epi::P16 ? 8 : HALF) * K * 2;
    unsigned goC[2][2] = {{0u, 0u}, {0u, 0u}}, goN[2][2] = {{0u, 0u}, {0u, 0u}}; int gR[2] = {0, 0}; unsigned gC[2] = {0u, 0u};
    if constexpr (GATHER) {
#pragma unroll
        for (int i = 0; i < 2; ++i) { int R, C; stage_rc(tid * 16 + i * 8192, R, C); gR[i] = R; gC[i] = (unsigned)C * 2u; } }
#define PG8_GO(dst, un_) do { _Pragma("unroll") for (int h_ = 0; h_ < 2; ++h_) _Pragma("unroll") for (int i_ = 0; i_ < 2; ++i_) \
        { const int r_ = h_ * HALF + gR[i_]; const int a_ = r_ < (un_).nvalid ? g.rowidx[(un_).arow + r_] : 0; dst[h_][i_] = (unsigned)((a_ >> 1) & (T - 1)) * (unsigned)(lda * 2) + gC[i_]; } } while (0)
    const unsigned ldsw = (unsigned)wid * 1024u;
    const int aoff = lds_byte(wr * 64 + fr, fq * 8), boff = lds_byte(wc * 32 + fr, fq * 8);
#define PG8_SA(b, h) (((b) * 2 + (h)) * HTB)
#define PG8_SB(b, h) ((4 + (b) * 2 + (h)) * HTB)
#define PG8_STAGE(bufoff, gbase, voff) do { _Pragma("unroll") for (int _i = 0; _i < 2; ++_i) \
        __builtin_amdgcn_global_load_lds((const unsigned*)((const char*)(gbase) + (voff)[_i]), (LAS unsigned*)(lds + (bufoff) + ldsw + _i * 8192), 16, 0, 0); } while (0)
#define PG8_LDA(dst, b, h) do { _Pragma("unroll") for (int m = 0; m < 4; ++m) _Pragma("unroll") for (int k = 0; k < 2; ++k) dst[m][k] = *(const LAS bf16x8*)(lds + PG8_SA(b, h) + aoff + m * 2048 + k * 1024); } while (0)
#define PG8_LDB(dst, b, h) do { _Pragma("unroll") for (int n = 0; n < 2; ++n) _Pragma("unroll") for (int k = 0; k < 2; ++k) dst[n][k] = *(const LAS bf16x8*)(lds + PG8_SB(b, h) + boff + n * 2048 + k * 1024); } while (0)
#define PG8_MMA(ai, bj, At, Bt) do { __builtin_amdgcn_s_setprio(1); _Pragma("unroll") for (int m = 0; m < 4; ++m) _Pragma("unroll") for (int n = 0; n < 2; ++n) _Pragma("unroll") for (int k = 0; k < 2; ++k) \
        acc[ai][bj][m][n] = __builtin_amdgcn_mfma_f32_16x16x32_bf16(Bt[n][k], At[m][k], acc[ai][bj][m][n], 0, 0, 0); __builtin_amdgcn_s_setprio(0); } while (0)
#define PG8_WAIT_V(n) asm volatile("s_waitcnt vmcnt(" #n ")" ::: "memory")
#define PG8_WAIT_L(n) asm volatile("s_waitcnt lgkmcnt(" #n ")" ::: "memory")
#define PG8_BAR __builtin_amdgcn_s_barrier()
#define PG8_SCHED __builtin_amdgcn_sched_barrier(0)
    Unit cur, nxt; int ui = 0;
    if (!S.next(0, cur)) return;
    Acc acc;
#pragma unroll
    for (int a = 0; a < 2; ++a)
#pragma unroll
        for (int b = 0; b < 2; ++b)
#pragma unroll
            for (int m = 0; m < 4; ++m)
#pragma unroll
                for (int n = 0; n < 2; ++n) acc[a][b][m][n] = (f32x4){0.f, 0.f, 0.f, 0.f};
    bf16x8 At[4][2], B0[2][2], B1[2][2];
    const char* cA = cur.A; const char* cB = cur.B;
    if constexpr (GATHER) PG8_GO(goC, cur);
    PG8_STAGE(PG8_SB(0, 0), cB, voffB); PG8_STAGE(PG8_SB(0, 1), cB + hstepB, voffB);
    if constexpr (GATHER) { PG8_STAGE(PG8_SA(0, 0), cA, goC[0]); PG8_STAGE(PG8_SA(0, 1), cA, goC[1]); } else { PG8_STAGE(PG8_SA(0, 0), cA, voffA); PG8_STAGE(PG8_SA(0, 1), cA + hstepA, voffA); }
    if (wr == 1) PG8_BAR;
    PG8_WAIT_V(2); PG8_BAR;
    PG8_STAGE(PG8_SB(1, 0), cB + kstep, voffB); if constexpr (GATHER) PG8_STAGE(PG8_SA(1, 0), cA + kstep, goC[0]); else PG8_STAGE(PG8_SA(1, 0), cA + kstep, voffA); PG8_STAGE(PG8_SB(1, 1), cB + hstepB + kstep, voffB);
    PG8_WAIT_V(6); PG8_BAR;
    for (;;) {
        const bool has_next = S.next(ui + 1, nxt);
        const char* nA = has_next ? nxt.A : cA; const char* nB = has_next ? nxt.B : cB;
        if constexpr (GATHER) { if (has_next) PG8_GO(goN, nxt); else { goN[0][0] = goC[0][0]; goN[0][1] = goC[0][1]; goN[1][0] = goC[1][0]; goN[1][1] = goC[1][1]; } }
        for (int t = 0; t < nt; t += 2) {
            const bool last = (t == nt - 2);
            const char* a1 = cA + (size_t)(t + 1) * kstep;
            const char* a2 = last ? nA : cA + (size_t)(t + 2) * kstep; const char* b2 = last ? nB : cB + (size_t)(t + 2) * kstep;
            const char* a3 = a2 + kstep; const char* b3 = b2 + kstep;
            unsigned g2h0[2], g2h1[2];
            if constexpr (GATHER) { g2h0[0] = last ? goN[0][0] : goC[0][0]; g2h0[1] = last ? goN[0][1] : goC[0][1]; g2h1[0] = last ? goN[1][0] : goC[1][0]; g2h1[1] = last ? goN[1][1] : goC[1][1]; }
            PG8_LDB(B0, 0, 0); if constexpr (!ONLY_B0) PG8_LDB(B1, 0, 1); PG8_SCHED; PG8_LDA(At, 0, 0); if constexpr (GATHER) PG8_STAGE(PG8_SA(1, 1), a1, goC[1]); else PG8_STAGE(PG8_SA(1, 1), a1 + hstepA, voffA);
            PG8_WAIT_V(8); PG8_WAIT_L(0); PG8_BAR; PG8_MMA(0, 0, At, B0); if constexpr (!ONLY_B0) PG8_MMA(0, 1, At, B1); PG8_BAR; PG8_SCHED;
            PG8_LDA(At, 0, 1); PG8_STAGE(PG8_SB(0, 0), b2, voffB); PG8_STAGE(PG8_SB(0, 1), b2 + hstepB, voffB); if constexpr (GATHER) PG8_STAGE(PG8_SA(0, 0), a2, g2h0); else PG8_STAGE(PG8_SA(0, 0), a2, voffA);
            PG8_WAIT_V(8); PG8_WAIT_L(0); PG8_BAR; PG8_MMA(1, 0, At, B0); if constexpr (!ONLY_B0) PG8_MMA(1, 1, At, B1); PG8_BAR; PG8_SCHED;
            PG8_LDB(B0, 1, 0); if constexpr (!ONLY_B0) PG8_LDB(B1, 1, 1); PG8_SCHED; PG8_LDA(At, 1, 0); if constexpr (GATHER) PG8_STAGE(PG8_SA(0, 1), a2, g2h1); else PG8_STAGE(PG8_SA(0, 1), a2 + hstepA, voffA);
            PG8_WAIT_V(8); PG8_WAIT_L(0); PG8_BAR; PG8_MMA(0, 0, At, B0); if constexpr (!ONLY_B0) PG8_MMA(0, 1, At, B1); PG8_BAR; PG8_SCHED;
            PG8_LDA(At, 1, 1); PG8_STAGE(PG8_SB(1, 0), b3, voffB); PG8_STAGE(PG8_SB(1, 1), b3 + hstepB, voffB); if constexpr (GATHER) PG8_STAGE(PG8_SA(1, 0), a3, g2h0); else PG8_STAGE(PG8_SA(1, 0), a3, voffA);
            PG8_WAIT_V(8); PG8_WAIT_L(0); PG8_BAR; PG8_MMA(1, 0, At, B0); if constexpr (!ONLY_B0) PG8_MMA(1, 1, At, B1); PG8_BAR; PG8_SCHED;
        }
        if (wr == 0) PG8_BAR;
        if constexpr (!Epi::AFTER_DRAIN) E(acc, cur, wr, wc, fr, fq);
        if (!has_next) break;
#pragma unroll
        for (int a = 0; a < 2; ++a)
#pragma unroll
            for (int b = 0; b < 2; ++b)
#pragma unroll
                for (int m = 0; m < 4; ++m)
#pragma unroll
                    for (int n = 0; n < 2; ++n) acc[a][b][m][n] = (f32x4){0.f, 0.f, 0.f, 0.f};
        cur = nxt; cA = nA; cB = nB; ++ui;
        if constexpr (GATHER) { goC[0][0] = goN[0][0]; goC[0][1] = goN[0][1]; goC[1][0] = goN[1][0]; goC[1][1] = goN[1][1]; }
        if (wr == 1) PG8_BAR;
    }
    PG8_WAIT_V(0);
    PG8_BAR;
    if constexpr (Epi::AFTER_DRAIN) E.fused(acc, cur, wr, wc, fr, fq, lds, tid);
#undef PG8_GO
#undef PG8_SA
#undef PG8_SB
#undef PG8_STAGE
#undef PG8_LDA
#undef PG8_LDB
#undef PG8_MMA
#undef PG8_WAIT_V
#undef PG8_WAIT_L
#undef PG8_BAR
#undef PG8_SCHED
}
}


namespace att8 {
typedef int i32x8 __attribute__((ext_vector_type(8)));
constexpr int NW = 8, QBLK = 32, KVBLK = 64;
constexpr float SCALE = 0.07216878364870322f;
constexpr float POFF = 3.f;
constexpr float PLIM = 448.f;
constexpr int KROW = 208, VROW = 80;
constexpr int SHM_K = KVBLK * KROW, SHM_V = DV * VROW;
constexpr int OFF_V = 0, OFF_K = 2 * SHM_V, OFF_WS = OFF_K + 3 * SHM_K, ATT_LDS = OFF_WS + NW * 64 * 4;
static_assert(ATT_LDS <= 65536, "O staging reuses [0, 64 KiB)");
#define SBAR() __builtin_amdgcn_sched_barrier(0)
__device__ __forceinline__ int crow(int r, int hi) { return (r & 3) + 8 * (r >> 2) + 4 * hi; }
__device__ __forceinline__ f32x16 mfma8(i32x8 a, i32x8 b, f32x16 c) { return __builtin_amdgcn_mfma_scale_f32_32x32x64_f8f6f4(a, b, c, 0, 0, 0, 0x7F7F7F7F, 0, 0x7F7F7F7F); }
__device__ __forceinline__ i32x8 ld32(const char* p) { const u32x4 a = *reinterpret_cast<const u32x4*>(p), b = *reinterpret_cast<const u32x4*>(p + 16); return (i32x8){(int)a.x, (int)a.y, (int)a.z, (int)a.w, (int)b.x, (int)b.y, (int)b.z, (int)b.w}; }
template <bool FIRST = false>
__device__ __forceinline__ void softmax_seg(f32x16& p0, f32x16& p1, f32x16& negm, float& l_reg, f32x16* o, i32x8& pa, float* al_l, int r32, int hi) {
    float ps = 0;
#pragma unroll
    for (int r = 0; r < 16; ++r) { p0[r] = __builtin_amdgcn_exp2f(p0[r]); ps += p0[r]; }
    asm volatile("" :: "v"(pa));
#pragma unroll
    for (int r = 0; r < 16; ++r) { p1[r] = __builtin_amdgcn_exp2f(p1[r]); ps += p1[r]; }
    if (FIRST || !__builtin_expect(__all(ps <= PLIM), 1)) {
        float alpha;
        float pm = fmaxf(p0[0], p1[0]);
#pragma unroll
        for (int r = 1; r < 16; ++r) pm = fmaxf(pm, fmaxf(p0[r], p1[r]));
        { auto rr = __builtin_amdgcn_permlane32_swap(__float_as_uint(pm), __float_as_uint(pm), false, false);
          pm = fmaxf(__uint_as_float(rr[0]), __uint_as_float(rr[1])); }
        const float d = __builtin_ceilf(fmaxf(__builtin_amdgcn_logf(pm) - POFF, 0.f));
        alpha = __builtin_amdgcn_exp2f(-d);
#pragma unroll
        for (int r = 0; r < 16; ++r) { p0[r] *= alpha; p1[r] *= alpha; negm[r] -= d; }
        ps *= alpha; l_reg *= alpha;
        if (hi == 0) al_l[r32] = alpha; asm volatile("s_waitcnt lgkmcnt(0)" ::: "memory");
#pragma unroll
        for (int dd = 0; dd < 4; ++dd)
#pragma unroll
            for (int r = 0; r < 16; ++r) o[dd][r] *= al_l[crow(r, hi)];
    }
    asm("v_add_f32_e32 %0, %0, %1" : "+v"(l_reg) : "v"(ps));
#pragma unroll
    for (int g = 0; g < 4; ++g) { int w = pa[g]; w = __builtin_amdgcn_cvt_pk_fp8_f32(p0[4 * g], p0[4 * g + 1], w, false); w = __builtin_amdgcn_cvt_pk_fp8_f32(p0[4 * g + 2], p0[4 * g + 3], w, true); pa[g] = w; }
#pragma unroll
    for (int g = 0; g < 4; ++g) { int w = pa[4 + g]; w = __builtin_amdgcn_cvt_pk_fp8_f32(p1[4 * g], p1[4 * g + 1], w, false); w = __builtin_amdgcn_cvt_pk_fp8_f32(p1[4 * g + 2], p1[4 * g + 3], w, true); pa[4 + g] = w; }
}
__device__ __forceinline__ f32x16 mfma8q(i32x8 a, i32x8 b, f32x16 c) { return __builtin_amdgcn_mfma_scale_f32_32x32x64_f8f6f4(a, b, c, 0, 0, 0, 0x7F7F7F7F, 0, 0x7C7C7C7C); }
constexpr int KPF = 2;
__device__ __forceinline__ void kfrag_load(i32x8 (&ka)[KPF][2], const char* Ks, int r32, int hi) {
#pragma unroll
    for (int ks = 0; ks < KPF; ++ks) { const int cb = ks * 64 + hi * 32; ka[ks][0] = ld32(Ks + r32 * KROW + cb); ka[ks][1] = ld32(Ks + (32 + r32) * KROW + cb); }
}
#define SGB(mask, n) __builtin_amdgcn_sched_group_barrier(mask, n, 0)
template <bool DO_QK, bool DO_PV, typename StageF>
__device__ __forceinline__ void mfma_seg(f32x16& p0, f32x16& p1, const f32x16& negm, f32x16* o, const i32x8 (&ka)[KPF][2], const char* Ks, const char* Vs, const i32x8* qr, i32x8 pa, int r32, int hi, StageF&& stage) {
    static_assert(KPF == 2, "gap placement below is written for two prefetched k-steps");
    i32x8 vb[4], kr[2];
    __builtin_amdgcn_s_setprio(1);
    SBAR();
    if (DO_PV) stage();
    if (DO_QK) { const int cb = 2 * 64 + hi * 32; kr[0] = ld32(Ks + r32 * KROW + cb); kr[1] = ld32(Ks + (32 + r32) * KROW + cb); }
    if (DO_PV) {
#pragma unroll
        for (int d0 = 0; d0 < 4; ++d0) vb[d0] = ld32(Vs + (32 * d0 + r32) * VROW + hi * 32); }
    if (!DO_PV) stage();
    if (DO_QK) { p0 = mfma8q(ka[0][0], qr[0], negm); p1 = mfma8q(ka[0][1], qr[0], negm); p0 = mfma8q(ka[1][0], qr[1], p0); p1 = mfma8q(ka[1][1], qr[1], p1);
                 p0 = mfma8q(kr[0], qr[2], p0); p1 = mfma8q(kr[1], qr[2], p1); }
    if (DO_QK && DO_PV) { SGB(0x008, 1); SGB(0x200, 3); SGB(0x020, 3); SGB(0x008, 1); SGB(0x100, 4); SGB(0x008, 1); SGB(0x100, 4); SGB(0x008, 1); SGB(0x100, 4); SGB(0x008, 2); }
    else if (DO_QK) { SGB(0x008, 1); SGB(0x100, 4); SGB(0x008, 1); SGB(0x200, 3); SGB(0x020, 3); SGB(0x008, 4); }
    SBAR();
    if (DO_PV) {
#pragma unroll
        for (int d0 = 0; d0 < 4; ++d0) o[d0] = mfma8(pa, vb[d0], o[d0]); }
    SBAR();
    __builtin_amdgcn_s_setprio(0);
}
#undef SGB
__device__ __forceinline__ void attn_unit_pp(const unsigned char* __restrict__ Qb, const unsigned char* __restrict__ Kh, const unsigned char* __restrict__ Vt, bf16_t* __restrict__ Ob, char* lds, int tid) {
    const int wid = __builtin_amdgcn_readfirstlane(tid >> 6), lane = tid & 63, r32 = lane & 31, hi = lane >> 5;
    const bool halfB = wid >= 4;
    char* V_lds = lds + OFF_V; char* K_lds = lds + OFF_K;
    float* ws = (float*)(lds + OFF_WS) + wid * 64; float* li_l = ws; float* al_l = ws + 32;
    float l_reg = 0; f32x16 o[4] = {}; i32x8 qr[3]; f32x16 negm;
    float m0_ = 60.f; asm volatile("" : "+v"(m0_));
#pragma unroll
    for (int r = 0; r < 16; ++r) negm[r] = m0_;
    const unsigned char* Qw = Qb + (long)(wid * QBLK + r32) * DQK + hi * 32;
#pragma unroll
    for (int ks = 0; ks < 3; ++ks) qr[ks] = ld32((const char*)Qw + ks * 64);
    const int kst0 = (tid / 12) * KROW + (tid % 12) * 16, kst1 = ((8192 + tid * 8) / 192) * KROW + ((8192 + tid * 8) % 192), vst = (tid >> 2) * VROW + (tid & 3) * 16;
    constexpr int NT = SEQ / KVBLK;
    u32x4 sv, sk0; u32x2 sk1;
    const __amdgpu_buffer_rsrc_t rsK = __builtin_amdgcn_make_buffer_rsrc((void*)Kh, (short)0, SEQ * DQK, 0x00020000), rsV = __builtin_amdgcn_make_buffer_rsrc((void*)Vt, (short)0, SEQ * DV, 0x00020000);
    const unsigned goff0 = (unsigned)tid * 16u, goff1 = (unsigned)tid * 8u + 8192u;
#define LOADK(t) do { const unsigned so_ = (unsigned)((t) < NT ? (t) : NT - 1) * 12288u; sk0 = __builtin_amdgcn_raw_buffer_load_b128(rsK, goff0, so_, 0); sk1 = __builtin_amdgcn_raw_buffer_load_b64(rsK, goff1, so_, 0); } while (0)
#define LOADV(t) do { sv = __builtin_amdgcn_raw_buffer_load_b128(rsV, goff0, (unsigned)((t) < NT ? (t) : NT - 1) * 8192u, 0); } while (0)
#define WRITEK(b) do { *(u32x4*)(K_lds + (b) * SHM_K + kst0) = sk0; *(u32x2*)(K_lds + (b) * SHM_K + kst1) = sk1; } while (0)
#define WRITEV(b) do { *(u32x4*)(V_lds + (b) * SHM_V + vst) = sv; } while (0)
#define BAR() do { SBAR(); __syncthreads(); SBAR(); } while (0)
    f32x16 p0, p1; i32x8 pa = {}; i32x8 ka[KPF][2];
    LOADK(0); WRITEK(0); LOADK(1); WRITEK(1); __syncthreads();
    LOADK(2); LOADV(0);
    kfrag_load(ka, K_lds, r32, hi);
#define CBAR(flag) do { SBAR(); asm volatile("" : "+v"(p0), "+v"(p1)); asm volatile("" : "+v"(o[0]), "+v"(o[1]), "+v"(o[2]), "+v"(o[3])); asm volatile("" : "+v"(pa)); SBAR(); if (flag) { __syncthreads(); } SBAR(); } while (0)
    const bool fB = halfB, fA = !halfB;
    mfma_seg<true, false>(p0, p1, negm, o, ka, K_lds, V_lds, qr, pa, r32, hi, [&]() { WRITEK(2); WRITEV(0); LOADK(3); LOADV(1); });
    CBAR(fB);
    softmax_seg<true>(p0, p1, negm, l_reg, o, pa, al_l, r32, hi);
    kfrag_load(ka, K_lds + SHM_K, r32, hi);
    CBAR(fA);
    int kb3 = 0, kb1 = 1, kb2 = 2;
    for (int t = 0; t < NT - 1; ++t) {
        mfma_seg<true, true>(p0, p1, negm, o, ka, K_lds + kb1 * SHM_K, V_lds + (t & 1) * SHM_V, qr, pa, r32, hi, [&]() { WRITEK(kb3); WRITEV((t + 1) & 1); LOADK(t + 4); LOADV(t + 2); });
        CBAR(fB);
        softmax_seg(p0, p1, negm, l_reg, o, pa, al_l, r32, hi);
        kfrag_load(ka, K_lds + kb2 * SHM_K, r32, hi);
        CBAR(fA);
        kb3 = (kb3 == 2) ? 0 : kb3 + 1; kb1 = (kb1 == 2) ? 0 : kb1 + 1; kb2 = (kb2 == 2) ? 0 : kb2 + 1;
    }
    mfma_seg<false, true>(p0, p1, negm, o, ka, K_lds, V_lds + ((NT - 1) & 1) * SHM_V, qr, pa, r32, hi, []() {});
#undef CBAR
    { auto rr = __builtin_amdgcn_permlane32_swap(__float_as_uint(l_reg), __float_as_uint(l_reg), false, false); l_reg = __uint_as_float(rr[0]) + __uint_as_float(rr[1]); }
    if (hi == 0) li_l[r32] = l_reg; asm volatile("s_waitcnt lgkmcnt(0)" ::: "memory");
    float rli[16];
#pragma unroll
    for (int r = 0; r < 16; ++r) rli[r] = __builtin_amdgcn_rcpf(li_l[crow(r, hi)]);
    __syncthreads();
    bf16_t* ost = (bf16_t*)(lds + wid * 8192);
#pragma unroll
    for (int r = 0; r < 16; ++r) { const int orow = crow(r, hi);
#pragma unroll
        for (int d0 = 0; d0 < 4; ++d0) ost[orow * 128 + d0 * 32 + r32] = (bf16_t)f2bf(o[d0][r] * rli[r]); }
    asm volatile("s_waitcnt lgkmcnt(0)" ::: "memory");
    bf16_t* Ow = Ob + (long)(wid * QBLK) * DM;
#pragma unroll
    for (int i = 0; i < 8; ++i) { const int ch = lane + 64 * i, row = ch >> 4, c = ch & 15;
        const u32x4 v = *(const u32x4*)((const char*)ost + row * 256 + c * 16); *(u32x4*)(Ow + (long)row * DM + c * 8) = v; }
    __syncthreads();
#undef LOADK
#undef LOADV
#undef WRITEK
#undef WRITEV
#undef BAR
}
#undef SBAR
}

struct Args { const void* in[23]; float* out; unsigned char* ws; int ph_lo, ph_hi; };
enum { I_X = 0, I_POS, I_CNW, I_CWIN, I_CK, I_CWOUT, I_MNW, I_MWDOWN, I_MQLN, I_MKVLN, I_MWQ, I_MWKV, I_MQHN, I_MKHN, I_MWO, I_FNW, I_RWG, I_RBG, I_RWE, I_RBE, I_EWG, I_EWU, I_EWD };

struct CvtItem { const float* W; bf16_t* WT; const float* ksc; int K, N, k0, n0, drow0; };
__device__ __forceinline__ unsigned char* ldptr(int i);
constexpr int CVT_PER_J = 768 + 256 + 176 + 144 + 128 + 256;
constexpr int CVT_MIX = 2 * CVT_PER_J, CVT_EXP = 4 * NE * 288, CVT_ITEMS = CVT_MIX + CVT_EXP;
__device__ __forceinline__ void cvt_decode(int it, CvtItem& c, unsigned char* ws) {
    if (it < CVT_MIX) {
        const int j = it / CVT_PER_J; int r = it - j * CVT_PER_J; int kb, nb;
        if (r < 768) { c.K = 1024; c.N = 3072; c.W = (const float*)ldptr(I_CWIN) + (size_t)j * 1024 * 3072; c.WT = (bf16_t*)(ws + WS_WIN) + (size_t)j * 3072 * 1024; c.ksc = (const float*)ldptr(I_CNW) + j * 1024;
            kb = r / 48; nb = r % 48; const int n0 = nb * 64;
            if (n0 < 1024) c.drow0 = n0; else if (n0 < 2048) { const int q = n0 - 1024; c.drow0 = 1024 + (q >> 7) * 256 + (q & 127); } else { const int q = n0 - 2048; c.drow0 = 1024 + (q >> 7) * 256 + 128 + (q & 127); } }
        else if ((r -= 768) < 256) { c.K = 1024; c.N = 1024; c.W = (const float*)ldptr(I_CWOUT) + (size_t)j * 1024 * 1024; c.WT = (bf16_t*)(ws + WS_WOUTC) + (size_t)j * 1024 * 1024; c.ksc = nullptr; kb = r / 16; nb = r % 16; c.drow0 = nb * 64; }
        else if ((r -= 256) < 176) { c.K = 1024; c.N = LAT; c.W = (const float*)ldptr(I_MWDOWN) + (size_t)j * 1024 * LAT; c.WT = (bf16_t*)(ws + WS_WDOWN) + (size_t)j * LATP * 1024; c.ksc = (const float*)ldptr(I_MNW) + j * 1024; kb = r / 11; nb = r % 11; c.drow0 = nb * 64; }
        else if ((r -= 176) < 144) { c.K = QLR; c.N = NH * DQK; c.W = (const float*)ldptr(I_MWQ) + (size_t)j * QLR * NH * DQK; c.WT = (bf16_t*)(ws + WS_WQ + (size_t)j * 1536 * 1024); c.ksc = (const float*)ldptr(I_MQLN) + j * QLR; kb = r / 24; nb = r % 24; c.drow0 = nb * 64; }
        else if ((r -= 144) < 128) { c.K = KVLR; c.N = NH * 256; c.W = (const float*)ldptr(I_MWKV) + (size_t)j * KVLR * NH * 256; c.WT = (bf16_t*)(ws + WS_WKV) + (size_t)j * 2048 * 256; c.ksc = (const float*)ldptr(I_MKVLN) + j * KVLR; kb = r / 32; nb = r % 32; c.drow0 = nb * 64; }
        else { r -= 128; c.K = 1024; c.N = 1024; c.W = (const float*)ldptr(I_MWO) + (size_t)j * 1024 * 1024; c.WT = (bf16_t*)(ws + WS_WO) + (size_t)j * 1024 * 1024; c.ksc = nullptr; kb = r / 16; nb = r % 16; c.drow0 = nb * 64; }
        c.k0 = kb * 64; c.n0 = nb * 64;
    } else {
        const int r = it - CVT_MIX; const int le = r / 288, q = r - le * 288, L = le >> 6; const int kind = q / 96, idx = q - kind * 96; int kb, nb;
        if (kind < 2) { c.K = 1024; c.N = DFF; c.W = (const float*)ldptr(kind == 0 ? I_EWG : I_EWU) + (size_t)le * 1024 * DFF; c.WT = (bf16_t*)(ws + WS_WE1) + (size_t)le * 768 * 1024; c.ksc = (const float*)ldptr(I_FNW) + L * 1024;
            kb = idx / 6; nb = idx % 6; const int n0 = nb * 64; c.drow0 = (n0 >> 7) * 256 + kind * 128 + (n0 & 127); }
        else { c.K = DFF; c.N = 1024; c.W = (const float*)ldptr(I_EWD) + (size_t)le * DFF * 1024; c.WT = (bf16_t*)(ws + WS_WE2) + (size_t)le * 1024 * DFF; c.ksc = nullptr; kb = idx / 16; nb = idx % 16; c.drow0 = nb * 64; }
        c.k0 = kb * 64; c.n0 = nb * 64;
    }
}
__device__ __forceinline__ void cvt_load(const CvtItem& c, f32x4 (&v)[16], int lane) {
    const float* p = c.W + (size_t)(c.k0 + (lane >> 4)) * c.N + c.n0 + 4 * (lane & 15);
#pragma unroll
    for (int i = 0; i < 16; ++i) v[i] = *(const f32x4*)(p + (size_t)(4 * i) * c.N);
}
__device__ __forceinline__ void cvt_lds_write(LAS float* tile, const f32x4 (&v)[16], int lane) {
#pragma unroll
    for (int i = 0; i < 16; ++i) { const int r = 4 * i + (lane >> 4), n = 4 * (lane & 15), x = r & 31; LAS float* row = tile + r * 64;
        row[(n + 0) ^ x] = v[i].x; row[(n + 1) ^ x] = v[i].y; row[(n + 2) ^ x] = v[i].z; row[(n + 3) ^ x] = v[i].w; }
}
__device__ __forceinline__ void cvt_out(const CvtItem& c, const LAS float* tile, int lane) {
    const int cc = lane & 7, np = lane >> 3;
    f32x4 s0 = {1.f, 1.f, 1.f, 1.f}, s1 = {1.f, 1.f, 1.f, 1.f};
    if (c.ksc) { s0 = *(const f32x4*)(c.ksc + c.k0 + 8 * cc); s1 = *(const f32x4*)(c.ksc + c.k0 + 8 * cc + 4); }
#pragma unroll
    for (int jj = 0; jj < 8; ++jj) { const int n = np + 8 * jj; float t[8];
#pragma unroll
        for (int q = 0; q < 8; ++q) { const int k = 8 * cc + q; t[q] = tile[k * 64 + (n ^ (k & 31))]; }
        u32x4 o; o.x = pk2(t[0] * s0.x, t[1] * s0.y); o.y = pk2(t[2] * s0.z, t[3] * s0.w); o.z = pk2(t[4] * s1.x, t[5] * s1.y); o.w = pk2(t[6] * s1.z, t[7] * s1.w);
        *(GAS u32x4*)(c.WT + (size_t)(c.drow0 + n) * c.K + c.k0 + 8 * cc) = o; }
}

constexpr int CVT_LAYER = NE * 288, CVT_W3 = 5120, CVT_WR = 2048, CVT_WG = 3072;
__host__ __device__ constexpr int cvt_layer_end(int Tl) { return CVT_MIX + (Tl + 1) * CVT_LAYER; }
__host__ __device__ constexpr int cvt_deferred(int Tl) { return CVT_WR + ((Tl & 1) ? CVT_WG : 0) + (Tl == 1 ? CVT_WR : 0) + CVT_W3; }
template <class Map>
__device__ __forceinline__ void cvt_loop(LAS unsigned char* lds, int count, int widx, int nw, int wave, int lane, Map map) {
    unsigned char* ws = ldptr(24);
    LAS float* tile = (LAS float*)(lds + wave * 16384);
    CvtItem cur, nxt; f32x4 v[16]; int it = widx;
    if (it < count) { cvt_decode(map(it), cur, ws); cvt_load(cur, v, lane); }
    while (it < count) {
        cvt_lds_write(tile, v, lane);
        const int itn = it + nw;
        if (itn < count) { cvt_decode(map(itn), nxt, ws); cvt_load(nxt, v, lane); }
        LDS_WAIT(); asm volatile("" ::: "memory");
        cvt_out(cur, tile, lane);
        LDS_WAIT(); asm volatile("" ::: "memory");
        cur = nxt; it = itn;
    }
}
__device__ __forceinline__ void cvt_window(LAS unsigned char* lds, int first, int count, int bx, int grid, int wave, int lane) {
    if (grid != 256 || bx < 128) return;
    cvt_loop(lds, count, (bx - 128) * NWAVES + wave, 128 * NWAVES, wave, lane, [first](int i) { return first + i; });
}
__device__ __forceinline__ void prologue_phase(LAS unsigned char* lds, int gw, int NGW, int wave, int lane, int gtid, int NGT, int grid) {
    unsigned char* ws = ldptr(24);
    {
        const int D1 = (grid == 256) ? cvt_deferred(1) : 0, D2 = (grid == 256) ? cvt_deferred(2) : 0, D3 = (grid == 256) ? cvt_deferred(3) : 0;
        const int s1 = cvt_layer_end(1) - D1, s2 = s1 + (cvt_layer_end(2) - D2 - cvt_layer_end(1));
        cvt_loop(lds, CVT_ITEMS - D1 - D2 - D3, gw, NGW, wave, lane, [=](int i) { return i < s1 ? i : (i < s2 ? i + D1 : i + D1 + D2); });
    }
    const float* fnw = (const float*)ldptr(I_FNW); const float* rwg = (const float*)ldptr(I_RWG); const float* rwe = (const float*)ldptr(I_RWE);
    for (int i = gtid; i < 4 * 256 * 128; i += NGT) {
        const int L = i >> 15, n = (i >> 7) & 255, k8 = (i & 127) * 8;
        u32x4 o = {0u, 0u, 0u, 0u};
        if (n < 72) { float v[8];
#pragma unroll
            for (int q = 0; q < 8; ++q) { const int k = k8 + q; const float g = fnw[L * 1024 + k];
                v[q] = g * (n < 8 ? rwg[((size_t)L * 1024 + k) * 8 + n] : rwe[((size_t)L * 1024 + k) * 64 + (n - 8)]); }
            o.x = pk2(v[0], v[1]); o.y = pk2(v[2], v[3]); o.z = pk2(v[4], v[5]); o.w = pk2(v[6], v[7]); }
        *(u32x4*)((bf16_t*)(ws + WS_WRT) + ((size_t)L * 256 + n) * 1024 + k8) = o;
    }
    for (int i = gtid; i < 2 * 64 * 128; i += NGT) { const int j = i >> 13, n = LAT + ((i >> 7) & 63), k8 = (i & 127) * 8;
        *(u32x4*)((bf16_t*)(ws + WS_WDOWN) + ((size_t)j * LATP + n) * 1024 + k8) = (u32x4){0u, 0u, 0u, 0u}; }
}

template <bool XF32_IN, bool F32_OUT>
__device__ __forceinline__ void resid_phase(const void* xin, const unsigned char* Y, void* xout, float* rinv, int gw, int NGW, int lane) {
    for (int m = gw; m < T; m += NGW) {
        f32x4 v[4];
        if constexpr (XF32_IN) { const f32x4* xr = (const f32x4*)((const float*)xin + (size_t)m * DM) + lane;
#pragma unroll
            for (int j = 0; j < 4; ++j) v[j] = xr[64 * j]; }
        else { const u32x2* xr = (const u32x2*)((const bf16_t*)xin + (size_t)m * DM) + lane;
#pragma unroll
            for (int j = 0; j < 4; ++j) { const u32x2 p = xr[64 * j]; v[j] = (f32x4){bflo(p.x), bfhi(p.x), bflo(p.y), bfhi(p.y)}; } }
        if (Y) { const unsigned* y0 = (const unsigned*)(Y + (size_t)(2 * m) * DM) + lane; const unsigned* y1 = y0 + 256;
#pragma unroll
            for (int j = 0; j < 4; ++j) { float p[4], q[4]; up4_fp8(y0[64 * j], p); up4_fp8(y1[64 * j], q);
                v[j].x += (p[0] + q[0]) * 0.0625f; v[j].y += (p[1] + q[1]) * 0.0625f; v[j].z += (p[2] + q[2]) * 0.0625f; v[j].w += (p[3] + q[3]) * 0.0625f; } }
        if constexpr (F32_OUT) { f32x4* xo = (f32x4*)((float*)xout + (size_t)m * DM) + lane;
#pragma unroll
            for (int j = 0; j < 4; ++j) xo[64 * j] = v[j]; }
        else { u32x2* xo = (u32x2*)((bf16_t*)xout + (size_t)m * DM) + lane;
#pragma unroll
            for (int j = 0; j < 4; ++j) { u32x2 w; w.x = pk2(v[j].x, v[j].y); w.y = pk2(v[j].z, v[j].w); xo[64 * j] = w; } }
        if (rinv) { float s = 0.f;
#pragma unroll
            for (int j = 0; j < 4; ++j) s += (v[j].x * v[j].x + v[j].y * v[j].y) + (v[j].z * v[j].z + v[j].w * v[j].w);
            const float r = 1.0f / sqrtf(wave_sum(s, lane) * (1.f / DM) + EPS);
            if (lane == 0) rinv[m] = r; }
    }
}

__device__ __forceinline__ void conv_phase(const bf16_t* GBp, const bf16_t* Zp, const float* ck, bf16_t* YCp, int gtid, int NGT) {
    for (int i = gtid; i < T * 128; i += NGT) {
        const int t = i >> 7, c8 = (i & 127) * 8, s = t & (SEQ - 1);
        const u32x4 zc = *(const u32x4*)(Zp + (size_t)t * DM + c8), g = *(const u32x4*)(GBp + (size_t)t * DM + c8);
        u32x4 zm = {0u, 0u, 0u, 0u}, zp = {0u, 0u, 0u, 0u};
        if (s > 0) zm = *(const u32x4*)(Zp + (size_t)(t - 1) * DM + c8);
        if (s < SEQ - 1) zp = *(const u32x4*)(Zp + (size_t)(t + 1) * DM + c8);
        const f32x4 k0a = *(const f32x4*)(ck + c8), k0b = *(const f32x4*)(ck + c8 + 4), k1a = *(const f32x4*)(ck + DM + c8), k1b = *(const f32x4*)(ck + DM + c8 + 4), k2a = *(const f32x4*)(ck + 2 * DM + c8), k2b = *(const f32x4*)(ck + 2 * DM + c8 + 4);
        float y[8];
#define CV(q, W, KA, LOHI) y[q] = LOHI(g.W) * (LOHI(zm.W) * k0##KA + LOHI(zc.W) * k1##KA + LOHI(zp.W) * k2##KA)
        CV(0, x, a[0], bflo); CV(1, x, a[1], bfhi); CV(2, y, a[2], bflo); CV(3, y, a[3], bfhi); CV(4, z, b[0], bflo); CV(5, z, b[1], bfhi); CV(6, w, b[2], bflo); CV(7, w, b[3], bfhi);
#undef CV
        u32x4 o; o.x = pk2(y[0], y[1]); o.y = pk2(y[2], y[3]); o.z = pk2(y[4], y[5]); o.w = pk2(y[6], y[7]);
        *(u32x4*)(YCp + (size_t)t * DM + c8) = o;
    }
}


__device__ __forceinline__ void ld16bf(const bf16_t* p, float* v) { const u32x4 a = *(const u32x4*)p, b = *(const u32x4*)(p + 8);
    v[0] = bflo(a.x); v[1] = bfhi(a.x); v[2] = bflo(a.y); v[3] = bfhi(a.y); v[4] = bflo(a.z); v[5] = bfhi(a.z); v[6] = bflo(a.w); v[7] = bfhi(a.w);
    v[8] = bflo(b.x); v[9] = bfhi(b.x); v[10] = bflo(b.y); v[11] = bfhi(b.y); v[12] = bflo(b.z); v[13] = bfhi(b.z); v[14] = bflo(b.w); v[15] = bfhi(b.w); }
__device__ __forceinline__ void ld16f8(const unsigned char* p, float* v) { const u32x4 a = *(const u32x4*)p; up4_fp8(a.x, v); up4_fp8(a.y, v + 4); up4_fp8(a.z, v + 8); up4_fp8(a.w, v + 12); }
__device__ __forceinline__ void ld4f8(const unsigned char* p, float* v) { up4_fp8(*(const unsigned*)p, v); }
__device__ __forceinline__ void ld4bf(const bf16_t* p, float* v) { const u32x2 a = *(const u32x2*)p; v[0] = bflo(a.x); v[1] = bfhi(a.x); v[2] = bflo(a.y); v[3] = bfhi(a.y); }
constexpr int QK_VP = 1040;
struct QkIn { u32x4 l0, l1, q16, k16, v16; u32x2 ra, rb; unsigned qa, qb; int pos; };
__device__ __forceinline__ void qk_load(QkIn& in, int t, const bf16_t* LATb, const unsigned char* QRAW, const unsigned char* KVRAW, const int* pos, int lane) {
    const int h = lane >> 3, i8 = lane & 7;
    const u32x4* ls = (const u32x4*)(LATb + (size_t)t * LATP);
    in.l0 = ls[lane]; in.l1 = (u32x4){0u, 0u, 0u, 0u}; if (lane < 24) in.l1 = ls[lane + 64];
    const unsigned char* qh = QRAW + (size_t)t * 1536 + h * DQK;
    in.q16 = *(const u32x4*)(qh + 16 * i8); in.qa = *(const unsigned*)(qh + 128 + 4 * i8); in.qb = *(const unsigned*)(qh + 160 + 4 * i8);
    const unsigned char* kh = KVRAW + (size_t)t * 2048 + h * 256;
    in.k16 = *(const u32x4*)(kh + 16 * i8); in.v16 = *(const u32x4*)(kh + 128 + 16 * i8);
    const bf16_t* lr = LATb + (size_t)t * LATP + 640;
    in.ra = *(const u32x2*)(lr + 4 * i8); in.rb = *(const u32x2*)(lr + 32 + 4 * i8);
    in.pos = pos[t];
}
__device__ __forceinline__ void up16_fp8(const u32x4 a, float* v) { up4_fp8(a.x, v); up4_fp8(a.y, v + 4); up4_fp8(a.z, v + 8); up4_fp8(a.w, v + 12); }
__device__ __forceinline__ void up4_bf(const u32x2 a, float* v) { v[0] = bflo(a.x); v[1] = bfhi(a.x); v[2] = bflo(a.y); v[3] = bfhi(a.y); }
__device__ __forceinline__ void qkprep8_phase(const bf16_t* LATb, const unsigned char* QRAW, const unsigned char* KVRAW, const int* pos, const float* qhn, const float* khn,
                                              unsigned char* Q8, unsigned char* K8, unsigned char* VT8, LAS unsigned char* lds, int vcu, int G, int wave, int lane, int tid) {
    const int h = lane >> 3, i8 = lane & 7;
    float gq[24], gk[24], invf[4];
#pragma unroll
    for (int q = 0; q < 16; ++q) { gq[q] = qhn[16 * i8 + q]; gk[q] = khn[16 * i8 + q]; }
#pragma unroll
    for (int q = 0; q < 4; ++q) { gq[16 + q] = qhn[128 + 4 * i8 + q]; gq[20 + q] = qhn[160 + 4 * i8 + q]; gk[16 + q] = khn[128 + 4 * i8 + q]; gk[20 + q] = khn[160 + 4 * i8 + q];
        invf[q] = powf(10000.f, -(float)(4 * i8 + q) * (1.f / 32.f)); }
    QkIn cur, nxt;
    if (vcu < T / 64) qk_load(cur, vcu * 64 + wave * 8, LATb, QRAW, KVRAW, pos, lane);
    for (int tile = vcu; tile < T / 64; tile += G) {
        for (int tt = 0; tt < 8; ++tt) {
            const int kk = wave * 8 + tt, t = tile * 64 + kk, b = t >> 14, s = t & (SEQ - 1);
            { const int tn = (tt < 7) ? t + 1 : (tile + G) * 64 + wave * 8; if (tn < T) qk_load(nxt, tn, LATb, QRAW, KVRAW, pos, lane); }
            const u32x4 l0 = cur.l0, l1 = cur.l1;
#define SS4(V_) (bflo(V_.x) * bflo(V_.x) + bfhi(V_.x) * bfhi(V_.x) + bflo(V_.y) * bflo(V_.y) + bfhi(V_.y) * bfhi(V_.y) + bflo(V_.z) * bflo(V_.z) + bfhi(V_.z) * bfhi(V_.z) + bflo(V_.w) * bflo(V_.w) + bfhi(V_.w) * bfhi(V_.w))
            const float s0 = SS4(l0), s1 = SS4(l1);
#undef SS4
            const float ssq_q = wave_sum(lane < 48 ? s0 : 0.f, lane), ssq_kv = wave_sum((lane >= 48 ? s0 : 0.f) + (lane < 16 ? s1 : 0.f), lane);
            const float r_q = __builtin_amdgcn_rsqf(ssq_q * (1.f / QLR) + EPS), r_kv = __builtin_amdgcn_rsqf(ssq_kv * (1.f / KVLR) + EPS);
            float cj[4], sj[4]; const float fpos = (float)cur.pos;
#pragma unroll
            for (int q = 0; q < 4; ++q) { const float ang = fpos * invf[q]; const double rev = (double)ang * 0.15915494309189535; const float fr = (float)(rev - floor(rev));
                cj[q] = __builtin_amdgcn_cosf(fr); sj[q] = __builtin_amdgcn_sinf(fr); }
            const size_t orow = ((size_t)(b * NH + h) * SEQ + s) * DQK;
            {
                float v[24];
                up16_fp8(cur.q16, v); up4_fp8(cur.qa, v + 16); up4_fp8(cur.qb, v + 20);
                float ss = 0.f;
#pragma unroll
                for (int q = 0; q < 24; ++q) ss += v[q] * v[q];
                ss += lane_xor_f(ss, 1, lane); ss += lane_xor_f(ss, 2, lane); ss += lane_xor_f(ss, 4, lane);
                const float sc = r_q * __builtin_amdgcn_rsqf(r_q * r_q * ss * (1.f / DQK) + EPS) * (8.f * 0.07216878364870322f * 1.4426950408889634f);
#pragma unroll
                for (int q = 0; q < 24; ++q) v[q] *= sc * gq[q];
                u32x4 w; w.x = pk4_fp8(v[0], v[1], v[2], v[3]); w.y = pk4_fp8(v[4], v[5], v[6], v[7]); w.z = pk4_fp8(v[8], v[9], v[10], v[11]); w.w = pk4_fp8(v[12], v[13], v[14], v[15]);
                *(u32x4*)(Q8 + orow + 16 * i8) = w;
                float o1[4], o2[4];
#pragma unroll
                for (int q = 0; q < 4; ++q) { o1[q] = v[16 + q] * cj[q] - v[20 + q] * sj[q]; o2[q] = v[20 + q] * cj[q] + v[16 + q] * sj[q]; }
                *(unsigned*)(Q8 + orow + 128 + 4 * i8) = pk4_fp8(o1[0], o1[1], o1[2], o1[3]); *(unsigned*)(Q8 + orow + 160 + 4 * i8) = pk4_fp8(o2[0], o2[1], o2[2], o2[3]); }
            {
                float v[24], vv[16];
                up16_fp8(cur.k16, v); up4_bf(cur.ra, v + 16); up4_bf(cur.rb, v + 20); up16_fp8(cur.v16, vv);
#pragma unroll
                for (int q = 0; q < 16; ++q) v[q] *= r_kv;
                float ss = 0.f;
#pragma unroll
                for (int q = 0; q < 24; ++q) ss += v[q] * v[q];
                ss += lane_xor_f(ss, 1, lane); ss += lane_xor_f(ss, 2, lane); ss += lane_xor_f(ss, 4, lane);
                const float sc = __builtin_amdgcn_rsqf(ss * (1.f / DQK) + EPS);
#pragma unroll
                for (int q = 0; q < 24; ++q) v[q] *= sc * gk[q];
                u32x4 w; w.x = pk4_fp8(v[0], v[1], v[2], v[3]); w.y = pk4_fp8(v[4], v[5], v[6], v[7]); w.z = pk4_fp8(v[8], v[9], v[10], v[11]); w.w = pk4_fp8(v[12], v[13], v[14], v[15]);
                *(u32x4*)(K8 + orow + 16 * i8) = w;
                float o1[4], o2[4];
#pragma unroll
                for (int q = 0; q < 4; ++q) { o1[q] = v[16 + q] * cj[q] - v[20 + q] * sj[q]; o2[q] = v[20 + q] * cj[q] + v[16 + q] * sj[q]; }
                *(unsigned*)(K8 + orow + 128 + 4 * i8) = pk4_fp8(o1[0], o1[1], o1[2], o1[3]); *(unsigned*)(K8 + orow + 160 + 4 * i8) = pk4_fp8(o2[0], o2[1], o2[2], o2[3]);
                u32x4 wv; wv.x = pk4_fp8(vv[0] * r_kv, vv[1] * r_kv, vv[2] * r_kv, vv[3] * r_kv); wv.y = pk4_fp8(vv[4] * r_kv, vv[5] * r_kv, vv[6] * r_kv, vv[7] * r_kv);
                wv.z = pk4_fp8(vv[8] * r_kv, vv[9] * r_kv, vv[10] * r_kv, vv[11] * r_kv); wv.w = pk4_fp8(vv[12] * r_kv, vv[13] * r_kv, vv[14] * r_kv, vv[15] * r_kv);
                *(LAS u32x4*)(lds + kk * QK_VP + h * 128 + 16 * i8) = wv; }
            cur = nxt;
        }
        __syncthreads();
        {
            const int t0 = tile * 64, b = t0 >> 14, st = (t0 & (SEQ - 1)) >> 6;
#pragma unroll
            for (int it = 0; it < 2; ++it) { const int item = tid + 512 * it, c = item & 3, n4 = (item >> 2) & 31, hh = item >> 7;
                const LAS unsigned char* src = lds + hh * 128 + n4 * 4; unsigned o[4][4];
#pragma unroll
                for (int j = 0; j < 4; ++j) { const int kb = 32 * (c & 1) + 8 * j + 4 * (c >> 1);
                    const unsigned d0 = *(const LAS unsigned*)(src + (kb + 0) * QK_VP), d1 = *(const LAS unsigned*)(src + (kb + 1) * QK_VP), d2 = *(const LAS unsigned*)(src + (kb + 2) * QK_VP), d3 = *(const LAS unsigned*)(src + (kb + 3) * QK_VP);
                    const unsigned t0_ = __builtin_amdgcn_perm(d1, d0, 0x05010400u), t1_ = __builtin_amdgcn_perm(d1, d0, 0x07030602u), t2_ = __builtin_amdgcn_perm(d3, d2, 0x05010400u), t3_ = __builtin_amdgcn_perm(d3, d2, 0x07030602u);
                    o[0][j] = __builtin_amdgcn_perm(t2_, t0_, 0x05040100u); o[1][j] = __builtin_amdgcn_perm(t2_, t0_, 0x07060302u); o[2][j] = __builtin_amdgcn_perm(t3_, t1_, 0x05040100u); o[3][j] = __builtin_amdgcn_perm(t3_, t1_, 0x07060302u); }
                unsigned char* dst = VT8 + ((size_t)(b * NH + hh) * (SEQ / 64) + st) * 8192 + (4 * n4) * 64 + 16 * c;
#pragma unroll
                for (int r = 0; r < 4; ++r) *(u32x4*)(dst + r * 64) = (u32x4){o[r][0], o[r][1], o[r][2], o[r][3]}; } }
        __syncthreads();
    }
}

__device__ __forceinline__ int build_tables(gu32* cnt, LAS int* tbl, LAS int* cntl, int tid) {
    if (tid < 64) {
        const int c = (int)__hip_atomic_load(cnt + 32 * tid, RLX_AGENT); const int nt = (c + 255) >> 8;
        int incl = nt;
#pragma unroll
        for (int o = 1; o < 64; o <<= 1) { const int v = __builtin_amdgcn_ds_bpermute((tid - o) << 2, incl); if (tid >= o) incl += v; }
        const int start = incl - nt; cntl[tid] = c; if (tid == 63) cntl[64] = incl;
        for (int q = 0; q < nt; ++q) tbl[start + q] = (tid << 16) | q;
    }
    __syncthreads();
    return cntl[64];
}

constexpr int PTAB_OFF = MISC_OFF + 128;
__device__ __forceinline__ unsigned char* ldptr(int i) {
    extern __shared__ __attribute__((aligned(16))) unsigned char lds_raw[];
    volatile LAS unsigned* pt = (volatile LAS unsigned*)((LAS unsigned char*)lds_raw + PTAB_OFF) + 2 * sgpr_now(i);
    const unsigned lo = __builtin_amdgcn_readfirstlane(pt[0]), hi = __builtin_amdgcn_readfirstlane(pt[1]);
    return (unsigned char*)(GAS unsigned char*)(((unsigned long long)hi << 32) | lo);
}
#define P_IN(i) ((const float*)ldptr(i))
#define P_OUT() ((float*)ldptr(23))
#define P_WS() (ldptr(24))
__device__ __forceinline__ void grid_barrier(int tid) {
    extern __shared__ __attribute__((aligned(16))) unsigned char lds_raw[];
    XcdBarrier b; b.bar = (unsigned*)(P_WS() + WS_CTL) + CW_BAR; b.x = xb_xcc_id(); b.st = (volatile LAS unsigned*)((LAS unsigned char*)lds_raw + MISC_OFF) + 8;
    xcd_barrier(b, tid == 0);
}

#define IN(k) (lo <= (k) && (k) < hi)
#define SEAM(k) do { if (hi > (k) + 1) grid_barrier(TID); } while (0)
#define TID (tid_now(wave_s))
#define LANE (tid_now(wave_s) & 63)
#define WAVE (sgpr_now(wave_s))
#define GRID (sgpr_now((int)gridDim.x))
#define BX (sgpr_now((int)blockIdx.x))
#define VCU ((GRID % 8 == 0) ? (BX % 8) * (GRID / 8) + BX / 8 : BX)
#define GW (VCU * NWAVES + WAVE)
#define NGW (GRID * NWAVES)
#define GTID (BX * (NWAVES * 64) + TID)
#define NGT (GRID * NWAVES * 64)
#define TBL ((LAS int*)(lds + TBL_OFF))
#define PSTART (TBL + 384)


template <int L>
__device__ __forceinline__ void layer_body(LAS unsigned char* lds, const int lo, const int hi, const int wave_s) {
    extern __shared__ __attribute__((aligned(16))) unsigned char lds_raw[];
        const int pb = 1 + 12 * L;
#define XBP ((bf16_t*)(ws + WS_XB))
#define RINVP ((float*)(ws + WS_RINV))
#define PSQP ((float*)(ws + WS_PSQ))
#define YP ((const unsigned char*)(ws + WS_Y))
        if (IN(pb + 0)) { unsigned char* ws = P_WS();
            if (L == 0) resid_phase<true, false>(P_IN(I_X), nullptr, XBP, RINVP, GW, NGW, LANE);
            else resid_phase<false, false>(XBP, YP, XBP, RINVP, GW, NGW, LANE);
            SEAM(pb + 0); }
        if ((L & 1) == 0) {
            if (IN(pb + 1)) { unsigned char* ws = P_WS(); const int j = L >> 1;
                pg8::Gemm g{DM, DM, nullptr}; pg8::StaticOrder S; S.init(ws + WS_XB, DM, (bf16_t*)(ws + WS_WIN) + (size_t)j * 3072 * 1024, DM, T, 3072, GRID, BX);
                pg8::EpiConvIn E{(bf16_t*)(ws + WS_GB), (bf16_t*)(ws + WS_Z), RINVP}; pg8::gemm_phase(lds, g, S, E, TID); SEAM(pb + 1); }
            if (IN(pb + 2)) { unsigned char* ws = P_WS(); const int j = L >> 1;
                conv_phase((const bf16_t*)(ws + WS_GB), (const bf16_t*)(ws + WS_Z), P_IN(I_CK) + j * 3 * DM, (bf16_t*)(ws + WS_YC), GTID, NGT); SEAM(pb + 2); }
            if (IN(pb + 3)) { unsigned char* ws = P_WS(); const int j = L >> 1;
                pg8::Gemm g{DM, DM, nullptr}; pg8::StaticOrder S; S.init(ws + WS_YC, DM, (bf16_t*)(ws + WS_WOUTC) + (size_t)j * 1024 * 1024, DM, T, DM, GRID, BX);
                pg8::EpiResid E{XBP, PSQP, LANE}; pg8::gemm_phase(lds, g, S, E, TID); SEAM(pb + 5); }
        } else {
            if (IN(pb + 1)) { unsigned char* ws = P_WS(); const int j = L >> 1;
                pg8::Gemm g{DM, DM, nullptr}; pg8::StaticOrder S; S.init(ws + WS_XB, DM, (bf16_t*)(ws + WS_WDOWN) + (size_t)j * LATP * 1024, DM, T, LATP, GRID, BX);
                pg8::EpiBf16 E{(bf16_t*)(ws + WS_LAT), LATP, RINVP}; pg8::gemm_phase(lds, g, S, E, TID);
                cvt_window(lds, cvt_layer_end(L) - CVT_WR - CVT_WG, CVT_WG, BX, GRID, WAVE, LANE);
                SEAM(pb + 1); }
            if (IN(pb + 2)) {
                { unsigned char* ws = P_WS(); const int j = L >> 1;
                  pg8::Gemm g{LATP, QLR, nullptr}; pg8::StaticOrder S; S.init(ws + WS_LAT, LATP, ws + WS_WQ + (size_t)j * 1536 * 1024, QLR, T, 1536, GRID, BX);
                  pg8::EpiFp8 E{ws + WS_QRAW, 1536}; pg8::gemm_phase(lds, g, S, E, TID); }
                { unsigned char* ws = P_WS(); const int j = L >> 1;
                  pg8::Gemm g{LATP, KVLR, nullptr}; pg8::StaticOrder S; S.init((bf16_t*)(ws + WS_LAT) + QLR, LATP, (bf16_t*)(ws + WS_WKV) + (size_t)j * 2048 * 256, KVLR, T, 2048, GRID, BX);
                  pg8::EpiFp8 E{ws + WS_KVRAW, 2048}; pg8::gemm_phase(lds, g, S, E, TID); }
                SEAM(pb + 2); }
            if (IN(pb + 3)) { unsigned char* ws = P_WS(); const int j = L >> 1;
                qkprep8_phase((const bf16_t*)(ws + WS_LAT), ws + WS_QRAW, ws + WS_KVRAW, (const int*)P_IN(I_POS),
                              P_IN(I_MQHN) + j * DQK, P_IN(I_MKHN) + j * DQK, ws + WS_Q, ws + WS_K, ws + WS_V, lds, VCU, GRID, WAVE, LANE, TID); SEAM(pb + 3); }
            if (IN(pb + 4)) {
                for (int i = 0;; ++i) {
                    int bh, qb;
                    if (GRID == 256) { if (i >= 4) break; const int idx = i * 32 + (VCU & 31); bh = 2 * (VCU >> 5) + (idx >> 6); qb = idx & 63; }
                    else { const int k = i * GRID + BX; if (k >= NB * NH * 64) break; bh = k >> 6; qb = k & 63; }
                    const int b = bh >> 3, h = bh & 7; unsigned char* ws = P_WS();
                    att8::attn_unit_pp(ws + WS_Q + ((size_t)bh * SEQ + qb * 256) * DQK, ws + WS_K + (size_t)bh * SEQ * DQK, ws + WS_V + (size_t)bh * SEQ * DV,
                                       (bf16_t*)(ws + WS_O) + ((size_t)(b * SEQ + qb * 256)) * DM + h * DV, (char*)lds_raw, TID);
                }
                SEAM(pb + 4); }
            if (IN(pb + 5)) { unsigned char* ws = P_WS(); const int j = L >> 1;
                pg8::Gemm g{DM, DM, nullptr}; pg8::StaticOrder S; S.init(ws + WS_O, DM, (bf16_t*)(ws + WS_WO) + (size_t)j * 1024 * 1024, DM, T, DM, GRID, BX);
                pg8::EpiResid E{XBP, PSQP, LANE}; pg8::gemm_phase(lds, g, S, E, TID); SEAM(pb + 5); }
        }
#define CNT ((gu32*)(ws + WS_CTL) + CW_CNT + L * 64 * 32)
        if (IN(pb + 7)) { unsigned char* ws = P_WS();
            pg8::Gemm g{DM, DM, nullptr}; pg8::StaticOrder S; S.init(ws + WS_XB, DM, (bf16_t*)(ws + WS_WRT) + (size_t)L * 256 * 1024, DM, T, 256, GRID, BX);
            { pg8::Unit u0; const int t_ = TID;
              if (S.next(0, u0) && t_ < 256) { const f32x4* q = (const f32x4*)(PSQP + (size_t)(u0.pm * 256 + t_) * 16); const f32x4 a = q[0], b = q[1], c = q[2], d = q[3];
                  const float ssum = ((a.x + a.y) + (a.z + a.w)) + ((b.x + b.y) + (b.z + b.w)) + ((c.x + c.y) + (c.z + c.w)) + ((d.x + d.y) + (d.z + d.w));
                  RINVP[u0.pm * 256 + t_] = 1.0f / sqrtf(ssum * (1.f / DM) + EPS); }
              VM_WAIT(); __syncthreads(); }
            pg8::EpiRoute E{RINVP, P_IN(I_RBG) + L * 8, P_IN(I_RBE) + L * 64, CNT, (int*)(ws + WS_SA), (float*)(ws + WS_SG), (float*)(ws + WS_SS)};
            pg8::gemm_phase<false, true>(lds, g, S, E, TID);
            cvt_window(lds, cvt_layer_end(L == 0 ? 1 : L) - (L == 0 ? 2 * CVT_WR + CVT_WG : CVT_WR), CVT_WR, BX, GRID, WAVE, LANE);
            SEAM(pb + 9); }
        if (IN(pb + 10)) { unsigned char* ws = P_WS(); const int ntiles = build_tables(CNT, TBL, PSTART, TID);
            pg8::Gemm g{DM, DM, (const int*)(ws + WS_SA)}; pg8::GroupedOrder S{ntiles * 3, 3, GRID, VCU, (const char*)(ws + WS_XB), (const char*)(ws + WS_WE1) + (size_t)L * NE * 768 * 1024 * 2, (size_t)0, (size_t)768 * 1024 * 2, (size_t)256 * 1024 * 2, TBL, PSTART};
            pg8::EpiSwiGLU E{(bf16_t*)(ws + WS_HID), (const float*)(ws + WS_SS)}; pg8::gemm_phase<true, false>(lds, g, S, E, TID);
            if (L < 3 && GRID == 256) {
                const int n_units = ntiles * 3, rounds = (n_units + 255) >> 8, nidle = rounds * 256 - n_units, first = cvt_layer_end(L + 1) - cvt_deferred(L + 1);
                if (nidle >= 32) { const int j = (rounds - 1) * 256 + VCU - n_units; if (j >= 0) cvt_loop(lds, CVT_W3, j * NWAVES + WAVE, nidle * NWAVES, WAVE, LANE, [first](int i) { return first + i; }); }
                else cvt_loop(lds, CVT_W3, VCU * NWAVES + WAVE, 256 * NWAVES, WAVE, LANE, [first](int i) { return first + i; });
            }
            SEAM(pb + 10); }
        if (IN(pb + 11)) { unsigned char* ws = P_WS(); const int ntiles = build_tables(CNT, TBL, PSTART, TID);
            pg8::Gemm g{DFF, DFF, nullptr}; pg8::GroupedOrder S{ntiles * 4, 4, GRID, VCU, (const char*)(ws + WS_HID), (const char*)(ws + WS_WE2) + (size_t)L * NE * 1024 * DFF * 2, (size_t)256 * DFF * 2, (size_t)1024 * DFF * 2, (size_t)256 * DFF * 2, TBL, PSTART};
            pg8::EpiScatterY E{ws + WS_Y, (const int*)(ws + WS_SA), (const float*)(ws + WS_SG)}; pg8::gemm_phase(lds, g, S, E, TID); SEAM(pb + 11); }
    }

__global__ void __launch_bounds__(NWAVES * 64, 2) fwd(Args args) {
    extern __shared__ __attribute__((aligned(16))) unsigned char lds_raw[];
    LAS unsigned char* lds = (LAS unsigned char*)lds_raw;
    for (int u = threadIdx.x; u < (LDS_BYTES - LDSCTL_OFF) / 4; u += NWAVES * 64) ((LAS unsigned*)(lds + LDSCTL_OFF))[u] = 0u;
    __syncthreads();
    if (threadIdx.x == 0) { LAS unsigned long long* pt = (LAS unsigned long long*)(lds + PTAB_OFF);
#pragma unroll
        for (int i = 0; i < 23; ++i) pt[i] = (unsigned long long)args.in[i];
        pt[23] = (unsigned long long)args.out; pt[24] = (unsigned long long)args.ws; }
    __syncthreads();
    const int lo = args.ph_lo, hi = args.ph_hi;
    if (hi - lo > 1) (void)xcd_barrier_post((unsigned*)(P_WS() + WS_CTL) + CW_BAR, (volatile LAS unsigned*)(lds + MISC_OFF) + 8, threadIdx.x == 0);
    const int wave_s = __builtin_amdgcn_readfirstlane((int)threadIdx.x >> 6);
    if (IN(0)) { prologue_phase(lds, GW, NGW, WAVE, LANE, GTID, NGT, GRID); SEAM(0); }

    layer_body<0>(lds, lo, hi, wave_s); layer_body<1>(lds, lo, hi, wave_s); layer_body<2>(lds, lo, hi, wave_s); layer_body<3>(lds, lo, hi, wave_s);
    if (IN(49)) { unsigned char* ws = P_WS(); resid_phase<false, true>(XBP, YP, P_OUT(), nullptr, GW, NGW, LANE);
    }
#undef IN
#undef SEAM
}

extern "C" void kernel_launch(void* const* d_in, const int* in_sizes, int n_in, void* d_out, int out_size, void* d_ws, size_t ws_size, hipStream_t stream) {
    static int grid = 0;
    if (grid == 0) {
        if (n_in != 23 || out_size != T * DM || ws_size < WS_END) { fprintf(stderr, "kernel_launch: unexpected shapes: n_in %d out %d ws %zu (need %zu)\n", n_in, out_size, ws_size, (size_t)WS_END); grid = -1; return; }
        int dev = 0, cus = 0, per_cu = 0;
        if (hipGetDevice(&dev) != hipSuccess || hipDeviceGetAttribute(&cus, hipDeviceAttributeMultiprocessorCount, dev) != hipSuccess) { grid = -1; return; }
        if (hipFuncSetAttribute((const void*)fwd, hipFuncAttributeMaxDynamicSharedMemorySize, LDS_BYTES) != hipSuccess) { fprintf(stderr, "kernel_launch: hipFuncSetAttribute failed\n"); grid = -1; return; }
        if (hipOccupancyMaxActiveBlocksPerMultiprocessor(&per_cu, (const void*)fwd, NWAVES * 64, LDS_BYTES) != hipSuccess || per_cu < 1) fprintf(stderr, "kernel_launch: occupancy query says %d\n", per_cu);
        (void)hipGetLastError();
        grid = cus;
    }
    if (grid < 0) return;
    if (hipMemsetAsync((char*)d_ws + WS_CTL, 0, CTL_ZERO_BYTES, stream) != hipSuccess) return;
    Args a{};
    for (int i = 0; i < 23; ++i) a.in[i] = d_in[i];
    a.out = (float*)d_out; a.ws = (unsigned char*)d_ws;
#if MK_ONE_LAUNCH
    a.ph_lo = 0; a.ph_hi = 50;
    hipLaunchKernelGGL(fwd, dim3(grid), dim3(NWAVES * 64), LDS_BYTES, stream, a);
#else
    for (int p = 0; p < 50; ++p) {
        if (p >= 1 && p < 49) { const int L = (p - 1) / 12, k = (p - 1) % 12;
            if (k == 6 || k == 8 || k == 9) continue;
            if (k < 6 && (L & 1) == 0 && k > 3) continue;
        }
        a.ph_lo = p; a.ph_hi = p + 1;
        hipLaunchKernelGGL(fwd, dim3(grid), dim3(NWAVES * 64), LDS_BYTES, stream, a);
    }
#endif
    const hipError_t le = hipPeekAtLastError();
    if (le != hipSuccess) fprintf(stderr, "kernel_launch: launch failed: %s\n", hipGetErrorName(le));
}
```
